# Optimizing an MI355X kernel written in HIP

```python
import math
import jax, jax.numpy as jnp
from jax import lax
import numpy as np

D_MODEL = 1024
BATCH = 8
SEQ = 2048
DEPTH = 1

D_MIX = D_MODEL
D_ATTN = D_MIX // 2
HEAD_DIM = 64
N_HEADS = D_ATTN // HEAD_DIM
N_KV_HEADS = 2
Q_PER_KV = N_HEADS // N_KV_HEADS
D_KV = N_KV_HEADS * HEAD_DIM
WINDOW = 128
BLOCK = 128
D_SSM = D_MIX - D_ATTN
SSM_GROUP = 16
N_SSM_GROUPS = D_SSM // SSM_GROUP
STATE = 64
D_IN = D_ATTN + 2 * D_KV + D_SSM
N_EXPERTS = 32
TOP_K = 4
D_FF = D_MODEL
SWIGLU_LIMIT = 7.0
SWIGLU_ALPHA = 1.702
EPS = 1e-6
NEG_INF = -1e30

kernel_name = "hybrid_swa_s5_moe_adaln_block"


def rmsnorm(x, gain):
    x32 = x.astype(jnp.float32)
    y = x32 * lax.rsqrt(jnp.mean(x32 * x32, axis=-1, keepdims=True) + EPS)
    return (y * gain.astype(jnp.float32)).astype(x.dtype)


def sliding_window_attention(q, k, v, sinks):
    B, S = q.shape[0], q.shape[1]
    nb = S // BLOCK
    qb = q.reshape(B, nb, BLOCK, N_KV_HEADS, Q_PER_KV, HEAD_DIM)
    pad = ((0, 0), (BLOCK, 0), (0, 0), (0, 0))
    kp = jnp.pad(k, pad).reshape(B, nb + 1, BLOCK, N_KV_HEADS, HEAD_DIM)
    vp = jnp.pad(v, pad).reshape(B, nb + 1, BLOCK, N_KV_HEADS, HEAD_DIM)
    kw = jnp.concatenate([kp[:, :-1], kp[:, 1:]], axis=2)
    vw = jnp.concatenate([vp[:, :-1], vp[:, 1:]], axis=2)
    scores = jnp.einsum('bnqhgd,bnkhd->bnhgqk', qb, kw).astype(jnp.float32)
    scores = scores * (1.0 / math.sqrt(HEAD_DIM))
    qi = jnp.arange(BLOCK)[:, None]
    kj = jnp.arange(2 * BLOCK)[None, :]
    diff = BLOCK + qi - kj
    band = (diff >= 0) & (diff < WINDOW)
    kpos = jnp.arange(nb)[:, None, None] * BLOCK - BLOCK + kj[None]
    mask = band[None] & (kpos >= 0)
    scores = jnp.where(mask[None, :, None, None], scores, NEG_INF)
    sink = sinks.astype(jnp.float32).reshape(N_KV_HEADS, Q_PER_KV)
    sink = jnp.broadcast_to(sink[None, None, :, :, None, None],
                            scores.shape[:-1] + (1,))
    probs = jax.nn.softmax(jnp.concatenate([scores, sink], axis=-1), axis=-1)[..., :-1]
    out = jnp.einsum('bnhgqk,bnkhd->bnqhgd', probs.astype(v.dtype), vw)
    return out.reshape(B, S, D_ATTN)


def _complex_affine_combine(e1, e2):
    a1r, a1i, b1r, b1i = e1
    a2r, a2i, b2r, b2i = e2
    ar = a2r * a1r - a2i * a1i
    ai = a2r * a1i + a2i * a1r
    br = a2r * b1r - a2i * b1i + b2r
    bi = a2r * b1i + a2i * b1r + b2i
    return (ar, ai, br, bi)


def s5_ssm(u, lam_re, lam_im, log_dt, b_re, b_im, c_re, c_im, d_skip):
    B, S = u.shape[0], u.shape[1]
    ug = u.astype(jnp.float32).reshape(B, S, N_SSM_GROUPS, SSM_GROUP)
    lr = lam_re.astype(jnp.float32)
    li = lam_im.astype(jnp.float32)
    dt = jnp.exp(log_dt.astype(jnp.float32))[:, None]
    mag = jnp.exp(lr * dt)
    lb_r = mag * jnp.cos(li * dt)
    lb_i = mag * jnp.sin(li * dt)
    den = lr * lr + li * li
    coef_r = ((lb_r - 1.0) * lr + lb_i * li) / den
    coef_i = (lb_i * lr - (lb_r - 1.0) * li) / den
    br = b_re.astype(jnp.float32)
    bi = b_im.astype(jnp.float32)
    bbar_r = coef_r[..., None] * br - coef_i[..., None] * bi
    bbar_i = coef_r[..., None] * bi + coef_i[..., None] * br
    bu_r = jnp.einsum('bsgh,gph->bsgp', ug, bbar_r)
    bu_i = jnp.einsum('bsgh,gph->bsgp', ug, bbar_i)
    a_r = jnp.broadcast_to(lb_r, bu_r.shape)
    a_i = jnp.broadcast_to(lb_i, bu_i.shape)
    _, _, x_r, x_i = lax.associative_scan(_complex_affine_combine,
                                          (a_r, a_i, bu_r, bu_i), axis=1)
    y = (jnp.einsum('bsgp,ghp->bsgh', x_r, c_re.astype(jnp.float32))
         - jnp.einsum('bsgp,ghp->bsgh', x_i, c_im.astype(jnp.float32)))
    y = y + d_skip.astype(jnp.float32).reshape(N_SSM_GROUPS, SSM_GROUP) * ug
    return y.reshape(B, S, D_SSM).astype(u.dtype)


def moe_ffn(h, w_router, b_router, w_gate_up, b_gate_up, w_down, b_down):
    B, S, D = h.shape
    T = B * S
    ht = h.reshape(T, D)
    logits = (ht @ w_router + b_router).astype(jnp.float32)
    top_val, top_idx = lax.top_k(logits, TOP_K)
    weights = jax.nn.softmax(top_val, axis=-1)
    flat_e = top_idx.reshape(-1)
    order = jnp.argsort(flat_e)
    tok = order // TOP_K
    e_sorted = flat_e[order]
    sizes = jnp.bincount(flat_e, length=N_EXPERTS).astype(jnp.int32)
    xs = ht[tok]
    gu = lax.ragged_dot(xs, w_gate_up, sizes) + b_gate_up[e_sorted]
    gate = jnp.minimum(gu[:, ::2], SWIGLU_LIMIT)
    up = jnp.clip(gu[:, 1::2], -SWIGLU_LIMIT, SWIGLU_LIMIT)
    act = (up + 1.0) * (gate * jax.nn.sigmoid(SWIGLU_ALPHA * gate))
    ys = lax.ragged_dot(act, w_down, sizes) + b_down[e_sorted]
    ys = ys * weights.reshape(-1)[order][:, None].astype(ys.dtype)
    out = jnp.zeros((T, D), ys.dtype).at[tok].add(ys)
    return out.reshape(B, S, D)


def setup_inputs(seed: int = 0) -> dict:
    key = jax.random.key(seed)
    ks = jax.random.split(key, 32)
    L = DEPTH

    def nrm(k, shape, scale):
        return jax.random.normal(k, shape, jnp.float32) * scale

    def gain(k, shape):
        return 1.0 + nrm(k, shape, 0.02)

    lam_im0 = jnp.pi * jnp.arange(STATE, dtype=jnp.float32)
    return {
        "x": nrm(ks[0], (BATCH, SEQ, D_MODEL), 1.0),
        "c": nrm(ks[1], (BATCH, D_MODEL), 1.0),
        "w_ada": nrm(ks[2], (L, D_MODEL, 6 * D_MODEL), 0.5 * D_MODEL ** -0.5),
        "b_ada": nrm(ks[3], (L, 6 * D_MODEL), 0.02),
        "norm_mix": gain(ks[4], (L, D_MODEL)),
        "w_in": nrm(ks[5], (L, D_MODEL, D_IN), D_MODEL ** -0.5),
        "b_in": nrm(ks[6], (L, D_IN), 0.02),
        "q_norm": gain(ks[7], (L, HEAD_DIM)),
        "k_norm": gain(ks[8], (L, HEAD_DIM)),
        "sinks": nrm(ks[9], (L, N_HEADS), 0.5),
        "lam_re": -0.5 + nrm(ks[10], (L, N_SSM_GROUPS, STATE), 0.01),
        "lam_im": lam_im0 + nrm(ks[11], (L, N_SSM_GROUPS, STATE), 0.01),
        "log_dt": jax.random.uniform(ks[12], (L, N_SSM_GROUPS), jnp.float32,
                                     minval=math.log(1e-3), maxval=math.log(1e-1)),
        "b_re": nrm(ks[13], (L, N_SSM_GROUPS, STATE, SSM_GROUP), (2 * SSM_GROUP) ** -0.5),
        "b_im": nrm(ks[14], (L, N_SSM_GROUPS, STATE, SSM_GROUP), (2 * SSM_GROUP) ** -0.5),
        "c_re": nrm(ks[15], (L, N_SSM_GROUPS, SSM_GROUP, STATE), (2 * STATE) ** -0.5),
        "c_im": nrm(ks[16], (L, N_SSM_GROUPS, SSM_GROUP, STATE), (2 * STATE) ** -0.5),
        "d_skip": nrm(ks[17], (L, D_SSM), 1.0),
        "w_glu": nrm(ks[18], (L, D_SSM, D_SSM), D_SSM ** -0.5),
        "b_glu": nrm(ks[19], (L, D_SSM), 0.02),
        "attn_out_norm": gain(ks[20], (L, D_ATTN)),
        "ssm_out_norm": gain(ks[21], (L, D_SSM)),
        "w_out": nrm(ks[22], (L, D_MIX, D_MODEL), D_MIX ** -0.5),
        "norm_ffn": gain(ks[23], (L, D_MODEL)),
        "w_router": nrm(ks[24], (L, D_MODEL, N_EXPERTS), D_MODEL ** -0.5),
        "b_router": nrm(ks[25], (L, N_EXPERTS), 0.01),
        "w_gate_up": nrm(ks[26], (L, N_EXPERTS, D_MODEL, 2 * D_FF), D_MODEL ** -0.5),
        "b_gate_up": nrm(ks[27], (L, N_EXPERTS, 2 * D_FF), 0.02),
        "w_down": nrm(ks[28], (L, N_EXPERTS, D_FF, D_MODEL), D_FF ** -0.5),
        "b_down": nrm(ks[29], (L, N_EXPERTS, D_MODEL), 0.02),
    }


def reference(x, c, w_ada, b_ada, norm_mix, w_in, b_in, q_norm, k_norm, sinks,
              lam_re, lam_im, log_dt, b_re, b_im, c_re, c_im, d_skip, w_glu, b_glu,
              attn_out_norm, ssm_out_norm, w_out, norm_ffn, w_router, b_router,
              w_gate_up, b_gate_up, w_down, b_down):
    B, S = x.shape[0], x.shape[1]
    c_act = jax.nn.silu(c)
    for l in range(DEPTH):
        mod = (c_act @ w_ada[l] + b_ada[l])[:, None, :]
        sh1, sc1, g1, sh2, sc2, g2 = jnp.split(mod, 6, axis=-1)

        h = rmsnorm(x, norm_mix[l]) * (1.0 + sc1) + sh1
        proj = h @ w_in[l] + b_in[l]
        q, k, v, u = jnp.split(proj, [D_ATTN, D_ATTN + D_KV, D_ATTN + 2 * D_KV], axis=-1)
        q = rmsnorm(q.reshape(B, S, N_KV_HEADS, Q_PER_KV, HEAD_DIM), q_norm[l])
        k = rmsnorm(k.reshape(B, S, N_KV_HEADS, HEAD_DIM), k_norm[l])
        v = v.reshape(B, S, N_KV_HEADS, HEAD_DIM)
        attn = sliding_window_attention(q, k, v, sinks[l])

        ssm = s5_ssm(u, lam_re[l], lam_im[l], log_dt[l], b_re[l], b_im[l],
                     c_re[l], c_im[l], d_skip[l])
        ssm = jax.nn.gelu(ssm)
        ssm = ssm * jax.nn.sigmoid(ssm @ w_glu[l] + b_glu[l])

        mixed = jnp.concatenate([rmsnorm(attn, attn_out_norm[l]),
                                 rmsnorm(ssm, ssm_out_norm[l])], axis=-1)
        x = x + g1 * (mixed @ w_out[l])

        h2 = rmsnorm(x, norm_ffn[l]) * (1.0 + sc2) + sh2
        x = x + g2 * moe_ffn(h2, w_router[l], b_router[l], w_gate_up[l],
                             b_gate_up[l], w_down[l], b_down[l])
    return x
```

```cpp
#include <hip/hip_runtime.h>
#include <stdint.h>
#include <stdio.h>

#ifndef FAST_ATTN
#define FAST_ATTN 1
#endif
#ifndef FAST_SSM
#define FAST_SSM 1
#endif
#ifndef MOE_FP8_GU
#define MOE_FP8_GU 1
#endif
#ifndef MOE_FP8_DN
#define MOE_FP8_DN 1
#endif
#ifndef YS_FP8
#define YS_FP8 1
#endif
#ifndef P3_CONV
#define P3_CONV 0
#endif
#ifndef FUSE_MIXNORM
#define FUSE_MIXNORM 1
#endif
#ifndef X1_DELTA
#define X1_DELTA 1
#endif
#ifndef SSM_MFMA_CARRY
#define SSM_MFMA_CARRY 1
#endif
#ifndef X1_BF16
#define X1_BF16 1
#endif
#ifndef FAST_SORT
#define FAST_SORT 1
#endif
#ifndef FAST_ROUTER
#define FAST_ROUTER 1
#endif
#ifndef MK_MODE
#define MK_MODE 1
#endif

typedef unsigned short bf16;
typedef float f32x4 __attribute__((ext_vector_type(4)));
typedef float f32x2 __attribute__((ext_vector_type(2)));
typedef unsigned u32x4 __attribute__((ext_vector_type(4)));
typedef unsigned u32x2 __attribute__((ext_vector_type(2)));
typedef short bf16x8 __attribute__((ext_vector_type(8)));
typedef int i32x4 __attribute__((ext_vector_type(4)));
typedef int i32x8 __attribute__((ext_vector_type(8)));
constexpr float W8_SCALE = 32.0f, H8_SCALE = 4.0f, A8_SCALE = 4.0f, Y8_SCALE = 16.0f;
#define GAS __attribute__((address_space(1)))
#define LAS __attribute__((address_space(3)))

constexpr int D = 1024, NB = 8, S = 2048, T = NB * S;
constexpr int DATT = 512, HD = 64, NH = 8, NKV = 2, DKV = 128;
constexpr int DSSM = 512, SG = 16, NG = 32, NST = 64;
constexpr int DIN = 1280, NE = 32, TOPK = 4, DFF = 1024;
constexpr int QOFF = 0, KOFF = 512, VOFF = 640, UOFF = 768;
constexpr float EPS = 1e-6f;
constexpr int MAXTILES = 288, MPAD = MAXTILES * 256;

constexpr size_t MiB = 1u << 20;
constexpr size_t WS_CTL = 0, CTL_ZERO_BYTES = 256 * 1024;
constexpr size_t WS_MOD = 1 * MiB;
constexpr size_t WS_SSMT = 2 * MiB;
constexpr size_t WS_WTIN = 4 * MiB;
constexpr size_t WS_WTGLU = 7 * MiB;
constexpr size_t WS_WTOUT = 8 * MiB;
constexpr size_t WS_WTGU = 16 * MiB;
constexpr size_t WS_WTDN = 144 * MiB;
constexpr size_t WS_H = 208 * MiB;
constexpr size_t WS_PROJ = 240 * MiB;
constexpr size_t WS_ATT = 280 * MiB;
constexpr size_t WS_G = 296 * MiB;
constexpr size_t WS_SSMG = 312 * MiB;
constexpr size_t WS_MIXED = 328 * MiB;
constexpr size_t WS_TOPE = 360 * MiB;
constexpr size_t WS_TOPW = 361 * MiB;
constexpr size_t WS_HIST = 362 * MiB;
constexpr size_t WS_TOKROW = 363 * MiB;
constexpr size_t WS_ROWPAIR = 364 * MiB;
constexpr size_t WS_WROW = 365 * MiB;
constexpr size_t WS_TILEE = 366 * MiB;
constexpr size_t WS_CNT = 1024;
constexpr int CNT_STRIDE = 64;
constexpr size_t WS_TOKE = 332 * MiB;
constexpr size_t WS_WROWE = 336 * MiB;
constexpr size_t WS_APOW = 340 * MiB;
constexpr size_t WS_DELTA = 624 * MiB;
constexpr size_t WS_H8 = 660 * MiB;
constexpr size_t WS_WRI = 367 * MiB;
constexpr size_t WS_ACT = 368 * MiB;
constexpr size_t WS_YS = 512 * MiB;
constexpr size_t WS_XST = 368 * MiB;
constexpr size_t WS_SC = 624 * MiB;
constexpr size_t WS_X1B = 700 * MiB;
constexpr size_t WS_END = 740 * MiB;
constexpr int CW_BAR = 4096;

constexpr int ST_AR = 0, ST_AI = 64, ST_BR = 128, ST_BI = 128 + 1024, SSMT_STRIDE = 128 + 2048;

__host__ __device__ __forceinline__ int gu_row(int n) { const int j = n >> 1, half = n & 1; return (j >> 7) * 256 + half * 128 + (j & 127); }

__device__ __forceinline__ unsigned f2bf(float f) { unsigned u = __builtin_bit_cast(unsigned, f); return (u + 0x7fffu + ((u >> 16) & 1u)) >> 16; }
__device__ __forceinline__ float bf2f(unsigned b) { return __builtin_bit_cast(float, (b & 0xffffu) << 16); }
__device__ __forceinline__ unsigned pk2(float lo, float hi) { return f2bf(lo) | (f2bf(hi) << 16); }
__device__ __forceinline__ unsigned pk4_fp8(float a, float b, float c, float d) { unsigned w = 0u; w = __builtin_amdgcn_cvt_pk_fp8_f32(a, b, w, false); w = __builtin_amdgcn_cvt_pk_fp8_f32(c, d, w, true); return w; }
__device__ __forceinline__ float bflo(unsigned w) { return __builtin_bit_cast(float, w << 16); }
__device__ __forceinline__ float bfhi(unsigned w) { return __builtin_bit_cast(float, w & 0xffff0000u); }
__device__ __forceinline__ float wave_sum(float v) {
#pragma unroll
    for (int o = 1; o < 64; o <<= 1) v += __shfl_xor(v, o);
    return v;
}
__device__ __forceinline__ float sigmoidf_(float x) { return __builtin_amdgcn_rcpf(1.0f + __expf(-x)); }
__device__ __forceinline__ float gelu_tanh(float x) { const float u2 = 1.5957691216057308f * (x + 0.044715f * x * x * x); return x * sigmoidf_(u2); }
__device__ __forceinline__ float dot8(u32x4 a, u32x4 b, float acc) {
    acc = fmaf(bflo(a.x), bflo(b.x), acc); acc = fmaf(bfhi(a.x), bfhi(b.x), acc);
    acc = fmaf(bflo(a.y), bflo(b.y), acc); acc = fmaf(bfhi(a.y), bfhi(b.y), acc);
    acc = fmaf(bflo(a.z), bflo(b.z), acc); acc = fmaf(bfhi(a.z), bfhi(b.z), acc);
    acc = fmaf(bflo(a.w), bflo(b.w), acc); acc = fmaf(bfhi(a.w), bfhi(b.w), acc);
    return acc;
}

__device__ __forceinline__ void ssm_table_item(int i, const float* lam_re, const float* lam_im, const float* log_dt, const float* b_re, const float* b_im, float* tab) {
    const int g = i / NST, p = i % NST;
    const float lr = lam_re[i], li = lam_im[i], dt = expf(log_dt[g]);
    const float mag = expf(lr * dt), ang = li * dt;
    const float lbr = mag * cosf(ang), lbi = mag * sinf(ang);
    const float den = lr * lr + li * li;
    const float cr = ((lbr - 1.0f) * lr + lbi * li) / den, ci = (lbi * lr - (lbr - 1.0f) * li) / den;
    float* t = tab + (size_t)g * SSMT_STRIDE;
    t[ST_AR + p] = lbr; t[ST_AI + p] = lbi;
    for (int h = 0; h < SG; ++h) { const float br = b_re[(size_t)i * SG + h], bi = b_im[(size_t)i * SG + h];
        t[ST_BR + p * SG + h] = cr * br - ci * bi; t[ST_BI + p * SG + h] = cr * bi + ci * br; }
}
__device__ __forceinline__ void norm_mod_row(int row, int lane, const float* x, const float* gain, const float* mod, int sh_off, int sc_off, bf16* H) {
    const int b = row / S;
    const f32x4* xr = (const f32x4*)(x + (size_t)row * D) + lane;
    f32x4 v[4]; float s = 0.f;
#pragma unroll
    for (int j = 0; j < 4; ++j) { v[j] = xr[64 * j]; s += (v[j].x * v[j].x + v[j].y * v[j].y) + (v[j].z * v[j].z + v[j].w * v[j].w); }
    const float r = rsqrtf(wave_sum(s) * (1.0f / D) + EPS);
    u32x2* o = (u32x2*)(H + (size_t)row * D) + lane;
#pragma unroll
    for (int j = 0; j < 4; ++j) { const int c = 4 * lane + 256 * j;
        const f32x4 g = *(const f32x4*)(gain + c), sc = *(const f32x4*)(mod + b * 6 * D + sc_off + c), sh = *(const f32x4*)(mod + b * 6 * D + sh_off + c);
        f32x4 y; y.x = v[j].x * r * g.x * (1.f + sc.x) + sh.x; y.y = v[j].y * r * g.y * (1.f + sc.y) + sh.y; y.z = v[j].z * r * g.z * (1.f + sc.z) + sh.z; y.w = v[j].w * r * g.w * (1.f + sc.w) + sh.w;
        u32x2 w; w.x = pk2(y.x, y.y); w.y = pk2(y.z, y.w); o[64 * j] = w; }
}
__device__ __forceinline__ void mixnorm_row(int row, int lane, const bf16* ATT, const bf16* SSMG, const float* ga, const float* gs, bf16* MIXED) {
    const u32x4 a = *((const u32x4*)(ATT + (size_t)row * DATT) + lane), s = *((const u32x4*)(SSMG + (size_t)row * DSSM) + lane);
    const float av[8] = {bflo(a.x), bfhi(a.x), bflo(a.y), bfhi(a.y), bflo(a.z), bfhi(a.z), bflo(a.w), bfhi(a.w)};
    const float sv[8] = {bflo(s.x), bfhi(s.x), bflo(s.y), bfhi(s.y), bflo(s.z), bfhi(s.z), bflo(s.w), bfhi(s.w)};
    float qa = 0.f, qs = 0.f;
#pragma unroll
    for (int i = 0; i < 8; ++i) { qa += av[i] * av[i]; qs += sv[i] * sv[i]; }
    const float ra = rsqrtf(wave_sum(qa) * (1.0f / DATT) + EPS), rs = rsqrtf(wave_sum(qs) * (1.0f / DSSM) + EPS);
    const f32x4 ga0 = *(const f32x4*)(ga + 8 * lane), ga1 = *(const f32x4*)(ga + 8 * lane + 4), gs0 = *(const f32x4*)(gs + 8 * lane), gs1 = *(const f32x4*)(gs + 8 * lane + 4);
    u32x4 oa, os;
    oa.x = pk2(av[0] * ra * ga0.x, av[1] * ra * ga0.y); oa.y = pk2(av[2] * ra * ga0.z, av[3] * ra * ga0.w); oa.z = pk2(av[4] * ra * ga1.x, av[5] * ra * ga1.y); oa.w = pk2(av[6] * ra * ga1.z, av[7] * ra * ga1.w);
    os.x = pk2(sv[0] * rs * gs0.x, sv[1] * rs * gs0.y); os.y = pk2(sv[2] * rs * gs0.z, sv[3] * rs * gs0.w); os.z = pk2(sv[4] * rs * gs1.x, sv[5] * rs * gs1.y); os.w = pk2(sv[6] * rs * gs1.z, sv[7] * rs * gs1.w);
    *((u32x4*)(MIXED + (size_t)row * D) + lane) = oa; *((u32x4*)(MIXED + (size_t)row * D + DATT) + lane) = os;
}
__device__ __forceinline__ void combine_row(int row, int lane, float* out, const float* mod, const bf16* YS, const int* rowpair) {
    const int b = row / S; const int* rp = rowpair + (size_t)row * 4;
    const int r0 = rp[0], r1 = rp[1], r2 = rp[2], r3 = rp[3];
#pragma unroll
    for (int j = 0; j < 2; ++j) { const int c = 8 * lane + 512 * j;
        const u32x4 a = *(const u32x4*)(YS + (size_t)r0 * D + c), b2 = *(const u32x4*)(YS + (size_t)r1 * D + c), c2 = *(const u32x4*)(YS + (size_t)r2 * D + c), d2 = *(const u32x4*)(YS + (size_t)r3 * D + c);
        float y[8];
        y[0] = bflo(a.x) + bflo(b2.x) + bflo(c2.x) + bflo(d2.x); y[1] = bfhi(a.x) + bfhi(b2.x) + bfhi(c2.x) + bfhi(d2.x);
        y[2] = bflo(a.y) + bflo(b2.y) + bflo(c2.y) + bflo(d2.y); y[3] = bfhi(a.y) + bfhi(b2.y) + bfhi(c2.y) + bfhi(d2.y);
        y[4] = bflo(a.z) + bflo(b2.z) + bflo(c2.z) + bflo(d2.z); y[5] = bfhi(a.z) + bfhi(b2.z) + bfhi(c2.z) + bfhi(d2.z);
        y[6] = bflo(a.w) + bflo(b2.w) + bflo(c2.w) + bflo(d2.w); y[7] = bfhi(a.w) + bfhi(b2.w) + bfhi(c2.w) + bfhi(d2.w);
        float* op = out + (size_t)row * D + c; const float* g2 = mod + b * 6 * D + 5 * D + c;
        f32x4 o0 = *(f32x4*)op, o1 = *(f32x4*)(op + 4); const f32x4 g0 = *(const f32x4*)g2, g1 = *(const f32x4*)(g2 + 4);
        o0.x += g0.x * y[0]; o0.y += g0.y * y[1]; o0.z += g0.z * y[2]; o0.w += g0.w * y[3]; o1.x += g1.x * y[4]; o1.y += g1.y * y[5]; o1.z += g1.z * y[6]; o1.w += g1.w * y[7];
        *(f32x4*)op = o0; *(f32x4*)(op + 4) = o1; }
}
__device__ __forceinline__ void combine_row8(int row, int lane, float* out, const float* mod, const unsigned char* YS8, const int* rowpair) {
    const int b = row / S; const i32x4 rp = *(const i32x4*)(rowpair + (size_t)row * 4); const int c = 16 * lane;
    const u32x4 q0 = *(const u32x4*)(YS8 + (size_t)rp.x * D + c), q1 = *(const u32x4*)(YS8 + (size_t)rp.y * D + c), q2 = *(const u32x4*)(YS8 + (size_t)rp.z * D + c), q3 = *(const u32x4*)(YS8 + (size_t)rp.w * D + c);
    float* op = out + (size_t)row * D + c; const float* g2 = mod + b * 6 * D + 5 * D + c;
#pragma unroll
    for (int j = 0; j < 4; ++j) { const unsigned w0 = q0[j], w1 = q1[j], w2 = q2[j], w3 = q3[j];
        const f32x2 lo = __builtin_amdgcn_cvt_pk_f32_fp8(w0, false) + __builtin_amdgcn_cvt_pk_f32_fp8(w1, false) + __builtin_amdgcn_cvt_pk_f32_fp8(w2, false) + __builtin_amdgcn_cvt_pk_f32_fp8(w3, false);
        const f32x2 hi = __builtin_amdgcn_cvt_pk_f32_fp8(w0, true) + __builtin_amdgcn_cvt_pk_f32_fp8(w1, true) + __builtin_amdgcn_cvt_pk_f32_fp8(w2, true) + __builtin_amdgcn_cvt_pk_f32_fp8(w3, true);
        f32x4 o = *(f32x4*)(op + 4 * j); const f32x4 g = *(const f32x4*)(g2 + 4 * j);
        o.x += g.x * lo.x * (1.0f / Y8_SCALE); o.y += g.y * lo.y * (1.0f / Y8_SCALE); o.z += g.z * hi.x * (1.0f / Y8_SCALE); o.w += g.w * hi.y * (1.0f / Y8_SCALE);
        *(f32x4*)(op + 4 * j) = o; }
}
__device__ __forceinline__ void combine_rows8x2(int row, int lane, float* out, const float* mod, const unsigned char* YS8, const int* rowpair, const float* xin = nullptr, const bf16* delta = nullptr, const LAS int* cb = nullptr) {
    const int b = row / S, c = 16 * lane; i32x4 rp0 = *(const i32x4*)(rowpair + (size_t)row * 4), rp1 = *(const i32x4*)(rowpair + (size_t)row * 4 + 4);
    if (FAST_SORT && cb) {
#pragma unroll
        for (int k = 0; k < 4; ++k) { rp0[k] = (rp0[k] & 0xFFFFF) + cb[32 + (rp0[k] >> 20)]; rp1[k] = (rp1[k] & 0xFFFFF) + cb[32 + (rp1[k] >> 20)]; } }
    u32x4 q[2][4];
    q[0][0] = *(const u32x4*)(YS8 + (size_t)rp0.x * D + c); q[0][1] = *(const u32x4*)(YS8 + (size_t)rp0.y * D + c); q[0][2] = *(const u32x4*)(YS8 + (size_t)rp0.z * D + c); q[0][3] = *(const u32x4*)(YS8 + (size_t)rp0.w * D + c);
    q[1][0] = *(const u32x4*)(YS8 + (size_t)rp1.x * D + c); q[1][1] = *(const u32x4*)(YS8 + (size_t)rp1.y * D + c); q[1][2] = *(const u32x4*)(YS8 + (size_t)rp1.z * D + c); q[1][3] = *(const u32x4*)(YS8 + (size_t)rp1.w * D + c);
    const float* g2 = mod + b * 6 * D + 5 * D + c;
    f32x4 g[4], o[2][4];
#pragma unroll
    for (int j = 0; j < 4; ++j) { g[j] = *(const f32x4*)(g2 + 4 * j) * (1.0f / Y8_SCALE); const float* src = delta ? xin : out;
        if (src) { o[0][j] = *(const f32x4*)(src + (size_t)row * D + c + 4 * j); o[1][j] = *(const f32x4*)(src + (size_t)(row + 1) * D + c + 4 * j); } else { o[0][j] = (f32x4){0.f, 0.f, 0.f, 0.f}; o[1][j] = o[0][j]; } }
    if (delta) {
#pragma unroll
        for (int r = 0; r < 2; ++r) { const u32x4 d0 = *(const u32x4*)(delta + (size_t)(row + r) * D + c), d1 = *(const u32x4*)(delta + (size_t)(row + r) * D + c + 8);
            o[r][0] += (f32x4){bflo(d0.x), bfhi(d0.x), bflo(d0.y), bfhi(d0.y)}; o[r][1] += (f32x4){bflo(d0.z), bfhi(d0.z), bflo(d0.w), bfhi(d0.w)};
            o[r][2] += (f32x4){bflo(d1.x), bfhi(d1.x), bflo(d1.y), bfhi(d1.y)}; o[r][3] += (f32x4){bflo(d1.z), bfhi(d1.z), bflo(d1.w), bfhi(d1.w)}; } }
#pragma unroll
    for (int r = 0; r < 2; ++r)
#pragma unroll
        for (int j = 0; j < 4; ++j) { const unsigned w0 = q[r][0][j], w1 = q[r][1][j], w2 = q[r][2][j], w3 = q[r][3][j];
            const f32x2 lo = __builtin_amdgcn_cvt_pk_f32_fp8(w0, false) + __builtin_amdgcn_cvt_pk_f32_fp8(w1, false) + __builtin_amdgcn_cvt_pk_f32_fp8(w2, false) + __builtin_amdgcn_cvt_pk_f32_fp8(w3, false);
            const f32x2 hi = __builtin_amdgcn_cvt_pk_f32_fp8(w0, true) + __builtin_amdgcn_cvt_pk_f32_fp8(w1, true) + __builtin_amdgcn_cvt_pk_f32_fp8(w2, true) + __builtin_amdgcn_cvt_pk_f32_fp8(w3, true);
            f32x4 t = o[r][j]; t.x += g[j].x * lo.x; t.y += g[j].y * lo.y; t.z += g[j].z * hi.x; t.w += g[j].w * hi.y;
            *(f32x4*)(out + (size_t)(row + r) * D + c + 4 * j) = t; }
}
__device__ __forceinline__ void attn_scores_item(int idx, const bf16* PROJ, const float* qg, const float* kg, float* SC) {
    const int t = idx / NH, h = idx % NH, kvh = h / 4, b = t / S, tl = t % S;
    const bf16* q = PROJ + (size_t)t * DIN + QOFF + h * HD;
    float sq = 0.f;
    for (int d = 0; d < HD; ++d) { const float v = bf2f(q[d]); sq += v * v; }
    const float rq = rsqrtf(sq * (1.0f / HD) + EPS);
    for (int i = 0; i < 128; ++i) {
        const int sl = tl - 127 + i; float sc = -1e30f;
        if (sl >= 0) { const bf16* k = PROJ + (size_t)(b * S + sl) * DIN + KOFF + kvh * HD;
            float sk = 0.f, dt = 0.f;
            for (int d = 0; d < HD; ++d) { const float kv = bf2f(k[d]); sk += kv * kv; dt += bf2f(q[d]) * qg[d] * kv * kg[d]; }
            sc = dt * rq * rsqrtf(sk * (1.0f / HD) + EPS) * 0.125f; }
        SC[(size_t)idx * 128 + i] = sc; }
}
__device__ __forceinline__ void attn_out_item(int idx, const bf16* PROJ, const float* SC, const float* sinks, bf16* ATT) {
    const int d = idx % HD, th = idx / HD, h = th % NH, t = th / NH, kvh = h / 4, b = t / S, tl = t % S;
    const float* sc = SC + (size_t)th * 128; const float sink = sinks[h];
    float m = sink;
    for (int i = 0; i < 128; ++i) m = fmaxf(m, sc[i]);
    float den = __expf(sink - m), o = 0.f;
    for (int i = 0; i < 128; ++i) { const int sl = tl - 127 + i; if (sl < 0) continue;
        const float p = __expf(sc[i] - m); den += p; o += p * bf2f(PROJ[(size_t)(b * S + sl) * DIN + VOFF + kvh * HD + d]); }
    ATT[(size_t)t * DATT + h * HD + d] = (bf16)f2bf(o / den);
}
__device__ __forceinline__ void ssm_scan_item(int idx, const bf16* PROJ, const float* tab, float* XST) {
    const int p = idx % NST, g = (idx / NST) % NG, b = idx / (NST * NG);
    const float* tg = tab + (size_t)g * SSMT_STRIDE;
    const float ar = tg[ST_AR + p], ai = tg[ST_AI + p];
    float br[SG], bi[SG];
#pragma unroll
    for (int h = 0; h < SG; ++h) { br[h] = tg[ST_BR + p * SG + h]; bi[h] = tg[ST_BI + p * SG + h]; }
    float xr = 0.f, xi = 0.f;
    for (int t = 0; t < S; ++t) {
        const u32x4* up = (const u32x4*)(PROJ + (size_t)(b * S + t) * DIN + UOFF + g * SG);
        const u32x4 u0 = up[0], u1 = up[1];
        const float u[SG] = {bflo(u0.x), bfhi(u0.x), bflo(u0.y), bfhi(u0.y), bflo(u0.z), bfhi(u0.z), bflo(u0.w), bfhi(u0.w),
                             bflo(u1.x), bfhi(u1.x), bflo(u1.y), bfhi(u1.y), bflo(u1.z), bfhi(u1.z), bflo(u1.w), bfhi(u1.w)};
        float bur = 0.f, bui = 0.f;
#pragma unroll
        for (int h = 0; h < SG; ++h) { bur = fmaf(br[h], u[h], bur); bui = fmaf(bi[h], u[h], bui); }
        const float nr = ar * xr - ai * xi + bur, ni = ar * xi + ai * xr + bui; xr = nr; xi = ni;
        float* o = XST + (((size_t)(b * S + t) * NG + g) * NST + p) * 2; o[0] = xr; o[1] = xi;
    }
}
__device__ __forceinline__ void ssm_out_item(int idx, const bf16* PROJ, const float* XST, const float* c_re, const float* c_im, const float* d_skip, bf16* G) {
    const int ch = idx % DSSM, t = idx / DSSM, g = ch / SG, h = ch % SG;
    const float* x = XST + ((size_t)t * NG + g) * NST * 2; const float* cr = c_re + ((size_t)g * SG + h) * NST; const float* ci = c_im + ((size_t)g * SG + h) * NST;
    float y = 0.f;
    for (int p = 0; p < NST; ++p) y += cr[p] * x[2 * p] - ci[p] * x[2 * p + 1];
    y += d_skip[ch] * bf2f(PROJ[(size_t)t * DIN + UOFF + ch]);
    G[(size_t)t * DSSM + ch] = (bf16)f2bf(gelu_tanh(y));
}
__device__ __forceinline__ void norm2_router_rows(int blk, int wave, int lane, const float* x1, const float* gain, const float* mod, const float* b_router,
                                                  const LAS float* wr, LAS int* lh, LAS float* xs, bf16* H, int* tope, float* topw, unsigned char* H8 = nullptr) {
    const int b = (blk * 64) / S;
    f32x4 gm[4], sh[4];
#pragma unroll
    for (int j = 0; j < 4; ++j) { const int c = 4 * lane + 256 * j; const f32x4 g = *(const f32x4*)(gain + c), sc = *(const f32x4*)(mod + b * 6 * D + 4 * D + c);
        gm[j] = g * (1.0f + sc); sh[j] = *(const f32x4*)(mod + b * 6 * D + 3 * D + c); }
    const int my_e = lane >> 1; const float my_b = b_router[my_e];
    LAS float* lg = xs + wave * 128;
    LAS int* sel_e = (LAS int*)(xs + wave * 128 + 64);
    LAS float* sel_v = xs + wave * 128 + 72;
#pragma unroll 1
    for (int i = 0; i < 8; i += 2) {
        const int row0 = blk * 64 + wave * 8 + i;
        f32x4 v[2][4]; float ssq[2];
#pragma unroll
        for (int r = 0; r < 2; ++r) { const f32x4* xr = (const f32x4*)(x1 + (size_t)(row0 + r) * D) + lane; float s = 0.f;
#pragma unroll
            for (int j = 0; j < 4; ++j) { v[r][j] = xr[64 * j]; s += (v[r][j].x * v[r][j].x + v[r][j].y * v[r][j].y) + (v[r][j].z * v[r][j].z + v[r][j].w * v[r][j].w); }
            ssq[r] = s; }
#pragma unroll
        for (int o2 = 1; o2 < 64; o2 <<= 1) { ssq[0] += __shfl_xor(ssq[0], o2); asm volatile("" : "+v"(ssq[0])); ssq[1] += __shfl_xor(ssq[1], o2); asm volatile("" : "+v"(ssq[1])); }
#pragma unroll
        for (int r = 0; r < 2; ++r) { const float rs = rsqrtf(ssq[r] * (1.0f / D) + EPS); u32x2* o = (u32x2*)(H + (size_t)(row0 + r) * D) + lane;
#pragma unroll
            for (int j = 0; j < 4; ++j) { v[r][j] = v[r][j] * rs * gm[j] + sh[j]; if (H) { u32x2 w; w.x = pk2(v[r][j].x, v[r][j].y); w.y = pk2(v[r][j].z, v[r][j].w); o[64 * j] = w; }
                if (H8) *(unsigned*)(H8 + (size_t)(row0 + r) * D + 4 * lane + 256 * j) = pk4_fp8(v[r][j].x * H8_SCALE, v[r][j].y * H8_SCALE, v[r][j].z * H8_SCALE, v[r][j].w * H8_SCALE); } }
        float pe0[NE], pe1[NE];
#pragma unroll
        for (int e = 0; e < NE; ++e) { float a0 = 0.f, a1 = 0.f;
#pragma unroll
            for (int j = 0; j < 4; ++j) { const f32x4 w = *(const LAS f32x4*)(wr + e * D + 4 * lane + 256 * j);
                a0 += (v[0][j].x * w.x + v[0][j].y * w.y) + (v[0][j].z * w.z + v[0][j].w * w.w); asm volatile("" : "+v"(a0)); a1 += (v[1][j].x * w.x + v[1][j].y * w.y) + (v[1][j].z * w.z + v[1][j].w * w.w); asm volatile("" : "+v"(a1)); }
            pe0[e] = a0; pe1[e] = a1; }
#define BFLY(half, bit) { const bool up = (lane & (bit)) != 0; _Pragma("unroll") for (int k = 0; k < (half); ++k) { \
            const float k0 = up ? pe0[(half) + k] : pe0[k], s0 = up ? pe0[k] : pe0[(half) + k], k1 = up ? pe1[(half) + k] : pe1[k], s1 = up ? pe1[k] : pe1[(half) + k]; \
            pe0[k] = k0 + __shfl_xor(s0, (bit)); asm volatile("" : "+v"(pe0[k])); pe1[k] = k1 + __shfl_xor(s1, (bit)); asm volatile("" : "+v"(pe1[k])); } }
        BFLY(16, 32) BFLY(8, 16) BFLY(4, 8) BFLY(2, 4) BFLY(1, 2)
#undef BFLY
        const float l0 = pe0[0] + __shfl_xor(pe0[0], 1) + my_b, l1 = pe1[0] + __shfl_xor(pe1[0], 1) + my_b;
        if ((lane & 1) == 0) { lg[my_e] = l0; lg[32 + my_e] = l1; }
        asm volatile("s_waitcnt lgkmcnt(0)" ::: "memory");
        int rk0 = 0, rk1 = 0;
#pragma unroll
        for (int q = 0; q < 8; ++q) { const f32x4 a = *(const LAS f32x4*)(lg + 4 * q), c = *(const LAS f32x4*)(lg + 32 + 4 * q);
#pragma unroll
            for (int t = 0; t < 4; ++t) { const int e2 = 4 * q + t; rk0 += (a[t] > l0 || (a[t] == l0 && e2 < my_e)) ? 1 : 0; rk1 += (c[t] > l1 || (c[t] == l1 && e2 < my_e)) ? 1 : 0; } }
        if ((lane & 1) == 0) { if (rk0 < 4) { sel_e[rk0] = my_e; sel_v[rk0] = l0; } if (rk1 < 4) { sel_e[4 + rk1] = my_e; sel_v[4 + rk1] = l1; } }
        asm volatile("s_waitcnt lgkmcnt(0)" ::: "memory");
        if (lane < 2) { const i32x4 ee = *(const LAS i32x4*)(sel_e + 4 * lane); const f32x4 vv = *(const LAS f32x4*)(sel_v + 4 * lane);
            const int e0 = ee.x, e1 = ee.y, e2 = ee.z, e3 = ee.w;
            const float x1v = __expf(vv.y - vv.x), x2v = __expf(vv.z - vv.x), x3v = __expf(vv.w - vv.x), inv = 1.0f / (1.0f + x1v + x2v + x3v);
            int* te = tope + (size_t)(row0 + lane) * 4; float* tw = topw + (size_t)(row0 + lane) * 4;
            *(i32x4*)te = (i32x4){e0, e1, e2, e3}; *(f32x4*)tw = (f32x4){inv, x1v * inv, x2v * inv, x3v * inv};
            (void)__hip_atomic_fetch_add(&lh[e0], 1, __ATOMIC_RELAXED, __HIP_MEMORY_SCOPE_WORKGROUP); (void)__hip_atomic_fetch_add(&lh[e1], 1, __ATOMIC_RELAXED, __HIP_MEMORY_SCOPE_WORKGROUP);
            (void)__hip_atomic_fetch_add(&lh[e2], 1, __ATOMIC_RELAXED, __HIP_MEMORY_SCOPE_WORKGROUP); (void)__hip_atomic_fetch_add(&lh[e3], 1, __ATOMIC_RELAXED, __HIP_MEMORY_SCOPE_WORKGROUP); }
        asm volatile("s_waitcnt lgkmcnt(0)" ::: "memory");
    }
}
__device__ __forceinline__ void sort_block(int blk, int tid, LAS int* sm, const int* hist, const int* tope, const float* topw, int* tokrow, int* rowpair, float* wrow, int* tilee) {
    LAS int* tot = sm; LAS int* mine = sm + 32; LAS int* base = sm + 64; LAS int* es = sm + 128;
    { const int e = tid & 31, part = tid >> 5; int hv[16]; int a = 0, m = 0;
#pragma unroll
      for (int k = 0; k < 16; ++k) hv[k] = hist[(16 * part + k) * NE + e];
#pragma unroll
      for (int k = 0; k < 16; ++k) { a += hv[k]; if (16 * part + k < blk) m += hv[k]; }
      LAS int* pa = sm + 384; pa[part * 32 + e] = a; pa[512 + part * 32 + e] = m; }
    __syncthreads();
    if (tid < NE) { const LAS int* pa = sm + 384; int a = 0, m = 0;
#pragma unroll
        for (int p = 0; p < 16; ++p) { a += pa[p * 32 + tid]; m += pa[512 + p * 32 + tid]; } tot[tid] = a; mine[tid] = m; }
    __syncthreads();
    if (tid == 0) { int o = 0; for (int e = 0; e < NE; ++e) { base[e] = o; o += ((tot[e] + 255) >> 8) << 8; } base[NE] = o; }
    int my_e = 0, rank = 0;
    if (tid < 256) { my_e = tope[(size_t)(blk * 64) * 4 + tid]; const int lane = tid & 63, w = tid >> 6;
        const unsigned long long lt = (lane == 0) ? 0ull : (~0ull >> (64 - lane));
#pragma unroll 4
        for (int e = 0; e < NE; ++e) { const unsigned long long m = __ballot(my_e == e); if (my_e == e) rank = __popcll(m & lt); if (lane == 0) es[w * 32 + e] = __popcll(m); } }
    __syncthreads();
    if (tid < 256) { const int e = my_e, w = tid >> 6; for (int w2 = 0; w2 < w; ++w2) rank += es[w2 * 32 + e];
        const int pos = base[e] + mine[e] + rank, tok = blk * 64 + (tid >> 2);
        tokrow[pos] = tok; rowpair[(size_t)blk * 256 + tid] = pos; wrow[pos] = topw[(size_t)blk * 256 + tid]; }
    if (blk < NE) { const int e = blk; for (int r = base[e] + tot[e] + tid; r < base[e + 1]; r += 512) { tokrow[r] = 0; wrow[r] = 0.f; }
        for (int ti = (base[e] >> 8) + tid; ti < (base[e + 1] >> 8); ti += 512) tilee[64 + ti] = e; }
    if (blk == 0 && tid == 0) tilee[0] = base[NE] >> 8;
    __syncthreads();
}

__global__ void k_transpose_cvt(const float* __restrict__ W, bf16* __restrict__ WT, int K, int N, int perm_gu) {
    __shared__ float tile[32][33];
    const float* Wb = W + (size_t)blockIdx.z * K * N; bf16* WTb = WT + (size_t)blockIdx.z * K * N;
    const int n0 = blockIdx.x * 32, k0 = blockIdx.y * 32;
    for (int i = threadIdx.y; i < 32; i += 8) tile[i][threadIdx.x] = Wb[(size_t)(k0 + i) * N + n0 + threadIdx.x];
    __syncthreads();
    for (int i = threadIdx.y; i < 32; i += 8) { const int n = n0 + i, nr = perm_gu ? gu_row(n) : n; WTb[(size_t)nr * K + k0 + threadIdx.x] = (bf16)f2bf(tile[threadIdx.x][i]); }
}
__global__ void k_mod(const float* __restrict__ c, const float* __restrict__ w_ada, const float* __restrict__ b_ada, float* __restrict__ mod) {
    __shared__ float ca[NB][D];
    for (int i = threadIdx.x; i < NB * D; i += blockDim.x) { const float v = c[i]; ca[i / D][i % D] = v * sigmoidf_(v); }
    __syncthreads();
    const int j = blockIdx.x * blockDim.x + threadIdx.x;
    float acc[NB];
#pragma unroll
    for (int b = 0; b < NB; ++b) acc[b] = 0.f;
    for (int k = 0; k < D; ++k) { const float w = w_ada[(size_t)k * (6 * D) + j];
#pragma unroll
        for (int b = 0; b < NB; ++b) acc[b] = fmaf(ca[b][k], w, acc[b]); }
#pragma unroll
    for (int b = 0; b < NB; ++b) mod[b * 6 * D + j] = acc[b] + b_ada[j];
}
__global__ void k_ssm_tables(const float* lam_re, const float* lam_im, const float* log_dt, const float* b_re, const float* b_im, float* tab) {
    const int i = blockIdx.x * blockDim.x + threadIdx.x; if (i >= NG * NST) return;
    ssm_table_item(i, lam_re, lam_im, log_dt, b_re, b_im, tab);
}
__global__ void k_norm_mod(const float* x, const float* gain, const float* mod, int sh_off, int sc_off, bf16* H) {
    const int row = blockIdx.x * (blockDim.x / 64) + (threadIdx.x >> 6), lane = threadIdx.x & 63; if (row >= T) return;
    norm_mod_row(row, lane, x, gain, mod, sh_off, sc_off, H);
}
template <class Epi> __global__ void k_gemm_naive(Epi e, int N, int K) {
    const int n = blockIdx.y * blockDim.x + threadIdx.x, m = blockIdx.x; if (n >= N) return;
    if (!e.active(m)) return;
    const bf16* a = e.arow(m); const bf16* b = e.brow(m, n);
    float acc = 0.f;
    for (int k = 0; k < K; k += 8) acc = dot8(*(const u32x4*)(a + k), *(const u32x4*)(b + k), acc);
    e.store(m, n, acc);
}
struct NEpiProj { const bf16* A; const bf16* Bt; const float* bias; bf16* O;
    __device__ bool active(int) const { return true; }
    __device__ const bf16* arow(int m) const { return A + (size_t)m * D; }
    __device__ const bf16* brow(int, int n) const { return Bt + (size_t)n * D; }
    __device__ void store(int m, int n, float acc) const { O[(size_t)m * DIN + n] = (bf16)f2bf(acc + bias[n]); } };
struct NEpiGlu { const bf16* A; const bf16* Bt; const float* bias; bf16* O;
    __device__ bool active(int) const { return true; }
    __device__ const bf16* arow(int m) const { return A + (size_t)m * DSSM; }
    __device__ const bf16* brow(int, int n) const { return Bt + (size_t)n * DSSM; }
    __device__ void store(int m, int n, float acc) const { const float g = bf2f(A[(size_t)m * DSSM + n]); O[(size_t)m * DSSM + n] = (bf16)f2bf(g * sigmoidf_(acc + bias[n])); } };
struct NEpiOut { const bf16* A; const bf16* Bt; const float* x; const float* mod; float* O;
    __device__ bool active(int) const { return true; }
    __device__ const bf16* arow(int m) const { return A + (size_t)m * D; }
    __device__ const bf16* brow(int, int n) const { return Bt + (size_t)n * D; }
    __device__ void store(int m, int n, float acc) const { const int b = m / S; O[(size_t)m * D + n] = x[(size_t)m * D + n] + mod[b * 6 * D + 2 * D + n] * acc; } };
struct NEpiGU { const bf16* H; const bf16* Wt; const float* bias; const int* tokrow; const int* tilee; bf16* ACT; };
struct NEpiDown { const bf16* ACT; const bf16* Wt; const float* bias; const float* wrow; const int* tilee; bf16* YS;
    __device__ bool active(int m) const { return (m >> 8) < tilee[0]; }
    __device__ const bf16* arow(int m) const { return ACT + (size_t)m * DFF; }
    __device__ const bf16* brow(int m, int n) const { const int e = tilee[64 + (m >> 8)]; return Wt + ((size_t)e * D + n) * DFF; }
    __device__ void store(int m, int n, float acc) const { const int e = tilee[64 + (m >> 8)]; YS[(size_t)m * D + n] = (bf16)f2bf((acc + bias[e * D + n]) * wrow[m]); } };
__global__ void k_moe_gu_naive(NEpiGU e) {
    const int j = blockIdx.y * blockDim.x + threadIdx.x, m = blockIdx.x;
    if ((m >> 8) >= e.tilee[0]) return;
    const int ex = e.tilee[64 + (m >> 8)], t = e.tokrow[m];
    const bf16* a = e.H + (size_t)t * D; const bf16* b0 = e.Wt + ((size_t)ex * 2 * DFF + gu_row(2 * j)) * D; const bf16* b1 = e.Wt + ((size_t)ex * 2 * DFF + gu_row(2 * j + 1)) * D;
    float g = 0.f, u = 0.f;
    for (int k = 0; k < D; k += 8) { const u32x4 av = *(const u32x4*)(a + k); g = dot8(av, *(const u32x4*)(b0 + k), g); u = dot8(av, *(const u32x4*)(b1 + k), u); }
    g += e.bias[ex * 2 * DFF + 2 * j]; u += e.bias[ex * 2 * DFF + 2 * j + 1];
    g = fminf(g, 7.0f); u = fminf(fmaxf(u, -7.0f), 7.0f);
    e.ACT[(size_t)m * DFF + j] = (bf16)f2bf((u + 1.0f) * (g * sigmoidf_(1.702f * g)));
}
__global__ void k_attn_scores(const bf16* PROJ, const float* qg, const float* kg, float* SC) { const int idx = blockIdx.x * blockDim.x + threadIdx.x; if (idx < T * NH) attn_scores_item(idx, PROJ, qg, kg, SC); }
__global__ void k_attn_out(const bf16* PROJ, const float* SC, const float* sinks, bf16* ATT) { const int idx = blockIdx.x * blockDim.x + threadIdx.x; if (idx < T * NH * HD) attn_out_item(idx, PROJ, SC, sinks, ATT); }
__global__ void k_ssm_scan(const bf16* PROJ, const float* tab, float* XST) { const int idx = blockIdx.x * blockDim.x + threadIdx.x; if (idx < NB * NG * NST) ssm_scan_item(idx, PROJ, tab, XST); }
__global__ void k_ssm_out(const bf16* PROJ, const float* XST, const float* c_re, const float* c_im, const float* d_skip, bf16* G) { const int idx = blockIdx.x * blockDim.x + threadIdx.x; if (idx < T * DSSM) ssm_out_item(idx, PROJ, XST, c_re, c_im, d_skip, G); }
__global__ void k_mixnorm(const bf16* ATT, const bf16* SSMG, const float* ga, const float* gs, bf16* MIXED) {
    const int row = blockIdx.x * (blockDim.x / 64) + (threadIdx.x >> 6), lane = threadIdx.x & 63; if (row >= T) return;
    mixnorm_row(row, lane, ATT, SSMG, ga, gs, MIXED);
}
__global__ void __launch_bounds__(512) k_norm2_router(const float* x1, const float* gain, const float* mod, const float* w_router, const float* b_router, bf16* H, int* tope, float* topw, int* hist) {
    extern __shared__ __attribute__((aligned(16))) unsigned char smem[];
    LAS float* wr = (LAS float*)smem; LAS int* lh = (LAS int*)((LAS unsigned char*)smem + 32 * 1024 * 4);
    const int tid = threadIdx.x;
    for (int i = tid; i < D * NE; i += 512) { const int c = i / NE, e = i % NE; wr[e * D + c] = w_router[i]; }
    if (tid < NE) lh[tid] = 0;
    __syncthreads();
    norm2_router_rows(blockIdx.x, tid >> 6, tid & 63, x1, gain, mod, b_router, wr, lh, (LAS float*)((LAS unsigned char*)smem + 32 * 1024 * 4 + 256), H, tope, topw);
    __syncthreads();
    if (tid < NE) hist[blockIdx.x * NE + tid] = lh[tid];
}
__global__ void __launch_bounds__(512) k_sort(const int* hist, const int* tope, const float* topw, int* tokrow, int* rowpair, float* wrow, int* tilee) {
    __shared__ int sm[1408];
    sort_block(blockIdx.x, threadIdx.x, (LAS int*)sm, hist, tope, topw, tokrow, rowpair, wrow, tilee);
}
__global__ void k_combine(float* out, const float* mod, const bf16* YS, const int* rowpair) {
    const int row = blockIdx.x * (blockDim.x / 64) + (threadIdx.x >> 6), lane = threadIdx.x & 63; if (row >= T) return;
    combine_row(row, lane, out, mod, YS, rowpair);
}

namespace pg8 {
constexpr int BM = 256, BK = 64, HALF = 128, HTB = HALF * BK * 2  , STAGE_BYTES = 8 * HTB, NXCD = 8, WGM = 8;
__host__ __device__ __forceinline__ int lds_byte(int r, int c) { const int st = (r >> 4) * 2 + (c >> 5), rr = r & 15, cc = c & 31, ob = rr * 64 + cc * 2; return st * 1024 + (ob ^ (((ob >> 9) & 1) << 5)); }
__host__ __device__ __forceinline__ void stage_rc(int b, int& R, int& C) { const int st = b / 1024, sb = b % 1024, swz = sb ^ (((sb >> 9) & 1) << 5); R = (st >> 1) * 16 + swz / 64; C = (st & 1) * 32 + (swz % 64) / 2; }
__host__ __device__ __forceinline__ int perm32(int rho) { const int n = rho >> 4, i = rho & 15; return 8 * (i >> 2) + 4 * n + (i & 3); }
struct Unit { int pm, pn; };
__device__ __forceinline__ bool order_next(int nM, int nN, int G, int c, int i, Unit& u) {
    const int nwg = nM * nN; const long L = (long)i * G + c; if (L >= nwg) return false;
    int wgid = (int)L; { const int q = nwg / NXCD, r = nwg % NXCD, xcd = wgid % NXCD, off = wgid / NXCD; wgid = (xcd < r ? xcd * (q + 1) : r * (q + 1) + (xcd - r) * q) + off; }
    const int nig = WGM * nN, gid = wgid / nig, fm = gid * WGM, gsz = (nM - fm) < WGM ? (nM - fm) : WGM;
    u.pm = fm + ((wgid % nig) % gsz); u.pn = (wgid % nig) / gsz; return true;
}
struct DenseOrder {
    const char* A; const char* Bt; int nM, nN, G, c; size_t tstep;
    __device__ __forceinline__ bool next(int i, Unit& u) const { return order_next(nM, nN, G, c, i, u); }
    __device__ __forceinline__ const char* a_base(const Unit& u) const { return A + (size_t)u.pm * tstep; }
    __device__ __forceinline__ const char* b_base(const Unit& u) const { return Bt + (size_t)u.pn * tstep; }
    __device__ __forceinline__ int a_row(int) const { return 0; }
    __device__ __forceinline__ int ka(int K) const { return K; }
    __device__ __forceinline__ size_t a_koff(int t) const { return (size_t)t * (BK * 2); }
};
struct MixOrder {
    const char* A; const char* Bt; int nM, nN, G, c; size_t delta;
    __device__ __forceinline__ bool next(int i, Unit& u) const { return order_next(nM, nN, G, c, i, u); }
    __device__ __forceinline__ const char* a_base(const Unit& u) const { return A + (size_t)u.pm * (256 * 512 * 2); }
    __device__ __forceinline__ const char* b_base(const Unit& u) const { return Bt + (size_t)u.pn * (256 * 1024 * 2); }
    __device__ __forceinline__ int a_row(int) const { return 0; }
    __device__ __forceinline__ int ka(int) const { return 512; }
    __device__ __forceinline__ size_t a_koff(int t) const { return (size_t)(t & 7) * (BK * 2) + (size_t)(t >> 3) * delta; }
};
struct MoeOrder {
    const char* A; const char* Bt; const int* tokrow; const LAS int* te; int nM, nN, G, c; size_t tstep, estride; const LAS int* cb = nullptr;
    __device__ __forceinline__ bool next(int i, Unit& u) const { return order_next(nM, nN, G, c, i, u); }
    __device__ __forceinline__ const char* a_base(const Unit& u) const { return A + (size_t)u.pm * tstep; }
    __device__ __forceinline__ const char* b_base(const Unit& u) const { return Bt + (size_t)__builtin_amdgcn_readfirstlane(te[u.pm]) * estride + (size_t)u.pn * tstep; }
    __device__ __forceinline__ int a_row(int r) const { if (FAST_SORT && cb) { const int e = te[r >> 8], rin = r - cb[32 + e]; return rin < cb[e] ? tokrow[(size_t)e * T + rin] : 0; } return tokrow[r]; }
    __device__ __forceinline__ int ka(int K) const { return K; }
    __device__ __forceinline__ size_t a_koff(int t) const { return (size_t)t * (BK * 2); }
};
__device__ __forceinline__ unsigned cvt_pk_bf16(float lo, float hi) { unsigned r; asm volatile("v_cvt_pk_bf16_f32 %0, %1, %2" : "=v"(r) : "v"(lo), "v"(hi)); return r; }

__device__ __forceinline__ void dma_row256(const float* src, LAS float* dst) { if (threadIdx.x < 64) __builtin_amdgcn_global_load_lds((const unsigned*)(src + 4 * threadIdx.x), (LAS unsigned*)dst, 16, 0, 0); }
struct EpiProj {
    static constexpr bool PERM = true, MIDK = false, BEGIN = true;
    bf16* O; int ldc; const float* bias; LAS float* tb;
    __device__ __forceinline__ void begin(const Unit& u, int ui) const { dma_row256(bias + u.pn * BM, tb + (ui & 1) * 512); }
    __device__ __forceinline__ void operator()(const f32x4 (&acc)[2][2][4][2], const Unit& u, int wr, int wc, int fr, int fq, int ui) const {
        const int row0 = u.pm * BM + wr * 64 + fr, col0 = u.pn * BM + wc * 32 + 8 * fq;
        f32x4 bv[2][2];
#pragma unroll
        for (int bj = 0; bj < 2; ++bj)
#pragma unroll
            for (int n = 0; n < 2; ++n) bv[bj][n] = *(const LAS f32x4*)(tb + (ui & 1) * 512 + wc * 32 + 8 * fq + bj * HALF + 4 * n);
#pragma unroll
        for (int ai = 0; ai < 2; ++ai)
#pragma unroll
            for (int m = 0; m < 4; ++m) { bf16* rowp = O + (size_t)(row0 + ai * HALF + m * 16) * ldc + col0;
#pragma unroll
                for (int bj = 0; bj < 2; ++bj) { const f32x4 v0 = acc[ai][bj][m][0] + bv[bj][0], v1 = acc[ai][bj][m][1] + bv[bj][1];
                    u32x4 w; w.x = cvt_pk_bf16(v0[0], v0[1]); w.y = cvt_pk_bf16(v0[2], v0[3]); w.z = cvt_pk_bf16(v1[0], v1[1]); w.w = cvt_pk_bf16(v1[2], v1[3]);
                    *(u32x4*)(rowp + bj * HALF) = w; } }
    }
};
struct EpiGlu {
    static constexpr bool PERM = true, MIDK = false, BEGIN = true;
    const bf16* Gin; bf16* O; const float* bias; float* SQ; LAS float* tb;
    __device__ __forceinline__ void begin(const Unit& u, int ui) const { dma_row256(bias + u.pn * BM, tb + (ui & 1) * 512); }
    __device__ __forceinline__ void operator()(const f32x4 (&acc)[2][2][4][2], const Unit& u, int wr, int wc, int fr, int fq, int ui) const {
        const int row0 = u.pm * BM + wr * 64 + fr, col0 = u.pn * BM + wc * 32 + 8 * fq;
        f32x4 bv[2][2];
#pragma unroll
        for (int bj = 0; bj < 2; ++bj)
#pragma unroll
            for (int n = 0; n < 2; ++n) bv[bj][n] = *(const LAS f32x4*)(tb + (ui & 1) * 512 + wc * 32 + 8 * fq + bj * HALF + 4 * n);
#pragma unroll
        for (int ai = 0; ai < 2; ++ai) {
            u32x4 gin[4][2];
#pragma unroll
            for (int m = 0; m < 4; ++m)
#pragma unroll
                for (int bj = 0; bj < 2; ++bj) gin[m][bj] = *(const u32x4*)(Gin + (size_t)(row0 + ai * HALF + m * 16) * DSSM + col0 + bj * HALF);
#pragma unroll
            for (int m = 0; m < 4; ++m) { const int row = row0 + ai * HALF + m * 16; const size_t off = (size_t)row * DSSM + col0; float sq = 0.f;
#pragma unroll
                for (int bj = 0; bj < 2; ++bj) { const f32x4 z0 = acc[ai][bj][m][0] + bv[bj][0], z1 = acc[ai][bj][m][1] + bv[bj][1];
                    const u32x4 g = gin[m][bj];
                    const float p0 = bflo(g.x) * sigmoidf_(z0[0]), p1 = bfhi(g.x) * sigmoidf_(z0[1]), p2 = bflo(g.y) * sigmoidf_(z0[2]), p3 = bfhi(g.y) * sigmoidf_(z0[3]);
                    const float p4 = bflo(g.z) * sigmoidf_(z1[0]), p5 = bfhi(g.z) * sigmoidf_(z1[1]), p6 = bflo(g.w) * sigmoidf_(z1[2]), p7 = bfhi(g.w) * sigmoidf_(z1[3]);
                    sq += ((p0 * p0 + p1 * p1) + (p2 * p2 + p3 * p3)) + ((p4 * p4 + p5 * p5) + (p6 * p6 + p7 * p7));
                    u32x4 w; w.x = cvt_pk_bf16(p0, p1); w.y = cvt_pk_bf16(p2, p3); w.z = cvt_pk_bf16(p4, p5); w.w = cvt_pk_bf16(p6, p7);
                    *(u32x4*)(O + off + bj * HALF) = w; }
                if (SQ) { sq += __shfl_xor(sq, 16); sq += __shfl_xor(sq, 32); if (fq == 0) SQ[(size_t)row * 8 + u.pn * 4 + wc] = sq; } } }
    }
};
struct EpiOut {
    static constexpr bool PERM = X1_DELTA != 0, MIDK = FUSE_MIXNORM != 0, BEGIN = true;
    const float* x; const float* mod; float* O; const float* ASQ; const float* SSQ; LAS float* tbl; LAS float* tb;
    __device__ __forceinline__ float row_sum8(const float* p, int row) const { const f32x4 a = *(const f32x4*)(p + (size_t)row * 8), b = *(const f32x4*)(p + (size_t)row * 8 + 4); return ((a.x + a.y) + (a.z + a.w)) + ((b.x + b.y) + (b.z + b.w)); }
    __device__ __forceinline__ void begin(const Unit& u, int ui) const {
        if (X1_DELTA) { const int b = (u.pm * BM) / S; dma_row256(mod + b * 6 * D + 2 * D + u.pn * BM, tb + (ui & 1) * 512); }
        if constexpr (!MIDK) return;
        const int r = threadIdx.x; if (r < BM) { const int row = u.pm * BM + r;
            const float ra = rsqrtf(row_sum8(ASQ, row) * (1.0f / DATT) + EPS), rs = rsqrtf(row_sum8(SSQ, row) * (1.0f / DSSM) + EPS);
            *(LAS f32x2*)(tbl + (ui & 1) * 512 + 2 * r) = (f32x2){ra / rs, rs}; }
    }
    __device__ __forceinline__ void mid(f32x4 (&acc)[2][2][4][2], int ui, int wr, int fr) const {
#pragma unroll
        for (int ai = 0; ai < 2; ++ai)
#pragma unroll
            for (int m = 0; m < 4; ++m) { const float rho = tbl[(ui & 1) * 512 + 2 * (wr * 64 + fr + ai * HALF + m * 16)];
#pragma unroll
                for (int bj = 0; bj < 2; ++bj)
#pragma unroll
                    for (int n = 0; n < 2; ++n) acc[ai][bj][m][n] = acc[ai][bj][m][n] * rho; }
    }
    __device__ __forceinline__ void operator()(const f32x4 (&acc)[2][2][4][2], const Unit& u, int wr, int wc, int fr, int fq, int ui = 0) const {
        const int b = (u.pm * BM) / S;
        if constexpr (X1_DELTA) {
            const int col0 = u.pn * BM + wc * 32 + 8 * fq;
            f32x4 gv[2][2];
#pragma unroll
            for (int bj = 0; bj < 2; ++bj)
#pragma unroll
                for (int n = 0; n < 2; ++n) gv[bj][n] = *(const LAS f32x4*)(tb + (ui & 1) * 512 + wc * 32 + 8 * fq + bj * HALF + 4 * n);
#pragma unroll
            for (int ai = 0; ai < 2; ++ai)
#pragma unroll
                for (int m = 0; m < 4; ++m) { const int lr = wr * 64 + fr + ai * HALF + m * 16; bf16* rowp = (bf16*)O + (size_t)(u.pm * BM + lr) * D + col0;
                    const float rs = MIDK ? tbl[(ui & 1) * 512 + 2 * lr + 1] : 1.0f;
#pragma unroll
                    for (int bj = 0; bj < 2; ++bj) { const f32x4 v0 = gv[bj][0] * (acc[ai][bj][m][0] * rs), v1 = gv[bj][1] * (acc[ai][bj][m][1] * rs);
                        u32x4 w; w.x = cvt_pk_bf16(v0[0], v0[1]); w.y = cvt_pk_bf16(v0[2], v0[3]); w.z = cvt_pk_bf16(v1[0], v1[1]); w.w = cvt_pk_bf16(v1[2], v1[3]);
                        *(u32x4*)(rowp + bj * HALF) = w; } }
        } else {
        const int row0 = u.pm * BM + wr * 64 + fr, col0 = u.pn * BM + wc * 32 + 4 * fq;
        f32x4 gv[2][2];
#pragma unroll
        for (int bj = 0; bj < 2; ++bj)
#pragma unroll
            for (int n = 0; n < 2; ++n) gv[bj][n] = *(const f32x4*)(mod + b * 6 * D + 2 * D + col0 + bj * HALF + n * 16);
#pragma unroll
        for (int ai = 0; ai < 2; ++ai)
#pragma unroll
            for (int m = 0; m < 4; ++m) { const int lr = wr * 64 + fr + ai * HALF + m * 16; const size_t off = (size_t)(u.pm * BM + lr) * D + col0;
                const float rs = MIDK ? tbl[(ui & 1) * 512 + 2 * lr + 1] : 1.0f;
#pragma unroll
                for (int bj = 0; bj < 2; ++bj)
#pragma unroll
                    for (int n = 0; n < 2; ++n) { const f32x4 xv = __builtin_nontemporal_load((const f32x4*)(x + off + bj * HALF + n * 16)); *(f32x4*)(O + off + bj * HALF + n * 16) = xv + gv[bj][n] * (acc[ai][bj][m][n] * rs); } }
        }
    }
};
template <bool OUT8> struct EpiGateUp {
    static constexpr bool PERM = true, MIDK = false, BEGIN = true;
    void* ACTp; const float* bias; const LAS int* te; float ascale; LAS float* tb;
    __device__ __forceinline__ void begin(const Unit& u, int ui) const { const int e = __builtin_amdgcn_readfirstlane(te[u.pm]); dma_row256(bias + (size_t)e * 2 * DFF + 2 * (u.pn * HALF), tb + (ui & 1) * 512); }
    __device__ __forceinline__ void operator()(const f32x4 (&acc)[2][2][4][2], const Unit& u, int wr, int wc, int fr, int fq, int ui) const {
        const int row0 = u.pm * BM + wr * 64 + fr, ac0 = u.pn * HALF + wc * 32 + 8 * fq;
        const LAS float* bp = tb + (ui & 1) * 512 + 2 * (wc * 32 + 8 * fq);
        const f32x4 b0 = *(const LAS f32x4*)bp, b1 = *(const LAS f32x4*)(bp + 4), b2 = *(const LAS f32x4*)(bp + 8), b3 = *(const LAS f32x4*)(bp + 12);
        const float bg[8] = {b0[0], b0[2], b1[0], b1[2], b2[0], b2[2], b3[0], b3[2]}, bu[8] = {b0[1], b0[3], b1[1], b1[3], b2[1], b2[3], b3[1], b3[3]};
        const f32x2 asc2 = {ascale, ascale}, zc2 = {-1.702f * 1.4426950408889634f, -1.702f * 1.4426950408889634f}, one2 = {1.0f, 1.0f}, os2 = {OUT8 ? A8_SCALE : 1.0f, OUT8 ? A8_SCALE : 1.0f};
#pragma unroll
        for (int ai = 0; ai < 2; ++ai)
#pragma unroll
            for (int m = 0; m < 4; ++m) { float a[8];
#pragma unroll
                for (int k = 0; k < 8; k += 2) {
                    f32x2 g = (f32x2){acc[ai][0][m][k >> 2][k & 3], acc[ai][0][m][k >> 2][(k & 3) + 1]} * asc2 + (f32x2){bg[k], bg[k + 1]};
                    f32x2 up = (f32x2){acc[ai][1][m][k >> 2][k & 3], acc[ai][1][m][k >> 2][(k & 3) + 1]} * asc2 + (f32x2){bu[k], bu[k + 1]};
                    g.x = fminf(g.x, 7.0f); g.y = fminf(g.y, 7.0f); up.x = __builtin_amdgcn_fmed3f(up.x, -7.0f, 7.0f); up.y = __builtin_amdgcn_fmed3f(up.y, -7.0f, 7.0f);
                    const f32x2 z = g * zc2; f32x2 ex; ex.x = __builtin_amdgcn_exp2f(z.x); ex.y = __builtin_amdgcn_exp2f(z.y);
                    const f32x2 dn = ex + one2; f32x2 sg; sg.x = __builtin_amdgcn_rcpf(dn.x); sg.y = __builtin_amdgcn_rcpf(dn.y);
                    const f32x2 r2 = (up * os2 + os2) * (g * sg); a[k] = r2.x; a[k + 1] = r2.y; }
                const size_t off = (size_t)(row0 + ai * HALF + m * 16) * DFF + ac0;
                if constexpr (OUT8) { u32x2 w; w.x = pk4_fp8(a[0], a[1], a[2], a[3]); w.y = pk4_fp8(a[4], a[5], a[6], a[7]); *(u32x2*)((unsigned char*)ACTp + off) = w; }
                else { u32x4 w; w.x = cvt_pk_bf16(a[0], a[1]); w.y = cvt_pk_bf16(a[2], a[3]); w.z = cvt_pk_bf16(a[4], a[5]); w.w = cvt_pk_bf16(a[6], a[7]); *(u32x4*)((bf16*)ACTp + off) = w; } }
    }
};
template <bool OUT8> struct EpiDown {
    static constexpr bool PERM = true, MIDK = false, BEGIN = true;
    void* YSp; const float* bias; const float* wrow; const LAS int* te; float ascale; const LAS int* cb; LAS float* tb;
    const float* zero;
    __device__ __forceinline__ void begin(const Unit& u, int ui) const { const int t = threadIdx.x, e = __builtin_amdgcn_readfirstlane(te[u.pm]);
        dma_row256(bias + (size_t)e * D + u.pn * BM, tb + (ui & 1) * 512);
        if (t >= 64 && t < 320) { const int w4 = __builtin_amdgcn_readfirstlane((t >> 6) - 1), r = t - 64, row = u.pm * BM + r; const float* src;
            if (FAST_SORT && cb) { const int rin = row - cb[32 + e]; src = rin < cb[e] ? wrow + (size_t)e * T + rin : zero; } else src = wrow + row;
            __builtin_amdgcn_global_load_lds((const unsigned*)src, (LAS unsigned*)(tb + (ui & 1) * 512 + 256 + 64 * w4), 4, 0, 0); } }
    __device__ __forceinline__ void operator()(const f32x4 (&acc)[2][2][4][2], const Unit& u, int wr, int wc, int fr, int fq, int ui) const {
        const int row0 = u.pm * BM + wr * 64 + fr, col0 = u.pn * BM + wc * 32 + 8 * fq;
        f32x4 bv[2][2];
#pragma unroll
        for (int bj = 0; bj < 2; ++bj)
#pragma unroll
            for (int n = 0; n < 2; ++n) bv[bj][n] = *(const LAS f32x4*)(tb + (ui & 1) * 512 + wc * 32 + 8 * fq + bj * HALF + 4 * n);
        float wts[2][4];
#pragma unroll
        for (int ai = 0; ai < 2; ++ai)
#pragma unroll
            for (int m = 0; m < 4; ++m) wts[ai][m] = tb[(ui & 1) * 512 + 256 + wr * 64 + fr + ai * HALF + m * 16];
#pragma unroll
        for (int ai = 0; ai < 2; ++ai)
#pragma unroll
            for (int m = 0; m < 4; ++m) { const int row = row0 + ai * HALF + m * 16; const float wt = wts[ai][m] * (OUT8 ? Y8_SCALE : 1.0f); const size_t off = (size_t)row * D + col0;
#pragma unroll
                for (int bj = 0; bj < 2; ++bj) { const f32x4 v0 = (acc[ai][bj][m][0] * ascale + bv[bj][0]) * wt, v1 = (acc[ai][bj][m][1] * ascale + bv[bj][1]) * wt;
                    if constexpr (OUT8) { u32x2 w; w.x = pk4_fp8(v0[0], v0[1], v0[2], v0[3]); w.y = pk4_fp8(v1[0], v1[1], v1[2], v1[3]); *(u32x2*)((unsigned char*)YSp + off + bj * HALF) = w; }
                    else { u32x4 w; w.x = cvt_pk_bf16(v0[0], v0[1]); w.y = cvt_pk_bf16(v0[2], v0[3]); w.z = cvt_pk_bf16(v1[0], v1[1]); w.w = cvt_pk_bf16(v1[2], v1[3]); *(u32x4*)((bf16*)YSp + off + bj * HALF) = w; } } }
    }
};

template <class Epi, class Sched, bool ALIGN_EPI, bool GATHER, bool FP8 = false>
__device__ __forceinline__ void gemm_phase(LAS unsigned char* lds, const int K, const Sched& S, const Epi& E) {
    const int tid = threadIdx.x, wid = __builtin_amdgcn_readfirstlane(tid >> 6), lane = tid & 63, wr = wid >> 2, wc = wid & 3, fr = lane & 15, fq = lane >> 4;
    const int nt = K / BK;
    int Rr[2], Cc[2]; unsigned voffA[2], voffB[2];
#pragma unroll
    for (int i = 0; i < 2; ++i) { int R, C; stage_rc(tid * 16 + i * 8192, R, C); const int Rb = Epi::PERM ? ((R & ~31) + perm32(R & 31)) : R;
        Rr[i] = R; Cc[i] = C; voffA[i] = (unsigned)(R * S.ka(K) + C) * 2u; voffB[i] = (unsigned)(Rb * K + C) * 2u; }
    const size_t kstep = (size_t)(BK * 2);
    const size_t hstep = (size_t)HALF * K * 2;
    const size_t hstepA = (size_t)HALF * S.ka(K) * 2;
    const unsigned ldsw = (unsigned)wid * 1024u;
    const int aoff = lds_byte(wr * 64 + fr, fq * 8), boff = lds_byte(wc * 32 + fr, fq * 8);
#define PG8_SA(b, h) (((b) * 2 + (h)) * HTB)
#define PG8_SB(b, h) ((4 + (b) * 2 + (h)) * HTB)
#define PG8_STAGE(bufoff, gbase, voff) do { _Pragma("unroll") for (int _i = 0; _i < 2; ++_i) \
        __builtin_amdgcn_global_load_lds((const unsigned*)((const char*)(gbase) + (voff)[_i]), (LAS unsigned*)(lds + (bufoff) + ldsw + _i * 8192), 16, 0, 0); } while (0)
#define PG8_STAGE_A(bufoff, ab, koff, h, g0, g1) do { if constexpr (GATHER) { if ((h) == 0) PG8_STAGE(bufoff, (ab) + (koff), g0); else PG8_STAGE(bufoff, (ab) + (koff), g1); } \
        else { PG8_STAGE(bufoff, (ab) + (koff) + (h) * hstepA, voffA); } } while (0)
#define PG8_LDA(dst, b, h) do { if constexpr (FP8) { _Pragma("unroll") for (int m = 0; m < 4; ++m) dst##8[m] = __builtin_shufflevector(*(const LAS i32x4*)(lds + PG8_SA(b, h) + aoff + m * 2048), *(const LAS i32x4*)(lds + PG8_SA(b, h) + aoff + m * 2048 + 1024), 0, 1, 2, 3, 4, 5, 6, 7); } \
        else { _Pragma("unroll") for (int m = 0; m < 4; ++m) _Pragma("unroll") for (int k = 0; k < 2; ++k) dst[m][k] = *(const LAS bf16x8*)(lds + PG8_SA(b, h) + aoff + m * 2048 + k * 1024); } } while (0)
#define PG8_LDB(dst, b, h) do { if constexpr (FP8) { _Pragma("unroll") for (int n = 0; n < 2; ++n) dst##8[n] = __builtin_shufflevector(*(const LAS i32x4*)(lds + PG8_SB(b, h) + boff + n * 2048), *(const LAS i32x4*)(lds + PG8_SB(b, h) + boff + n * 2048 + 1024), 0, 1, 2, 3, 4, 5, 6, 7); } \
        else { _Pragma("unroll") for (int n = 0; n < 2; ++n) _Pragma("unroll") for (int k = 0; k < 2; ++k) dst[n][k] = *(const LAS bf16x8*)(lds + PG8_SB(b, h) + boff + n * 2048 + k * 1024); } } while (0)
#define PG8_CAT8(x) __builtin_shufflevector(__builtin_bit_cast(i32x4, (x)[0]), __builtin_bit_cast(i32x4, (x)[1]), 0, 1, 2, 3, 4, 5, 6, 7)
#define PG8_MMA(ai, bj, At, Bt) do { __builtin_amdgcn_s_setprio(1); if constexpr (FP8) { _Pragma("unroll") for (int m = 0; m < 4; ++m) _Pragma("unroll") for (int n = 0; n < 2; ++n) \
        asm volatile("v_mfma_scale_f32_16x16x128_f8f6f4 %0, %1, %2, %0, %3, %3 op_sel_hi:[0,0,0]" : "+v"(acc[ai][bj][m][n]) : "v"(Bt##8[n]), "v"(At##8[m]), "v"(one8)); } \
      else { _Pragma("unroll") for (int m = 0; m < 4; ++m) _Pragma("unroll") for (int n = 0; n < 2; ++n) _Pragma("unroll") for (int k = 0; k < 2; ++k) \
        acc[ai][bj][m][n] = __builtin_amdgcn_mfma_f32_16x16x32_bf16(Bt[n][k], At[m][k], acc[ai][bj][m][n], 0, 0, 0); } __builtin_amdgcn_s_setprio(0); } while (0)
#define PG8_WAIT_V(n) asm volatile("s_waitcnt vmcnt(" #n ")" ::: "memory")
#define PG8_WAIT_L(n) asm volatile("s_waitcnt lgkmcnt(" #n ")" ::: "memory")
#define PG8_BAR __builtin_amdgcn_s_barrier()
#define PG8_SCHED __builtin_amdgcn_sched_barrier(0)
#define PG8_GOFF(U, o0, o1) do { if constexpr (GATHER) { _Pragma("unroll") for (int _i = 0; _i < 2; ++_i) { \
        o0[_i] = (unsigned)(S.a_row((U).pm * BM + Rr[_i]) * K + Cc[_i]) * 2u; o1[_i] = (unsigned)(S.a_row((U).pm * BM + HALF + Rr[_i]) * K + Cc[_i]) * 2u; } } } while (0)
    Unit cur, nxt; int ui = 0;
    if (!S.next(0, cur)) return;
    f32x4 acc[2][2][4][2];
#pragma unroll
    for (int a = 0; a < 2; ++a)
#pragma unroll
        for (int b = 0; b < 2; ++b)
#pragma unroll
            for (int m = 0; m < 4; ++m)
#pragma unroll
                for (int n = 0; n < 2; ++n) acc[a][b][m][n] = (f32x4){0.f, 0.f, 0.f, 0.f};
    const int one8 = 0x7f7f7f7f;
    bf16x8 At[4][2], B0[2][2], B1[2][2]; i32x8 At8[4], B08[2], B18[2];
    unsigned cg0[2] = {0u, 0u}, cg1[2] = {0u, 0u}, ng0[2] = {0u, 0u}, ng1[2] = {0u, 0u};
    const char* cA = GATHER ? S.A : S.a_base(cur); const char* cB = S.b_base(cur);
    PG8_GOFF(cur, cg0, cg1);
    PG8_STAGE(PG8_SB(0, 0), cB, voffB); PG8_STAGE(PG8_SB(0, 1), cB + hstep, voffB); PG8_STAGE_A(PG8_SA(0, 0), cA, 0, 0, cg0, cg1); PG8_STAGE_A(PG8_SA(0, 1), cA, 0, 1, cg0, cg1);
    if constexpr (Epi::BEGIN) E.begin(cur, 0);
    if (wr == 1) PG8_BAR;
    PG8_WAIT_V(2); PG8_BAR;
    PG8_STAGE(PG8_SB(1, 0), cB + kstep, voffB); PG8_STAGE_A(PG8_SA(1, 0), cA, S.a_koff(1), 0, cg0, cg1); PG8_STAGE(PG8_SB(1, 1), cB + hstep + kstep, voffB);
    PG8_WAIT_V(6); PG8_BAR;
    for (;;) {
        const bool has_next = S.next(ui + 1, nxt);
        const char* nA = has_next ? (GATHER ? S.A : S.a_base(nxt)) : cA; const char* nB = has_next ? S.b_base(nxt) : cB;
        if constexpr (GATHER) { if (has_next) { PG8_GOFF(nxt, ng0, ng1); } else { ng0[0] = cg0[0]; ng0[1] = cg0[1]; ng1[0] = cg1[0]; ng1[1] = cg1[1]; } }
#pragma unroll 1
        for (int t = 0; t < nt; t += 2) {
            const bool last = (t == nt - 2);
            if constexpr (Epi::MIDK) { if (t == nt / 2) E.mid(acc, ui, wr, fr); }
            const size_t k1 = S.a_koff(t + 1);
            const char* a2 = last ? nA : cA; const char* b2 = last ? nB : cB + (size_t)(t + 2) * kstep;
            const size_t k2 = last ? S.a_koff(0) : S.a_koff(t + 2), k3 = last ? S.a_koff(1) : S.a_koff(t + 3);
            const char* b3 = b2 + kstep;
            unsigned s0[2], s1[2];
            if constexpr (GATHER) { s0[0] = last ? ng0[0] : cg0[0]; s0[1] = last ? ng0[1] : cg0[1]; s1[0] = last ? ng1[0] : cg1[0]; s1[1] = last ? ng1[1] : cg1[1]; } else { s0[0] = s0[1] = s1[0] = s1[1] = 0u; }
            PG8_LDB(B0, 0, 0); PG8_LDB(B1, 0, 1); PG8_SCHED; PG8_LDA(At, 0, 0); PG8_STAGE_A(PG8_SA(1, 1), cA, k1, 1, cg0, cg1);
            PG8_WAIT_V(8); PG8_WAIT_L(0); PG8_BAR; PG8_MMA(0, 0, At, B0); PG8_MMA(0, 1, At, B1); PG8_BAR; PG8_SCHED;
            PG8_LDA(At, 0, 1); PG8_STAGE(PG8_SB(0, 0), b2, voffB); PG8_STAGE(PG8_SB(0, 1), b2 + hstep, voffB); PG8_STAGE_A(PG8_SA(0, 0), a2, k2, 0, s0, s1);
            PG8_WAIT_V(8); PG8_WAIT_L(0); PG8_BAR; PG8_MMA(1, 0, At, B0); PG8_MMA(1, 1, At, B1); PG8_BAR; PG8_SCHED;
            PG8_LDB(B0, 1, 0); PG8_LDB(B1, 1, 1); PG8_SCHED; PG8_LDA(At, 1, 0); PG8_STAGE_A(PG8_SA(0, 1), a2, k2, 1, s0, s1);
            PG8_WAIT_V(8); PG8_WAIT_L(0); PG8_BAR; PG8_MMA(0, 0, At, B0); PG8_MMA(0, 1, At, B1); PG8_BAR; PG8_SCHED;
            PG8_LDA(At, 1, 1); PG8_STAGE(PG8_SB(1, 0), b3, voffB); PG8_STAGE(PG8_SB(1, 1), b3 + hstep, voffB); PG8_STAGE_A(PG8_SA(1, 0), a2, k3, 0, s0, s1);
            PG8_WAIT_V(8); PG8_WAIT_L(0); PG8_BAR; PG8_MMA(1, 0, At, B0); PG8_MMA(1, 1, At, B1); PG8_BAR; PG8_SCHED;
        }
        if constexpr (ALIGN_EPI) { if (wr == 0) PG8_BAR; }
        if constexpr (FP8) asm volatile("s_nop 15\n\ts_nop 15" ::: "memory");
        E(acc, cur, wr, wc, fr, fq, ui);
        if (!has_next) break;
#pragma unroll
        for (int a = 0; a < 2; ++a)
#pragma unroll
            for (int b = 0; b < 2; ++b)
#pragma unroll
                for (int m = 0; m < 4; ++m)
#pragma unroll
                    for (int n = 0; n < 2; ++n) acc[a][b][m][n] = (f32x4){0.f, 0.f, 0.f, 0.f};
        cur = nxt; cA = nA; cB = nB; ++ui;
        if constexpr (Epi::BEGIN) E.begin(cur, ui);
        if constexpr (GATHER) { cg0[0] = ng0[0]; cg0[1] = ng0[1]; cg1[0] = ng1[0]; cg1[1] = ng1[1]; }
        if constexpr (ALIGN_EPI) { if (wr == 1) PG8_BAR; }
    }
    PG8_WAIT_V(0);
    if constexpr (!ALIGN_EPI) { if (wr == 0) PG8_BAR; }
    PG8_BAR;
#undef PG8_SA
#undef PG8_SB
#undef PG8_STAGE
#undef PG8_STAGE_A
#undef PG8_LDA
#undef PG8_LDB
#undef PG8_MMA
#undef PG8_CAT8
#undef PG8_WAIT_V
#undef PG8_WAIT_L
#undef PG8_BAR
#undef PG8_SCHED
#undef PG8_GOFF
}
}

#ifndef BAR_ACQUIRE
#define BAR_ACQUIRE 0
#endif
#define XB_TMO      128
#define XB_XCNT(j)  (256  + 64 * (j))
#define XB_XSUB(j)  (1280 + 64 * (j))
#define XB_XGEN(j)  (2304 + 64 * (j))
#define XB_TOP      3328
#define XB_TOPGEN   3392
#define XCD_BAR_WORDS 3456
#define XB_SPIN_CAP (1u << 18)

__device__ __forceinline__ unsigned xb_ld(unsigned* p)              { return __hip_atomic_load(p, __ATOMIC_RELAXED, __HIP_MEMORY_SCOPE_AGENT); }
__device__ __forceinline__ unsigned xb_add(unsigned* p, unsigned v) { return __hip_atomic_fetch_add(p, v, __ATOMIC_RELAXED, __HIP_MEMORY_SCOPE_AGENT); }
__device__ __forceinline__ unsigned xb_xcc_id() { return (unsigned)__builtin_amdgcn_s_getreg((3 << 11) | 20) & 0xFu; }
#define XB_SPIN(cond, bar) do { unsigned _sp = 0; while (cond) { __builtin_amdgcn_s_sleep(1); \
    if ((++_sp & 255u) == 0u) { if (xb_ld(&(bar)[XB_TMO])) break; if (_sp > XB_SPIN_CAP) { atomicAdd(&(bar)[XB_TMO], 1u); break; } } } } while (0)

struct XcdBarrier {
    unsigned* bar; unsigned x;
    volatile LAS unsigned* st;
};
__device__ __forceinline__ XcdBarrier xcd_barrier_post(unsigned* bar, volatile LAS unsigned* st) {
    XcdBarrier b; b.bar = bar; b.x = xb_xcc_id(); b.st = st;
    if (threadIdx.x == 0) (void)xb_add(&bar[XB_XCNT(b.x)], 1u);
    return b;
}
__device__ __forceinline__ void xcd_barrier_complete(unsigned* bar, unsigned x, unsigned& nloc, unsigned& nx) {
    const unsigned G = gridDim.x * gridDim.y * gridDim.z;
    unsigned sum, cnt, mine, sp = 0u;
    for (;;) {
        sum = 0u; cnt = 0u; mine = 0u;
#pragma unroll
        for (unsigned j = 0; j < 16; ++j) { const unsigned c = xb_ld(&bar[XB_XCNT(j)]); sum += c; cnt += (c > 0u) ? 1u : 0u; mine = (j == x) ? c : mine; }
        if (sum == G) break;
        __builtin_amdgcn_s_sleep(1);
        if ((++sp & 255u) == 0u) { if (xb_ld(&bar[XB_TMO])) break; if (sp > XB_SPIN_CAP) { atomicAdd(&bar[XB_TMO], 1u); break; } }
    }
    nloc = mine > 0u ? mine : 1u; nx = cnt > 0u ? cnt : 1u;
}
__device__ __forceinline__ void xcd_barrier(const XcdBarrier& b) {
    asm volatile("s_waitcnt vmcnt(0)" ::: "memory");
    __syncthreads();
    if (threadIdx.x == 0) {
        unsigned* bar = b.bar;
        __builtin_amdgcn_s_waitcnt(0);
        unsigned nloc = b.st[0], nx = b.st[1];
        if (nloc == 0u) { xcd_barrier_complete(bar, b.x, nloc, nx); b.st[0] = nloc; b.st[1] = nx; }
        const unsigned old = xb_add(&bar[XB_XSUB(b.x)], 1u);
        const unsigned gen = old / nloc;
        if (old + 1u == (gen + 1u) * nloc) {
            __builtin_amdgcn_fence(__ATOMIC_RELEASE, "agent");
            asm volatile("s_waitcnt vmcnt(0)" ::: "memory");
            const unsigned og = xb_add(&bar[XB_TOP], 1u);
            const unsigned tg = og / nx;
            if (og + 1u == (tg + 1u) * nx) xb_add(&bar[XB_TOPGEN], 1u);
            else XB_SPIN(xb_ld(&bar[XB_TOPGEN]) == tg, bar);
            if (BAR_ACQUIRE) __builtin_amdgcn_fence(__ATOMIC_ACQUIRE, "agent");
            xb_add(&bar[XB_XGEN(b.x)], 1u);
            if (BAR_ACQUIRE) asm volatile("s_waitcnt vmcnt(0)" ::: "memory");
        } else {
            XB_SPIN(xb_ld(&bar[XB_XGEN(b.x)]) == gen, bar);
            if (BAR_ACQUIRE) __builtin_amdgcn_fence(__ATOMIC_ACQUIRE, "agent");
            asm volatile("s_waitcnt vmcnt(0)" ::: "memory");
        }
    }
    __syncthreads();
}


__device__ __forceinline__ bf16x8 as_bf16x8(u32x4 v) { return __builtin_bit_cast(bf16x8, v); }
typedef __bf16 bf16x2_t __attribute__((ext_vector_type(2)));
__device__ __forceinline__ unsigned cvtpk(float lo, float hi) { const f32x2 v = {lo, hi}; const bf16x2_t b = __builtin_convertvector(v, bf16x2_t); return __builtin_bit_cast(unsigned, b); }
#define LDS_FENCE() asm volatile("s_waitcnt lgkmcnt(0)" ::: "memory")
__device__ __forceinline__ float fma_s(float a, float b, float c) { float r; asm("v_fma_f32 %0, %1, %2, %3" : "=v"(r) : "v"(a), "v"(b), "v"(c)); return r; }

constexpr int KN_PITCH = 144, VT_PITCH = 528;
constexpr int ATT_KN_OFF = 0, ATT_VT_OFF = 256 * KN_PITCH, ATT_LDS_BYTES = ATT_VT_OFF + 64 * VT_PITCH;
__device__ __forceinline__ void attn_unit(LAS unsigned char* lds, int unit, int tid, const bf16* PROJ, const float* qg, const float* kg, const float* sinks, bf16* ATT, float* ATTSQ = nullptr) {
    const int lane = tid & 63, wave = __builtin_amdgcn_readfirstlane(tid >> 6), l15 = lane & 15, q4 = lane >> 4;
    const int kvh = unit & 1, n = (unit >> 1) & 15, b = unit >> 5;
    const int tok0 = b * S + n * 128;
    {
        const int c = tid & 7; const f32x4 g0 = *(const f32x4*)(kg + 8 * c), g1 = *(const f32x4*)(kg + 8 * c + 4);
        const int vkey = tid & 255; const bool vvalid = (n > 0) || (vkey >= 128);
        u32x4 kraw[4], vraw[4];
#pragma unroll
        for (int j = 0; j < 4; ++j) { const int key = (tid >> 3) + 64 * j; const bool valid = (n > 0) || (key >= 128);
            kraw[j] = (u32x4){0u, 0u, 0u, 0u}; if (valid) kraw[j] = *(const u32x4*)(PROJ + (size_t)(tok0 - 128 + key) * DIN + KOFF + kvh * HD + 8 * c);
            vraw[j] = (u32x4){0u, 0u, 0u, 0u}; if (vvalid) vraw[j] = *(const u32x4*)(PROJ + (size_t)(tok0 - 128 + vkey) * DIN + VOFF + kvh * HD + 8 * ((tid >> 8) + 2 * j)); }
#pragma unroll
        for (int j = 0; j < 4; ++j) { const int key = (tid >> 3) + 64 * j; const u32x4 raw = kraw[j];
            const float f[8] = {bflo(raw.x), bfhi(raw.x), bflo(raw.y), bfhi(raw.y), bflo(raw.z), bfhi(raw.z), bflo(raw.w), bfhi(raw.w)};
            float ss = 0.f;
#pragma unroll
            for (int i = 0; i < 8; ++i) ss += f[i] * f[i];
            ss += __shfl_xor(ss, 1); ss += __shfl_xor(ss, 2); ss += __shfl_xor(ss, 4);
            const float r = rsqrtf(ss * (1.0f / HD) + EPS);
            u32x4 w; w.x = cvtpk(f[0] * r * g0.x, f[1] * r * g0.y); w.y = cvtpk(f[2] * r * g0.z, f[3] * r * g0.w); w.z = cvtpk(f[4] * r * g1.x, f[5] * r * g1.y); w.w = cvtpk(f[6] * r * g1.z, f[7] * r * g1.w);
            *(LAS u32x4*)(lds + ATT_KN_OFF + key * KN_PITCH + c * 16) = w; }
#pragma unroll
        for (int j = 0; j < 4; ++j) { const int cc = (tid >> 8) + 2 * j; const u32x4 raw = vraw[j];
            LAS unsigned short* vt = (LAS unsigned short*)(lds + ATT_VT_OFF + (8 * cc) * VT_PITCH + vkey * 2);
            vt[0 * (VT_PITCH / 2)] = (unsigned short)(raw.x & 0xffffu); vt[1 * (VT_PITCH / 2)] = (unsigned short)(raw.x >> 16);
            vt[2 * (VT_PITCH / 2)] = (unsigned short)(raw.y & 0xffffu); vt[3 * (VT_PITCH / 2)] = (unsigned short)(raw.y >> 16);
            vt[4 * (VT_PITCH / 2)] = (unsigned short)(raw.z & 0xffffu); vt[5 * (VT_PITCH / 2)] = (unsigned short)(raw.z >> 16);
            vt[6 * (VT_PITCH / 2)] = (unsigned short)(raw.w & 0xffffu); vt[7 * (VT_PITCH / 2)] = (unsigned short)(raw.w >> 16); }
    }
    __syncthreads();
    const int g = wave >> 1, h = kvh * 4 + g, qi0 = 64 * (wave & 1);
    const float sink = sinks[h];
    const f32x4 gq00 = *(const f32x4*)(qg + 8 * q4), gq01 = *(const f32x4*)(qg + 8 * q4 + 4), gq10 = *(const f32x4*)(qg + 32 + 8 * q4), gq11 = *(const f32x4*)(qg + 32 + 8 * q4 + 4);
    u32x4 qn0, qn1;
    { const size_t tq0 = (size_t)(tok0 + qi0 + l15); qn0 = *(const u32x4*)(PROJ + tq0 * DIN + QOFF + h * HD + 8 * q4); qn1 = *(const u32x4*)(PROJ + tq0 * DIN + QOFF + h * HD + 32 + 8 * q4); }
#pragma unroll 1
    for (int qt = 0; qt < 4; ++qt) {
        const int q0 = qi0 + 16 * qt, qi = q0 + l15; const size_t tq = (size_t)(tok0 + qi);
        const u32x4 r0 = qn0, r1 = qn1;
        { const size_t tqn = (size_t)(tok0 + qi0 + 16 * ((qt + 1) & 3) + l15); qn0 = *(const u32x4*)(PROJ + tqn * DIN + QOFF + h * HD + 8 * q4); qn1 = *(const u32x4*)(PROJ + tqn * DIN + QOFF + h * HD + 32 + 8 * q4); }
        const float f0[8] = {bflo(r0.x), bfhi(r0.x), bflo(r0.y), bfhi(r0.y), bflo(r0.z), bfhi(r0.z), bflo(r0.w), bfhi(r0.w)};
        const float f1[8] = {bflo(r1.x), bfhi(r1.x), bflo(r1.y), bfhi(r1.y), bflo(r1.z), bfhi(r1.z), bflo(r1.w), bfhi(r1.w)};
        float ss = 0.f;
#pragma unroll
        for (int i = 0; i < 8; ++i) ss += f0[i] * f0[i] + f1[i] * f1[i];
        ss += __shfl_xor(ss, 16); ss += __shfl_xor(ss, 32);
        const float rq = rsqrtf(ss * (1.0f / HD) + EPS) * 0.125f;
        u32x4 w0, w1;
        w0.x = cvtpk(f0[0] * rq * gq00.x, f0[1] * rq * gq00.y); w0.y = cvtpk(f0[2] * rq * gq00.z, f0[3] * rq * gq00.w); w0.z = cvtpk(f0[4] * rq * gq01.x, f0[5] * rq * gq01.y); w0.w = cvtpk(f0[6] * rq * gq01.z, f0[7] * rq * gq01.w);
        w1.x = cvtpk(f1[0] * rq * gq10.x, f1[1] * rq * gq10.y); w1.y = cvtpk(f1[2] * rq * gq10.z, f1[3] * rq * gq10.w); w1.z = cvtpk(f1[4] * rq * gq11.x, f1[5] * rq * gq11.y); w1.w = cvtpk(f1[6] * rq * gq11.z, f1[7] * rq * gq11.w);
        const bf16x8 bq0 = as_bf16x8(w0), bq1 = as_bf16x8(w1);
        const int kt0 = ((q0 >> 4) >> 1) * 2;
        f32x4 s[10];
#pragma unroll
        for (int i = 0; i < 10; ++i) { const LAS unsigned char* kp = lds + ATT_KN_OFF + (16 * (kt0 + i) + l15) * KN_PITCH + 16 * q4;
            const bf16x8 a0 = *(const LAS bf16x8*)kp, a1 = *(const LAS bf16x8*)(kp + 64);
            f32x4 z = (f32x4){0.f, 0.f, 0.f, 0.f};
            z = __builtin_amdgcn_mfma_f32_16x16x32_bf16(a0, bq0, z, 0, 0, 0); s[i] = __builtin_amdgcn_mfma_f32_16x16x32_bf16(a1, bq1, z, 0, 0, 0); }
        float m = sink;
#pragma unroll
        for (int i = 0; i < 10; ++i)
#pragma unroll
            for (int r = 0; r < 4; ++r) { const int kj = 16 * (kt0 + i) + 4 * q4 + r; const bool valid = (kj < 128) ? ((kj > qi) && (n > 0)) : ((kj - 128) <= qi);
                const float v = valid ? s[i][r] : -1e30f; s[i][r] = v; m = fmaxf(m, v); }
        m = fmaxf(m, __shfl_xor(m, 16)); m = fmaxf(m, __shfl_xor(m, 32));
        float den = 0.f;
#pragma unroll
        for (int i = 0; i < 10; ++i)
#pragma unroll
            for (int r = 0; r < 4; ++r) { const float p = __expf(s[i][r] - m); s[i][r] = p; den += p; }
        den += __shfl_xor(den, 16); den += __shfl_xor(den, 32); den += __expf(sink - m);
        f32x4 o[4];
#pragma unroll
        for (int dt = 0; dt < 4; ++dt) o[dt] = (f32x4){0.f, 0.f, 0.f, 0.f};
#pragma unroll
        for (int ks = 0; ks < 5; ++ks) { u32x4 pw; pw.x = cvtpk(s[2 * ks][0], s[2 * ks][1]); pw.y = cvtpk(s[2 * ks][2], s[2 * ks][3]); pw.z = cvtpk(s[2 * ks + 1][0], s[2 * ks + 1][1]); pw.w = cvtpk(s[2 * ks + 1][2], s[2 * ks + 1][3]);
            const bf16x8 bp = as_bf16x8(pw); const int keyb = 16 * kt0 + 32 * ks + 4 * q4;
#pragma unroll
            for (int dt = 0; dt < 4; ++dt) { const LAS unsigned char* vp = lds + ATT_VT_OFF + (16 * dt + l15) * VT_PITCH + keyb * 2;
                const u32x2 lo = *(const LAS u32x2*)vp, hi = *(const LAS u32x2*)(vp + 32);
                u32x4 av; av.x = lo.x; av.y = lo.y; av.z = hi.x; av.w = hi.y;
                o[dt] = __builtin_amdgcn_mfma_f32_16x16x32_bf16(as_bf16x8(av), bp, o[dt], 0, 0, 0); } }
        const float inv = 1.0f / den; float osq = 0.f;
#pragma unroll
        for (int dt = 0; dt < 4; ++dt) { const float o0 = o[dt][0] * inv, o1 = o[dt][1] * inv, o2 = o[dt][2] * inv, o3 = o[dt][3] * inv; osq += (o0 * o0 + o1 * o1) + (o2 * o2 + o3 * o3);
            u32x2 w; w.x = cvtpk(o0, o1); w.y = cvtpk(o2, o3);
            *(u32x2*)(ATT + tq * DATT + h * HD + 16 * dt + 4 * q4) = w; }
        if (ATTSQ) { osq += __shfl_xor(osq, 16); osq += __shfl_xor(osq, 32); if (q4 == 0) ATTSQ[tq * NH + h] = osq; }
    }
    __syncthreads();
}


__device__ __forceinline__ void ssm_apow_item(int i, const float* lam_re, const float* lam_im, const float* log_dt, unsigned char* APOW) {
    const int lane = i & 63, f = (i >> 6) & 63, g = i >> 12, ks = f & 7, rt = f >> 3, st = rt >> 1, c = rt & 1, fr = lane & 15, fq = lane >> 4, p = 16 * st + fr;
    const float dt = expf(log_dt[g]), lrd = lam_re[g * NST + p] * dt, lid = lam_im[g * NST + p] * dt;
    float v[8];
#pragma unroll
    for (int j = 0; j < 8; ++j) { const int t = 32 * ks + 16 * (j >> 2) + 4 * fq + (j & 3); const float k = (float)(255 - t), m = __expf(lrd * k), a = lid * k; v[j] = m * (c ? __sinf(a) : __cosf(a)); }
    u32x4 w; w.x = cvtpk(v[0], v[1]); w.y = cvtpk(v[2], v[3]); w.z = cvtpk(v[4], v[5]); w.w = cvtpk(v[6], v[7]);
    *(u32x4*)(APOW + (size_t)i * 16) = w;
}
struct Tr8 { const float* src; unsigned char* dst; int N, K, n0, k0, isgu, pad; };
__device__ __forceinline__ void tr8_setup(Tr8& t, const float* W, int K, int N, unsigned char* WT, int item, int lane, int isgu) {
    const int nblk = N / 32, kb = item / nblk, nb = item % nblk, q = lane & 7, o = lane >> 3;
    t.k0 = 128 * kb + 16 * o; t.n0 = 32 * nb + 4 * q; t.N = N; t.K = K; t.isgu = isgu; t.src = W + (size_t)t.k0 * N + t.n0; t.dst = WT; t.pad = 0;
}
__device__ __forceinline__ void tr8_load(const Tr8& t, f32x4 (&v)[16]) {
#pragma unroll
    for (int j = 0; j < 16; ++j) v[j] = __builtin_nontemporal_load((const f32x4*)(t.src + (size_t)j * t.N));
}
__device__ __forceinline__ void tr8_store(const Tr8& t, const f32x4 (&v)[16]) {
#pragma unroll
    for (int i = 0; i < 4; ++i) { const int nr = t.isgu ? gu_row(t.n0 + i) : (t.n0 + i);
        u32x4 a; a.x = pk4_fp8(v[0][i] * W8_SCALE, v[1][i] * W8_SCALE, v[2][i] * W8_SCALE, v[3][i] * W8_SCALE); a.y = pk4_fp8(v[4][i] * W8_SCALE, v[5][i] * W8_SCALE, v[6][i] * W8_SCALE, v[7][i] * W8_SCALE);
        a.z = pk4_fp8(v[8][i] * W8_SCALE, v[9][i] * W8_SCALE, v[10][i] * W8_SCALE, v[11][i] * W8_SCALE); a.w = pk4_fp8(v[12][i] * W8_SCALE, v[13][i] * W8_SCALE, v[14][i] * W8_SCALE, v[15][i] * W8_SCALE);
        __builtin_nontemporal_store(a, (u32x4*)(t.dst + (size_t)nr * t.K + t.k0)); }
}
struct ConvStream { const float* w_gu; const float* w_dn; unsigned char* wt_gu; unsigned char* wt_dn; int gu_first, n_gu, n_dn, stride; };

constexpr int SSM_BU_PITCH = 132, SSM_BU_BYTES = 16 * SSM_BU_PITCH * 4, SSM_X_PITCH = 272, SSM_WAVE_BYTES = SSM_BU_BYTES + 16 * SSM_X_PITCH, SSM_XEND_OFF = 8 * SSM_WAVE_BYTES, SSM_LDS_BYTES = SSM_XEND_OFF + 8 * 64 * 8;
__device__ __forceinline__ void ssm_unit(LAS unsigned char* lds, int unit, int tid, const bf16* PROJ, const float* tab, const float* c_re, const float* c_im, const float* d_skip, bf16* Gout, const bool has_cs, const ConvStream cs, const unsigned char* APOW = nullptr) {
    const int lane = tid & 63, wave = __builtin_amdgcn_readfirstlane(tid >> 6), l15 = lane & 15, q4 = lane >> 4;
    const int g = unit & 31, b = unit >> 5;
    if constexpr (SSM_MFMA_CARRY && !P3_CONV) {
        const unsigned char* gsrc = APOW + (size_t)g * 65536 + (size_t)wave * 8192 + lane * 16;
#pragma unroll
        for (int c4 = 0; c4 < 2; ++c4) { const unsigned* gp = (const unsigned*)(gsrc + c4 * 4096); LAS unsigned* lp = (LAS unsigned*)(lds + wave * 8192 + c4 * 4096);
            __builtin_amdgcn_global_load_lds(gp, lp, 16, 0, 0); __builtin_amdgcn_global_load_lds(gp, lp, 16, 1024, 0); __builtin_amdgcn_global_load_lds(gp, lp, 16, 2048, 0); __builtin_amdgcn_global_load_lds(gp, lp, 16, 3072, 0); } }
    Tr8 ct; ct.src = nullptr; ct.dst = nullptr; ct.N = ct.K = ct.n0 = ct.k0 = ct.isgu = ct.pad = 0; f32x4 cv[16]; bool cpend = false; int cq = unit * 8 + wave;
#pragma unroll
    for (int j = 0; j < 16; ++j) cv[j] = (f32x4){0.f, 0.f, 0.f, 0.f};
#define SSM_CONV_STEP() do { if (has_cs) { if (cpend) tr8_store(ct, cv); \
        constexpr int IGU = (D / 128) * (2 * DFF / 32), IDN = (DFF / 128) * (D / 32); cpend = cq < cs.n_gu + cs.n_dn; \
        { const bool isgu = cq < cs.n_gu || !cpend; const int r = !cpend ? 0 : (isgu ? cs.gu_first + cq : cq - cs.n_gu), e = r / (isgu ? IGU : IDN), it = r % (isgu ? IGU : IDN); \
          if (isgu) tr8_setup(ct, cs.w_gu + (size_t)e * D * 2 * DFF, D, 2 * DFF, cs.wt_gu + (size_t)e * 2 * DFF * D, it, lane, 1); \
          else tr8_setup(ct, cs.w_dn + (size_t)e * DFF * D, DFF, D, cs.wt_dn + (size_t)e * D * DFF, it, lane, 0); } \
        tr8_load(ct, cv); cq += cs.stride; } } while (0)
    const float* tg = tab + (size_t)g * SSMT_STRIDE;
    const float ar = tg[ST_AR + lane], ai = tg[ST_AI + lane], nai = -ai;
    bf16x8 bb[8];
#define SSM_SETUP_BB() do { _Pragma("unroll") for (int nt = 0; nt < 8; ++nt) { u32x4 w = (u32x4){0u, 0u, 0u, 0u}; \
        if (q4 < 2) { const int p = 8 * nt + (l15 >> 1); const float* src = tg + ((l15 & 1) ? ST_BI : ST_BR) + p * SG + 8 * q4; const f32x4 v0 = *(const f32x4*)src, v1 = *(const f32x4*)(src + 4); \
            w.x = cvtpk(v0.x, v0.y); w.y = cvtpk(v0.z, v0.w); w.z = cvtpk(v1.x, v1.y); w.w = cvtpk(v1.z, v1.w); } \
        bb[nt] = as_bf16x8(w); } } while (0)
    if constexpr (!(SSM_MFMA_CARRY && !P3_CONV)) SSM_SETUP_BB();
    bf16x8 cm[4];
#pragma unroll
    for (int ks = 0; ks < 4; ++ks) { const int pb = 16 * ks + 4 * q4; const f32x4 cr = *(const f32x4*)(c_re + ((size_t)g * SG + l15) * NST + pb), ci = *(const f32x4*)(c_im + ((size_t)g * SG + l15) * NST + pb);
        u32x4 w; w.x = cvtpk(cr.x, -ci.x); w.y = cvtpk(cr.y, -ci.y); w.z = cvtpk(cr.z, -ci.z); w.w = cvtpk(cr.w, -ci.w); cm[ks] = as_bf16x8(w); }
    LAS float* BU = (LAS float*)(lds + wave * SSM_WAVE_BYTES); LAS unsigned char* XT = lds + wave * SSM_WAVE_BYTES + SSM_BU_BYTES;
    LAS f32x2* xend = (LAS f32x2*)(lds + SSM_XEND_OFF);
    const bf16* ubase = PROJ + (size_t)(b * S) * DIN + UOFF + g * SG;
    const int tseg = 256 * wave;
    float xr = 0.f, xi = 0.f;
#define SSM_LOAD_U(dst, t0) do { dst = (u32x4){0u, 0u, 0u, 0u}; if (q4 < 2) dst = *(const u32x4*)(ubase + (size_t)((t0) + l15) * DIN + 8 * q4); } while (0)
#define SSM_BU_TILE(araw) do { const bf16x8 afr = as_bf16x8(araw); \
        _Pragma("unroll") for (int nt = 0; nt < 8; ++nt) { const f32x4 d = __builtin_amdgcn_mfma_f32_16x16x32_bf16(afr, bb[nt], (f32x4){0.f, 0.f, 0.f, 0.f}, 0, 0, 0); \
            _Pragma("unroll") for (int r = 0; r < 4; ++r) BU[(4 * q4 + r) * SSM_BU_PITCH + 16 * nt + l15] = d[r]; } LDS_FENCE(); } while (0)
    u32x4 ucur, unext, unn; SSM_LOAD_U(ucur, tseg); SSM_LOAD_U(unext, tseg + 16);
    if constexpr (SSM_MFMA_CARRY && !P3_CONV) {
        u32x4 idw = (u32x4){0u, 0u, 0u, 0u};
        { const int m = l15 - 8 * q4; const unsigned one = (m & 1) ? 0x3F800000u : 0x00003F80u;
          if (q4 < 2 && m >= 0 && m < 8) { idw.x = (m >> 1) == 0 ? one : 0u; idw.y = (m >> 1) == 1 ? one : 0u; idw.z = (m >> 1) == 2 ? one : 0u; idw.w = (m >> 1) == 3 ? one : 0u; } }
        const bf16x8 ident = as_bf16x8(idw);
        f32x4 V[8]; u32x4 na, nb;
#pragma unroll
        for (int rt = 0; rt < 8; ++rt) V[rt] = (f32x4){0.f, 0.f, 0.f, 0.f};
        asm volatile("s_waitcnt vmcnt(0)" ::: "memory");
        __syncthreads();
#pragma unroll 2
        for (int ks = 0; ks < 8; ++ks) {
            SSM_LOAD_U(na, tseg + 16 * ((2 * ks + 2) & 15)); SSM_LOAD_U(nb, tseg + 16 * ((2 * ks + 3) & 15));
            u32x4 afc[8];
#pragma unroll
            for (int rt = 0; rt < 8; ++rt) afc[rt] = *(const LAS u32x4*)(lds + (rt * 8 + ks) * 1024 + lane * 16);
            const f32x4 d0 = __builtin_amdgcn_mfma_f32_16x16x32_bf16(as_bf16x8(ucur), ident, (f32x4){0.f, 0.f, 0.f, 0.f}, 0, 0, 0), d1 = __builtin_amdgcn_mfma_f32_16x16x32_bf16(as_bf16x8(unext), ident, (f32x4){0.f, 0.f, 0.f, 0.f}, 0, 0, 0);
            u32x4 utw; utw.x = cvtpk(d0[0], d0[1]); utw.y = cvtpk(d0[2], d0[3]); utw.z = cvtpk(d1[0], d1[1]); utw.w = cvtpk(d1[2], d1[3]);
            const bf16x8 ut = as_bf16x8(utw);
#pragma unroll
            for (int rt = 0; rt < 8; ++rt) V[rt] = __builtin_amdgcn_mfma_f32_16x16x32_bf16(as_bf16x8(afc[rt]), ut, V[rt], 0, 0, 0);
            ucur = na; unext = nb; }
        __syncthreads();
        float bre[4][4], bim[4][4];
#pragma unroll
        for (int st = 0; st < 4; ++st)
#pragma unroll
            for (int i = 0; i < 4; ++i) { const int p = 16 * st + 4 * q4 + i; bre[st][i] = bf2f(f2bf(tg[ST_BR + p * SG + l15])); bim[st][i] = bf2f(f2bf(tg[ST_BI + p * SG + l15])); }
        LAS f32x2* PP = (LAS f32x2*)(lds + wave * SSM_WAVE_BYTES);
#pragma unroll
        for (int st = 0; st < 4; ++st)
#pragma unroll
            for (int i = 0; i < 4; ++i) { const float vr = V[2 * st][i], vi = V[2 * st + 1][i], br = bre[st][i], bi = bim[st][i];
                PP[(16 * st + 4 * q4 + i) * 18 + l15] = (f32x2){br * vr - bi * vi, br * vi + bi * vr}; }
        LDS_FENCE();
        { float sr = 0.f, si = 0.f;
#pragma unroll
          for (int q = 0; q < 8; ++q) { const f32x4 v = *(const LAS f32x4*)(PP + lane * 18 + 2 * q); sr += v.x + v.z; si += v.y + v.w; }
          xr = sr; xi = si; }
        LDS_FENCE();
    } else {
#pragma unroll 1
    for (int tile4 = 0; tile4 < 16; tile4 += 4) {
#pragma unroll
      for (int ti = 0; ti < 4; ++ti) { const int tile = tile4 + ti; SSM_LOAD_U(unn, tseg + 16 * ((tile + 2) & 15)); if (ti == 0) SSM_CONV_STEP(); SSM_BU_TILE(ucur); ucur = unext; unext = unn;
#pragma unroll
        for (int tt = 0; tt < 16; ++tt) { const f32x2 bu = *(const LAS f32x2*)(BU + tt * SSM_BU_PITCH + 2 * lane); const float nr = fma_s(ar, xr, fma_s(nai, xi, bu.x)), ni = fma_s(ar, xi, fma_s(ai, xr, bu.y)); xr = nr; xi = ni; }
        LDS_FENCE(); } }
    }
    xend[wave * 64 + lane] = (f32x2){xr, xi};
    __syncthreads();
    { float pr = ar, pi = ai;
#pragma unroll
      for (int i = 0; i < 8; ++i) { const float nr = pr * pr - pi * pi, ni = 2.0f * pr * pi; pr = nr; pi = ni; }
      xr = 0.f; xi = 0.f;
      for (int w2 = 0; w2 < wave; ++w2) { const f32x2 e = xend[w2 * 64 + lane]; const float npi = -pi; const float nr = fma_s(pr, xr, fma_s(npi, xi, e.x)), ni = fma_s(pr, xi, fma_s(pi, xr, e.y)); xr = nr; xi = ni; } }
    const f32x4 dsk = *(const f32x4*)(d_skip + g * SG + 4 * q4);
    if constexpr (SSM_MFMA_CARRY && !P3_CONV) SSM_SETUP_BB();
    u32x2 uucur = *(const u32x2*)(ubase + (size_t)(tseg + l15) * DIN + 4 * q4), uunext = *(const u32x2*)(ubase + (size_t)(tseg + 16 + l15) * DIN + 4 * q4), uunn;
#pragma unroll 1
    for (int tile4 = 0; tile4 < 16; tile4 += 4) {
#pragma unroll
      for (int ti = 0; ti < 4; ++ti) { const int tile = tile4 + ti; const int t0 = tseg + 16 * tile; SSM_LOAD_U(unn, tseg + 16 * ((tile + 2) & 15)); uunn = *(const u32x2*)(ubase + (size_t)(tseg + 16 * ((tile + 2) & 15) + l15) * DIN + 4 * q4); if (ti == 0) SSM_CONV_STEP(); SSM_BU_TILE(ucur); ucur = unext; unext = unn;
        f32x2 buv[16];
#pragma unroll
        for (int tt = 0; tt < 16; ++tt) buv[tt] = *(const LAS f32x2*)(BU + tt * SSM_BU_PITCH + 2 * lane);
#pragma unroll
        for (int tt = 0; tt < 16; ++tt) { const f32x2 bu = buv[tt]; const float nr = fma_s(ar, xr, fma_s(nai, xi, bu.x)), ni = fma_s(ar, xi, fma_s(ai, xr, bu.y)); xr = nr; xi = ni;
            *(LAS unsigned*)(XT + tt * SSM_X_PITCH + 4 * lane) = cvtpk(xr, xi); }
        LDS_FENCE();
        f32x4 y = (f32x4){0.f, 0.f, 0.f, 0.f};
#pragma unroll
        for (int ks = 0; ks < 4; ++ks) { const bf16x8 bx = *(const LAS bf16x8*)(XT + l15 * SSM_X_PITCH + (32 * ks + 8 * q4) * 2); y = __builtin_amdgcn_mfma_f32_16x16x32_bf16(cm[ks], bx, y, 0, 0, 0); }
        const size_t t = (size_t)(t0 + l15); const u32x2 uu = uucur; uucur = uunext; uunext = uunn;
        const float y0 = gelu_tanh(y[0] + dsk.x * bflo(uu.x)), y1 = gelu_tanh(y[1] + dsk.y * bfhi(uu.x)), y2 = gelu_tanh(y[2] + dsk.z * bflo(uu.y)), y3 = gelu_tanh(y[3] + dsk.w * bfhi(uu.y));
        u32x2 w; w.x = cvtpk(y0, y1); w.y = cvtpk(y2, y3);
        *(u32x2*)(Gout + ((size_t)(b * S) + t) * DSSM + g * SG + 4 * q4) = w;
        LDS_FENCE(); } }
#undef SSM_BU_TILE
#undef SSM_SETUP_BB
#undef SSM_LOAD_U
#undef SSM_CONV_STEP
    if (has_cs && cpend) tr8_store(ct, cv);
    __syncthreads();
}

constexpr int NWAVES = 8;
constexpr int RING_OFF = 0, RING_BYTES = 131072;
constexpr int LDSCTL_OFF = RING_BYTES;
constexpr int MISC_OFF = LDSCTL_OFF + 320;
constexpr int LH_OFF = LDSCTL_OFF + 512;
constexpr int SORT_OFF = RING_OFF;
constexpr int RSCR_OFF = LDSCTL_OFF + 8192;
constexpr int TE_OFF = LDSCTL_OFF + 4096;
constexpr int LDS_BYTES = 147456;
#define LDS_WAIT() asm volatile("s_waitcnt lgkmcnt(0)" ::: "memory")
#ifndef DEFER_P4_N
#define DEFER_P4_N 4
#endif
#ifndef DEFER_P2_N
#define DEFER_P2_N 5
#endif
#ifndef DN_DEFER_P9_N
#define DN_DEFER_P9_N 3072
#endif
constexpr int DN_DEFER_P9 = (MOE_FP8_GU && MOE_FP8_DN) ? DN_DEFER_P9_N : 0;
constexpr int DEFER_P2_PER_WAVE = MOE_FP8_GU ? DEFER_P2_N : 0, DEFER_P4_PER_WAVE = MOE_FP8_GU ? DEFER_P4_N : 0;
#ifndef P2_RESHAPE
#define P2_RESHAPE 1
#endif
#ifndef P2_CONV_N
#define P2_CONV_N 10
#endif
constexpr int P2_GEMM_WGS = 160;
constexpr int GU_DEFER_P2 = (P2_RESHAPE && MOE_FP8_GU) ? (256 - P2_GEMM_WGS) * 8 * P2_CONV_N : 192 * 8 * DEFER_P2_PER_WAVE, GU_DEFER_P4 = 128 * 8 * DEFER_P4_PER_WAVE, GU_DEFER = GU_DEFER_P2 + GU_DEFER_P4;
enum Phase { P_PRO = 0, P_NORM1, P_INPROJ, P_MIX_A, P_MIX_B, P_GLU, P_MIXNORM, P_OUTPROJ, P_ROUTER, P_SORT, P_GATEUP, P_DOWN, P_COMBINE, P_COUNT };

__device__ __forceinline__ void router_image_item(int i, const float* w_router, unsigned char* WRI) {
    const int lane = i & 63, rest = i >> 6, hl = rest & 1, nt = (rest >> 1) & 1, ks = (rest >> 2) & 3, w = rest >> 4, fr = lane & 15, fq = lane >> 4;
    const float* src = w_router + (size_t)(128 * w + 32 * ks + 8 * fq) * NE + 16 * nt + fr;
    float v[8];
#pragma unroll
    for (int j = 0; j < 8; ++j) v[j] = src[j * NE];
    u32x4 p;
#pragma unroll
    for (int j = 0; j < 4; ++j) { float a = v[2 * j], b = v[2 * j + 1]; unsigned hi = cvtpk(a, b); if (hl) { a -= bflo(hi); b -= bfhi(hi); hi = cvtpk(a, b); } p[j] = hi; }
    *(u32x4*)(WRI + (size_t)i * 16) = p;
}
__device__ __forceinline__ void router_block_mfma(LAS unsigned char* lds, int blk, int tid, int wave, int lane, const float* x1, const float* gain, const float* mod, const float* b_router,
                                                  const unsigned char* WRI, LAS int* lh, unsigned char* H8, int* tope, float* topw, const bf16* delta = nullptr, int* cnt = nullptr, int* toke = nullptr, float* wrowe = nullptr, int* paire = nullptr, bf16* x1b = nullptr) {
    asm volatile("" : "+v"(lane), "+v"(tid));
    const int b = (blk * 64) / S, fr = lane & 15, fq = lane >> 4;
    LAS unsigned char* Wl = lds + RING_OFF + wave * 16384;
    LAS float* gsh = (LAS float*)(lds + RSCR_OFF);
    LAS float* ssqx = (LAS float*)(lds + TE_OFF);
    LAS int* sel_e = (LAS int*)(lds + TE_OFF + 2048);
    LAS float* sel_v = (LAS float*)(lds + TE_OFF + 3072);
    LAS float* lg = (LAS float*)(lds + RING_OFF + 8192);
    { const unsigned char* gsrc = WRI + (size_t)wave * 16384 + lane * 16;
#pragma unroll
      for (int c4 = 0; c4 < 4; ++c4) { const unsigned* gp = (const unsigned*)(gsrc + c4 * 4096); LAS unsigned* lp = (LAS unsigned*)(Wl + c4 * 4096);
          __builtin_amdgcn_global_load_lds(gp, lp, 16, 0, 0); __builtin_amdgcn_global_load_lds(gp, lp, 16, 1024, 0); __builtin_amdgcn_global_load_lds(gp, lp, 16, 2048, 0); __builtin_amdgcn_global_load_lds(gp, lp, 16, 3072, 0); } }
    f32x4 xv[4][4][2];
    const float* xb = x1 + (size_t)(blk * 64 + fr) * D + 128 * wave + 8 * fq;
#pragma unroll
    for (int m = 0; m < 4; ++m)
#pragma unroll
        for (int ks = 0; ks < 4; ++ks) { xv[m][ks][0] = *(const f32x4*)(xb + (size_t)(16 * m) * D + 32 * ks); xv[m][ks][1] = *(const f32x4*)(xb + (size_t)(16 * m) * D + 32 * ks + 4); }
    if (delta) {
        const bf16* db = delta + (size_t)(blk * 64 + fr) * D + 128 * wave + 8 * fq; u32x4 dv[4][4];
#pragma unroll
        for (int m = 0; m < 4; ++m)
#pragma unroll
            for (int ks = 0; ks < 4; ++ks) dv[m][ks] = *(const u32x4*)(db + (size_t)(16 * m) * D + 32 * ks);
#pragma unroll
        for (int m = 0; m < 4; ++m)
#pragma unroll
            for (int ks = 0; ks < 4; ++ks) { const u32x4 d = dv[m][ks];
                xv[m][ks][0] += (f32x4){bflo(d.x), bfhi(d.x), bflo(d.y), bfhi(d.y)}; xv[m][ks][1] += (f32x4){bflo(d.z), bfhi(d.z), bflo(d.w), bfhi(d.w)}; } }
    if (x1b) { bf16* xo = x1b + (size_t)(blk * 64 + fr) * D + 128 * wave + 8 * fq;
#pragma unroll
        for (int m = 0; m < 4; ++m)
#pragma unroll
            for (int ks = 0; ks < 4; ++ks) { const f32x4 a = xv[m][ks][0], c2 = xv[m][ks][1]; u32x4 w; w.x = cvtpk(a.x, a.y); w.y = cvtpk(a.z, a.w); w.z = cvtpk(c2.x, c2.y); w.w = cvtpk(c2.z, c2.w);
                *(u32x4*)(xo + (size_t)(16 * m) * D + 32 * ks) = w; } }
    if (lane < 32) { const int c = 128 * wave + 4 * lane; const f32x4 g = *(const f32x4*)(gain + c), sc = *(const f32x4*)(mod + b * 6 * D + 4 * D + c);
        *(LAS f32x4*)(gsh + c) = g * (1.0f + sc); *(LAS f32x4*)(gsh + 1024 + c) = *(const f32x4*)(mod + b * 6 * D + 3 * D + c); }
    float ss[4];
#pragma unroll
    for (int m = 0; m < 4; ++m) { float a = 0.f;
#pragma unroll
        for (int ks = 0; ks < 4; ++ks)
#pragma unroll
            for (int h = 0; h < 2; ++h) { const f32x4 v = xv[m][ks][h]; a += (v.x * v.x + v.y * v.y) + (v.z * v.z + v.w * v.w); }
        a += __shfl_xor(a, 16); a += __shfl_xor(a, 32); ss[m] = a; }
    if (fq == 0) {
#pragma unroll
        for (int m = 0; m < 4; ++m) ssqx[(16 * m + fr) * 8 + wave] = ss[m]; }
    asm volatile("s_waitcnt vmcnt(0)" ::: "memory");
    __syncthreads();
    float r[4];
#pragma unroll
    for (int m = 0; m < 4; ++m) { const f32x4 a = *(const LAS f32x4*)(ssqx + (16 * m + fr) * 8), c = *(const LAS f32x4*)(ssqx + (16 * m + fr) * 8 + 4);
        r[m] = rsqrtf((((a.x + a.y) + (a.z + a.w)) + ((c.x + c.y) + (c.z + c.w))) * (1.0f / D) + EPS); }
    f32x4 acc[4][2];
#pragma unroll
    for (int m = 0; m < 4; ++m)
#pragma unroll
        for (int nt = 0; nt < 2; ++nt) acc[m][nt] = (f32x4){0.f, 0.f, 0.f, 0.f};
#pragma unroll
    for (int ks = 0; ks < 4; ++ks) { const int kk = 128 * wave + 32 * ks + 8 * fq;
        const f32x4 g0 = *(const LAS f32x4*)(gsh + kk), g1 = *(const LAS f32x4*)(gsh + kk + 4), s0 = *(const LAS f32x4*)(gsh + 1024 + kk), s1 = *(const LAS f32x4*)(gsh + 1024 + kk + 4);
        bf16x8 Wh[2], Wo[2];
#pragma unroll
        for (int nt = 0; nt < 2; ++nt) { Wh[nt] = *(const LAS bf16x8*)(Wl + ((ks * 2 + nt) * 2 + 0) * 1024 + lane * 16); Wo[nt] = *(const LAS bf16x8*)(Wl + ((ks * 2 + nt) * 2 + 1) * 1024 + lane * 16); }
#pragma unroll
        for (int m = 0; m < 4; ++m) { const f32x4 h0 = xv[m][ks][0] * r[m] * g0 + s0, h1 = xv[m][ks][1] * r[m] * g1 + s1;
            u32x2 w8; w8.x = pk4_fp8(h0.x * H8_SCALE, h0.y * H8_SCALE, h0.z * H8_SCALE, h0.w * H8_SCALE); w8.y = pk4_fp8(h1.x * H8_SCALE, h1.y * H8_SCALE, h1.z * H8_SCALE, h1.w * H8_SCALE);
            *(u32x2*)(H8 + (size_t)(blk * 64 + 16 * m + fr) * D + kk) = w8;
            u32x4 hi, lo;
            hi.x = cvtpk(h0.x, h0.y); hi.y = cvtpk(h0.z, h0.w); hi.z = cvtpk(h1.x, h1.y); hi.w = cvtpk(h1.z, h1.w);
            lo.x = cvtpk(h0.x - bflo(hi.x), h0.y - bfhi(hi.x)); lo.y = cvtpk(h0.z - bflo(hi.y), h0.w - bfhi(hi.y)); lo.z = cvtpk(h1.x - bflo(hi.z), h1.y - bfhi(hi.z)); lo.w = cvtpk(h1.z - bflo(hi.w), h1.w - bfhi(hi.w));
            const bf16x8 Xh = __builtin_bit_cast(bf16x8, hi), Xl = __builtin_bit_cast(bf16x8, lo);
#pragma unroll
            for (int nt = 0; nt < 2; ++nt) { acc[m][nt] = __builtin_amdgcn_mfma_f32_16x16x32_bf16(Wo[nt], Xh, acc[m][nt], 0, 0, 0); acc[m][nt] = __builtin_amdgcn_mfma_f32_16x16x32_bf16(Wh[nt], Xl, acc[m][nt], 0, 0, 0);
                acc[m][nt] = __builtin_amdgcn_mfma_f32_16x16x32_bf16(Wh[nt], Xh, acc[m][nt], 0, 0, 0); } } }
    { LAS float* part = (LAS float*)Wl;
#pragma unroll
      for (int m = 0; m < 4; ++m)
#pragma unroll
          for (int nt = 0; nt < 2; ++nt) *(LAS f32x4*)(part + (16 * m + fr) * 32 + 16 * nt + 4 * fq) = acc[m][nt]; }
    __syncthreads();
    { const int row = tid >> 3, eg = tid & 7; f32x4 sum = *(const f32x4*)(b_router + 4 * eg);
#pragma unroll
      for (int w2 = 0; w2 < 8; ++w2) sum += *(const LAS f32x4*)(lds + RING_OFF + w2 * 16384 + (row * 32 + 4 * eg) * 4);
      *(LAS f32x4*)(lg + row * 32 + 4 * eg) = sum; }
    __syncthreads();
    { const int row = 8 * wave + (lane >> 3), eg = lane & 7; const LAS float* lgr = lg + row * 32;
      const f32x4 mine = *(const LAS f32x4*)(lgr + 4 * eg); const int e0m = 4 * eg;
      int rk0 = 0, rk1 = 0, rk2 = 0, rk3 = 0;
#pragma unroll
      for (int q = 0; q < 8; ++q) { const f32x4 a = *(const LAS f32x4*)(lgr + 4 * q);
#pragma unroll
          for (int t = 0; t < 4; ++t) { const int e2 = 4 * q + t; const float av = a[t];
              rk0 += (av > mine.x || (av == mine.x && e2 < e0m + 0)) ? 1 : 0; rk1 += (av > mine.y || (av == mine.y && e2 < e0m + 1)) ? 1 : 0;
              rk2 += (av > mine.z || (av == mine.z && e2 < e0m + 2)) ? 1 : 0; rk3 += (av > mine.w || (av == mine.w && e2 < e0m + 3)) ? 1 : 0; } }
      if (rk0 < 4) { sel_e[row * 4 + rk0] = e0m + 0; sel_v[row * 4 + rk0] = mine.x; }
      if (rk1 < 4) { sel_e[row * 4 + rk1] = e0m + 1; sel_v[row * 4 + rk1] = mine.y; }
      if (rk2 < 4) { sel_e[row * 4 + rk2] = e0m + 2; sel_v[row * 4 + rk2] = mine.z; }
      if (rk3 < 4) { sel_e[row * 4 + rk3] = e0m + 3; sel_v[row * 4 + rk3] = mine.w; }
      asm volatile("s_waitcnt lgkmcnt(0)" ::: "memory");
      if (eg == 0) { const i32x4 ee = *(const LAS i32x4*)(sel_e + row * 4); const f32x4 vv = *(const LAS f32x4*)(sel_v + row * 4);
          const float x1v = __expf(vv.y - vv.x), x2v = __expf(vv.z - vv.x), x3v = __expf(vv.w - vv.x), inv = 1.0f / (1.0f + x1v + x2v + x3v);
          const size_t g = (size_t)(blk * 64 + row) * 4;
          if (cnt) *(LAS f32x4*)(sel_v + row * 4) = (f32x4){inv, x1v * inv, x2v * inv, x3v * inv};
          else { *(i32x4*)(tope + g) = ee; *(f32x4*)(topw + g) = (f32x4){inv, x1v * inv, x2v * inv, x3v * inv}; }
          (void)__hip_atomic_fetch_add(&lh[ee.x], 1, __ATOMIC_RELAXED, __HIP_MEMORY_SCOPE_WORKGROUP); (void)__hip_atomic_fetch_add(&lh[ee.y], 1, __ATOMIC_RELAXED, __HIP_MEMORY_SCOPE_WORKGROUP);
          (void)__hip_atomic_fetch_add(&lh[ee.z], 1, __ATOMIC_RELAXED, __HIP_MEMORY_SCOPE_WORKGROUP); (void)__hip_atomic_fetch_add(&lh[ee.w], 1, __ATOMIC_RELAXED, __HIP_MEMORY_SCOPE_WORKGROUP); }
      asm volatile("s_waitcnt lgkmcnt(0)" ::: "memory"); }
    if (cnt) {
        LAS int* offs = (LAS int*)ssqx; LAS int* es = (LAS int*)ssqx + 32;
        __syncthreads();
        if (tid < NE) { offs[tid] = __hip_atomic_fetch_add(cnt + tid * CNT_STRIDE, lh[tid], __ATOMIC_RELAXED, __HIP_MEMORY_SCOPE_AGENT); lh[tid] = 0; }
        int my_e = 0, rank = 0;
        if (tid < 256) { my_e = sel_e[tid]; const unsigned long long lt = (lane == 0) ? 0ull : (~0ull >> (64 - lane));
#pragma unroll 4
            for (int e = 0; e < NE; ++e) { const unsigned long long mk = __ballot(my_e == e); if (my_e == e) rank = __popcll(mk & lt); if (lane == 0) es[wave * 32 + e] = __popcll(mk); } }
        __syncthreads();
        if (tid < 256) { for (int w2 = 0; w2 < wave; ++w2) rank += es[w2 * 32 + my_e];
            const int slot = offs[my_e] + rank;
            toke[(size_t)my_e * T + slot] = blk * 64 + (tid >> 2); wrowe[(size_t)my_e * T + slot] = sel_v[tid]; paire[(size_t)blk * 256 + tid] = slot | (my_e << 20); }
    }
}

struct Args { const float* in[30]; float* out; unsigned char* ws; int ph_lo, ph_hi, li, pad; };

template <bool GU> __device__ __forceinline__ void p0_transpose_item(const float* W, int K, int N, bf16* WT, int item, int lane, const float* kscale = nullptr) {
    const int nblk = N / 64, kb = item / nblk, nb = item % nblk, q = lane & 15, o = lane >> 4, k0 = 64 * kb + 16 * o, n0 = 64 * nb + 4 * q;
    const float* src = W + (size_t)k0 * N + n0;
    f32x4 v[16];
#pragma unroll
    for (int j = 0; j < 16; ++j) v[j] = *(const f32x4*)(src + (size_t)j * N);
    if (kscale) {
#pragma unroll
        for (int j = 0; j < 16; ++j) v[j] = v[j] * kscale[k0 + j]; }
#pragma unroll
    for (int i = 0; i < 4; ++i) { const int nr = GU ? gu_row(n0 + i) : (n0 + i);
        u32x4 a, b;
        a.x = cvtpk(v[0][i], v[1][i]); a.y = cvtpk(v[2][i], v[3][i]); a.z = cvtpk(v[4][i], v[5][i]); a.w = cvtpk(v[6][i], v[7][i]);
        b.x = cvtpk(v[8][i], v[9][i]); b.y = cvtpk(v[10][i], v[11][i]); b.z = cvtpk(v[12][i], v[13][i]); b.w = cvtpk(v[14][i], v[15][i]);
        u32x4* dst = (u32x4*)(WT + (size_t)nr * K + k0); dst[0] = a; dst[1] = b; }
}

template <bool GU> __device__ __forceinline__ void p0_transpose_item_fp8(const float* W, int K, int N, unsigned char* WT, int item, int lane) {
    const int nblk = N / 32, kb = item / nblk, nb = item % nblk, q = lane & 7, o = lane >> 3, k0 = 128 * kb + 16 * o, n0 = 32 * nb + 4 * q;
    const float* src = W + (size_t)k0 * N + n0;
    f32x4 v[16];
#pragma unroll
    for (int j = 0; j < 16; ++j) v[j] = __builtin_nontemporal_load((const f32x4*)(src + (size_t)j * N)) * W8_SCALE;
#pragma unroll
    for (int i = 0; i < 4; ++i) { const int nr = GU ? gu_row(n0 + i) : (n0 + i);
        u32x4 a; a.x = pk4_fp8(v[0][i], v[1][i], v[2][i], v[3][i]); a.y = pk4_fp8(v[4][i], v[5][i], v[6][i], v[7][i]); a.z = pk4_fp8(v[8][i], v[9][i], v[10][i], v[11][i]); a.w = pk4_fp8(v[12][i], v[13][i], v[14][i], v[15][i]);
        __builtin_nontemporal_store(a, (u32x4*)(WT + (size_t)nr * K + k0)); }
}

__global__ void __launch_bounds__(NWAVES * 64, 2) mk_fwd(Args args) {
    extern __shared__ __attribute__((aligned(16))) unsigned char lds_raw[];
    LAS unsigned char* lds = (LAS unsigned char*)lds_raw;
    const int tid = threadIdx.x, lane = tid & 63, wave = __builtin_amdgcn_readfirstlane(tid >> 6);
    const int G = gridDim.x, bx = blockIdx.x, vcu = (G % 8 == 0) ? (bx % 8) * (G / 8) + bx / 8 : bx;
    const int gw = vcu * NWAVES + wave, NGW = G * NWAVES;
    unsigned char* ws = args.ws;
    const float* x = args.in[0]; const float* c_in = args.in[1]; const float* w_ada = args.in[2]; const float* b_ada = args.in[3];
    const float* norm_mix = args.in[4]; const float* w_in = args.in[5]; const float* b_in = args.in[6];
    const float* q_norm = args.in[7]; const float* k_norm = args.in[8]; const float* sinks = args.in[9];
    const float* lam_re = args.in[10]; const float* lam_im = args.in[11]; const float* log_dt = args.in[12];
    const float* b_re = args.in[13]; const float* b_im = args.in[14]; const float* c_re = args.in[15]; const float* c_im = args.in[16];
    const float* d_skip = args.in[17]; const float* w_glu = args.in[18]; const float* b_glu = args.in[19];
    const float* attn_out_norm = args.in[20]; const float* ssm_out_norm = args.in[21]; const float* w_out = args.in[22];
    const float* norm_ffn = args.in[23]; const float* w_router = args.in[24]; const float* b_router = args.in[25];
    const float* w_gate_up = args.in[26]; const float* b_gate_up = args.in[27]; const float* w_down = args.in[28]; const float* b_down = args.in[29];
    float* out = args.out;
    float* MOD = (float*)(ws + WS_MOD); float* SSMT = (float*)(ws + WS_SSMT);
    bf16* WTIN = (bf16*)(ws + WS_WTIN); bf16* WTGLU = (bf16*)(ws + WS_WTGLU); bf16* WTOUT = (bf16*)(ws + WS_WTOUT); bf16* WTGU = (bf16*)(ws + WS_WTGU); bf16* WTDN = (bf16*)(ws + WS_WTDN);
    bf16* H = (bf16*)(ws + WS_H); bf16* PROJ = (bf16*)(ws + WS_PROJ); bf16* ATT = (bf16*)(ws + WS_ATT); bf16* Gb = (bf16*)(ws + WS_G); bf16* SSMG = (bf16*)(ws + WS_SSMG); bf16* MIXED = (bf16*)(ws + WS_MIXED);
    int* TOPE = (int*)(ws + WS_TOPE); float* TOPW = (float*)(ws + WS_TOPW); int* HIST = (int*)(ws + WS_HIST); int* TOKROW = (int*)(ws + WS_TOKROW); int* ROWPAIR = (int*)(ws + WS_ROWPAIR);
    float* WROW = (float*)(ws + WS_WROW); int* TILEE = (int*)(ws + WS_TILEE); bf16* ACT = (bf16*)(ws + WS_ACT); bf16* YS = (bf16*)(ws + WS_YS);
    float* XST = (float*)(ws + WS_XST); float* SC = (float*)(ws + WS_SC);

    for (int u = tid; u < (LDS_BYTES - LDSCTL_OFF) / 4; u += NWAVES * 64) ((LAS unsigned*)(lds + LDSCTL_OFF))[u] = 0u;
    __syncthreads();
    volatile LAS unsigned* MISC = (volatile LAS unsigned*)(lds + MISC_OFF);
    XcdBarrier bar = xcd_barrier_post((unsigned*)(ws + WS_CTL) + CW_BAR + args.li * XCD_BAR_WORDS, MISC + 8);
    const int lo = args.ph_lo, hi = args.ph_hi;
#define IN(k) (lo <= (k) && (k) < hi)
#define SEAM(k) do { if (IN(k) && IN((k) + 1)) xcd_barrier(bar); } while (0)

    if (IN(P_PRO)) {
        if (vcu < 96) {
            LAS float* ca = (LAS float*)(lds + RING_OFF);
            LAS float* red = (LAS float*)(lds + RING_OFF + 32768);
            for (int k = tid; k < D; k += 512) { float cv8[NB];
#pragma unroll
                for (int b = 0; b < NB; ++b) { const float v = c_in[b * D + k]; cv8[b] = v * sigmoidf_(v); }
                *(LAS f32x4*)(ca + k * 8) = (f32x4){cv8[0], cv8[1], cv8[2], cv8[3]}; *(LAS f32x4*)(ca + k * 8 + 4) = (f32x4){cv8[4], cv8[5], cv8[6], cv8[7]}; }
            __syncthreads();
            float acc[NB];
#pragma unroll
            for (int b = 0; b < NB; ++b) acc[b] = 0.f;
            const float* wp = w_ada + (size_t)(128 * wave) * (6 * D) + 64 * vcu + lane;
#pragma unroll 1
            for (int k0 = 0; k0 < 128; k0 += 64) {
                float wv[64];
#pragma unroll
                for (int j = 0; j < 64; ++j) wv[j] = __builtin_nontemporal_load(wp + (size_t)(k0 + j) * (6 * D));
#pragma unroll
                for (int j = 0; j < 64; ++j) { const float w = wv[j]; const f32x4 c0 = *(const LAS f32x4*)(ca + (128 * wave + k0 + j) * 8), c1 = *(const LAS f32x4*)(ca + (128 * wave + k0 + j) * 8 + 4);
                    acc[0] = fmaf(c0.x, w, acc[0]); acc[1] = fmaf(c0.y, w, acc[1]); acc[2] = fmaf(c0.z, w, acc[2]); acc[3] = fmaf(c0.w, w, acc[3]);
                    acc[4] = fmaf(c1.x, w, acc[4]); acc[5] = fmaf(c1.y, w, acc[5]); acc[6] = fmaf(c1.z, w, acc[6]); acc[7] = fmaf(c1.w, w, acc[7]); } }
#pragma unroll
            for (int b = 0; b < NB; ++b) red[(wave * 8 + b) * 64 + lane] = acc[b];
            __syncthreads();
            { float s = b_ada[64 * vcu + lane];
#pragma unroll
              for (int w2 = 0; w2 < 8; ++w2) s += red[(w2 * 8 + wave) * 64 + lane];
              MOD[wave * 6 * D + 64 * vcu + lane] = s; }
            __syncthreads();
        } else if (vcu < 100) { const int i = (vcu - 96) * 512 + tid; ssm_table_item(i, lam_re, lam_im, log_dt, b_re, b_im, SSMT); }
        else if (FAST_ROUTER && MOE_FP8_GU && vcu < 116) router_image_item((vcu - 100) * 512 + tid, w_router, ws + WS_WRI);
        if constexpr (SSM_MFMA_CARRY && !P3_CONV) for (int i = vcu * 512 + tid; i < NG * 64 * 64; i += G * 512) ssm_apow_item(i, lam_re, lam_im, log_dt, ws + WS_APOW);
        constexpr int I_IN = (D / 64) * (DIN / 64), I_GLU = (DSSM / 64) * (DSSM / 64), I_OUT = (D / 64) * (D / 64), I_GU = MOE_FP8_GU ? (D / 128) * (2 * DFF / 32) : (D / 64) * (2 * DFF / 64), I_DN = MOE_FP8_DN ? (DFF / 128) * (D / 32) : (DFF / 64) * (D / 64);
        constexpr int NITEMS = I_IN + I_GLU + I_OUT + NE * I_GU + NE * I_DN;
        const int gu_defer = (G == 256) ? GU_DEFER : 0;
        const int nitems_p0 = (G == 256 && P3_CONV) ? (I_IN + I_GLU + I_OUT) : (NITEMS - gu_defer - (G == 256 ? DN_DEFER_P9 : 0));
        for (int it0 = gw; it0 < nitems_p0; it0 += NGW) {
            int r = (it0 < I_IN + I_GLU + I_OUT) ? it0 : it0 + gu_defer;
            if (r < I_IN) { p0_transpose_item<false>(w_in, D, DIN, WTIN, r, lane); continue; } r -= I_IN;
            if (r < I_GLU) { p0_transpose_item<false>(w_glu, DSSM, DSSM, WTGLU, r, lane); continue; } r -= I_GLU;
            if (r < I_OUT) { const int kb = r / (D / 64);
                p0_transpose_item<false>(w_out, D, D, WTOUT, r, lane, FUSE_MIXNORM ? (kb < 8 ? attn_out_norm : ssm_out_norm - DATT) : nullptr); continue; } r -= I_OUT;
            if (r < NE * I_GU) { const int e = r / I_GU;
                if constexpr (MOE_FP8_GU) p0_transpose_item_fp8<true>(w_gate_up + (size_t)e * D * 2 * DFF, D, 2 * DFF, (unsigned char*)WTGU + (size_t)e * 2 * DFF * D, r % I_GU, lane);
                else p0_transpose_item<true>(w_gate_up + (size_t)e * D * 2 * DFF, D, 2 * DFF, WTGU + (size_t)e * 2 * DFF * D, r % I_GU, lane);
                continue; } r -= NE * I_GU;
            { const int e = r / I_DN;
              if constexpr (MOE_FP8_DN) p0_transpose_item_fp8<false>(w_down + (size_t)e * DFF * D, DFF, D, (unsigned char*)WTDN + (size_t)e * D * DFF, r % I_DN, lane);
              else p0_transpose_item<false>(w_down + (size_t)e * DFF * D, DFF, D, WTDN + (size_t)e * D * DFF, r % I_DN, lane); }
        }
    }
    SEAM(P_PRO);
    if (IN(P_NORM1)) {
        for (int m0 = 8 * gw; m0 < T; m0 += 8 * NGW) { const int b = m0 / S; f32x4 gm[4], shv[4];
#pragma unroll
            for (int j = 0; j < 4; ++j) { const int c = 4 * lane + 256 * j; gm[j] = *(const f32x4*)(norm_mix + c) * (1.0f + *(const f32x4*)(MOD + b * 6 * D + D + c)); shv[j] = *(const f32x4*)(MOD + b * 6 * D + c); }
#pragma unroll 2
            for (int i = 0; i < 8; ++i) { const int m = m0 + i; const f32x4* xr = (const f32x4*)(x + (size_t)m * D) + lane; f32x4 v[4]; float ss = 0.f;
#pragma unroll
                for (int j = 0; j < 4; ++j) { v[j] = xr[64 * j]; ss += (v[j].x * v[j].x + v[j].y * v[j].y) + (v[j].z * v[j].z + v[j].w * v[j].w); }
                const float r = rsqrtf(wave_sum(ss) * (1.0f / D) + EPS); u32x2* o = (u32x2*)(H + (size_t)m * D) + lane;
#pragma unroll
                for (int j = 0; j < 4; ++j) { const f32x4 y = v[j] * r * gm[j] + shv[j]; u32x2 w; w.x = cvtpk(y.x, y.y); w.y = cvtpk(y.z, y.w); o[64 * j] = w; } } }
    }
    SEAM(P_NORM1);
    if (IN(P_INPROJ)) {
        constexpr int I_GU8 = (D / 128) * (2 * DFF / 32);
        const bool reshape = P2_RESHAPE && GU_DEFER_P2 > 0 && G == 256;
        const int Gg = reshape ? P2_GEMM_WGS : G;
        if (bx < Gg) {
            pg8::DenseOrder So{(const char*)H, (const char*)WTIN, T / 256, DIN / 256, Gg, bx, (size_t)256 * D * 2};
            pg8::EpiProj E{PROJ, DIN, b_in, (LAS float*)(lds + RSCR_OFF + 4096)};
            pg8::gemm_phase<pg8::EpiProj, pg8::DenseOrder, true, false>(lds + RING_OFF, D, So, E);
            if constexpr (GU_DEFER_P2 > 0 && !P2_RESHAPE) { if (G == 256 && bx >= 64) {
                for (int k = 0; k < DEFER_P2_PER_WAVE; ++k) { const int r = ((bx - 64) * 8 + wave) * DEFER_P2_PER_WAVE + k, e = r / I_GU8;
                    p0_transpose_item_fp8<true>(w_gate_up + (size_t)e * D * 2 * DFF, D, 2 * DFF, (unsigned char*)WTGU + (size_t)e * 2 * DFF * D, r % I_GU8, lane); } } }
        } else {
            const int nconv = (G - Gg) * 8;
            for (int r = (bx - Gg) * 8 + wave; r < GU_DEFER_P2; r += nconv) { const int e = r / I_GU8;
                p0_transpose_item_fp8<true>(w_gate_up + (size_t)e * D * 2 * DFF, D, 2 * DFF, (unsigned char*)WTGU + (size_t)e * 2 * DFF * D, r % I_GU8, lane); }
        }
    }
    SEAM(P_INPROJ);
    if (IN(P_MIX_A)) {
#if FAST_ATTN
        for (int u = bx; u < NB * 16 * NKV; u += G) attn_unit(lds + RING_OFF, u, tid, PROJ, q_norm, k_norm, sinks, ATT, FUSE_MIXNORM ? (float*)(ws + WS_MIXED) : nullptr);
#else
        for (int idx = bx * 512 + tid; idx < T * NH; idx += G * 512) attn_scores_item(idx, PROJ, q_norm, k_norm, SC);
#endif
#if FAST_SSM
        { constexpr int IGU = (D / 128) * (2 * DFF / 32), IDN = (DFF / 128) * (D / 32);
          const ConvStream cstr{w_gate_up, w_down, (unsigned char*)WTGU, (unsigned char*)WTDN, GU_DEFER, NE * IGU - GU_DEFER, NE * IDN - DN_DEFER_P9, 2048};
          const bool use_cs = (G == 256) && P3_CONV;
          for (int u = bx; u < NB * NG; u += G) ssm_unit(lds + RING_OFF, u, tid, PROJ, SSMT, c_re, c_im, d_skip, Gb, use_cs, cstr, ws + WS_APOW); }
#else
        if (wave == 0) for (int idx = bx * 64 + lane; idx < NB * NG * NST; idx += G * 64) ssm_scan_item(idx, PROJ, SSMT, XST);
#endif
    }
    SEAM(P_MIX_A);
    if (IN(P_MIX_B)) {
#if !FAST_ATTN
        for (int idx = bx * 512 + tid; idx < T * NH * HD; idx += G * 512) attn_out_item(idx, PROJ, SC, sinks, ATT);
#endif
#if !FAST_SSM
        for (int idx = bx * 512 + tid; idx < T * DSSM; idx += G * 512) ssm_out_item(idx, PROJ, XST, c_re, c_im, d_skip, Gb);
#endif
    }
#if !(FAST_ATTN && FAST_SSM)
    SEAM(P_MIX_B);
#endif
    if (IN(P_GLU)) {
        pg8::DenseOrder So{(const char*)Gb, (const char*)WTGLU, T / 256, DSSM / 256, G, bx, (size_t)256 * DSSM * 2};
        pg8::EpiGlu E{Gb, SSMG, b_glu, FUSE_MIXNORM ? (float*)(ws + WS_MIXED + MiB) : nullptr, (LAS float*)(lds + RSCR_OFF + 4096)};
        pg8::gemm_phase<pg8::EpiGlu, pg8::DenseOrder, true, false>(lds + RING_OFF, DSSM, So, E);
        if constexpr (GU_DEFER_P4 > 0) { if (G == 256 && bx >= 128) {
            constexpr int I_GU8 = (D / 128) * (2 * DFF / 32);
            for (int k = 0; k < DEFER_P4_PER_WAVE; ++k) { const int r = GU_DEFER_P2 + ((bx - 128) * 8 + wave) * DEFER_P4_PER_WAVE + k, e = r / I_GU8;
                p0_transpose_item_fp8<true>(w_gate_up + (size_t)e * D * 2 * DFF, D, 2 * DFF, (unsigned char*)WTGU + (size_t)e * 2 * DFF * D, r % I_GU8, lane); } } }
    }
    SEAM(P_GLU);
    if (IN(P_MIXNORM) && !FUSE_MIXNORM) {
        const f32x4 ga0 = *(const f32x4*)(attn_out_norm + 8 * lane), ga1 = *(const f32x4*)(attn_out_norm + 8 * lane + 4), gs0 = *(const f32x4*)(ssm_out_norm + 8 * lane), gs1 = *(const f32x4*)(ssm_out_norm + 8 * lane + 4);
        for (int m0 = 2 * gw; m0 < T; m0 += 2 * NGW) {
            u32x4 a[2], q[2];
#pragma unroll
            for (int r = 0; r < 2; ++r) { a[r] = *((const u32x4*)(ATT + (size_t)(m0 + r) * DATT) + lane); q[r] = *((const u32x4*)(SSMG + (size_t)(m0 + r) * DSSM) + lane); }
#pragma unroll
            for (int r = 0; r < 2; ++r) {
                const float av[8] = {bflo(a[r].x), bfhi(a[r].x), bflo(a[r].y), bfhi(a[r].y), bflo(a[r].z), bfhi(a[r].z), bflo(a[r].w), bfhi(a[r].w)};
                const float sv[8] = {bflo(q[r].x), bfhi(q[r].x), bflo(q[r].y), bfhi(q[r].y), bflo(q[r].z), bfhi(q[r].z), bflo(q[r].w), bfhi(q[r].w)};
                float qa = 0.f, qs = 0.f;
#pragma unroll
                for (int i = 0; i < 8; ++i) { qa += av[i] * av[i]; qs += sv[i] * sv[i]; }
                const float ra = rsqrtf(wave_sum(qa) * (1.0f / DATT) + EPS), rs = rsqrtf(wave_sum(qs) * (1.0f / DSSM) + EPS);
                u32x4 oa, os;
                oa.x = pk2(av[0] * ra * ga0.x, av[1] * ra * ga0.y); oa.y = pk2(av[2] * ra * ga0.z, av[3] * ra * ga0.w); oa.z = pk2(av[4] * ra * ga1.x, av[5] * ra * ga1.y); oa.w = pk2(av[6] * ra * ga1.z, av[7] * ra * ga1.w);
                os.x = pk2(sv[0] * rs * gs0.x, sv[1] * rs * gs0.y); os.y = pk2(sv[2] * rs * gs0.z, sv[3] * rs * gs0.w); os.z = pk2(sv[4] * rs * gs1.x, sv[5] * rs * gs1.y); os.w = pk2(sv[6] * rs * gs1.z, sv[7] * rs * gs1.w);
                *((u32x4*)(MIXED + (size_t)(m0 + r) * D) + lane) = oa; *((u32x4*)(MIXED + (size_t)(m0 + r) * D + DATT) + lane) = os; } }
    }
    if (!FUSE_MIXNORM) SEAM(P_MIXNORM);
    if (IN(P_OUTPROJ)) {
        if constexpr (FUSE_MIXNORM) {
            pg8::MixOrder So{(const char*)ATT, (const char*)WTOUT, T / 256, D / 256, G, bx, (size_t)(WS_SSMG - WS_ATT)};
            pg8::EpiOut E{x, MOD, X1_DELTA ? (float*)(ws + WS_DELTA) : out, (const float*)(ws + WS_MIXED), (const float*)(ws + WS_MIXED + MiB), (LAS float*)(lds + RSCR_OFF), (LAS float*)(lds + RSCR_OFF + 4096)};
            pg8::gemm_phase<pg8::EpiOut, pg8::MixOrder, false, false>(lds + RING_OFF, D, So, E);
        } else {
            pg8::DenseOrder So{(const char*)MIXED, (const char*)WTOUT, T / 256, D / 256, G, bx, (size_t)256 * D * 2};
            pg8::EpiOut E{x, MOD, X1_DELTA ? (float*)(ws + WS_DELTA) : out, nullptr, nullptr, (LAS float*)(lds + RSCR_OFF), (LAS float*)(lds + RSCR_OFF + 4096)};
            pg8::gemm_phase<pg8::EpiOut, pg8::DenseOrder, false, false>(lds + RING_OFF, D, So, E);
        }
    }
    SEAM(P_OUTPROJ);
    if (IN(P_ROUTER)) {
        LAS float* wr = (LAS float*)(lds + RING_OFF); LAS int* lh = (LAS int*)(lds + LH_OFF);
        constexpr bool FR = FAST_ROUTER && MOE_FP8_GU, FS = FR && FAST_SORT && MOE_FP8_DN && YS_FP8;
        if constexpr (!FR) for (int c = tid; c < D; c += 512) {
            f32x4 wv[8];
#pragma unroll
            for (int k = 0; k < 8; ++k) wv[k] = *(const f32x4*)(w_router + (size_t)c * NE + 4 * k);
#pragma unroll
            for (int k = 0; k < 8; ++k) { wr[(4 * k + 0) * D + c] = wv[k].x; wr[(4 * k + 1) * D + c] = wv[k].y; wr[(4 * k + 2) * D + c] = wv[k].z; wr[(4 * k + 3) * D + c] = wv[k].w; } }
        if (tid < NE) lh[tid] = 0;
        __syncthreads();
        for (int vb = bx; vb < 256; vb += G) {
            if constexpr (FR) router_block_mfma(lds, vb, tid, wave, lane, X1_DELTA ? x : out, norm_ffn, MOD, b_router, ws + WS_WRI, lh, ws + WS_H8, TOPE, TOPW, X1_DELTA ? (const bf16*)(ws + WS_DELTA) : nullptr, FS ? (int*)(ws + WS_CNT) : nullptr, (int*)(ws + WS_TOKE), (float*)(ws + WS_WROWE), ROWPAIR, (X1_DELTA && X1_BF16) ? (bf16*)(ws + WS_X1B) : nullptr);
            else norm2_router_rows(vb, wave, lane, out, norm_ffn, MOD, b_router, wr, lh, (LAS float*)(lds + RSCR_OFF), MOE_FP8_GU ? (bf16*)nullptr : H, TOPE, TOPW, MOE_FP8_GU ? (unsigned char*)PROJ : nullptr);
            __syncthreads();
            if (!FS && tid < NE) { HIST[vb * NE + tid] = lh[tid]; lh[tid] = 0; }
            __syncthreads();
        }
    }
    SEAM(P_ROUTER);
    constexpr bool FSK = FAST_ROUTER && MOE_FP8_GU && FAST_SORT && MOE_FP8_DN && YS_FP8;
    if (IN(P_SORT) && !FSK) for (int vb = bx; vb < 256; vb += G) sort_block(vb, tid, (LAS int*)(lds + SORT_OFF), HIST, TOPE, TOPW, TOKROW, ROWPAIR, WROW, TILEE);
    if (!FSK) SEAM(P_SORT);
    LAS int* cbt = (LAS int*)(lds + TE_OFF + 2048);
    if (IN(P_GATEUP) || IN(P_DOWN) || (FSK && IN(P_COMBINE))) {
        LAS int* te = (LAS int*)(lds + TE_OFF);
        if constexpr (FSK) {
            if (wave == 0) { const int cv = (lane < NE) ? ((const int*)(ws + WS_CNT))[lane * CNT_STRIDE] : 0; int inc = ((cv + 255) >> 8) << 8;
#pragma unroll
                for (int o = 1; o < 32; o <<= 1) { const int t = __shfl_up(inc, o); if (lane >= o) inc += t; }
                if (lane < NE) { cbt[lane] = cv; cbt[33 + lane] = inc; } if (lane == 0) cbt[32] = 0; }
            __syncthreads();
            if (tid < NE) for (int ti = cbt[32 + tid] >> 8; ti < (cbt[33 + tid] >> 8); ++ti) te[ti] = tid;
        } else for (int i = tid; i < MAXTILES; i += 512) te[i] = TILEE[64 + i];
        __syncthreads();
    }
    if (IN(P_GATEUP)) {
        const LAS int* te = (const LAS int*)(lds + TE_OFF); const int ntiles = __builtin_amdgcn_readfirstlane(FSK ? (cbt[64] >> 8) : TILEE[0]);
        if constexpr (MOE_FP8_GU) {
            pg8::MoeOrder So{(const char*)(ws + WS_H8), (const char*)WTGU, FSK ? (const int*)(ws + WS_TOKE) : TOKROW, te, ntiles, 2 * DFF / 256, G, bx, (size_t)256 * D, (size_t)2 * DFF * D, FSK ? cbt : nullptr};
            pg8::EpiGateUp<MOE_FP8_DN != 0> E{(void*)ACT, b_gate_up, te, 1.0f / (W8_SCALE * H8_SCALE), (LAS float*)(lds + RSCR_OFF + 4096)};
            pg8::gemm_phase<pg8::EpiGateUp<MOE_FP8_DN != 0>, pg8::MoeOrder, true, true, true>(lds + RING_OFF, D / 2, So, E);
            if constexpr (DN_DEFER_P9 > 0) { if (G == 256) {
                constexpr int IDN8 = (DFF / 128) * (D / 32);
                const int rem = (ntiles * (2 * DFF / 256)) % G; const bool all = (rem == 0) || (G - rem < 64);
                const int n_idle = all ? G : G - rem, j = all ? bx : bx - rem;
                if (j >= 0) for (int r = NE * IDN8 - DN_DEFER_P9 + j * 8 + wave; r < NE * IDN8; r += n_idle * 8) { const int e = r / IDN8;
                    p0_transpose_item_fp8<false>(w_down + (size_t)e * DFF * D, DFF, D, (unsigned char*)WTDN + (size_t)e * D * DFF, r % IDN8, lane); } } }
        } else {
            pg8::MoeOrder So{(const char*)H, (const char*)WTGU, TOKROW, te, ntiles, 2 * DFF / 256, G, bx, (size_t)256 * D * 2, (size_t)2 * DFF * D * 2};
            pg8::EpiGateUp<MOE_FP8_DN != 0> E{(void*)ACT, b_gate_up, te, 1.0f, (LAS float*)(lds + RSCR_OFF + 4096)};
            pg8::gemm_phase<pg8::EpiGateUp<MOE_FP8_DN != 0>, pg8::MoeOrder, true, true, false>(lds + RING_OFF, D, So, E);
        }
    }
    SEAM(P_GATEUP);
    if (IN(P_DOWN)) {
        const LAS int* te = (const LAS int*)(lds + TE_OFF); const int ntiles = __builtin_amdgcn_readfirstlane(FSK ? (cbt[64] >> 8) : TILEE[0]);
        if constexpr (MOE_FP8_DN) {
            pg8::MoeOrder So{(const char*)ACT, (const char*)WTDN, TOKROW, te, ntiles, D / 256, G, bx, (size_t)256 * DFF, (size_t)D * DFF};
            pg8::EpiDown<YS_FP8 != 0> E{(void*)YS, b_down, FSK ? (const float*)(ws + WS_WROWE) : WROW, te, 1.0f / (W8_SCALE * A8_SCALE), FSK ? cbt : nullptr, (LAS float*)(lds + RSCR_OFF + 4096), (const float*)(ws + WS_CTL)};
            pg8::gemm_phase<pg8::EpiDown<YS_FP8 != 0>, pg8::MoeOrder, true, false, true>(lds + RING_OFF, DFF / 2, So, E);
        } else {
            pg8::MoeOrder So{(const char*)ACT, (const char*)WTDN, TOKROW, te, ntiles, D / 256, G, bx, (size_t)256 * DFF * 2, (size_t)D * DFF * 2};
            pg8::EpiDown<YS_FP8 != 0> E{(void*)YS, b_down, WROW, te, 1.0f, nullptr, (LAS float*)(lds + RSCR_OFF + 4096), (const float*)(ws + WS_CTL)};
            pg8::gemm_phase<pg8::EpiDown<YS_FP8 != 0>, pg8::MoeOrder, true, false, false>(lds + RING_OFF, DFF, So, E);
        }
    }
    SEAM(P_DOWN);
    if (IN(P_COMBINE)) { if constexpr (YS_FP8) { for (int m = 2 * gw; m < T; m += 2 * NGW) combine_rows8x2(m, lane, out, MOD, (const unsigned char*)YS, ROWPAIR, (X1_DELTA && !X1_BF16) ? x : nullptr, X1_DELTA ? (const bf16*)(ws + (X1_BF16 ? WS_X1B : WS_DELTA)) : nullptr, FSK ? cbt : nullptr); } else { for (int m = gw; m < T; m += NGW) combine_row(m, lane, out, MOD, YS, ROWPAIR); } }
#undef IN
#undef SEAM
}

static int g_grid = 0;
static void mk_setup() {
    if (g_grid != 0) return;
    int dev = 0, cus = 0, per_cu = 0;
    if (hipGetDevice(&dev) != hipSuccess || hipDeviceGetAttribute(&cus, hipDeviceAttributeMultiprocessorCount, dev) != hipSuccess) { fprintf(stderr, "kernel_launch: device query failed\n"); g_grid = -1; return; }
    if (hipFuncSetAttribute((const void*)mk_fwd, hipFuncAttributeMaxDynamicSharedMemorySize, LDS_BYTES) != hipSuccess) { fprintf(stderr, "kernel_launch: hipFuncSetAttribute failed\n"); g_grid = -1; return; }
    if (hipOccupancyMaxActiveBlocksPerMultiprocessor(&per_cu, (const void*)mk_fwd, NWAVES * 64, LDS_BYTES) != hipSuccess || per_cu < 1) { fprintf(stderr, "kernel_launch: occupancy query says %d workgroups per CU\n", per_cu); (void)hipGetLastError(); g_grid = -1; return; }
    g_grid = cus;
    (void)hipFuncSetAttribute((const void*)k_norm2_router, hipFuncAttributeMaxDynamicSharedMemorySize, 32 * 1024 * 4 + 256 + 4096);
}
static void mk_launch(const Args& base, int lo, int hi, int li, hipStream_t stream) {
    Args a = base; a.ph_lo = lo; a.ph_hi = hi; a.li = li; a.pad = 0;
    hipLaunchKernelGGL(mk_fwd, dim3(g_grid), dim3(NWAVES * 64), LDS_BYTES, stream, a);
}

extern "C" void kernel_launch(void* const* d_in, const int* in_sizes, int n_in, void* d_out, int out_size, void* d_ws, size_t ws_size, hipStream_t stream) {
    if (n_in != 30 || out_size != T * D || ws_size < WS_END) { fprintf(stderr, "kernel_launch: unexpected shapes (n_in %d out %d ws %zu)\n", n_in, out_size, ws_size); return; }
    mk_setup(); if (g_grid < 0) return;
    Args base{};
    for (int i = 0; i < 30; ++i) base.in[i] = (const float*)d_in[i];
    base.out = (float*)d_out; base.ws = (unsigned char*)d_ws;
    (void)hipMemsetAsync((char*)d_ws + WS_CTL, 0, CTL_ZERO_BYTES, stream);
#if MK_MODE == 1
    mk_launch(base, 0, P_COUNT, 0, stream);
#else
    const float* x = (const float*)d_in[0]; const float* c = (const float*)d_in[1]; const float* w_ada = (const float*)d_in[2]; const float* b_ada = (const float*)d_in[3];
    const float* norm_mix = (const float*)d_in[4]; const float* w_in = (const float*)d_in[5]; const float* b_in = (const float*)d_in[6];
    const float* q_norm = (const float*)d_in[7]; const float* k_norm = (const float*)d_in[8]; const float* sinks = (const float*)d_in[9];
    const float* lam_re = (const float*)d_in[10]; const float* lam_im = (const float*)d_in[11]; const float* log_dt = (const float*)d_in[12];
    const float* b_re = (const float*)d_in[13]; const float* b_im = (const float*)d_in[14]; const float* c_re = (const float*)d_in[15]; const float* c_im = (const float*)d_in[16];
    const float* d_skip = (const float*)d_in[17]; const float* w_glu = (const float*)d_in[18]; const float* b_glu = (const float*)d_in[19];
    const float* attn_out_norm = (const float*)d_in[20]; const float* ssm_out_norm = (const float*)d_in[21]; const float* w_out = (const float*)d_in[22];
    const float* norm_ffn = (const float*)d_in[23]; const float* w_router = (const float*)d_in[24]; const float* b_router = (const float*)d_in[25];
    const float* w_gate_up = (const float*)d_in[26]; const float* b_gate_up = (const float*)d_in[27]; const float* w_down = (const float*)d_in[28]; const float* b_down = (const float*)d_in[29];
    unsigned char* ws = (unsigned char*)d_ws; float* out = (float*)d_out;
    float* MOD = (float*)(ws + WS_MOD); float* SSMT = (float*)(ws + WS_SSMT);
    bf16* WTIN = (bf16*)(ws + WS_WTIN); bf16* WTGLU = (bf16*)(ws + WS_WTGLU); bf16* WTOUT = (bf16*)(ws + WS_WTOUT); bf16* WTGU = (bf16*)(ws + WS_WTGU); bf16* WTDN = (bf16*)(ws + WS_WTDN);
    bf16* H = (bf16*)(ws + WS_H); bf16* PROJ = (bf16*)(ws + WS_PROJ); bf16* ATT = (bf16*)(ws + WS_ATT); bf16* Gb = (bf16*)(ws + WS_G); bf16* SSMG = (bf16*)(ws + WS_SSMG); bf16* MIXED = (bf16*)(ws + WS_MIXED);
    int* TOPE = (int*)(ws + WS_TOPE); float* TOPW = (float*)(ws + WS_TOPW); int* HIST = (int*)(ws + WS_HIST); int* TOKROW = (int*)(ws + WS_TOKROW); int* ROWPAIR = (int*)(ws + WS_ROWPAIR);
    float* WROW = (float*)(ws + WS_WROW); int* TILEE = (int*)(ws + WS_TILEE); bf16* ACT = (bf16*)(ws + WS_ACT); bf16* YS = (bf16*)(ws + WS_YS);
    float* XST = (float*)(ws + WS_XST); float* SC = (float*)(ws + WS_SC);
#ifndef REF_PRO
#define REF_PRO 1
#endif
#ifndef REF_NORM1
#define REF_NORM1 1
#endif
#ifndef REF_INPROJ
#define REF_INPROJ 1
#endif
#ifndef REF_MIX
#define REF_MIX 1
#endif
#ifndef REF_GLU
#define REF_GLU 1
#endif
#ifndef REF_MIXNORM
#define REF_MIXNORM 1
#endif
#ifndef REF_OUTPROJ
#define REF_OUTPROJ 1
#endif
#ifndef REF_ROUTER
#define REF_ROUTER 1
#endif
#ifndef REF_SORT
#define REF_SORT 1
#endif
#ifndef REF_GATEUP
#define REF_GATEUP 1
#endif
#ifndef REF_DOWN
#define REF_DOWN 1
#endif
#ifndef REF_COMBINE
#define REF_COMBINE 1
#endif
    int li = 0;
    if (REF_PRO) {
        hipLaunchKernelGGL(k_transpose_cvt, dim3(DIN / 32, D / 32, 1), dim3(32, 8), 0, stream, w_in, WTIN, D, DIN, 0);
        hipLaunchKernelGGL(k_transpose_cvt, dim3(DSSM / 32, DSSM / 32, 1), dim3(32, 8), 0, stream, w_glu, WTGLU, DSSM, DSSM, 0);
        hipLaunchKernelGGL(k_transpose_cvt, dim3(D / 32, D / 32, 1), dim3(32, 8), 0, stream, w_out, WTOUT, D, D, 0);
        hipLaunchKernelGGL(k_transpose_cvt, dim3(2 * DFF / 32, D / 32, NE), dim3(32, 8), 0, stream, w_gate_up, WTGU, D, 2 * DFF, 1);
        hipLaunchKernelGGL(k_transpose_cvt, dim3(D / 32, DFF / 32, NE), dim3(32, 8), 0, stream, w_down, WTDN, DFF, D, 0);
        hipLaunchKernelGGL(k_mod, dim3(6 * D / 256), dim3(256), 0, stream, c, w_ada, b_ada, MOD);
        hipLaunchKernelGGL(k_ssm_tables, dim3(NG * NST / 256), dim3(256), 0, stream, lam_re, lam_im, log_dt, b_re, b_im, SSMT);
    } else mk_launch(base, P_PRO, P_PRO + 1, li++, stream);
    if (REF_NORM1) hipLaunchKernelGGL(k_norm_mod, dim3(T / 4), dim3(256), 0, stream, x, norm_mix, (const float*)MOD, 0, D, H);
    else mk_launch(base, P_NORM1, P_NORM1 + 1, li++, stream);
    if (REF_INPROJ) { NEpiProj e{}; e.A = H; e.Bt = WTIN; e.bias = b_in; e.O = PROJ; hipLaunchKernelGGL(k_gemm_naive<NEpiProj>, dim3(T, DIN / 256), dim3(256), 0, stream, e, DIN, D); }
    else mk_launch(base, P_INPROJ, P_INPROJ + 1, li++, stream);
    if (REF_MIX) {
        hipLaunchKernelGGL(k_attn_scores, dim3(T * NH / 256), dim3(256), 0, stream, (const bf16*)PROJ, q_norm, k_norm, SC);
        hipLaunchKernelGGL(k_attn_out, dim3(T * NH * HD / 256), dim3(256), 0, stream, (const bf16*)PROJ, (const float*)SC, sinks, ATT);
        hipLaunchKernelGGL(k_ssm_scan, dim3(NB * NG * NST / 64), dim3(64), 0, stream, (const bf16*)PROJ, (const float*)SSMT, XST);
        hipLaunchKernelGGL(k_ssm_out, dim3(T * DSSM / 256), dim3(256), 0, stream, (const bf16*)PROJ, (const float*)XST, c_re, c_im, d_skip, Gb);
    } else { mk_launch(base, P_MIX_A, P_MIX_A + 1, li++, stream); mk_launch(base, P_MIX_B, P_MIX_B + 1, li++, stream); }
    if (REF_GLU) { NEpiGlu e{}; e.A = Gb; e.Bt = WTGLU; e.bias = b_glu; e.O = SSMG; hipLaunchKernelGGL(k_gemm_naive<NEpiGlu>, dim3(T, DSSM / 256), dim3(256), 0, stream, e, DSSM, DSSM); }
    else mk_launch(base, P_GLU, P_GLU + 1, li++, stream);
    if (REF_MIXNORM) hipLaunchKernelGGL(k_mixnorm, dim3(T / 4), dim3(256), 0, stream, (const bf16*)ATT, (const bf16*)SSMG, attn_out_norm, ssm_out_norm, MIXED);
    else mk_launch(base, P_MIXNORM, P_MIXNORM + 1, li++, stream);
    if (REF_OUTPROJ) { NEpiOut e{}; e.A = MIXED; e.Bt = WTOUT; e.x = x; e.mod = MOD; e.O = out; hipLaunchKernelGGL(k_gemm_naive<NEpiOut>, dim3(T, D / 256), dim3(256), 0, stream, e, D, D); }
    else mk_launch(base, P_OUTPROJ, P_OUTPROJ + 1, li++, stream);
    if (REF_ROUTER) hipLaunchKernelGGL(k_norm2_router, dim3(256), dim3(512), 32 * 1024 * 4 + 256 + 4096, stream, (const float*)out, norm_ffn, (const float*)MOD, w_router, b_router, H, TOPE, TOPW, HIST);
    else mk_launch(base, P_ROUTER, P_ROUTER + 1, li++, stream);
    if (REF_SORT) hipLaunchKernelGGL(k_sort, dim3(256), dim3(512), 0, stream, (const int*)HIST, (const int*)TOPE, (const float*)TOPW, TOKROW, ROWPAIR, WROW, TILEE);
    else mk_launch(base, P_SORT, P_SORT + 1, li++, stream);
    if (REF_GATEUP) { NEpiGU e{}; e.H = H; e.Wt = WTGU; e.bias = b_gate_up; e.tokrow = TOKROW; e.tilee = TILEE; e.ACT = ACT; hipLaunchKernelGGL(k_moe_gu_naive, dim3(MPAD, DFF / 256), dim3(256), 0, stream, e); }
    else mk_launch(base, P_GATEUP, P_GATEUP + 1, li++, stream);
    if (REF_DOWN) { NEpiDown e{}; e.ACT = ACT; e.Wt = WTDN; e.bias = b_down; e.wrow = WROW; e.tilee = TILEE; e.YS = YS; hipLaunchKernelGGL(k_gemm_naive<NEpiDown>, dim3(MPAD, D / 256), dim3(256), 0, stream, e, D, DFF); }
    else mk_launch(base, P_DOWN, P_DOWN + 1, li++, stream);
    if (REF_COMBINE) hipLaunchKernelGGL(k_combine, dim3(T / 4), dim3(256), 0, stream, out, (const float*)MOD, (const bf16*)YS, (const int*)ROWPAIR);
    else mk_launch(base, P_COMBINE, P_COMBINE + 1, li++, stream);
#endif
}
```

```cpp
#include <hip/hip_runtime.h>
#include <stdint.h>
#include <stdio.h>

#ifndef FAST_ATTN
#define FAST_ATTN 1
#endif
#ifndef FAST_SSM
#define FAST_SSM 1
#endif
#ifndef MOE_FP8_GU
#define MOE_FP8_GU 1
#endif
#ifndef MOE_FP8_DN
#define MOE_FP8_DN 1
#endif
#ifndef YS_FP8
#define YS_FP8 1
#endif
#ifndef P3_CONV
#define P3_CONV 0
#endif
#ifndef FUSE_MIXNORM
#define FUSE_MIXNORM 1
#endif
#ifndef X1_DELTA
#define X1_DELTA 1
#endif
#ifndef SSM_MFMA_CARRY
#define SSM_MFMA_CARRY 1
#endif
#ifndef X1_BF16
#define X1_BF16 1
#endif
#ifndef FAST_SORT
#define FAST_SORT 1
#endif
#ifndef FAST_ROUTER
#define FAST_ROUTER 1
#endif
#ifndef MK_MODE
#define MK_MODE 1
#endif

typedef unsigned short bf16;
typedef float f32x4 __attribute__((ext_vector_type(4)));
typedef float f32x2 __attribute__((ext_vector_type(2)));
typedef unsigned u32x4 __attribute__((ext_vector_type(4)));
typedef unsigned u32x2 __attribute__((ext_vector_type(2)));
typedef short bf16x8 __attribute__((ext_vector_type(8)));
typedef int i32x4 __attribute__((ext_vector_type(4)));
typedef int i32x8 __attribute__((ext_vector_type(8)));
constexpr float W8_SCALE = 32.0f, H8_SCALE = 4.0f, A8_SCALE = 4.0f, Y8_SCALE = 16.0f;
#define GAS __attribute__((address_space(1)))
#define LAS __attribute__((address_space(3)))

constexpr int D = 1024, NB = 8, S = 2048, T = NB * S;
constexpr int DATT = 512, HD = 64, NH = 8, NKV = 2, DKV = 128;
constexpr int DSSM = 512, SG = 16, NG = 32, NST = 64;
constexpr int DIN = 1280, NE = 32, TOPK = 4, DFF = 1024;
constexpr int QOFF = 0, KOFF = 512, VOFF = 640, UOFF = 768;
constexpr float EPS = 1e-6f;
constexpr int MAXTILES = 288, MPAD = MAXTILES * 256;

constexpr size_t MiB = 1u << 20;
constexpr size_t WS_CTL = 0, CTL_ZERO_BYTES = 256 * 1024;
constexpr size_t WS_MOD = 1 * MiB;
constexpr size_t WS_SSMT = 2 * MiB;
constexpr size_t WS_WTIN = 4 * MiB;
constexpr size_t WS_WTGLU = 7 * MiB;
constexpr size_t WS_WTOUT = 8 * MiB;
constexpr size_t WS_WTGU = 16 * MiB;
constexpr size_t WS_WTDN = 144 * MiB;
constexpr size_t WS_H = 208 * MiB;
constexpr size_t WS_PROJ = 240 * MiB;
constexpr size_t WS_ATT = 280 * MiB;
constexpr size_t WS_G = 296 * MiB;
constexpr size_t WS_SSMG = 312 * MiB;
constexpr size_t WS_MIXED = 328 * MiB;
constexpr size_t WS_TOPE = 360 * MiB;
constexpr size_t WS_TOPW = 361 * MiB;
constexpr size_t WS_HIST = 362 * MiB;
constexpr size_t WS_TOKROW = 363 * MiB;
constexpr size_t WS_ROWPAIR = 364 * MiB;
constexpr size_t WS_WROW = 365 * MiB;
constexpr size_t WS_TILEE = 366 * MiB;
constexpr size_t WS_CNT = 1024;
constexpr int CNT_STRIDE = 64;
constexpr size_t WS_TOKE = 332 * MiB;
constexpr size_t WS_WROWE = 336 * MiB;
constexpr size_t WS_APOW = 340 * MiB;
constexpr size_t WS_DELTA = 624 * MiB;
constexpr size_t WS_H8 = 660 * MiB;
constexpr size_t WS_WRI = 367 * MiB;
constexpr size_t WS_ACT = 368 * MiB;
constexpr size_t WS_YS = 512 * MiB;
constexpr size_t WS_XST = 368 * MiB;
constexpr size_t WS_SC = 624 * MiB;
constexpr size_t WS_X1B = 700 * MiB;
constexpr size_t WS_END = 740 * MiB;
constexpr int CW_BAR = 4096;

constexpr int ST_AR = 0, ST_AI = 64, ST_BR = 128, ST_BI = 128 + 1024, SSMT_STRIDE = 128 + 2048;

__host__ __device__ __forceinline__ int gu_row(int n) { const int j = n >> 1, half = n & 1; return (j >> 7) * 256 + half * 128 + (j & 127); }

__device__ __forceinline__ unsigned f2bf(float f) { unsigned u = __builtin_bit_cast(unsigned, f); return (u + 0x7fffu + ((u >> 16) & 1u)) >> 16; }
__device__ __forceinline__ float bf2f(unsigned b) { return __builtin_bit_cast(float, (b & 0xffffu) << 16); }
__device__ __forceinline__ unsigned pk2(float lo, float hi) { return f2bf(lo) | (f2bf(hi) << 16); }
__device__ __forceinline__ unsigned pk4_fp8(float a, float b, float c, float d) { unsigned w = 0u; w = __builtin_amdgcn_cvt_pk_fp8_f32(a, b, w, false); w = __builtin_amdgcn_cvt_pk_fp8_f32(c, d, w, true); return w; }
__device__ __forceinline__ float bflo(unsigned w) { return __builtin_bit_cast(float, w << 16); }
__device__ __forceinline__ float bfhi(unsigned w) { return __builtin_bit_cast(float, w & 0xffff0000u); }
__device__ __forceinline__ float wave_sum(float v) {
#pragma unroll
    for (int o = 1; o < 64; o <<= 1) v += __shfl_xor(v, o);
    return v;
}
__device__ __forceinline__ float sigmoidf_(float x) { return __builtin_amdgcn_rcpf(1.0f + __expf(-x)); }
__device__ __forceinline__ float gelu_tanh(float x) { const float u2 = 1.5957691216057308f * (x + 0.044715f * x * x * x); return x * sigmoidf_(u2); }
__device__ __forceinline__ float dot8(u32x4 a, u32x4 b, float acc) {
    acc = fmaf(bflo(a.x), bflo(b.x), acc); acc = fmaf(bfhi(a.x), bfhi(b.x), acc);
    acc = fmaf(bflo(a.y), bflo(b.y), acc); acc = fmaf(bfhi(a.y), bfhi(b.y), acc);
    acc = fmaf(bflo(a.z), bflo(b.z), acc); acc = fmaf(bfhi(a.z), bfhi(b.z), acc);
    acc = fmaf(bflo(a.w), bflo(b.w), acc); acc = fmaf(bfhi(a.w), bfhi(b.w), acc);
    return acc;
}

__device__ __forceinline__ void ssm_table_item(int i, const float* lam_re, const float* lam_im, const float* log_dt, const float* b_re, const float* b_im, float* tab) {
    const int g = i / NST, p = i % NST;
    const float lr = lam_re[i], li = lam_im[i], dt = expf(log_dt[g]);
    const float mag = expf(lr * dt), ang = li * dt;
    const float lbr = mag * cosf(ang), lbi = mag * sinf(ang);
    const float den = lr * lr + li * li;
    const float cr = ((lbr - 1.0f) * lr + lbi * li) / den, ci = (lbi * lr - (lbr - 1.0f) * li) / den;
    float* t = tab + (size_t)g * SSMT_STRIDE;
    t[ST_AR + p] = lbr; t[ST_AI + p] = lbi;
    for (int h = 0; h < SG; ++h) { const float br = b_re[(size_t)i * SG + h], bi = b_im[(size_t)i * SG + h];
        t[ST_BR + p * SG + h] = cr * br - ci * bi; t[ST_BI + p * SG + h] = cr * bi + ci * br; }
}
__device__ __forceinline__ void norm_mod_row(int row, int lane, const float* x, const float* gain, const float* mod, int sh_off, int sc_off, bf16* H) {
    const int b = row / S;
    const f32x4* xr = (const f32x4*)(x + (size_t)row * D) + lane;
    f32x4 v[4]; float s = 0.f;
#pragma unroll
    for (int j = 0; j < 4; ++j) { v[j] = xr[64 * j]; s += (v[j].x * v[j].x + v[j].y * v[j].y) + (v[j].z * v[j].z + v[j].w * v[j].w); }
    const float r = rsqrtf(wave_sum(s) * (1.0f / D) + EPS);
    u32x2* o = (u32x2*)(H + (size_t)row * D) + lane;
#pragma unroll
    for (int j = 0; j < 4; ++j) { const int c = 4 * lane + 256 * j;
        const f32x4 g = *(const f32x4*)(gain + c), sc = *(const f32x4*)(mod + b * 6 * D + sc_off + c), sh = *(const f32x4*)(mod + b * 6 * D + sh_off + c);
        f32x4 y; y.x = v[j].x * r * g.x * (1.f + sc.x) + sh.x; y.y = v[j].y * r * g.y * (1.f + sc.y) + sh.y; y.z = v[j].z * r * g.z * (1.f + sc.z) + sh.z; y.w = v[j].w * r * g.w * (1.f + sc.w) + sh.w;
        u32x2 w; w.x = pk2(y.x, y.y); w.y = pk2(y.z, y.w); o[64 * j] = w; }
}
__device__ __forceinline__ void mixnorm_row(int row, int lane, const bf16* ATT, const bf16* SSMG, const float* ga, const float* gs, bf16* MIXED) {
    const u32x4 a = *((const u32x4*)(ATT + (size_t)row * DATT) + lane), s = *((const u32x4*)(SSMG + (size_t)row * DSSM) + lane);
    const float av[8] = {bflo(a.x), bfhi(a.x), bflo(a.y), bfhi(a.y), bflo(a.z), bfhi(a.z), bflo(a.w), bfhi(a.w)};
    const float sv[8] = {bflo(s.x), bfhi(s.x), bflo(s.y), bfhi(s.y), bflo(s.z), bfhi(s.z), bflo(s.w), bfhi(s.w)};
    float qa = 0.f, qs = 0.f;
#pragma unroll
    for (int i = 0; i < 8; ++i) { qa += av[i] * av[i]; qs += sv[i] * sv[i]; }
    const float ra = rsqrtf(wave_sum(qa) * (1.0f / DATT) + EPS), rs = rsqrtf(wave_sum(qs) * (1.0f / DSSM) + EPS);
    const f32x4 ga0 = *(const f32x4*)(ga + 8 * lane), ga1 = *(const f32x4*)(ga + 8 * lane + 4), gs0 = *(const f32x4*)(gs + 8 * lane), gs1 = *(const f32x4*)(gs + 8 * lane + 4);
    u32x4 oa, os;
    oa.x = pk2(av[0] * ra * ga0.x, av[1] * ra * ga0.y); oa.y = pk2(av[2] * ra * ga0.z, av[3] * ra * ga0.w); oa.z = pk2(av[4] * ra * ga1.x, av[5] * ra * ga1.y); oa.w = pk2(av[6] * ra * ga1.z, av[7] * ra * ga1.w);
    os.x = pk2(sv[0] * rs * gs0.x, sv[1] * rs * gs0.y); os.y = pk2(sv[2] * rs * gs0.z, sv[3] * rs * gs0.w); os.z = pk2(sv[4] * rs * gs1.x, sv[5] * rs * gs1.y); os.w = pk2(sv[6] * rs * gs1.z, sv[7] * rs * gs1.w);
    *((u32x4*)(MIXED + (size_t)row * D) + lane) = oa; *((u32x4*)(MIXED + (size_t)row * D + DATT) + lane) = os;
}
__device__ __forceinline__ void combine_row(int row, int lane, float* out, const float* mod, const bf16* YS, const int* rowpair) {
    const int b = row / S; const int* rp = rowpair + (size_t)row * 4;
    const int r0 = rp[0], r1 = rp[1], r2 = rp[2], r3 = rp[3];
#pragma unroll
    for (int j = 0; j < 2; ++j) { const int c = 8 * lane + 512 * j;
        const u32x4 a = *(const u32x4*)(YS + (size_t)r0 * D + c), b2 = *(const u32x4*)(YS + (size_t)r1 * D + c), c2 = *(const u32x4*)(YS + (size_t)r2 * D + c), d2 = *(const u32x4*)(YS + (size_t)r3 * D + c);
        float y[8];
        y[0] = bflo(a.x) + bflo(b2.x) + bflo(c2.x) + bflo(d2.x); y[1] = bfhi(a.x) + bfhi(b2.x) + bfhi(c2.x) + bfhi(d2.x);
        y[2] = bflo(a.y) + bflo(b2.y) + bflo(c2.y) + bflo(d2.y); y[3] = bfhi(a.y) + bfhi(b2.y) + bfhi(c2.y) + bfhi(d2.y);
        y[4] = bflo(a.z) + bflo(b2.z) + bflo(c2.z) + bflo(d2.z); y[5] = bfhi(a.z) + bfhi(b2.z) + bfhi(c2.z) + bfhi(d2.z);
        y[6] = bflo(a.w) + bflo(b2.w) + bflo(c2.w) + bflo(d2.w); y[7] = bfhi(a.w) + bfhi(b2.w) + bfhi(c2.w) + bfhi(d2.w);
        float* op = out + (size_t)row * D + c; const float* g2 = mod + b * 6 * D + 5 * D + c;
        f32x4 o0 = *(f32x4*)op, o1 = *(f32x4*)(op + 4); const f32x4 g0 = *(const f32x4*)g2, g1 = *(const f32x4*)(g2 + 4);
        o0.x += g0.x * y[0]; o0.y += g0.y * y[1]; o0.z += g0.z * y[2]; o0.w += g0.w * y[3]; o1.x += g1.x * y[4]; o1.y += g1.y * y[5]; o1.z += g1.z * y[6]; o1.w += g1.w * y[7];
        *(f32x4*)op = o0; *(f32x4*)(op + 4) = o1; }
}
__device__ __forceinline__ void combine_row8(int row, int lane, float* out, const float* mod, const unsigned char* YS8, const int* rowpair) {
    const int b = row / S; const i32x4 rp = *(const i32x4*)(rowpair + (size_t)row * 4); const int c = 16 * lane;
    const u32x4 q0 = *(const u32x4*)(YS8 + (size_t)rp.x * D + c), q1 = *(const u32x4*)(YS8 + (size_t)rp.y * D + c), q2 = *(const u32x4*)(YS8 + (size_t)rp.z * D + c), q3 = *(const u32x4*)(YS8 + (size_t)rp.w * D + c);
    float* op = out + (size_t)row * D + c; const float* g2 = mod + b * 6 * D + 5 * D + c;
#pragma unroll
    for (int j = 0; j < 4; ++j) { const unsigned w0 = q0[j], w1 = q1[j], w2 = q2[j], w3 = q3[j];
        const f32x2 lo = __builtin_amdgcn_cvt_pk_f32_fp8(w0, false) + __builtin_amdgcn_cvt_pk_f32_fp8(w1, false) + __builtin_amdgcn_cvt_pk_f32_fp8(w2, false) + __builtin_amdgcn_cvt_pk_f32_fp8(w3, false);
        const f32x2 hi = __builtin_amdgcn_cvt_pk_f32_fp8(w0, true) + __builtin_amdgcn_cvt_pk_f32_fp8(w1, true) + __builtin_amdgcn_cvt_pk_f32_fp8(w2, true) + __builtin_amdgcn_cvt_pk_f32_fp8(w3, true);
        f32x4 o = *(f32x4*)(op + 4 * j); const f32x4 g = *(const f32x4*)(g2 + 4 * j);
        o.x += g.x * lo.x * (1.0f / Y8_SCALE); o.y += g.y * lo.y * (1.0f / Y8_SCALE); o.z += g.z * hi.x * (1.0f / Y8_SCALE); o.w += g.w * hi.y * (1.0f / Y8_SCALE);
        *(f32x4*)(op + 4 * j) = o; }
}
__device__ __forceinline__ void combine_rows8x2(int row, int lane, float* out, const float* mod, const unsigned char* YS8, const int* rowpair, const float* xin = nullptr, const bf16* delta = nullptr, const LAS int* cb = nullptr) {
    const int b = row / S, c = 16 * lane; i32x4 rp0 = *(const i32x4*)(rowpair + (size_t)row * 4), rp1 = *(const i32x4*)(rowpair + (size_t)row * 4 + 4);
    if (FAST_SORT && cb) {
#pragma unroll
        for (int k = 0; k < 4; ++k) { rp0[k] = (rp0[k] & 0xFFFFF) + cb[32 + (rp0[k] >> 20)]; rp1[k] = (rp1[k] & 0xFFFFF) + cb[32 + (rp1[k] >> 20)]; } }
    u32x4 q[2][4];
    q[0][0] = *(const u32x4*)(YS8 + (size_t)rp0.x * D + c); q[0][1] = *(const u32x4*)(YS8 + (size_t)rp0.y * D + c); q[0][2] = *(const u32x4*)(YS8 + (size_t)rp0.z * D + c); q[0][3] = *(const u32x4*)(YS8 + (size_t)rp0.w * D + c);
    q[1][0] = *(const u32x4*)(YS8 + (size_t)rp1.x * D + c); q[1][1] = *(const u32x4*)(YS8 + (size_t)rp1.y * D + c); q[1][2] = *(const u32x4*)(YS8 + (size_t)rp1.z * D + c); q[1][3] = *(const u32x4*)(YS8 + (size_t)rp1.w * D + c);
    const float* g2 = mod + b * 6 * D + 5 * D + c;
    f32x4 g[4], o[2][4];
#pragma unroll
    for (int j = 0; j < 4; ++j) { g[j] = *(const f32x4*)(g2 + 4 * j) * (1.0f / Y8_SCALE); const float* src = delta ? xin : out;
        if (src) { o[0][j] = *(const f32x4*)(src + (size_t)row * D + c + 4 * j); o[1][j] = *(const f32x4*)(src + (size_t)(row + 1) * D + c + 4 * j); } else { o[0][j] = (f32x4){0.f, 0.f, 0.f, 0.f}; o[1][j] = o[0][j]; } }
    if (delta) {
#pragma unroll
        for (int r = 0; r < 2; ++r) { const u32x4 d0 = *(const u32x4*)(delta + (size_t)(row + r) * D + c), d1 = *(const u32x4*)(delta + (size_t)(row + r) * D + c + 8);
            o[r][0] += (f32x4){bflo(d0.x), bfhi(d0.x), bflo(d0.y), bfhi(d0.y)}; o[r][1] += (f32x4){bflo(d0.z), bfhi(d0.z), bflo(d0.w), bfhi(d0.w)};
            o[r][2] += (f32x4){bflo(d1.x), bfhi(d1.x), bflo(d1.y), bfhi(d1.y)}; o[r][3] += (f32x4){bflo(d1.z), bfhi(d1.z), bflo(d1.w), bfhi(d1.w)}; } }
#pragma unroll
    for (int r = 0; r < 2; ++r)
#pragma unroll
        for (int j = 0; j < 4; ++j) { const unsigned w0 = q[r][0][j], w1 = q[r][1][j], w2 = q[r][2][j], w3 = q[r][3][j];
            const f32x2 lo = __builtin_amdgcn_cvt_pk_f32_fp8(w0, false) + __builtin_amdgcn_cvt_pk_f32_fp8(w1, false) + __builtin_amdgcn_cvt_pk_f32_fp8(w2, false) + __builtin_amdgcn_cvt_pk_f32_fp8(w3, false);
            const f32x2 hi = __builtin_amdgcn_cvt_pk_f32_fp8(w0, true) + __builtin_amdgcn_cvt_pk_f32_fp8(w1, true) + __builtin_amdgcn_cvt_pk_f32_fp8(w2, true) + __builtin_amdgcn_cvt_pk_f32_fp8(w3, true);
            f32x4 t = o[r][j]; t.x += g[j].x * lo.x; t.y += g[j].y * lo.y; t.z += g[j].z * hi.x; t.w += g[j].w * hi.y;
            *(f32x4*)(out + (size_t)(row + r) * D + c + 4 * j) = t; }
}
__device__ __forceinline__ void attn_scores_item(int idx, const bf16* PROJ, const float* qg, const float* kg, float* SC) {
    const int t = idx / NH, h = idx % NH, kvh = h / 4, b = t / S, tl = t % S;
    const bf16* q = PROJ + (size_t)t * DIN + QOFF + h * HD;
    float sq = 0.f;
    for (int d = 0; d < HD; ++d) { const float v = bf2f(q[d]); sq += v * v; }
    const float rq = rsqrtf(sq * (1.0f / HD) + EPS);
    for (int i = 0; i < 128; ++i) {
        const int sl = tl - 127 + i; float sc = -1e30f;
        if (sl >= 0) { const bf16* k = PROJ + (size_t)(b * S + sl) * DIN + KOFF + kvh * HD;
            float sk = 0.f, dt = 0.f;
            for (int d = 0; d < HD; ++d) { const float kv = bf2f(k[d]); sk += kv * kv; dt += bf2f(q[d]) * qg[d] * kv * kg[d]; }
            sc = dt * rq * rsqrtf(sk * (1.0f / HD) + EPS) * 0.125f; }
        SC[(size_t)idx * 128 + i] = sc; }
}
__device__ __forceinline__ void attn_out_item(int idx, const bf16* PROJ, const float* SC, const float* sinks, bf16* ATT) {
    const int d = idx % HD, th = idx / HD, h = th % NH, t = th / NH, kvh = h / 4, b = t / S, tl = t % S;
    const float* sc = SC + (size_t)th * 128; const float sink = sinks[h];
    float m = sink;
    for (int i = 0; i < 128; ++i) m = fmaxf(m, sc[i]);
    float den = __expf(sink - m), o = 0.f;
    for (int i = 0; i < 128; ++i) { const int sl = tl - 127 + i; if (sl < 0) continue;
        const float p = __expf(sc[i] - m); den += p; o += p * bf2f(PROJ[(size_t)(b * S + sl) * DIN + VOFF + kvh * HD + d]); }
    ATT[(size_t)t * DATT + h * HD + d] = (bf16)f2bf(o / den);
}
__device__ __forceinline__ void ssm_scan_item(int idx, const bf16* PROJ, const float* tab, float* XST) {
    const int p = idx % NST, g = (idx / NST) % NG, b = idx / (NST * NG);
    const float* tg = tab + (size_t)g * SSMT_STRIDE;
    const float ar = tg[ST_AR + p], ai = tg[ST_AI + p];
    float br[SG], bi[SG];
#pragma unroll
    for (int h = 0; h < SG; ++h) { br[h] = tg[ST_BR + p * SG + h]; bi[h] = tg[ST_BI + p * SG + h]; }
    float xr = 0.f, xi = 0.f;
    for (int t = 0; t < S; ++t) {
        const u32x4* up = (const u32x4*)(PROJ + (size_t)(b * S + t) * DIN + UOFF + g * SG);
        const u32x4 u0 = up[0], u1 = up[1];
        const float u[SG] = {bflo(u0.x), bfhi(u0.x), bflo(u0.y), bfhi(u0.y), bflo(u0.z), bfhi(u0.z), bflo(u0.w), bfhi(u0.w),
                             bflo(u1.x), bfhi(u1.x), bflo(u1.y), bfhi(u1.y), bflo(u1.z), bfhi(u1.z), bflo(u1.w), bfhi(u1.w)};
        float bur = 0.f, bui = 0.f;
#pragma unroll
        for (int h = 0; h < SG; ++h) { bur = fmaf(br[h], u[h], bur); bui = fmaf(bi[h], u[h], bui); }
        const float nr = ar * xr - ai * xi + bur, ni = ar * xi + ai * xr + bui; xr = nr; xi = ni;
        float* o = XST + (((size_t)(b * S + t) * NG + g) * NST + p) * 2; o[0] = xr; o[1] = xi;
    }
}
__device__ __forceinline__ void ssm_out_item(int idx, const bf16* PROJ, const float* XST, const float* c_re, const float* c_im, const float* d_skip, bf16* G) {
    const int ch = idx % DSSM, t = idx / DSSM, g = ch / SG, h = ch % SG;
    const float* x = XST + ((size_t)t * NG + g) * NST * 2; const float* cr = c_re + ((size_t)g * SG + h) * NST; const float* ci = c_im + ((size_t)g * SG + h) * NST;
    float y = 0.f;
    for (int p = 0; p < NST; ++p) y += cr[p] * x[2 * p] - ci[p] * x[2 * p + 1];
    y += d_skip[ch] * bf2f(PROJ[(size_t)t * DIN + UOFF + ch]);
    G[(size_t)t * DSSM + ch] = (bf16)f2bf(gelu_tanh(y));
}
__device__ __forceinline__ void norm2_router_rows(int blk, int wave, int lane, const float* x1, const float* gain, const float* mod, const float* b_router,
                                                  const LAS float* wr, LAS int* lh, LAS float* xs, bf16* H, int* tope, float* topw, unsigned char* H8 = nullptr) {
    const int b = (blk * 64) / S;
    f32x4 gm[4], sh[4];
#pragma unroll
    for (int j = 0; j < 4; ++j) { const int c = 4 * lane + 256 * j; const f32x4 g = *(const f32x4*)(gain + c), sc = *(const f32x4*)(mod + b * 6 * D + 4 * D + c);
        gm[j] = g * (1.0f + sc); sh[j] = *(const f32x4*)(mod + b * 6 * D + 3 * D + c); }
    const int my_e = lane >> 1; const float my_b = b_router[my_e];
    LAS float* lg = xs + wave * 128;
    LAS int* sel_e = (LAS int*)(xs + wave * 128 + 64);
    LAS float* sel_v = xs + wave * 128 + 72;
#pragma unroll 1
    for (int i = 0; i < 8; i += 2) {
        const int row0 = blk * 64 + wave * 8 + i;
        f32x4 v[2][4]; float ssq[2];
#pragma unroll
        for (int r = 0; r < 2; ++r) { const f32x4* xr = (const f32x4*)(x1 + (size_t)(row0 + r) * D) + lane; float s = 0.f;
#pragma unroll
            for (int j = 0; j < 4; ++j) { v[r][j] = xr[64 * j]; s += (v[r][j].x * v[r][j].x + v[r][j].y * v[r][j].y) + (v[r][j].z * v[r][j].z + v[r][j].w * v[r][j].w); }
            ssq[r] = s; }
#pragma unroll
        for (int o2 = 1; o2 < 64; o2 <<= 1) { ssq[0] += __shfl_xor(ssq[0], o2); asm volatile("" : "+v"(ssq[0])); ssq[1] += __shfl_xor(ssq[1], o2); asm volatile("" : "+v"(ssq[1])); }
#pragma unroll
        for (int r = 0; r < 2; ++r) { const float rs = rsqrtf(ssq[r] * (1.0f / D) + EPS); u32x2* o = (u32x2*)(H + (size_t)(row0 + r) * D) + lane;
#pragma unroll
            for (int j = 0; j < 4; ++j) { v[r][j] = v[r][j] * rs * gm[j] + sh[j]; if (H) { u32x2 w; w.x = pk2(v[r][j].x, v[r][j].y); w.y = pk2(v[r][j].z, v[r][j].w); o[64 * j] = w; }
                if (H8) *(unsigned*)(H8 + (size_t)(row0 + r) * D + 4 * lane + 256 * j) = pk4_fp8(v[r][j].x * H8_SCALE, v[r][j].y * H8_SCALE, v[r][j].z * H8_SCALE, v[r][j].w * H8_SCALE); } }
        float pe0[NE], pe1[NE];
#pragma unroll
        for (int e = 0; e < NE; ++e) { float a0 = 0.f, a1 = 0.f;
#pragma unroll
            for (int j = 0; j < 4; ++j) { const f32x4 w = *(const LAS f32x4*)(wr + e * D + 4 * lane + 256 * j);
                a0 += (v[0][j].x * w.x + v[0][j].y * w.y) + (v[0][j].z * w.z + v[0][j].w * w.w); asm volatile("" : "+v"(a0)); a1 += (v[1][j].x * w.x + v[1][j].y * w.y) + (v[1][j].z * w.z + v[1][j].w * w.w); asm volatile("" : "+v"(a1)); }
            pe0[e] = a0; pe1[e] = a1; }
#define BFLY(half, bit) { const bool up = (lane & (bit)) != 0; _Pragma("unroll") for (int k = 0; k < (half); ++k) { \
            const float k0 = up ? pe0[(half) + k] : pe0[k], s0 = up ? pe0[k] : pe0[(half) + k], k1 = up ? pe1[(half) + k] : pe1[k], s1 = up ? pe1[k] : pe1[(half) + k]; \
            pe0[k] = k0 + __shfl_xor(s0, (bit)); asm volatile("" : "+v"(pe0[k])); pe1[k] = k1 + __shfl_xor(s1, (bit)); asm volatile("" : "+v"(pe1[k])); } }
        BFLY(16, 32) BFLY(8, 16) BFLY(4, 8) BFLY(2, 4) BFLY(1, 2)
#undef BFLY
        const float l0 = pe0[0] + __shfl_xor(pe0[0], 1) + my_b, l1 = pe1[0] + __shfl_xor(pe1[0], 1) + my_b;
        if ((lane & 1) == 0) { lg[my_e] = l0; lg[32 + my_e] = l1; }
        asm volatile("s_waitcnt lgkmcnt(0)" ::: "memory");
        int rk0 = 0, rk1 = 0;
#pragma unroll
        for (int q = 0; q < 8; ++q) { const f32x4 a = *(const LAS f32x4*)(lg + 4 * q), c = *(const LAS f32x4*)(lg + 32 + 4 * q);
#pragma unroll
            for (int t = 0; t < 4; ++t) { const int e2 = 4 * q + t; rk0 += (a[t] > l0 || (a[t] == l0 && e2 < my_e)) ? 1 : 0; rk1 += (c[t] > l1 || (c[t] == l1 && e2 < my_e)) ? 1 : 0; } }
        if ((lane & 1) == 0) { if (rk0 < 4) { sel_e[rk0] = my_e; sel_v[rk0] = l0; } if (rk1 < 4) { sel_e[4 + rk1] = my_e; sel_v[4 + rk1] = l1; } }
        asm volatile("s_waitcnt lgkmcnt(0)" ::: "memory");
        if (lane < 2) { const i32x4 ee = *(const LAS i32x4*)(sel_e + 4 * lane); const f32x4 vv = *(const LAS f32x4*)(sel_v + 4 * lane);
            const int e0 = ee.x, e1 = ee.y, e2 = ee.z, e3 = ee.w;
            const float x1v = __expf(vv.y - vv.x), x2v = __expf(vv.z - vv.x), x3v = __expf(vv.w - vv.x), inv = 1.0f / (1.0f + x1v + x2v + x3v);
            int* te = tope + (size_t)(row0 + lane) * 4; float* tw = topw + (size_t)(row0 + lane) * 4;
            *(i32x4*)te = (i32x4){e0, e1, e2, e3}; *(f32x4*)tw = (f32x4){inv, x1v * inv, x2v * inv, x3v * inv};
            (void)__hip_atomic_fetch_add(&lh[e0], 1, __ATOMIC_RELAXED, __HIP_MEMORY_SCOPE_WORKGROUP); (void)__hip_atomic_fetch_add(&lh[e1], 1, __ATOMIC_RELAXED, __HIP_MEMORY_SCOPE_WORKGROUP);
            (void)__hip_atomic_fetch_add(&lh[e2], 1, __ATOMIC_RELAXED, __HIP_MEMORY_SCOPE_WORKGROUP); (void)__hip_atomic_fetch_add(&lh[e3], 1, __ATOMIC_RELAXED, __HIP_MEMORY_SCOPE_WORKGROUP); }
        asm volatile("s_waitcnt lgkmcnt(0)" ::: "memory");
    }
}
__device__ __forceinline__ void sort_block(int blk, int tid, LAS int* sm, const int* hist, const int* tope, const float* topw, int* tokrow, int* rowpair, float* wrow, int* tilee) {
    LAS int* tot = sm; LAS int* mine = sm + 32; LAS int* base = sm + 64; LAS int* es = sm + 128;
    { const int e = tid & 31, part = tid >> 5; int hv[16]; int a = 0, m = 0;
#pragma unroll
      for (int k = 0; k < 16; ++k) hv[k] = hist[(16 * part + k) * NE + e];
#pragma unroll
      for (int k = 0; k < 16; ++k) { a += hv[k]; if (16 * part + k < blk) m += hv[k]; }
      LAS int* pa = sm + 384; pa[part * 32 + e] = a; pa[512 + part * 32 + e] = m; }
    __syncthreads();
    if (tid < NE) { const LAS int* pa = sm + 384; int a = 0, m = 0;
#pragma unroll
        for (int p = 0; p < 16; ++p) { a += pa[p * 32 + tid]; m += pa[512 + p * 32 + tid]; } tot[tid] = a; mine[tid] = m; }
    __syncthreads();
    if (tid == 0) { int o = 0; for (int e = 0; e < NE; ++e) { base[e] = o; o += ((tot[e] + 255) >> 8) << 8; } base[NE] = o; }
    int my_e = 0, rank = 0;
    if (tid < 256) { my_e = tope[(size_t)(blk * 64) * 4 + tid]; const int lane = tid & 63, w = tid >> 6;
        const unsigned long long lt = (lane == 0) ? 0ull : (~0ull >> (64 - lane));
#pragma unroll 4
        for (int e = 0; e < NE; ++e) { const unsigned long long m = __ballot(my_e == e); if (my_e == e) rank = __popcll(m & lt); if (lane == 0) es[w * 32 + e] = __popcll(m); } }
    __syncthreads();
    if (tid < 256) { const int e = my_e, w = tid >> 6; for (int w2 = 0; w2 < w; ++w2) rank += es[w2 * 32 + e];
        const int pos = base[e] + mine[e] + rank, tok = blk * 64 + (tid >> 2);
        tokrow[pos] = tok; rowpair[(size_t)blk * 256 + tid] = pos; wrow[pos] = topw[(size_t)blk * 256 + tid]; }
    if (blk < NE) { const int e = blk; for (int r = base[e] + tot[e] + tid; r < base[e + 1]; r += 512) { tokrow[r] = 0; wrow[r] = 0.f; }
        for (int ti = (base[e] >> 8) + tid; ti < (base[e + 1] >> 8); ti += 512) tilee[64 + ti] = e; }
    if (blk == 0 && tid == 0) tilee[0] = base[NE] >> 8;
    __syncthreads();
}

__global__ void k_transpose_cvt(const float* __restrict__ W, bf16* __restrict__ WT, int K, int N, int perm_gu) {
    __shared__ float tile[32][33];
    const float* Wb = W + (size_t)blockIdx.z * K * N; bf16* WTb = WT + (size_t)blockIdx.z * K * N;
    const int n0 = blockIdx.x * 32, k0 = blockIdx.y * 32;
    for (int i = threadIdx.y; i < 32; i += 8) tile[i][threadIdx.x] = Wb[(size_t)(k0 + i) * N + n0 + threadIdx.x];
    __syncthreads();
    for (int i = threadIdx.y; i < 32; i += 8) { const int n = n0 + i, nr = perm_gu ? gu_row(n) : n; WTb[(size_t)nr * K + k0 + threadIdx.x] = (bf16)f2bf(tile[threadIdx.x][i]); }
}
__global__ void k_mod(const float* __restrict__ c, const float* __restrict__ w_ada, const float* __restrict__ b_ada, float* __restrict__ mod) {
    __shared__ float ca[NB][D];
    for (int i = threadIdx.x; i < NB * D; i += blockDim.x) { const float v = c[i]; ca[i / D][i % D] = v * sigmoidf_(v); }
    __syncthreads();
    const int j = blockIdx.x * blockDim.x + threadIdx.x;
    float acc[NB];
#pragma unroll
    for (int b = 0; b < NB; ++b) acc[b] = 0.f;
    for (int k = 0; k < D; ++k) { const float w = w_ada[(size_t)k * (6 * D) + j];
#pragma unroll
        for (int b = 0; b < NB; ++b) acc[b] = fmaf(ca[b][k], w, acc[b]); }
#pragma unroll
    for (int b = 0; b < NB; ++b) mod[b * 6 * D + j] = acc[b] + b_ada[j];
}
__global__ void k_ssm_tables(const float* lam_re, const float* lam_im, const float* log_dt, const float* b_re, const float* b_im, float* tab) {
    const int i = blockIdx.x * blockDim.x + threadIdx.x; if (i >= NG * NST) return;
    ssm_table_item(i, lam_re, lam_im, log_dt, b_re, b_im, tab);
}
__global__ void k_norm_mod(const float* x, const float* gain, const float* mod, int sh_off, int sc_off, bf16* H) {
    const int row = blockIdx.x * (blockDim.x / 64) + (threadIdx.x >> 6), lane = threadIdx.x & 63; if (row >= T) return;
    norm_mod_row(row, lane, x, gain, mod, sh_off, sc_off, H);
}
template <class Epi> __global__ void k_gemm_naive(Epi e, int N, int K) {
    const int n = blockIdx.y * blockDim.x + threadIdx.x, m = blockIdx.x; if (n >= N) return;
    if (!e.active(m)) return;
    const bf16* a = e.arow(m); const bf16* b = e.brow(m, n);
    float acc = 0.f;
    for (int k = 0; k < K; k += 8) acc = dot8(*(const u32x4*)(a + k), *(const u32x4*)(b + k), acc);
    e.store(m, n, acc);
}
struct NEpiProj { const bf16* A; const bf16* Bt; const float* bias; bf16* O;
    __device__ bool active(int) const { return true; }
    __device__ const bf16* arow(int m) const { return A + (size_t)m * D; }
    __device__ const bf16* brow(int, int n) const { return Bt + (size_t)n * D; }
    __device__ void store(int m, int n, float acc) const { O[(size_t)m * DIN + n] = (bf16)f2bf(acc + bias[n]); } };
struct NEpiGlu { const bf16* A; const bf16* Bt; const float* bias; bf16* O;
    __device__ bool active(int) const { return true; }
    __device__ const bf16* arow(int m) const { return A + (size_t)m * DSSM; }
    __device__ const bf16* brow(int, int n) const { return Bt + (size_t)n * DSSM; }
    __device__ void store(int m, int n, float acc) const { const float g = bf2f(A[(size_t)m * DSSM + n]); O[(size_t)m * DSSM + n] = (bf16)f2bf(g * sigmoidf_(acc + bias[n])); } };
struct NEpiOut { const bf16* A; const bf16* Bt; const float* x; const float* mod; float* O;
    __device__ bool active(int) const { return true; }
    __device__ const bf16* arow(int m) const { return A + (size_t)m * D; }
    __device__ const bf16* brow(int, int n) const { return Bt + (size_t)n * D; }
    __device__ void store(int m, int n, float acc) const { const int b = m / S; O[(size_t)m * D + n] = x[(size_t)m * D + n] + mod[b * 6 * D + 2 * D + n] * acc; } };
struct NEpiGU { const bf16* H; const bf16* Wt; const float* bias; const int* tokrow; const int* tilee; bf16* ACT; };
struct NEpiDown { const bf16* ACT; const bf16* Wt; const float* bias; const float* wrow; const int* tilee; bf16* YS;
    __device__ bool active(int m) const { return (m >> 8) < tilee[0]; }
    __device__ const bf16* arow(int m) const { return ACT + (size_t)m * DFF; }
    __device__ const bf16* brow(int m, int n) const { const int e = tilee[64 + (m >> 8)]; return Wt + ((size_t)e * D + n) * DFF; }
    __device__ void store(int m, int n, float acc) const { const int e = tilee[64 + (m >> 8)]; YS[(size_t)m * D + n] = (bf16)f2bf((acc + bias[e * D + n]) * wrow[m]); } };
__global__ void k_moe_gu_naive(NEpiGU e) {
    const int j = blockIdx.y * blockDim.x + threadIdx.x, m = blockIdx.x;
    if ((m >> 8) >= e.tilee[0]) return;
    const int ex = e.tilee[64 + (m >> 8)], t = e.tokrow[m];
    const bf16* a = e.H + (size_t)t * D; const bf16* b0 = e.Wt + ((size_t)ex * 2 * DFF + gu_row(2 * j)) * D; const bf16* b1 = e.Wt + ((size_t)ex * 2 * DFF + gu_row(2 * j + 1)) * D;
    float g = 0.f, u = 0.f;
    for (int k = 0; k < D; k += 8) { const u32x4 av = *(const u32x4*)(a + k); g = dot8(av, *(const u32x4*)(b0 + k), g); u = dot8(av, *(const u32x4*)(b1 + k), u); }
    g += e.bias[ex * 2 * DFF + 2 * j]; u += e.bias[ex * 2 * DFF + 2 * j + 1];
    g = fminf(g, 7.0f); u = fminf(fmaxf(u, -7.0f), 7.0f);
    e.ACT[(size_t)m * DFF + j] = (bf16)f2bf((u + 1.0f) * (g * sigmoidf_(1.702f * g)));
}
__global__ void k_attn_scores(const bf16* PROJ, const float* qg, const float* kg, float* SC) { const int idx = blockIdx.x * blockDim.x + threadIdx.x; if (idx < T * NH) attn_scores_item(idx, PROJ, qg, kg, SC); }
__global__ void k_attn_out(const bf16* PROJ, const float* SC, const float* sinks, bf16* ATT) { const int idx = blockIdx.x * blockDim.x + threadIdx.x; if (idx < T * NH * HD) attn_out_item(idx, PROJ, SC, sinks, ATT); }
__global__ void k_ssm_scan(const bf16* PROJ, const float* tab, float* XST) { const int idx = blockIdx.x * blockDim.x + threadIdx.x; if (idx < NB * NG * NST) ssm_scan_item(idx, PROJ, tab, XST); }
__global__ void k_ssm_out(const bf16* PROJ, const float* XST, const float* c_re, const float* c_im, const float* d_skip, bf16* G) { const int idx = blockIdx.x * blockDim.x + threadIdx.x; if (idx < T * DSSM) ssm_out_item(idx, PROJ, XST, c_re, c_im, d_skip, G); }
__global__ void k_mixnorm(const bf16* ATT, const bf16* SSMG, const float* ga, const float* gs, bf16* MIXED) {
    const int row = blockIdx.x * (blockDim.x / 64) + (threadIdx.x >> 6), lane = threadIdx.x & 63; if (row >= T) return;
    mixnorm_row(row, lane, ATT, SSMG, ga, gs, MIXED);
}
__global__ void __launch_bounds__(512) k_norm2_router(const float* x1, const float* gain, const float* mod, const float* w_router, const float* b_router, bf16* H, int* tope, float* topw, int* hist) {
    extern __shared__ __attribute__((aligned(16))) unsigned char smem[];
    LAS float* wr = (LAS float*)smem; LAS int* lh = (LAS int*)((LAS unsigned char*)smem + 32 * 1024 * 4);
    const int tid = threadIdx.x;
    for (int i = tid; i < D * NE; i += 512) { const int c = i / NE, e = i % NE; wr[e * D + c] = w_router[i]; }
    if (tid < NE) lh[tid] = 0;
    __syncthreads();
    norm2_router_rows(blockIdx.x, tid >> 6, tid & 63, x1, gain, mod, b_router, wr, lh, (LAS float*)((LAS unsigned char*)smem + 32 * 1024 * 4 + 256), H, tope, topw);
    __syncthreads();
    if (tid < NE) hist[blockIdx.x * NE + tid] = lh[tid];
}
__global__ void __launch_bounds__(512) k_sort(const int* hist, const int* tope, const float* topw, int* tokrow, int* rowpair, float* wrow, int* tilee) {
    __shared__ int sm[1408];
    sort_block(blockIdx.x, threadIdx.x, (LAS int*)sm, hist, tope, topw, tokrow, rowpair, wrow, tilee);
}
__global__ void k_combine(float* out, const float* mod, const bf16* YS, const int* rowpair) {
    const int row = blockIdx.x * (blockDim.x / 64) + (threadIdx.x >> 6), lane = threadIdx.x & 63; if (row >= T) return;
    combine_row(row, lane, out, mod, YS, rowpair);
}

namespace pg8 {
constexpr int BM = 256, BK = 64, HALF = 128, HTB = HALF * BK * 2  , STAGE_BYTES = 8 * HTB, NXCD = 8, WGM = 8;
__host__ __device__ __forceinline__ int lds_byte(int r, int c) { const int st = (r >> 4) * 2 + (c >> 5), rr = r & 15, cc = c & 31, ob = rr * 64 + cc * 2; return st * 1024 + (ob ^ (((ob >> 9) & 1) << 5)); }
__host__ __device__ __forceinline__ void stage_rc(int b, int& R, int& C) { const int st = b / 1024, sb = b % 1024, swz = sb ^ (((sb >> 9) & 1) << 5); R = (st >> 1) * 16 + swz / 64; C = (st & 1) * 32 + (swz % 64) / 2; }
__host__ __device__ __forceinline__ int perm32(int rho) { const int n = rho >> 4, i = rho & 15; return 8 * (i >> 2) + 4 * n + (i & 3); }
struct Unit { int pm, pn; };
__device__ __forceinline__ bool order_next(int nM, int nN, int G, int c, int i, Unit& u) {
    const int nwg = nM * nN; const long L = (long)i * G + c; if (L >= nwg) return false;
    int wgid = (int)L; { const int q = nwg / NXCD, r = nwg % NXCD, xcd = wgid % NXCD, off = wgid / NXCD; wgid = (xcd < r ? xcd * (q + 1) : r * (q + 1) + (xcd - r) * q) + off; }
    const int nig = WGM * nN, gid = wgid / nig, fm = gid * WGM, gsz = (nM - fm) < WGM ? (nM - fm) : WGM;
    u.pm = fm + ((wgid % nig) % gsz); u.pn = (wgid % nig) / gsz; return true;
}
struct DenseOrder {
    const char* A; const char* Bt; int nM, nN, G, c; size_t tstep;
    __device__ __forceinline__ bool next(int i, Unit& u) const { return order_next(nM, nN, G, c, i, u); }
    __device__ __forceinline__ const char* a_base(const Unit& u) const { return A + (size_t)u.pm * tstep; }
    __device__ __forceinline__ const char* b_base(const Unit& u) const { return Bt + (size_t)u.pn * tstep; }
    __device__ __forceinline__ int a_row(int) const { return 0; }
    __device__ __forceinline__ int ka(int K) const { return K; }
    __device__ __forceinline__ size_t a_koff(int t) const { return (size_t)t * (BK * 2); }
};
struct MixOrder {
    const char* A; const char* Bt; int nM, nN, G, c; size_t delta;
    __device__ __forceinline__ bool next(int i, Unit& u) const { return order_next(nM, nN, G, c, i, u); }
    __device__ __forceinline__ const char* a_base(const Unit& u) const { return A + (size_t)u.pm * (256 * 512 * 2); }
    __device__ __forceinline__ const char* b_base(const Unit& u) const { return Bt + (size_t)u.pn * (256 * 1024 * 2); }
    __device__ __forceinline__ int a_row(int) const { return 0; }
    __device__ __forceinline__ int ka(int) const { return 512; }
    __device__ __forceinline__ size_t a_koff(int t) const { return (size_t)(t & 7) * (BK * 2) + (size_t)(t >> 3) * delta; }
};
struct MoeOrder {
    const char* A; const char* Bt; const int* tokrow; const LAS int* te; int nM, nN, G, c; size_t tstep, estride; const LAS int* cb = nullptr;
    __device__ __forceinline__ bool next(int i, Unit& u) const { return order_next(nM, nN, G, c, i, u); }
    __device__ __forceinline__ const char* a_base(const Unit& u) const { return A + (size_t)u.pm * tstep; }
    __device__ __forceinline__ const char* b_base(const Unit& u) const { return Bt + (size_t)__builtin_amdgcn_readfirstlane(te[u.pm]) * estride + (size_t)u.pn * tstep; }
    __device__ __forceinline__ int a_row(int r) const { if (FAST_SORT && cb) { const int e = te[r >> 8], rin = r - cb[32 + e]; return rin < cb[e] ? tokrow[(size_t)e * T + rin] : 0; } return tokrow[r]; }
    __device__ __forceinline__ int ka(int K) const { return K; }
    __device__ __forceinline__ size_t a_koff(int t) const { return (size_t)t * (BK * 2); }
};
__device__ __forceinline__ unsigned cvt_pk_bf16(float lo, float hi) { unsigned r; asm volatile("v_cvt_pk_bf16_f32 %0, %1, %2" : "=v"(r) : "v"(lo), "v"(hi)); return r; }

__device__ __forceinline__ void dma_row256(const float* src, LAS float* dst) { if (threadIdx.x < 64) __builtin_amdgcn_global_load_lds((const unsigned*)(src + 4 * threadIdx.x), (LAS unsigned*)dst, 16, 0, 0); }
struct EpiProj {
    static constexpr bool PERM = true, MIDK = false, BEGIN = true;
    bf16* O; int ldc; const float* bias; LAS float* tb;
    __device__ __forceinline__ void begin(const Unit& u, int ui) const { dma_row256(bias + u.pn * BM, tb + (ui & 1) * 512); }
    __device__ __forceinline__ void operator()(const f32x4 (&acc)[2][2][4][2], const Unit& u, int wr, int wc, int fr, int fq, int ui) const {
        const int row0 = u.pm * BM + wr * 64 + fr, col0 = u.pn * BM + wc * 32 + 8 * fq;
        f32x4 bv[2][2];
#pragma unroll
        for (int bj = 0; bj < 2; ++bj)
#pragma unroll
            for (int n = 0; n < 2; ++n) bv[bj][n] = *(const LAS f32x4*)(tb + (ui & 1) * 512 + wc * 32 + 8 * fq + bj * HALF + 4 * n);
#pragma unroll
        for (int ai = 0; ai < 2; ++ai)
#pragma unroll
            for (int m = 0; m < 4; ++m) { bf16* rowp = O + (size_t)(row0 + ai * HALF + m * 16) * ldc + col0;
#pragma unroll
                for (int bj = 0; bj < 2; ++bj) { const f32x4 v0 = acc[ai][bj][m][0] + bv[bj][0], v1 = acc[ai][bj][m][1] + bv[bj][1];
                    u32x4 w; w.x = cvt_pk_bf16(v0[0], v0[1]); w.y = cvt_pk_bf16(v0[2], v0[3]); w.z = cvt_pk_bf16(v1[0], v1[1]); w.w = cvt_pk_bf16(v1[2], v1[3]);
                    *(u32x4*)(rowp + bj * HALF) = w; } }
    }
};
struct EpiGlu {
    static constexpr bool PERM = true, MIDK = false, BEGIN = true;
    const bf16* Gin; bf16* O; const float* bias; float* SQ; LAS float* tb;
    __device__ __forceinline__ void begin(const Unit& u, int ui) const { dma_row256(bias + u.pn * BM, tb + (ui & 1) * 512); }
    __device__ __forceinline__ void operator()(const f32x4 (&acc)[2][2][4][2], const Unit& u, int wr, int wc, int fr, int fq, int ui) const {
        const int row0 = u.pm * BM + wr * 64 + fr, col0 = u.pn * BM + wc * 32 + 8 * fq;
        f32x4 bv[2][2];
#pragma unroll
        for (int bj = 0; bj < 2; ++bj)
#pragma unroll
            for (int n = 0; n < 2; ++n) bv[bj][n] = *(const LAS f32x4*)(tb + (ui & 1) * 512 + wc * 32 + 8 * fq + bj * HALF + 4 * n);
#pragma unroll
        for (int ai = 0; ai < 2; ++ai) {
            u32x4 gin[4][2];
#pragma unroll
            for (int m = 0; m < 4; ++m)
#pragma unroll
                for (int bj = 0; bj < 2; ++bj) gin[m][bj] = *(const u32x4*)(Gin + (size_t)(row0 + ai * HALF + m * 16) * DSSM + col0 + bj * HALF);
#pragma unroll
            for (int m = 0; m < 4; ++m) { const int row = row0 + ai * HALF + m * 16; const size_t off = (size_t)row * DSSM + col0; float sq = 0.f;
#pragma unroll
                for (int bj = 0; bj < 2; ++bj) { const f32x4 z0 = acc[ai][bj][m][0] + bv[bj][0], z1 = acc[ai][bj][m][1] + bv[bj][1];
                    const u32x4 g = gin[m][bj];
                    const float p0 = bflo(g.x) * sigmoidf_(z0[0]), p1 = bfhi(g.x) * sigmoidf_(z0[1]), p2 = bflo(g.y) * sigmoidf_(z0[2]), p3 = bfhi(g.y) * sigmoidf_(z0[3]);
                    const float p4 = bflo(g.z) * sigmoidf_(z1[0]), p5 = bfhi(g.z) * sigmoidf_(z1[1]), p6 = bflo(g.w) * sigmoidf_(z1[2]), p7 = bfhi(g.w) * sigmoidf_(z1[3]);
                    sq += ((p0 * p0 + p1 * p1) + (p2 * p2 + p3 * p3)) + ((p4 * p4 + p5 * p5) + (p6 * p6 + p7 * p7));
                    u32x4 w; w.x = cvt_pk_bf16(p0, p1); w.y = cvt_pk_bf16(p2, p3); w.z = cvt_pk_bf16(p4, p5); w.w = cvt_pk_bf16(p6, p7);
                    *(u32x4*)(O + off + bj * HALF) = w; }
                if (SQ) { sq += __shfl_xor(sq, 16); sq += __shfl_xor(sq, 32); if (fq == 0) SQ[(size_t)row * 8 + u.pn * 4 + wc] = sq; } } }
    }
};
struct EpiOut {
    static constexpr bool PERM = X1_DELTA != 0, MIDK = FUSE_MIXNORM != 0, BEGIN = true;
    const float* x; const float* mod; float* O; const float* ASQ; const float* SSQ; LAS float* tbl; LAS float* tb;
    __device__ __forceinline__ float row_sum8(const float* p, int row) const { const f32x4 a = *(const f32x4*)(p + (size_t)row * 8), b = *(const f32x4*)(p + (size_t)row * 8 + 4); return ((a.x + a.y) + (a.z + a.w)) + ((b.x + b.y) + (b.z + b.w)); }
    __device__ __forceinline__ void begin(const Unit& u, int ui) const {
        if (X1_DELTA) { const int b = (u.pm * BM) / S; dma_row256(mod + b * 6 * D + 2 * D + u.pn * BM, tb + (ui & 1) * 512); }
        if constexpr (!MIDK) return;
        const int r = threadIdx.x; if (r < BM) { const int row = u.pm * BM + r;
            const float ra = rsqrtf(row_sum8(ASQ, row) * (1.0f / DATT) + EPS), rs = rsqrtf(row_sum8(SSQ, row) * (1.0f / DSSM) + EPS);
            *(LAS f32x2*)(tbl + (ui & 1) * 512 + 2 * r) = (f32x2){ra / rs, rs}; }
    }
    __device__ __forceinline__ void mid(f32x4 (&acc)[2][2][4][2], int ui, int wr, int fr) const {
#pragma unroll
        for (int ai = 0; ai < 2; ++ai)
#pragma unroll
            for (int m = 0; m < 4; ++m) { const float rho = tbl[(ui & 1) * 512 + 2 * (wr * 64 + fr + ai * HALF + m * 16)];
#pragma unroll
                for (int bj = 0; bj < 2; ++bj)
#pragma unroll
                    for (int n = 0; n < 2; ++n) acc[ai][bj][m][n] = acc[ai][bj][m][n] * rho; }
    }
    __device__ __forceinline__ void operator()(const f32x4 (&acc)[2][2][4][2], const Unit& u, int wr, int wc, int fr, int fq, int ui = 0) const {
        const int b = (u.pm * BM) / S;
        if constexpr (X1_DELTA) {
            const int col0 = u.pn * BM + wc * 32 + 8 * fq;
            f32x4 gv[2][2];
#pragma unroll
            for (int bj = 0; bj < 2; ++bj)
#pragma unroll
                for (int n = 0; n < 2; ++n) gv[bj][n] = *(const LAS f32x4*)(tb + (ui & 1) * 512 + wc * 32 + 8 * fq + bj * HALF + 4 * n);
#pragma unroll
            for (int ai = 0; ai < 2; ++ai)
#pragma unroll
                for (int m = 0; m < 4; ++m) { const int lr = wr * 64 + fr + ai * HALF + m * 16; bf16* rowp = (bf16*)O + (size_t)(u.pm * BM + lr) * D + col0;
                    const float rs = MIDK ? tbl[(ui & 1) * 512 + 2 * lr + 1] : 1.0f;
#pragma unroll
                    for (int bj = 0; bj < 2; ++bj) { const f32x4 v0 = gv[bj][0] * (acc[ai][bj][m][0] * rs), v1 = gv[bj][1] * (acc[ai][bj][m][1] * rs);
                        u32x4 w; w.x = cvt_pk_bf16(v0[0], v0[1]); w.y = cvt_pk_bf16(v0[2], v0[3]); w.z = cvt_pk_bf16(v1[0], v1[1]); w.w = cvt_pk_bf16(v1[2], v1[3]);
                        *(u32x4*)(rowp + bj * HALF) = w; } }
        } else {
        const int row0 = u.pm * BM + wr * 64 + fr, col0 = u.pn * BM + wc * 32 + 4 * fq;
        f32x4 gv[2][2];
#pragma unroll
        for (int bj = 0; bj < 2; ++bj)
#pragma unroll
            for (int n = 0; n < 2; ++n) gv[bj][n] = *(const f32x4*)(mod + b * 6 * D + 2 * D + col0 + bj * HALF + n * 16);
#pragma unroll
        for (int ai = 0; ai < 2; ++ai)
#pragma unroll
            for (int m = 0; m < 4; ++m) { const int lr = wr * 64 + fr + ai * HALF + m * 16; const size_t off = (size_t)(u.pm * BM + lr) * D + col0;
                const float rs = MIDK ? tbl[(ui & 1) * 512 + 2 * lr + 1] : 1.0f;
#pragma unroll
                for (int bj = 0; bj < 2; ++bj)
#pragma unroll
                    for (int n = 0; n < 2; ++n) { const f32x4 xv = __builtin_nontemporal_load((const f32x4*)(x + off + bj * HALF + n * 16)); *(f32x4*)(O + off + bj * HALF + n * 16) = xv + gv[bj][n] * (acc[ai][bj][m][n] * rs); } }
        }
    }
};
template <bool OUT8> struct EpiGateUp {
    static constexpr bool PERM = true, MIDK = false, BEGIN = true;
    void* ACTp; const float* bias; const LAS int* te; float ascale; LAS float* tb;
    __device__ __forceinline__ void begin(const Unit& u, int ui) const { const int e = __builtin_amdgcn_readfirstlane(te[u.pm]); dma_row256(bias + (size_t)e * 2 * DFF + 2 * (u.pn * HALF), tb + (ui & 1) * 512); }
    __device__ __forceinline__ void operator()(const f32x4 (&acc)[2][2][4][2], const Unit& u, int wr, int wc, int fr, int fq, int ui) const {
        const int row0 = u.pm * BM + wr * 64 + fr, ac0 = u.pn * HALF + wc * 32 + 8 * fq;
        const LAS float* bp = tb + (ui & 1) * 512 + 2 * (wc * 32 + 8 * fq);
        const f32x4 b0 = *(const LAS f32x4*)bp, b1 = *(const LAS f32x4*)(bp + 4), b2 = *(const LAS f32x4*)(bp + 8), b3 = *(const LAS f32x4*)(bp + 12);
        const float bg[8] = {b0[0], b0[2], b1[0], b1[2], b2[0], b2[2], b3[0], b3[2]}, bu[8] = {b0[1], b0[3], b1[1], b1[3], b2[1], b2[3], b3[1], b3[3]};
        const f32x2 asc2 = {ascale, ascale}, zc2 = {-1.702f * 1.4426950408889634f, -1.702f * 1.4426950408889634f}, one2 = {1.0f, 1.0f}, os2 = {OUT8 ? A8_SCALE : 1.0f, OUT8 ? A8_SCALE : 1.0f};
#pragma unroll
        for (int ai = 0; ai < 2; ++ai)
#pragma unroll
            for (int m = 0; m < 4; ++m) { float a[8];
#pragma unroll
                for (int k = 0; k < 8; k += 2) {
                    f32x2 g = (f32x2){acc[ai][0][m][k >> 2][k & 3], acc[ai][0][m][k >> 2][(k & 3) + 1]} * asc2 + (f32x2){bg[k], bg[k + 1]};
                    f32x2 up = (f32x2){acc[ai][1][m][k >> 2][k & 3], acc[ai][1][m][k >> 2][(k & 3) + 1]} * asc2 + (f32x2){bu[k], bu[k + 1]};
                    g.x = fminf(g.x, 7.0f); g.y = fminf(g.y, 7.0f); up.x = __builtin_amdgcn_fmed3f(up.x, -7.0f, 7.0f); up.y = __builtin_amdgcn_fmed3f(up.y, -7.0f, 7.0f);
                    const f32x2 z = g * zc2; f32x2 ex; ex.x = __builtin_amdgcn_exp2f(z.x); ex.y = __builtin_amdgcn_exp2f(z.y);
                    const f32x2 dn = ex + one2; f32x2 sg; sg.x = __builtin_amdgcn_rcpf(dn.x); sg.y = __builtin_amdgcn_rcpf(dn.y);
                    const f32x2 r2 = (up * os2 + os2) * (g * sg); a[k] = r2.x; a[k + 1] = r2.y; }
                const size_t off = (size_t)(row0 + ai * HALF + m * 16) * DFF + ac0;
                if constexpr (OUT8) { u32x2 w; w.x = pk4_fp8(a[0], a[1], a[2], a[3]); w.y = pk4_fp8(a[4], a[5], a[6], a[7]); *(u32x2*)((unsigned char*)ACTp + off) = w; }
                else { u32x4 w; w.x = cvt_pk_bf16(a[0], a[1]); w.y = cvt_pk_bf16(a[2], a[3]); w.z = cvt_pk_bf16(a[4], a[5]); w.w = cvt_pk_bf16(a[6], a[7]); *(u32x4*)((bf16*)ACTp + off) = w; } }
    }
};
template <bool OUT8> struct EpiDown {
    static constexpr bool PERM = true, MIDK = false, BEGIN = true;
    void* YSp; const float* bias; const float* wrow; const LAS int* te; float ascale; const LAS int* cb; LAS float* tb;
    const float* zero;
    __device__ __forceinline__ void begin(const Unit& u, int ui) const { const int t = threadIdx.x, e = __builtin_amdgcn_readfirstlane(te[u.pm]);
        dma_row256(bias + (size_t)e * D + u.pn * BM, tb + (ui & 1) * 512);
        if (t >= 64 && t < 320) { const int w4 = __builtin_amdgcn_readfirstlane((t >> 6) - 1), r = t - 64, row = u.pm * BM + r; const float* src;
            if (FAST_SORT && cb) { const int rin = row - cb[32 + e]; src = rin < cb[e] ? wrow + (size_t)e * T + rin : zero; } else src = wrow + row;
            __builtin_amdgcn_global_load_lds((const unsigned*)src, (LAS unsigned*)(tb + (ui & 1) * 512 + 256 + 64 * w4), 4, 0, 0); } }
    __device__ __forceinline__ void operator()(const f32x4 (&acc)[2][2][4][2], const Unit& u, int wr, int wc, int fr, int fq, int ui) const {
        const int row0 = u.pm * BM + wr * 64 + fr, col0 = u.pn * BM + wc * 32 + 8 * fq;
        f32x4 bv[2][2];
#pragma unroll
        for (int bj = 0; bj < 2; ++bj)
#pragma unroll
            for (int n = 0; n < 2; ++n) bv[bj][n] = *(const LAS f32x4*)(tb + (ui & 1) * 512 + wc * 32 + 8 * fq + bj * HALF + 4 * n);
        float wts[2][4];
#pragma unroll
        for (int ai = 0; ai < 2; ++ai)
#pragma unroll
            for (int m = 0; m < 4; ++m) wts[ai][m] = tb[(ui & 1) * 512 + 256 + wr * 64 + fr + ai * HALF + m * 16];
#pragma unroll
        for (int ai = 0; ai < 2; ++ai)
#pragma unroll
            for (int m = 0; m < 4; ++m) { const int row = row0 + ai * HALF + m * 16; const float wt = wts[ai][m] * (OUT8 ? Y8_SCALE : 1.0f); const size_t off = (size_t)row * D + col0;
#pragma unroll
                for (int bj = 0; bj < 2; ++bj) { const f32x4 v0 = (acc[ai][bj][m][0] * ascale + bv[bj][0]) * wt, v1 = (acc[ai][bj][m][1] * ascale + bv[bj][1]) * wt;
                    if constexpr (OUT8) { u32x2 w; w.x = pk4_fp8(v0[0], v0[1], v0[2], v0[3]); w.y = pk4_fp8(v1[0], v1[1], v1[2], v1[3]); *(u32x2*)((unsigned char*)YSp + off + bj * HALF) = w; }
                    else { u32x4 w; w.x = cvt_pk_bf16(v0[0], v0[1]); w.y = cvt_pk_bf16(v0[2], v0[3]); w.z = cvt_pk_bf16(v1[0], v1[1]); w.w = cvt_pk_bf16(v1[2], v1[3]); *(u32x4*)((bf16*)YSp + off + bj * HALF) = w; } } }
    }
};

template <class Epi, class Sched, bool ALIGN_EPI, bool GATHER, bool FP8 = false>
__device__ __forceinline__ void gemm_phase(LAS unsigned char* lds, const int K, const Sched& S, const Epi& E) {
    const int tid = threadIdx.x, wid = __builtin_amdgcn_readfirstlane(tid >> 6), lane = tid & 63, wr = wid >> 2, wc = wid & 3, fr = lane & 15, fq = lane >> 4;
    const int nt = K / BK;
    int Rr[2], Cc[2]; unsigned voffA[2], voffB[2];
#pragma unroll
    for (int i = 0; i < 2; ++i) { int R, C; stage_rc(tid * 16 + i * 8192, R, C); const int Rb = Epi::PERM ? ((R & ~31) + perm32(R & 31)) : R;
        Rr[i] = R; Cc[i] = C; voffA[i] = (unsigned)(R * S.ka(K) + C) * 2u; voffB[i] = (unsigned)(Rb * K + C) * 2u; }
    const size_t kstep = (size_t)(BK * 2);
    const size_t hstep = (size_t)HALF * K * 2;
    const size_t hstepA = (size_t)HALF * S.ka(K) * 2;
    const unsigned ldsw = (unsigned)wid * 1024u;
    const int aoff = lds_byte(wr * 64 + fr, fq * 8), boff = lds_byte(wc * 32 + fr, fq * 8);
#define PG8_SA(b, h) (((b) * 2 + (h)) * HTB)
#define PG8_SB(b, h) ((4 + (b) * 2 + (h)) * HTB)
#define PG8_STAGE(bufoff, gbase, voff) do { _Pragma("unroll") for (int _i = 0; _i < 2; ++_i) \
        __builtin_amdgcn_global_load_lds((const unsigned*)((const char*)(gbase) + (voff)[_i]), (LAS unsigned*)(lds + (bufoff) + ldsw + _i * 8192), 16, 0, 0); } while (0)
#define PG8_STAGE_A(bufoff, ab, koff, h, g0, g1) do { if constexpr (GATHER) { if ((h) == 0) PG8_STAGE(bufoff, (ab) + (koff), g0); else PG8_STAGE(bufoff, (ab) + (koff), g1); } \
        else { PG8_STAGE(bufoff, (ab) + (koff) + (h) * hstepA, voffA); } } while (0)
#define PG8_LDA(dst, b, h) do { if constexpr (FP8) { _Pragma("unroll") for (int m = 0; m < 4; ++m) dst##8[m] = __builtin_shufflevector(*(const LAS i32x4*)(lds + PG8_SA(b, h) + aoff + m * 2048), *(const LAS i32x4*)(lds + PG8_SA(b, h) + aoff + m * 2048 + 1024), 0, 1, 2, 3, 4, 5, 6, 7); } \
        else { _Pragma("unroll") for (int m = 0; m < 4; ++m) _Pragma("unroll") for (int k = 0; k < 2; ++k) dst[m][k] = *(const LAS bf16x8*)(lds + PG8_SA(b, h) + aoff + m * 2048 + k * 1024); } } while (0)
#define PG8_LDB(dst, b, h) do { if constexpr (FP8) { _Pragma("unroll") for (int n = 0; n < 2; ++n) dst##8[n] = __builtin_shufflevector(*(const LAS i32x4*)(lds + PG8_SB(b, h) + boff + n * 2048), *(const LAS i32x4*)(lds + PG8_SB(b, h) + boff + n * 2048 + 1024), 0, 1, 2, 3, 4, 5, 6, 7); } \
        else { _Pragma("unroll") for (int n = 0; n < 2; ++n) _Pragma("unroll") for (int k = 0; k < 2; ++k) dst[n][k] = *(const LAS bf16x8*)(lds + PG8_SB(b, h) + boff + n * 2048 + k * 1024); } } while (0)
#define PG8_CAT8(x) __builtin_shufflevector(__builtin_bit_cast(i32x4, (x)[0]), __builtin_bit_cast(i32x4, (x)[1]), 0, 1, 2, 3, 4, 5, 6, 7)
#define PG8_MMA(ai, bj, At, Bt) do { __builtin_amdgcn_s_setprio(1); if constexpr (FP8) { _Pragma("unroll") for (int m = 0; m < 4; ++m) _Pragma("unroll") for (int n = 0; n < 2; ++n) \
        asm volatile("v_mfma_scale_f32_16x16x128_f8f6f4 %0, %1, %2, %0, %3, %3 op_sel_hi:[0,0,0]" : "+v"(acc[ai][bj][m][n]) : "v"(Bt##8[n]), "v"(At##8[m]), "v"(one8)); } \
      else { _Pragma("unroll") for (int m = 0; m < 4; ++m) _Pragma("unroll") for (int n = 0; n < 2; ++n) _Pragma("unroll") for (int k = 0; k < 2; ++k) \
        acc[ai][bj][m][n] = __builtin_amdgcn_mfma_f32_16x16x32_bf16(Bt[n][k], At[m][k], acc[ai][bj][m][n], 0, 0, 0); } __builtin_amdgcn_s_setprio(0); } while (0)
#define PG8_WAIT_V(n) asm volatile("s_waitcnt vmcnt(" #n ")" ::: "memory")
#define PG8_WAIT_L(n) asm volatile("s_waitcnt lgkmcnt(" #n ")" ::: "memory")
#define PG8_BAR __builtin_amdgcn_s_barrier()
#define PG8_SCHED __builtin_amdgcn_sched_barrier(0)
#define PG8_GOFF(U, o0, o1) do { if constexpr (GATHER) { _Pragma("unroll") for (int _i = 0; _i < 2; ++_i) { \
        o0[_i] = (unsigned)(S.a_row((U).pm * BM + Rr[_i]) * K + Cc[_i]) * 2u; o1[_i] = (unsigned)(S.a_row((U).pm * BM + HALF + Rr[_i]) * K + Cc[_i]) * 2u; } } } while (0)
    Unit cur, nxt; int ui = 0;
    if (!S.next(0, cur)) return;
    f32x4 acc[2][2][4][2];
#pragma unroll
    for (int a = 0; a < 2; ++a)
#pragma unroll
        for (int b = 0; b < 2; ++b)
#pragma unroll
            for (int m = 0; m < 4; ++m)
#pragma unroll
                for (int n = 0; n < 2; ++n) acc[a][b][m][n] = (f32x4){0.f, 0.f, 0.f, 0.f};
    const int one8 = 0x7f7f7f7f;
    bf16x8 At[4][2], B0[2][2], B1[2][2]; i32x8 At8[4], B08[2], B18[2];
    unsigned cg0[2] = {0u, 0u}, cg1[2] = {0u, 0u}, ng0[2] = {0u, 0u}, ng1[2] = {0u, 0u};
    const char* cA = GATHER ? S.A : S.a_base(cur); const char* cB = S.b_base(cur);
    PG8_GOFF(cur, cg0, cg1);
    PG8_STAGE(PG8_SB(0, 0), cB, voffB); PG8_STAGE(PG8_SB(0, 1), cB + hstep, voffB); PG8_STAGE_A(PG8_SA(0, 0), cA, 0, 0, cg0, cg1); PG8_STAGE_A(PG8_SA(0, 1), cA, 0, 1, cg0, cg1);
    if constexpr (Epi::BEGIN) E.begin(cur, 0);
    if (wr == 1) PG8_BAR;
    PG8_WAIT_V(2); PG8_BAR;
    PG8_STAGE(PG8_SB(1, 0), cB + kstep, voffB); PG8_STAGE_A(PG8_SA(1, 0), cA, S.a_koff(1), 0, cg0, cg1); PG8_STAGE(PG8_SB(1, 1), cB + hstep + kstep, voffB);
    PG8_WAIT_V(6); PG8_BAR;
    for (;;) {
        const bool has_next = S.next(ui + 1, nxt);
        const char* nA = has_next ? (GATHER ? S.A : S.a_base(nxt)) : cA; const char* nB = has_next ? S.b_base(nxt) : cB;
        if constexpr (GATHER) { if (has_next) { PG8_GOFF(nxt, ng0, ng1); } else { ng0[0] = cg0[0]; ng0[1] = cg0[1]; ng1[0] = cg1[0]; ng1[1] = cg1[1]; } }
#pragma unroll 1
        for (int t = 0; t < nt; t += 2) {
            const bool last = (t == nt - 2);
            if constexpr (Epi::MIDK) { if (t == nt / 2) E.mid(acc, ui, wr, fr); }
            const size_t k1 = S.a_koff(t + 1);
            const char* a2 = last ? nA : cA; const char* b2 = last ? nB : cB + (size_t)(t + 2) * kstep;
            const size_t k2 = last ? S.a_koff(0) : S.a_koff(t + 2), k3 = last ? S.a_koff(1) : S.a_koff(t + 3);
            const char* b3 = b2 + kstep;
            unsigned s0[2], s1[2];
            if constexpr (GATHER) { s0[0] = last ? ng0[0] : cg0[0]; s0[1] = last ? ng0[1] : cg0[1]; s1[0] = last ? ng1[0] : cg1[0]; s1[1] = last ? ng1[1] : cg1[1]; } else { s0[0] = s0[1] = s1[0] = s1[1] = 0u; }
            PG8_LDB(B0, 0, 0); PG8_LDB(B1, 0, 1); PG8_SCHED; PG8_LDA(At, 0, 0); PG8_STAGE_A(PG8_SA(1, 1), cA, k1, 1, cg0, cg1);
            PG8_WAIT_V(8); PG8_WAIT_L(0); PG8_BAR; PG8_MMA(0, 0, At, B0); PG8_MMA(0, 1, At, B1); PG8_BAR; PG8_SCHED;
            PG8_LDA(At, 0, 1); PG8_STAGE(PG8_SB(0, 0), b2, voffB); PG8_STAGE(PG8_SB(0, 1), b2 + hstep, voffB); PG8_STAGE_A(PG8_SA(0, 0), a2, k2, 0, s0, s1);
            PG8_WAIT_V(8); PG8_WAIT_L(0); PG8_BAR; PG8_MMA(1, 0, At, B0); PG8_MMA(1, 1, At, B1); PG8_BAR; PG8_SCHED;
            PG8_LDB(B0, 1, 0); PG8_LDB(B1, 1, 1); PG8_SCHED; PG8_LDA(At, 1, 0); PG8_STAGE_A(PG8_SA(0, 1), a2, k2, 1, s0, s1);
            PG8_WAIT_V(8); PG8_WAIT_L(0); PG8_BAR; PG8_MMA(0, 0, At, B0); PG8_MMA(0, 1, At, B1); PG8_BAR; PG8_SCHED;
            PG8_LDA(At, 1, 1); PG8_STAGE(PG8_SB(1, 0), b3, voffB); PG8_STAGE(PG8_SB(1, 1), b3 + hstep, voffB); PG8_STAGE_A(PG8_SA(1, 0), a2, k3, 0, s0, s1);
            PG8_WAIT_V(8); PG8_WAIT_L(0); PG8_BAR; PG8_MMA(1, 0, At, B0); PG8_MMA(1, 1, At, B1); PG8_BAR; PG8_SCHED;
        }
        if constexpr (ALIGN_EPI) { if (wr == 0) PG8_BAR; }
        if constexpr (FP8) asm volatile("s_nop 15\n\ts_nop 15" ::: "memory");
        E(acc, cur, wr, wc, fr, fq, ui);
        if (!has_next) break;
#pragma unroll
        for (int a = 0; a < 2; ++a)
#pragma unroll
            for (int b = 0; b < 2; ++b)
#pragma unroll
                for (int m = 0; m < 4; ++m)
#pragma unroll
                    for (int n = 0; n < 2; ++n) acc[a][b][m][n] = (f32x4){0.f, 0.f, 0.f, 0.f};
        cur = nxt; cA = nA; cB = nB; ++ui;
        if constexpr (Epi::BEGIN) E.begin(cur, ui);
        if constexpr (GATHER) { cg0[0] = ng0[0]; cg0[1] = ng0[1]; cg1[0] = ng1[0]; cg1[1] = ng1[1]; }
        if constexpr (ALIGN_EPI) { if (wr == 1) PG8_BAR; }
    }
    PG8_WAIT_V(0);
    if constexpr (!ALIGN_EPI) { if (wr == 0) PG8_BAR; }
    PG8_BAR;
#undef PG8_SA
#undef PG8_SB
#undef PG8_STAGE
#undef PG8_STAGE_A
#undef PG8_LDA
#undef PG8_LDB
#undef PG8_MMA
#undef PG8_CAT8
#undef PG8_WAIT_V
#undef PG8_WAIT_L
#undef PG8_BAR
#undef PG8_SCHED
#undef PG8_GOFF
}
}

#ifndef BAR_ACQUIRE
#define BAR_ACQUIRE 0
#endif
#define XB_TMO      128
#define XB_XCNT(j)  (256  + 64 * (j))
#define XB_XSUB(j)  (1280 + 64 * (j))
#define XB_XGEN(j)  (2304 + 64 * (j))
#define XB_TOP      3328
#define XB_TOPGEN   3392
#define XCD_BAR_WORDS 3456
#define XB_SPIN_CAP (1u << 18)

__device__ __forceinline__ unsigned xb_ld(unsigned* p)              { return __hip_atomic_load(p, __ATOMIC_RELAXED, __HIP_MEMORY_SCOPE_AGENT); }
__device__ __forceinline__ unsigned xb_add(unsigned* p, unsigned v) { return __hip_atomic_fetch_add(p, v, __ATOMIC_RELAXED, __HIP_MEMORY_SCOPE_AGENT); }
__device__ __forceinline__ unsigned xb_xcc_id() { return (unsigned)__builtin_amdgcn_s_getreg((3 << 11) | 20) & 0xFu; }
#define XB_SPIN(cond, bar) do { unsigned _sp = 0; while (cond) { __builtin_amdgcn_s_sleep(1); \
    if ((++_sp & 255u) == 0u) { if (xb_ld(&(bar)[XB_TMO])) break; if (_sp > XB_SPIN_CAP) { atomicAdd(&(bar)[XB_TMO], 1u); break; } } } } while (0)

struct XcdBarrier {
    unsigned* bar; unsigned x;
    volatile LAS unsigned* st;
};
__device__ __forceinline__ XcdBarrier xcd_barrier_post(unsigned* bar, volatile LAS unsigned* st) {
    XcdBarrier b; b.bar = bar; b.x = xb_xcc_id(); b.st = st;
    if (threadIdx.x == 0) (void)xb_add(&bar[XB_XCNT(b.x)], 1u);
    return b;
}
__device__ __forceinline__ void xcd_barrier_complete(unsigned* bar, unsigned x, unsigned& nloc, unsigned& nx) {
    const unsigned G = gridDim.x * gridDim.y * gridDim.z;
    unsigned sum, cnt, mine, sp = 0u;
    for (;;) {
        sum = 0u; cnt = 0u; mine = 0u;
#pragma unroll
        for (unsigned j = 0; j < 16; ++j) { const unsigned c = xb_ld(&bar[XB_XCNT(j)]); sum += c; cnt += (c > 0u) ? 1u : 0u; mine = (j == x) ? c : mine; }
        if (sum == G) break;
        __builtin_amdgcn_s_sleep(1);
        if ((++sp & 255u) == 0u) { if (xb_ld(&bar[XB_TMO])) break; if (sp > XB_SPIN_CAP) { atomicAdd(&bar[XB_TMO], 1u); break; } }
    }
    nloc = mine > 0u ? mine : 1u; nx = cnt > 0u ? cnt : 1u;
}
__device__ __forceinline__ void xcd_barrier(const XcdBarrier& b) {
    asm volatile("s_waitcnt vmcnt(0)" ::: "memory");
    __syncthreads();
    if (threadIdx.x == 0) {
        unsigned* bar = b.bar;
        __builtin_amdgcn_s_waitcnt(0);
        unsigned nloc = b.st[0], nx = b.st[1];
        if (nloc == 0u) { xcd_barrier_complete(bar, b.x, nloc, nx); b.st[0] = nloc; b.st[1] = nx; }
        const unsigned old = xb_add(&bar[XB_XSUB(b.x)], 1u);
        const unsigned gen = old / nloc;
        if (old + 1u == (gen + 1u) * nloc) {
            __builtin_amdgcn_fence(__ATOMIC_RELEASE, "agent");
            asm volatile("s_waitcnt vmcnt(0)" ::: "memory");
            const unsigned og = xb_add(&bar[XB_TOP], 1u);
            const unsigned tg = og / nx;
            if (og + 1u == (tg + 1u) * nx) xb_add(&bar[XB_TOPGEN], 1u);
            else XB_SPIN(xb_ld(&bar[XB_TOPGEN]) == tg, bar);
            if (BAR_ACQUIRE) __builtin_amdgcn_fence(__ATOMIC_ACQUIRE, "agent");
            xb_add(&bar[XB_XGEN(b.x)], 1u);
            if (BAR_ACQUIRE) asm volatile("s_waitcnt vmcnt(0)" ::: "memory");
        } else {
            XB_SPIN(xb_ld(&bar[XB_XGEN(b.x)]) == gen, bar);
            if (BAR_ACQUIRE) __builtin_amdgcn_fence(__ATOMIC_ACQUIRE, "agent");
            asm volatile("s_waitcnt vmcnt(0)" ::: "memory");
        }
    }
    __syncthreads();
}


__device__ __forceinline__ bf16x8 as_bf16x8(u32x4 v) { return __builtin_bit_cast(bf16x8, v); }
typedef __bf16 bf16x2_t __attribute__((ext_vector_type(2)));
__device__ __forceinline__ unsigned cvtpk(float lo, float hi) { const f32x2 v = {lo, hi}; const bf16x2_t b = __builtin_convertvector(v, bf16x2_t); return __builtin_bit_cast(unsigned, b); }
#define LDS_FENCE() asm volatile("s_waitcnt lgkmcnt(0)" ::: "memory")
__device__ __forceinline__ float fma_s(float a, float b, float c) { float r; asm("v_fma_f32 %0, %1, %2, %3" : "=v"(r) : "v"(a), "v"(b), "v"(c)); return r; }

constexpr int KN_PITCH = 144, VT_PITCH = 528;
constexpr int ATT_KN_OFF = 0, ATT_VT_OFF = 256 * KN_PITCH, ATT_LDS_BYTES = ATT_VT_OFF + 64 * VT_PITCH;
__device__ __forceinline__ void attn_unit(LAS unsigned char* lds, int unit, int tid, const bf16* PROJ, const float* qg, const float* kg, const float* sinks, bf16* ATT, float* ATTSQ = nullptr) {
    const int lane = tid & 63, wave = __builtin_amdgcn_readfirstlane(tid >> 6), l15 = lane & 15, q4 = lane >> 4;
    const int kvh = unit & 1, n = (unit >> 1) & 15, b = unit >> 5;
    const int tok0 = b * S + n * 128;
    {
        const int c = tid & 7; const f32x4 g0 = *(const f32x4*)(kg + 8 * c), g1 = *(const f32x4*)(kg + 8 * c + 4);
        const int vkey = tid & 255; const bool vvalid = (n > 0) || (vkey >= 128);
        u32x4 kraw[4], vraw[4];
#pragma unroll
        for (int j = 0; j < 4; ++j) { const int key = (tid >> 3) + 64 * j; const bool valid = (n > 0) || (key >= 128);
            kraw[j] = (u32x4){0u, 0u, 0u, 0u}; if (valid) kraw[j] = *(const u32x4*)(PROJ + (size_t)(tok0 - 128 + key) * DIN + KOFF + kvh * HD + 8 * c);
            vraw[j] = (u32x4){0u, 0u, 0u, 0u}; if (vvalid) vraw[j] = *(const u32x4*)(PROJ + (size_t)(tok0 - 128 + vkey) * DIN + VOFF + kvh * HD + 8 * ((tid >> 8) + 2 * j)); }
#pragma unroll
        for (int j = 0; j < 4; ++j) { const int key = (tid >> 3) + 64 * j; const u32x4 raw = kraw[j];
            const float f[8] = {bflo(raw.x), bfhi(raw.x), bflo(raw.y), bfhi(raw.y), bflo(raw.z), bfhi(raw.z), bflo(raw.w), bfhi(raw.w)};
            float ss = 0.f;
#pragma unroll
            for (int i = 0; i < 8; ++i) ss += f[i] * f[i];
            ss += __shfl_xor(ss, 1); ss += __shfl_xor(ss, 2); ss += __shfl_xor(ss, 4);
            const float r = rsqrtf(ss * (1.0f / HD) + EPS);
            u32x4 w; w.x = cvtpk(f[0] * r * g0.x, f[1] * r * g0.y); w.y = cvtpk(f[2] * r * g0.z, f[3] * r * g0.w); w.z = cvtpk(f[4] * r * g1.x, f[5] * r * g1.y); w.w = cvtpk(f[6] * r * g1.z, f[7] * r * g1.w);
            *(LAS u32x4*)(lds + ATT_KN_OFF + key * KN_PITCH + c * 16) = w; }
#pragma unroll
        for (int j = 0; j < 4; ++j) { const int cc = (tid >> 8) + 2 * j; const u32x4 raw = vraw[j];
            LAS unsigned short* vt = (LAS unsigned short*)(lds + ATT_VT_OFF + (8 * cc) * VT_PITCH + vkey * 2);
            vt[0 * (VT_PITCH / 2)] = (unsigned short)(raw.x & 0xffffu); vt[1 * (VT_PITCH / 2)] = (unsigned short)(raw.x >> 16);
            vt[2 * (VT_PITCH / 2)] = (unsigned short)(raw.y & 0xffffu); vt[3 * (VT_PITCH / 2)] = (unsigned short)(raw.y >> 16);
            vt[4 * (VT_PITCH / 2)] = (unsigned short)(raw.z & 0xffffu); vt[5 * (VT_PITCH / 2)] = (unsigned short)(raw.z >> 16);
            vt[6 * (VT_PITCH / 2)] = (unsigned short)(raw.w & 0xffffu); vt[7 * (VT_PITCH / 2)] = (unsigned short)(raw.w >> 16); }
    }
    __syncthreads();
    const int g = wave >> 1, h = kvh * 4 + g, qi0 = 64 * (wave & 1);
    const float sink = sinks[h];
    const f32x4 gq00 = *(const f32x4*)(qg + 8 * q4), gq01 = *(const f32x4*)(qg + 8 * q4 + 4), gq10 = *(const f32x4*)(qg + 32 + 8 * q4), gq11 = *(const f32x4*)(qg + 32 + 8 * q4 + 4);
    u32x4 qn0, qn1;
    { const size_t tq0 = (size_t)(tok0 + qi0 + l15); qn0 = *(const u32x4*)(PROJ + tq0 * DIN + QOFF + h * HD + 8 * q4); qn1 = *(const u32x4*)(PROJ + tq0 * DIN + QOFF + h * HD + 32 + 8 * q4); }
#pragma unroll 1
    for (int qt = 0; qt < 4; ++qt) {
        const int q0 = qi0 + 16 * qt, qi = q0 + l15; const size_t tq = (size_t)(tok0 + qi);
        const u32x4 r0 = qn0, r1 = qn1;
        { const size_t tqn = (size_t)(tok0 + qi0 + 16 * ((qt + 1) & 3) + l15); qn0 = *(const u32x4*)(PROJ + tqn * DIN + QOFF + h * HD + 8 * q4); qn1 = *(const u32x4*)(PROJ + tqn * DIN + QOFF + h * HD + 32 + 8 * q4); }
        const float f0[8] = {bflo(r0.x), bfhi(r0.x), bflo(r0.y), bfhi(r0.y), bflo(r0.z), bfhi(r0.z), bflo(r0.w), bfhi(r0.w)};
        const float f1[8] = {bflo(r1.x), bfhi(r1.x), bflo(r1.y), bfhi(r1.y), bflo(r1.z), bfhi(r1.z), bflo(r1.w), bfhi(r1.w)};
        float ss = 0.f;
#pragma unroll
        for (int i = 0; i < 8; ++i) ss += f0[i] * f0[i] + f1[i] * f1[i];
        ss += __shfl_xor(ss, 16); ss += __shfl_xor(ss, 32);
        const float rq = rsqrtf(ss * (1.0f / HD) + EPS) * 0.125f;
        u32x4 w0, w1;
        w0.x = cvtpk(f0[0] * rq * gq00.x, f0[1] * rq * gq00.y); w0.y = cvtpk(f0[2] * rq * gq00.z, f0[3] * rq * gq00.w); w0.z = cvtpk(f0[4] * rq * gq01.x, f0[5] * rq * gq01.y); w0.w = cvtpk(f0[6] * rq * gq01.z, f0[7] * rq * gq01.w);
        w1.x = cvtpk(f1[0] * rq * gq10.x, f1[1] * rq * gq10.y); w1.y = cvtpk(f1[2] * rq * gq10.z, f1[3] * rq * gq10.w); w1.z = cvtpk(f1[4] * rq * gq11.x, f1[5] * rq * gq11.y); w1.w = cvtpk(f1[6] * rq * gq11.z, f1[7] * rq * gq11.w);
        const bf16x8 bq0 = as_bf16x8(w0), bq1 = as_bf16x8(w1);
        const int kt0 = ((q0 >> 4) >> 1) * 2;
        f32x4 s[10];
#pragma unroll
        for (int i = 0; i < 10; ++i) { const LAS unsigned char* kp = lds + ATT_KN_OFF + (16 * (kt0 + i) + l15) * KN_PITCH + 16 * q4;
            const bf16x8 a0 = *(const LAS bf16x8*)kp, a1 = *(const LAS bf16x8*)(kp + 64);
            f32x4 z = (f32x4){0.f, 0.f, 0.f, 0.f};
            z = __builtin_amdgcn_mfma_f32_16x16x32_bf16(a0, bq0, z, 0, 0, 0); s[i] = __builtin_amdgcn_mfma_f32_16x16x32_bf16(a1, bq1, z, 0, 0, 0); }
        float m = sink;
#pragma unroll
        for (int i = 0; i < 10; ++i)
#pragma unroll
            for (int r = 0; r < 4; ++r) { const int kj = 16 * (kt0 + i) + 4 * q4 + r; const bool valid = (kj < 128) ? ((kj > qi) && (n > 0)) : ((kj - 128) <= qi);
                const float v = valid ? s[i][r] : -1e30f; s[i][r] = v; m = fmaxf(m, v); }
        m = fmaxf(m, __shfl_xor(m, 16)); m = fmaxf(m, __shfl_xor(m, 32));
        float den = 0.f;
#pragma unroll
        for (int i = 0; i < 10; ++i)
#pragma unroll
            for (int r = 0; r < 4; ++r) { const float p = __expf(s[i][r] - m); s[i][r] = p; den += p; }
        den += __shfl_xor(den, 16); den += __shfl_xor(den, 32); den += __expf(sink - m);
        f32x4 o[4];
#pragma unroll
        for (int dt = 0; dt < 4; ++dt) o[dt] = (f32x4){0.f, 0.f, 0.f, 0.f};
#pragma unroll
        for (int ks = 0; ks < 5; ++ks) { u32x4 pw; pw.x = cvtpk(s[2 * ks][0], s[2 * ks][1]); pw.y = cvtpk(s[2 * ks][2], s[2 * ks][3]); pw.z = cvtpk(s[2 * ks + 1][0], s[2 * ks + 1][1]); pw.w = cvtpk(s[2 * ks + 1][2], s[2 * ks + 1][3]);
            const bf16x8 bp = as_bf16x8(pw); const int keyb = 16 * kt0 + 32 * ks + 4 * q4;
#pragma unroll
            for (int dt = 0; dt < 4; ++dt) { const LAS unsigned char* vp = lds + ATT_VT_OFF + (16 * dt + l15) * VT_PITCH + keyb * 2;
                const u32x2 lo = *(const LAS u32x2*)vp, hi = *(const LAS u32x2*)(vp + 32);
                u32x4 av; av.x = lo.x; av.y = lo.y; av.z = hi.x; av.w = hi.y;
                o[dt] = __builtin_amdgcn_mfma_f32_16x16x32_bf16(as_bf16x8(av), bp, o[dt], 0, 0, 0); } }
        const float inv = 1.0f / den; float osq = 0.f;
#pragma unroll
        for (int dt = 0; dt < 4; ++dt) { const float o0 = o[dt][0] * inv, o1 = o[dt][1] * inv, o2 = o[dt][2] * inv, o3 = o[dt][3] * inv; osq += (o0 * o0 + o1 * o1) + (o2 * o2 + o3 * o3);
            u32x2 w; w.x = cvtpk(o0, o1); w.y = cvtpk(o2, o3);
            *(u32x2*)(ATT + tq * DATT + h * HD + 16 * dt + 4 * q4) = w; }
        if (ATTSQ) { osq += __shfl_xor(osq, 16); osq += __shfl_xor(osq, 32); if (q4 == 0) ATTSQ[tq * NH + h] = osq; }
    }
    __syncthreads();
}


__device__ __forceinline__ void ssm_apow_item(int i, const float* lam_re, const float* lam_im, const float* log_dt, unsigned char* APOW) {
    const int lane = i & 63, f = (i >> 6) & 63, g = i >> 12, ks = f & 7, rt = f >> 3, st = rt >> 1, c = rt & 1, fr = lane & 15, fq = lane >> 4, p = 16 * st + fr;
    const float dt = expf(log_dt[g]), lrd = lam_re[g * NST + p] * dt, lid = lam_im[g * NST + p] * dt;
    float v[8];
#pragma unroll
    for (int j = 0; j < 8; ++j) { const int t = 32 * ks + 16 * (j >> 2) + 4 * fq + (j & 3); const float k = (float)(255 - t), m = __expf(lrd * k), a = lid * k; v[j] = m * (c ? __sinf(a) : __cosf(a)); }
    u32x4 w; w.x = cvtpk(v[0], v[1]); w.y = cvtpk(v[2], v[3]); w.z = cvtpk(v[4], v[5]); w.w = cvtpk(v[6], v[7]);
    *(u32x4*)(APOW + (size_t)i * 16) = w;
}
struct Tr8 { const float* src; unsigned char* dst; int N, K, n0, k0, isgu, pad; };
__device__ __forceinline__ void tr8_setup(Tr8& t, const float* W, int K, int N, unsigned char* WT, int item, int lane, int isgu) {
    const int nblk = N / 32, kb = item / nblk, nb = item % nblk, q = lane & 7, o = lane >> 3;
    t.k0 = 128 * kb + 16 * o; t.n0 = 32 * nb + 4 * q; t.N = N; t.K = K; t.isgu = isgu; t.src = W + (size_t)t.k0 * N + t.n0; t.dst = WT; t.pad = 0;
}
__device__ __forceinline__ void tr8_load(const Tr8& t, f32x4 (&v)[16]) {
#pragma unroll
    for (int j = 0; j < 16; ++j) v[j] = __builtin_nontemporal_load((const f32x4*)(t.src + (size_t)j * t.N));
}
__device__ __forceinline__ void tr8_store(const Tr8& t, const f32x4 (&v)[16]) {
#pragma unroll
    for (int i = 0; i < 4; ++i) { const int nr = t.isgu ? gu_row(t.n0 + i) : (t.n0 + i);
        u32x4 a; a.x = pk4_fp8(v[0][i] * W8_SCALE, v[1][i] * W8_SCALE, v[2][i] * W8_SCALE, v[3][i] * W8_SCALE); a.y = pk4_fp8(v[4][i] * W8_SCALE, v[5][i] * W8_SCALE, v[6][i] * W8_SCALE, v[7][i] * W8_SCALE);
        a.z = pk4_fp8(v[8][i] * W8_SCALE, v[9][i] * W8_SCALE, v[10][i] * W8_SCALE, v[11][i] * W8_SCALE); a.w = pk4_fp8(v[12][i] * W8_SCALE, v[13][i] * W8_SCALE, v[14][i] * W8_SCALE, v[15][i] * W8_SCALE);
        __builtin_nontemporal_store(a, (u32x4*)(t.dst + (size_t)nr * t.K + t.k0)); }
}

__device__ __forceinline__ void conv_pair(const float* W, int K, int N, unsigned char* WT, int per_e, int isgu, int ra, int rb, bool vb, int lane) {
    Tr8 ta, tb; f32x4 va[16], vv[16];
    { const int e = ra / per_e; tr8_setup(ta, W + (size_t)e * K * N, K, N, WT + (size_t)e * N * K, ra % per_e, lane, isgu); }
    { const int r2 = vb ? rb : ra, e = r2 / per_e; tr8_setup(tb, W + (size_t)e * K * N, K, N, WT + (size_t)e * N * K, r2 % per_e, lane, isgu); }
    tr8_load(ta, va); tr8_load(tb, vv);
    tr8_store(ta, va); if (vb) tr8_store(tb, vv);
}
struct ConvStream { const float* w_gu; const float* w_dn; unsigned char* wt_gu; unsigned char* wt_dn; int gu_first, n_gu, n_dn, stride; };

constexpr int SSM_BU_PITCH = 132, SSM_BU_BYTES = 16 * SSM_BU_PITCH * 4, SSM_X_PITCH = 272, SSM_WAVE_BYTES = SSM_BU_BYTES + 16 * SSM_X_PITCH, SSM_XEND_OFF = 8 * SSM_WAVE_BYTES, SSM_LDS_BYTES = SSM_XEND_OFF + 8 * 64 * 8;
__device__ __forceinline__ void ssm_unit(LAS unsigned char* lds, int unit, int tid, const bf16* PROJ, const float* tab, const float* c_re, const float* c_im, const float* d_skip, bf16* Gout, const bool has_cs, const ConvStream cs, const unsigned char* APOW = nullptr) {
    const int lane = tid & 63, wave = __builtin_amdgcn_readfirstlane(tid >> 6), l15 = lane & 15, q4 = lane >> 4;
    const int g = unit & 31, b = unit >> 5;
    if constexpr (SSM_MFMA_CARRY && !P3_CONV) {
        const unsigned char* gsrc = APOW + (size_t)g * 65536 + (size_t)wave * 8192 + lane * 16;
#pragma unroll
        for (int c4 = 0; c4 < 2; ++c4) { const unsigned* gp = (const unsigned*)(gsrc + c4 * 4096); LAS unsigned* lp = (LAS unsigned*)(lds + wave * 8192 + c4 * 4096);
            __builtin_amdgcn_global_load_lds(gp, lp, 16, 0, 0); __builtin_amdgcn_global_load_lds(gp, lp, 16, 1024, 0); __builtin_amdgcn_global_load_lds(gp, lp, 16, 2048, 0); __builtin_amdgcn_global_load_lds(gp, lp, 16, 3072, 0); } }
    Tr8 ct; ct.src = nullptr; ct.dst = nullptr; ct.N = ct.K = ct.n0 = ct.k0 = ct.isgu = ct.pad = 0; f32x4 cv[16]; bool cpend = false; int cq = unit * 8 + wave;
#pragma unroll
    for (int j = 0; j < 16; ++j) cv[j] = (f32x4){0.f, 0.f, 0.f, 0.f};
#define SSM_CONV_STEP() do { if (has_cs) { if (cpend) tr8_store(ct, cv); \
        constexpr int IGU = (D / 128) * (2 * DFF / 32), IDN = (DFF / 128) * (D / 32); cpend = cq < cs.n_gu + cs.n_dn; \
        { const bool isgu = cq < cs.n_gu || !cpend; const int r = !cpend ? 0 : (isgu ? cs.gu_first + cq : cq - cs.n_gu), e = r / (isgu ? IGU : IDN), it = r % (isgu ? IGU : IDN); \
          if (isgu) tr8_setup(ct, cs.w_gu + (size_t)e * D * 2 * DFF, D, 2 * DFF, cs.wt_gu + (size_t)e * 2 * DFF * D, it, lane, 1); \
          else tr8_setup(ct, cs.w_dn + (size_t)e * DFF * D, DFF, D, cs.wt_dn + (size_t)e * D * DFF, it, lane, 0); } \
        tr8_load(ct, cv); cq += cs.stride; } } while (0)
    const float* tg = tab + (size_t)g * SSMT_STRIDE;
    const float ar = tg[ST_AR + lane], ai = tg[ST_AI + lane], nai = -ai;
    bf16x8 bb[8];
#define SSM_SETUP_BB() do { _Pragma("unroll") for (int nt = 0; nt < 8; ++nt) { u32x4 w = (u32x4){0u, 0u, 0u, 0u}; \
        if (q4 < 2) { const int p = 8 * nt + (l15 >> 1); const float* src = tg + ((l15 & 1) ? ST_BI : ST_BR) + p * SG + 8 * q4; const f32x4 v0 = *(const f32x4*)src, v1 = *(const f32x4*)(src + 4); \
            w.x = cvtpk(v0.x, v0.y); w.y = cvtpk(v0.z, v0.w); w.z = cvtpk(v1.x, v1.y); w.w = cvtpk(v1.z, v1.w); } \
        bb[nt] = as_bf16x8(w); } } while (0)
    if constexpr (!(SSM_MFMA_CARRY && !P3_CONV)) SSM_SETUP_BB();
    bf16x8 cm[4];
#pragma unroll
    for (int ks = 0; ks < 4; ++ks) { const int pb = 16 * ks + 4 * q4; const f32x4 cr = *(const f32x4*)(c_re + ((size_t)g * SG + l15) * NST + pb), ci = *(const f32x4*)(c_im + ((size_t)g * SG + l15) * NST + pb);
        u32x4 w; w.x = cvtpk(cr.x, -ci.x); w.y = cvtpk(cr.y, -ci.y); w.z = cvtpk(cr.z, -ci.z); w.w = cvtpk(cr.w, -ci.w); cm[ks] = as_bf16x8(w); }
    LAS float* BU = (LAS float*)(lds + wave * SSM_WAVE_BYTES); LAS unsigned char* XT = lds + wave * SSM_WAVE_BYTES + SSM_BU_BYTES;
    LAS f32x2* xend = (LAS f32x2*)(lds + SSM_XEND_OFF);
    const bf16* ubase = PROJ + (size_t)(b * S) * DIN + UOFF + g * SG;
    const int tseg = 256 * wave;
    float xr = 0.f, xi = 0.f;
#define SSM_LOAD_U(dst, t0) do { dst = (u32x4){0u, 0u, 0u, 0u}; if (q4 < 2) dst = *(const u32x4*)(ubase + (size_t)((t0) + l15) * DIN + 8 * q4); } while (0)
#define SSM_BU_TILE(araw) do { const bf16x8 afr = as_bf16x8(araw); \
        _Pragma("unroll") for (int nt = 0; nt < 8; ++nt) { const f32x4 d = __builtin_amdgcn_mfma_f32_16x16x32_bf16(afr, bb[nt], (f32x4){0.f, 0.f, 0.f, 0.f}, 0, 0, 0); \
            _Pragma("unroll") for (int r = 0; r < 4; ++r) BU[(4 * q4 + r) * SSM_BU_PITCH + 16 * nt + l15] = d[r]; } LDS_FENCE(); } while (0)
    u32x4 ucur, unext, unn; SSM_LOAD_U(ucur, tseg); SSM_LOAD_U(unext, tseg + 16);
    if constexpr (SSM_MFMA_CARRY && !P3_CONV) {
        u32x4 idw = (u32x4){0u, 0u, 0u, 0u};
        { const int m = l15 - 8 * q4; const unsigned one = (m & 1) ? 0x3F800000u : 0x00003F80u;
          if (q4 < 2 && m >= 0 && m < 8) { idw.x = (m >> 1) == 0 ? one : 0u; idw.y = (m >> 1) == 1 ? one : 0u; idw.z = (m >> 1) == 2 ? one : 0u; idw.w = (m >> 1) == 3 ? one : 0u; } }
        const bf16x8 ident = as_bf16x8(idw);
        f32x4 V[8]; u32x4 na, nb;
#pragma unroll
        for (int rt = 0; rt < 8; ++rt) V[rt] = (f32x4){0.f, 0.f, 0.f, 0.f};
        asm volatile("s_waitcnt vmcnt(0)" ::: "memory");
        __syncthreads();
#pragma unroll 2
        for (int ks = 0; ks < 8; ++ks) {
            SSM_LOAD_U(na, tseg + 16 * ((2 * ks + 2) & 15)); SSM_LOAD_U(nb, tseg + 16 * ((2 * ks + 3) & 15));
            u32x4 afc[8];
#pragma unroll
            for (int rt = 0; rt < 8; ++rt) afc[rt] = *(const LAS u32x4*)(lds + (rt * 8 + ks) * 1024 + lane * 16);
            const f32x4 d0 = __builtin_amdgcn_mfma_f32_16x16x32_bf16(as_bf16x8(ucur), ident, (f32x4){0.f, 0.f, 0.f, 0.f}, 0, 0, 0), d1 = __builtin_amdgcn_mfma_f32_16x16x32_bf16(as_bf16x8(unext), ident, (f32x4){0.f, 0.f, 0.f, 0.f}, 0, 0, 0);
            u32x4 utw; utw.x = cvtpk(d0[0], d0[1]); utw.y = cvtpk(d0[2], d0[3]); utw.z = cvtpk(d1[0], d1[1]); utw.w = cvtpk(d1[2], d1[3]);
            const bf16x8 ut = as_bf16x8(utw);
#pragma unroll
            for (int rt = 0; rt < 8; ++rt) V[rt] = __builtin_amdgcn_mfma_f32_16x16x32_bf16(as_bf16x8(afc[rt]), ut, V[rt], 0, 0, 0);
            ucur = na; unext = nb; }
        __syncthreads();
        float bre[4][4], bim[4][4];
#pragma unroll
        for (int st = 0; st < 4; ++st)
#pragma unroll
            for (int i = 0; i < 4; ++i) { const int p = 16 * st + 4 * q4 + i; bre[st][i] = bf2f(f2bf(tg[ST_BR + p * SG + l15])); bim[st][i] = bf2f(f2bf(tg[ST_BI + p * SG + l15])); }
        LAS f32x2* PP = (LAS f32x2*)(lds + wave * SSM_WAVE_BYTES);
#pragma unroll
        for (int st = 0; st < 4; ++st)
#pragma unroll
            for (int i = 0; i < 4; ++i) { const float vr = V[2 * st][i], vi = V[2 * st + 1][i], br = bre[st][i], bi = bim[st][i];
                PP[(16 * st + 4 * q4 + i) * 18 + l15] = (f32x2){br * vr - bi * vi, br * vi + bi * vr}; }
        LDS_FENCE();
        { float sr = 0.f, si = 0.f;
#pragma unroll
          for (int q = 0; q < 8; ++q) { const f32x4 v = *(const LAS f32x4*)(PP + lane * 18 + 2 * q); sr += v.x + v.z; si += v.y + v.w; }
          xr = sr; xi = si; }
        LDS_FENCE();
    } else {
#pragma unroll 1
    for (int tile4 = 0; tile4 < 16; tile4 += 4) {
#pragma unroll
      for (int ti = 0; ti < 4; ++ti) { const int tile = tile4 + ti; SSM_LOAD_U(unn, tseg + 16 * ((tile + 2) & 15)); if (ti == 0) SSM_CONV_STEP(); SSM_BU_TILE(ucur); ucur = unext; unext = unn;
#pragma unroll
        for (int tt = 0; tt < 16; ++tt) { const f32x2 bu = *(const LAS f32x2*)(BU + tt * SSM_BU_PITCH + 2 * lane); const float nr = fma_s(ar, xr, fma_s(nai, xi, bu.x)), ni = fma_s(ar, xi, fma_s(ai, xr, bu.y)); xr = nr; xi = ni; }
        LDS_FENCE(); } }
    }
    xend[wave * 64 + lane] = (f32x2){xr, xi};
    __syncthreads();
    { float pr = ar, pi = ai;
#pragma unroll
      for (int i = 0; i < 8; ++i) { const float nr = pr * pr - pi * pi, ni = 2.0f * pr * pi; pr = nr; pi = ni; }
      xr = 0.f; xi = 0.f;
      for (int w2 = 0; w2 < wave; ++w2) { const f32x2 e = xend[w2 * 64 + lane]; const float npi = -pi; const float nr = fma_s(pr, xr, fma_s(npi, xi, e.x)), ni = fma_s(pr, xi, fma_s(pi, xr, e.y)); xr = nr; xi = ni; } }
    const f32x4 dsk = *(const f32x4*)(d_skip + g * SG + 4 * q4);
    if constexpr (SSM_MFMA_CARRY && !P3_CONV) SSM_SETUP_BB();
    u32x2 uucur = *(const u32x2*)(ubase + (size_t)(tseg + l15) * DIN + 4 * q4), uunext = *(const u32x2*)(ubase + (size_t)(tseg + 16 + l15) * DIN + 4 * q4), uunn;
#pragma unroll 1
    for (int tile4 = 0; tile4 < 16; tile4 += 4) {
#pragma unroll
      for (int ti = 0; ti < 4; ++ti) { const int tile = tile4 + ti; const int t0 = tseg + 16 * tile; SSM_LOAD_U(unn, tseg + 16 * ((tile + 2) & 15)); uunn = *(const u32x2*)(ubase + (size_t)(tseg + 16 * ((tile + 2) & 15) + l15) * DIN + 4 * q4); if (ti == 0) SSM_CONV_STEP(); SSM_BU_TILE(ucur); ucur = unext; unext = unn;
        f32x2 buv[16];
#pragma unroll
        for (int tt = 0; tt < 16; ++tt) buv[tt] = *(const LAS f32x2*)(BU + tt * SSM_BU_PITCH + 2 * lane);
#pragma unroll
        for (int tt = 0; tt < 16; ++tt) { const f32x2 bu = buv[tt]; const float nr = fma_s(ar, xr, fma_s(nai, xi, bu.x)), ni = fma_s(ar, xi, fma_s(ai, xr, bu.y)); xr = nr; xi = ni;
            *(LAS unsigned*)(XT + tt * SSM_X_PITCH + 4 * lane) = cvtpk(xr, xi); }
        LDS_FENCE();
        f32x4 y = (f32x4){0.f, 0.f, 0.f, 0.f};
#pragma unroll
        for (int ks = 0; ks < 4; ++ks) { const bf16x8 bx = *(const LAS bf16x8*)(XT + l15 * SSM_X_PITCH + (32 * ks + 8 * q4) * 2); y = __builtin_amdgcn_mfma_f32_16x16x32_bf16(cm[ks], bx, y, 0, 0, 0); }
        const size_t t = (size_t)(t0 + l15); const u32x2 uu = uucur; uucur = uunext; uunext = uunn;
        const float y0 = gelu_tanh(y[0] + dsk.x * bflo(uu.x)), y1 = gelu_tanh(y[1] + dsk.y * bfhi(uu.x)), y2 = gelu_tanh(y[2] + dsk.z * bflo(uu.y)), y3 = gelu_tanh(y[3] + dsk.w * bfhi(uu.y));
        u32x2 w; w.x = cvtpk(y0, y1); w.y = cvtpk(y2, y3);
        *(u32x2*)(Gout + ((size_t)(b * S) + t) * DSSM + g * SG + 4 * q4) = w;
        LDS_FENCE(); } }
#undef SSM_BU_TILE
#undef SSM_SETUP_BB
#undef SSM_LOAD_U
#undef SSM_CONV_STEP
    if (has_cs && cpend) tr8_store(ct, cv);
    __syncthreads();
}

constexpr int NWAVES = 8;
constexpr int RING_OFF = 0, RING_BYTES = 131072;
constexpr int LDSCTL_OFF = RING_BYTES;
constexpr int MISC_OFF = LDSCTL_OFF + 320;
constexpr int LH_OFF = LDSCTL_OFF + 512;
constexpr int SORT_OFF = RING_OFF;
constexpr int RSCR_OFF = LDSCTL_OFF + 8192;
constexpr int TE_OFF = LDSCTL_OFF + 4096;
constexpr int LDS_BYTES = 147456;
#define LDS_WAIT() asm volatile("s_waitcnt lgkmcnt(0)" ::: "memory")
#ifndef DEFER_P4_N
#define DEFER_P4_N 4
#endif
#ifndef DEFER_P2_N
#define DEFER_P2_N 5
#endif
#ifndef DN_DEFER_P9_N
#define DN_DEFER_P9_N 3072
#endif
constexpr int DN_DEFER_P9 = (MOE_FP8_GU && MOE_FP8_DN) ? DN_DEFER_P9_N : 0;
constexpr int DEFER_P2_PER_WAVE = MOE_FP8_GU ? DEFER_P2_N : 0, DEFER_P4_PER_WAVE = MOE_FP8_GU ? DEFER_P4_N : 0;
#ifndef P2_RESHAPE
#define P2_RESHAPE 1
#endif
#ifndef P2_CONV_N
#define P2_CONV_N 10
#endif
constexpr int P2_GEMM_WGS = 160;
constexpr int GU_DEFER_P2 = (P2_RESHAPE && MOE_FP8_GU) ? (256 - P2_GEMM_WGS) * 8 * P2_CONV_N : 192 * 8 * DEFER_P2_PER_WAVE, GU_DEFER_P4 = 128 * 8 * DEFER_P4_PER_WAVE, GU_DEFER = GU_DEFER_P2 + GU_DEFER_P4;
enum Phase { P_PRO = 0, P_NORM1, P_INPROJ, P_MIX_A, P_MIX_B, P_GLU, P_MIXNORM, P_OUTPROJ, P_ROUTER, P_SORT, P_GATEUP, P_DOWN, P_COMBINE, P_COUNT };

__device__ __forceinline__ void router_image_item(int i, const float* w_router, unsigned char* WRI) {
    const int lane = i & 63, rest = i >> 6, hl = rest & 1, nt = (rest >> 1) & 1, ks = (rest >> 2) & 3, w = rest >> 4, fr = lane & 15, fq = lane >> 4;
    const float* src = w_router + (size_t)(128 * w + 32 * ks + 8 * fq) * NE + 16 * nt + fr;
    float v[8];
#pragma unroll
    for (int j = 0; j < 8; ++j) v[j] = src[j * NE];
    u32x4 p;
#pragma unroll
    for (int j = 0; j < 4; ++j) { float a = v[2 * j], b = v[2 * j + 1]; unsigned hi = cvtpk(a, b); if (hl) { a -= bflo(hi); b -= bfhi(hi); hi = cvtpk(a, b); } p[j] = hi; }
    *(u32x4*)(WRI + (size_t)i * 16) = p;
}
__device__ __forceinline__ void router_block_mfma(LAS unsigned char* lds, int blk, int tid, int wave, int lane, const float* x1, const float* gain, const float* mod, const float* b_router,
                                                  const unsigned char* WRI, LAS int* lh, unsigned char* H8, int* tope, float* topw, const bf16* delta = nullptr, int* cnt = nullptr, int* toke = nullptr, float* wrowe = nullptr, int* paire = nullptr, bf16* x1b = nullptr) {
    asm volatile("" : "+v"(lane), "+v"(tid));
    const int b = (blk * 64) / S, fr = lane & 15, fq = lane >> 4;
    LAS unsigned char* Wl = lds + RING_OFF + wave * 16384;
    LAS float* gsh = (LAS float*)(lds + RSCR_OFF);
    LAS float* ssqx = (LAS float*)(lds + TE_OFF);
    LAS int* sel_e = (LAS int*)(lds + TE_OFF + 2048);
    LAS float* sel_v = (LAS float*)(lds + TE_OFF + 3072);
    LAS float* lg = (LAS float*)(lds + RING_OFF + 8192);
    { const unsigned char* gsrc = WRI + (size_t)wave * 16384 + lane * 16;
#pragma unroll
      for (int c4 = 0; c4 < 4; ++c4) { const unsigned* gp = (const unsigned*)(gsrc + c4 * 4096); LAS unsigned* lp = (LAS unsigned*)(Wl + c4 * 4096);
          __builtin_amdgcn_global_load_lds(gp, lp, 16, 0, 0); __builtin_amdgcn_global_load_lds(gp, lp, 16, 1024, 0); __builtin_amdgcn_global_load_lds(gp, lp, 16, 2048, 0); __builtin_amdgcn_global_load_lds(gp, lp, 16, 3072, 0); } }
    f32x4 xv[4][4][2];
    const float* xb = x1 + (size_t)(blk * 64 + fr) * D + 128 * wave + 8 * fq;
#pragma unroll
    for (int m = 0; m < 4; ++m)
#pragma unroll
        for (int ks = 0; ks < 4; ++ks) { xv[m][ks][0] = *(const f32x4*)(xb + (size_t)(16 * m) * D + 32 * ks); xv[m][ks][1] = *(const f32x4*)(xb + (size_t)(16 * m) * D + 32 * ks + 4); }
    if (delta) {
        const bf16* db = delta + (size_t)(blk * 64 + fr) * D + 128 * wave + 8 * fq; u32x4 dv[4][4];
#pragma unroll
        for (int m = 0; m < 4; ++m)
#pragma unroll
            for (int ks = 0; ks < 4; ++ks) dv[m][ks] = *(const u32x4*)(db + (size_t)(16 * m) * D + 32 * ks);
#pragma unroll
        for (int m = 0; m < 4; ++m)
#pragma unroll
            for (int ks = 0; ks < 4; ++ks) { const u32x4 d = dv[m][ks];
                xv[m][ks][0] += (f32x4){bflo(d.x), bfhi(d.x), bflo(d.y), bfhi(d.y)}; xv[m][ks][1] += (f32x4){bflo(d.z), bfhi(d.z), bflo(d.w), bfhi(d.w)}; } }
    if (x1b) { bf16* xo = x1b + (size_t)(blk * 64 + fr) * D + 128 * wave + 8 * fq;
#pragma unroll
        for (int m = 0; m < 4; ++m)
#pragma unroll
            for (int ks = 0; ks < 4; ++ks) { const f32x4 a = xv[m][ks][0], c2 = xv[m][ks][1]; u32x4 w; w.x = cvtpk(a.x, a.y); w.y = cvtpk(a.z, a.w); w.z = cvtpk(c2.x, c2.y); w.w = cvtpk(c2.z, c2.w);
                *(u32x4*)(xo + (size_t)(16 * m) * D + 32 * ks) = w; } }
    if (lane < 32) { const int c = 128 * wave + 4 * lane; const f32x4 g = *(const f32x4*)(gain + c), sc = *(const f32x4*)(mod + b * 6 * D + 4 * D + c);
        *(LAS f32x4*)(gsh + c) = g * (1.0f + sc); *(LAS f32x4*)(gsh + 1024 + c) = *(const f32x4*)(mod + b * 6 * D + 3 * D + c); }
    float ss[4];
#pragma unroll
    for (int m = 0; m < 4; ++m) { float a = 0.f;
#pragma unroll
        for (int ks = 0; ks < 4; ++ks)
#pragma unroll
            for (int h = 0; h < 2; ++h) { const f32x4 v = xv[m][ks][h]; a += (v.x * v.x + v.y * v.y) + (v.z * v.z + v.w * v.w); }
        a += __shfl_xor(a, 16); a += __shfl_xor(a, 32); ss[m] = a; }
    if (fq == 0) {
#pragma unroll
        for (int m = 0; m < 4; ++m) ssqx[(16 * m + fr) * 8 + wave] = ss[m]; }
    asm volatile("s_waitcnt vmcnt(0)" ::: "memory");
    __syncthreads();
    float r[4];
#pragma unroll
    for (int m = 0; m < 4; ++m) { const f32x4 a = *(const LAS f32x4*)(ssqx + (16 * m + fr) * 8), c = *(const LAS f32x4*)(ssqx + (16 * m + fr) * 8 + 4);
        r[m] = rsqrtf((((a.x + a.y) + (a.z + a.w)) + ((c.x + c.y) + (c.z + c.w))) * (1.0f / D) + EPS); }
    f32x4 acc[4][2];
#pragma unroll
    for (int m = 0; m < 4; ++m)
#pragma unroll
        for (int nt = 0; nt < 2; ++nt) acc[m][nt] = (f32x4){0.f, 0.f, 0.f, 0.f};
#pragma unroll
    for (int ks = 0; ks < 4; ++ks) { const int kk = 128 * wave + 32 * ks + 8 * fq;
        const f32x4 g0 = *(const LAS f32x4*)(gsh + kk), g1 = *(const LAS f32x4*)(gsh + kk + 4), s0 = *(const LAS f32x4*)(gsh + 1024 + kk), s1 = *(const LAS f32x4*)(gsh + 1024 + kk + 4);
        bf16x8 Wh[2], Wo[2];
#pragma unroll
        for (int nt = 0; nt < 2; ++nt) { Wh[nt] = *(const LAS bf16x8*)(Wl + ((ks * 2 + nt) * 2 + 0) * 1024 + lane * 16); Wo[nt] = *(const LAS bf16x8*)(Wl + ((ks * 2 + nt) * 2 + 1) * 1024 + lane * 16); }
#pragma unroll
        for (int m = 0; m < 4; ++m) { const f32x4 h0 = xv[m][ks][0] * r[m] * g0 + s0, h1 = xv[m][ks][1] * r[m] * g1 + s1;
            u32x2 w8; w8.x = pk4_fp8(h0.x * H8_SCALE, h0.y * H8_SCALE, h0.z * H8_SCALE, h0.w * H8_SCALE); w8.y = pk4_fp8(h1.x * H8_SCALE, h1.y * H8_SCALE, h1.z * H8_SCALE, h1.w * H8_SCALE);
            *(u32x2*)(H8 + (size_t)(blk * 64 + 16 * m + fr) * D + kk) = w8;
            u32x4 hi, lo;
            hi.x = cvtpk(h0.x, h0.y); hi.y = cvtpk(h0.z, h0.w); hi.z = cvtpk(h1.x, h1.y); hi.w = cvtpk(h1.z, h1.w);
            lo.x = cvtpk(h0.x - bflo(hi.x), h0.y - bfhi(hi.x)); lo.y = cvtpk(h0.z - bflo(hi.y), h0.w - bfhi(hi.y)); lo.z = cvtpk(h1.x - bflo(hi.z), h1.y - bfhi(hi.z)); lo.w = cvtpk(h1.z - bflo(hi.w), h1.w - bfhi(hi.w));
            const bf16x8 Xh = __builtin_bit_cast(bf16x8, hi), Xl = __builtin_bit_cast(bf16x8, lo);
#pragma unroll
            for (int nt = 0; nt < 2; ++nt) { acc[m][nt] = __builtin_amdgcn_mfma_f32_16x16x32_bf16(Wo[nt], Xh, acc[m][nt], 0, 0, 0); acc[m][nt] = __builtin_amdgcn_mfma_f32_16x16x32_bf16(Wh[nt], Xl, acc[m][nt], 0, 0, 0);
                acc[m][nt] = __builtin_amdgcn_mfma_f32_16x16x32_bf16(Wh[nt], Xh, acc[m][nt], 0, 0, 0); } } }
    { LAS float* part = (LAS float*)Wl;
#pragma unroll
      for (int m = 0; m < 4; ++m)
#pragma unroll
          for (int nt = 0; nt < 2; ++nt) *(LAS f32x4*)(part + (16 * m + fr) * 32 + 16 * nt + 4 * fq) = acc[m][nt]; }
    __syncthreads();
    { const int row = tid >> 3, eg = tid & 7; f32x4 sum = *(const f32x4*)(b_router + 4 * eg);
#pragma unroll
      for (int w2 = 0; w2 < 8; ++w2) sum += *(const LAS f32x4*)(lds + RING_OFF + w2 * 16384 + (row * 32 + 4 * eg) * 4);
      *(LAS f32x4*)(lg + row * 32 + 4 * eg) = sum; }
    __syncthreads();
    { const int row = 8 * wave + (lane >> 3), eg = lane & 7; const LAS float* lgr = lg + row * 32;
      const f32x4 mine = *(const LAS f32x4*)(lgr + 4 * eg); const int e0m = 4 * eg;
      int rk0 = 0, rk1 = 0, rk2 = 0, rk3 = 0;
#pragma unroll
      for (int q = 0; q < 8; ++q) { const f32x4 a = *(const LAS f32x4*)(lgr + 4 * q);
#pragma unroll
          for (int t = 0; t < 4; ++t) { const int e2 = 4 * q + t; const float av = a[t];
              rk0 += (av > mine.x || (av == mine.x && e2 < e0m + 0)) ? 1 : 0; rk1 += (av > mine.y || (av == mine.y && e2 < e0m + 1)) ? 1 : 0;
              rk2 += (av > mine.z || (av == mine.z && e2 < e0m + 2)) ? 1 : 0; rk3 += (av > mine.w || (av == mine.w && e2 < e0m + 3)) ? 1 : 0; } }
      if (rk0 < 4) { sel_e[row * 4 + rk0] = e0m + 0; sel_v[row * 4 + rk0] = mine.x; }
      if (rk1 < 4) { sel_e[row * 4 + rk1] = e0m + 1; sel_v[row * 4 + rk1] = mine.y; }
      if (rk2 < 4) { sel_e[row * 4 + rk2] = e0m + 2; sel_v[row * 4 + rk2] = mine.z; }
      if (rk3 < 4) { sel_e[row * 4 + rk3] = e0m + 3; sel_v[row * 4 + rk3] = mine.w; }
      asm volatile("s_waitcnt lgkmcnt(0)" ::: "memory");
      if (eg == 0) { const i32x4 ee = *(const LAS i32x4*)(sel_e + row * 4); const f32x4 vv = *(const LAS f32x4*)(sel_v + row * 4);
          const float x1v = __expf(vv.y - vv.x), x2v = __expf(vv.z - vv.x), x3v = __expf(vv.w - vv.x), inv = 1.0f / (1.0f + x1v + x2v + x3v);
          const size_t g = (size_t)(blk * 64 + row) * 4;
          if (cnt) *(LAS f32x4*)(sel_v + row * 4) = (f32x4){inv, x1v * inv, x2v * inv, x3v * inv};
          else { *(i32x4*)(tope + g) = ee; *(f32x4*)(topw + g) = (f32x4){inv, x1v * inv, x2v * inv, x3v * inv}; }
          (void)__hip_atomic_fetch_add(&lh[ee.x], 1, __ATOMIC_RELAXED, __HIP_MEMORY_SCOPE_WORKGROUP); (void)__hip_atomic_fetch_add(&lh[ee.y], 1, __ATOMIC_RELAXED, __HIP_MEMORY_SCOPE_WORKGROUP);
          (void)__hip_atomic_fetch_add(&lh[ee.z], 1, __ATOMIC_RELAXED, __HIP_MEMORY_SCOPE_WORKGROUP); (void)__hip_atomic_fetch_add(&lh[ee.w], 1, __ATOMIC_RELAXED, __HIP_MEMORY_SCOPE_WORKGROUP); }
      asm volatile("s_waitcnt lgkmcnt(0)" ::: "memory"); }
    if (cnt) {
        LAS int* offs = (LAS int*)ssqx; LAS int* es = (LAS int*)ssqx + 32;
        __syncthreads();
        if (tid < NE) { offs[tid] = __hip_atomic_fetch_add(cnt + tid * CNT_STRIDE, lh[tid], __ATOMIC_RELAXED, __HIP_MEMORY_SCOPE_AGENT); lh[tid] = 0; }
        int my_e = 0, rank = 0;
        if (tid < 256) { my_e = sel_e[tid]; const unsigned long long lt = (lane == 0) ? 0ull : (~0ull >> (64 - lane));
#pragma unroll 4
            for (int e = 0; e < NE; ++e) { const unsigned long long mk = __ballot(my_e == e); if (my_e == e) rank = __popcll(mk & lt); if (lane == 0) es[wave * 32 + e] = __popcll(mk); } }
        __syncthreads();
        if (tid < 256) { for (int w2 = 0; w2 < wave; ++w2) rank += es[w2 * 32 + my_e];
            const int slot = offs[my_e] + rank;
            toke[(size_t)my_e * T + slot] = blk * 64 + (tid >> 2); wrowe[(size_t)my_e * T + slot] = sel_v[tid]; paire[(size_t)blk * 256 + tid] = slot | (my_e << 20); }
    }
}

struct Args { const float* in[30]; float* out; unsigned char* ws; int ph_lo, ph_hi, li, pad; };

template <bool GU> __device__ __forceinline__ void p0_transpose_item(const float* W, int K, int N, bf16* WT, int item, int lane, const float* kscale = nullptr) {
    const int nblk = N / 64, kb = item / nblk, nb = item % nblk, q = lane & 15, o = lane >> 4, k0 = 64 * kb + 16 * o, n0 = 64 * nb + 4 * q;
    const float* src = W + (size_t)k0 * N + n0;
    f32x4 v[16];
#pragma unroll
    for (int j = 0; j < 16; ++j) v[j] = *(const f32x4*)(src + (size_t)j * N);
    if (kscale) {
#pragma unroll
        for (int j = 0; j < 16; ++j) v[j] = v[j] * kscale[k0 + j]; }
#pragma unroll
    for (int i = 0; i < 4; ++i) { const int nr = GU ? gu_row(n0 + i) : (n0 + i);
        u32x4 a, b;
        a.x = cvtpk(v[0][i], v[1][i]); a.y = cvtpk(v[2][i], v[3][i]); a.z = cvtpk(v[4][i], v[5][i]); a.w = cvtpk(v[6][i], v[7][i]);
        b.x = cvtpk(v[8][i], v[9][i]); b.y = cvtpk(v[10][i], v[11][i]); b.z = cvtpk(v[12][i], v[13][i]); b.w = cvtpk(v[14][i], v[15][i]);
        u32x4* dst = (u32x4*)(WT + (size_t)nr * K + k0); dst[0] = a; dst[1] = b; }
}

template <bool GU> __device__ __forceinline__ void p0_transpose_item_fp8(const float* W, int K, int N, unsigned char* WT, int item, int lane) {
    const int nblk = N / 32, kb = item / nblk, nb = item % nblk, q = lane & 7, o = lane >> 3, k0 = 128 * kb + 16 * o, n0 = 32 * nb + 4 * q;
    const float* src = W + (size_t)k0 * N + n0;
    f32x4 v[16];
#pragma unroll
    for (int j = 0; j < 16; ++j) v[j] = __builtin_nontemporal_load((const f32x4*)(src + (size_t)j * N)) * W8_SCALE;
#pragma unroll
    for (int i = 0; i < 4; ++i) { const int nr = GU ? gu_row(n0 + i) : (n0 + i);
        u32x4 a; a.x = pk4_fp8(v[0][i], v[1][i], v[2][i], v[3][i]); a.y = pk4_fp8(v[4][i], v[5][i], v[6][i], v[7][i]); a.z = pk4_fp8(v[8][i], v[9][i], v[10][i], v[11][i]); a.w = pk4_fp8(v[12][i], v[13][i], v[14][i], v[15][i]);
        __builtin_nontemporal_store(a, (u32x4*)(WT + (size_t)nr * K + k0)); }
}

__global__ void __launch_bounds__(NWAVES * 64, 2) mk_fwd(Args args) {
    extern __shared__ __attribute__((aligned(16))) unsigned char lds_raw[];
    LAS unsigned char* lds = (LAS unsigned char*)lds_raw;
    const int tid = threadIdx.x, lane = tid & 63, wave = __builtin_amdgcn_readfirstlane(tid >> 6);
    const int G = gridDim.x, bx = blockIdx.x, vcu = (G % 8 == 0) ? (bx % 8) * (G / 8) + bx / 8 : bx;
    const int gw = vcu * NWAVES + wave, NGW = G * NWAVES;
    unsigned char* ws = args.ws;
    const float* x = args.in[0]; const float* c_in = args.in[1]; const float* w_ada = args.in[2]; const float* b_ada = args.in[3];
    const float* norm_mix = args.in[4]; const float* w_in = args.in[5]; const float* b_in = args.in[6];
    const float* q_norm = args.in[7]; const float* k_norm = args.in[8]; const float* sinks = args.in[9];
    const float* lam_re = args.in[10]; const float* lam_im = args.in[11]; const float* log_dt = args.in[12];
    const float* b_re = args.in[13]; const float* b_im = args.in[14]; const float* c_re = args.in[15]; const float* c_im = args.in[16];
    const float* d_skip = args.in[17]; const float* w_glu = args.in[18]; const float* b_glu = args.in[19];
    const float* attn_out_norm = args.in[20]; const float* ssm_out_norm = args.in[21]; const float* w_out = args.in[22];
    const float* norm_ffn = args.in[23]; const float* w_router = args.in[24]; const float* b_router = args.in[25];
    const float* w_gate_up = args.in[26]; const float* b_gate_up = args.in[27]; const float* w_down = args.in[28]; const float* b_down = args.in[29];
    float* out = args.out;
    float* MOD = (float*)(ws + WS_MOD); float* SSMT = (float*)(ws + WS_SSMT);
    bf16* WTIN = (bf16*)(ws + WS_WTIN); bf16* WTGLU = (bf16*)(ws + WS_WTGLU); bf16* WTOUT = (bf16*)(ws + WS_WTOUT); bf16* WTGU = (bf16*)(ws + WS_WTGU); bf16* WTDN = (bf16*)(ws + WS_WTDN);
    bf16* H = (bf16*)(ws + WS_H); bf16* PROJ = (bf16*)(ws + WS_PROJ); bf16* ATT = (bf16*)(ws + WS_ATT); bf16* Gb = (bf16*)(ws + WS_G); bf16* SSMG = (bf16*)(ws + WS_SSMG); bf16* MIXED = (bf16*)(ws + WS_MIXED);
    int* TOPE = (int*)(ws + WS_TOPE); float* TOPW = (float*)(ws + WS_TOPW); int* HIST = (int*)(ws + WS_HIST); int* TOKROW = (int*)(ws + WS_TOKROW); int* ROWPAIR = (int*)(ws + WS_ROWPAIR);
    float* WROW = (float*)(ws + WS_WROW); int* TILEE = (int*)(ws + WS_TILEE); bf16* ACT = (bf16*)(ws + WS_ACT); bf16* YS = (bf16*)(ws + WS_YS);
    float* XST = (float*)(ws + WS_XST); float* SC = (float*)(ws + WS_SC);

    for (int u = tid; u < (LDS_BYTES - LDSCTL_OFF) / 4; u += NWAVES * 64) ((LAS unsigned*)(lds + LDSCTL_OFF))[u] = 0u;
    __syncthreads();
    volatile LAS unsigned* MISC = (volatile LAS unsigned*)(lds + MISC_OFF);
    XcdBarrier bar = xcd_barrier_post((unsigned*)(ws + WS_CTL) + CW_BAR + args.li * XCD_BAR_WORDS, MISC + 8);
    const int lo = args.ph_lo, hi = args.ph_hi;
#define IN(k) (lo <= (k) && (k) < hi)
#define SEAM(k) do { if (IN(k) && IN((k) + 1)) xcd_barrier(bar); } while (0)

    if (IN(P_PRO)) {
        if (vcu < 96) {
            LAS float* ca = (LAS float*)(lds + RING_OFF);
            LAS float* red = (LAS float*)(lds + RING_OFF + 32768);
            for (int k = tid; k < D; k += 512) { float cv8[NB];
#pragma unroll
                for (int b = 0; b < NB; ++b) { const float v = c_in[b * D + k]; cv8[b] = v * sigmoidf_(v); }
                *(LAS f32x4*)(ca + k * 8) = (f32x4){cv8[0], cv8[1], cv8[2], cv8[3]}; *(LAS f32x4*)(ca + k * 8 + 4) = (f32x4){cv8[4], cv8[5], cv8[6], cv8[7]}; }
            __syncthreads();
            float acc[NB];
#pragma unroll
            for (int b = 0; b < NB; ++b) acc[b] = 0.f;
            const float* wp = w_ada + (size_t)(128 * wave) * (6 * D) + 64 * vcu + lane;
#pragma unroll 1
            for (int k0 = 0; k0 < 128; k0 += 64) {
                float wv[64];
#pragma unroll
                for (int j = 0; j < 64; ++j) wv[j] = __builtin_nontemporal_load(wp + (size_t)(k0 + j) * (6 * D));
#pragma unroll
                for (int j = 0; j < 64; ++j) { const float w = wv[j]; const f32x4 c0 = *(const LAS f32x4*)(ca + (128 * wave + k0 + j) * 8), c1 = *(const LAS f32x4*)(ca + (128 * wave + k0 + j) * 8 + 4);
                    acc[0] = fmaf(c0.x, w, acc[0]); acc[1] = fmaf(c0.y, w, acc[1]); acc[2] = fmaf(c0.z, w, acc[2]); acc[3] = fmaf(c0.w, w, acc[3]);
                    acc[4] = fmaf(c1.x, w, acc[4]); acc[5] = fmaf(c1.y, w, acc[5]); acc[6] = fmaf(c1.z, w, acc[6]); acc[7] = fmaf(c1.w, w, acc[7]); } }
#pragma unroll
            for (int b = 0; b < NB; ++b) red[(wave * 8 + b) * 64 + lane] = acc[b];
            __syncthreads();
            { float s = b_ada[64 * vcu + lane];
#pragma unroll
              for (int w2 = 0; w2 < 8; ++w2) s += red[(w2 * 8 + wave) * 64 + lane];
              MOD[wave * 6 * D + 64 * vcu + lane] = s; }
            __syncthreads();
        } else if (vcu < 100) { const int i = (vcu - 96) * 512 + tid; ssm_table_item(i, lam_re, lam_im, log_dt, b_re, b_im, SSMT); }
        else if (FAST_ROUTER && MOE_FP8_GU && vcu < 116) router_image_item((vcu - 100) * 512 + tid, w_router, ws + WS_WRI);
        if constexpr (SSM_MFMA_CARRY && !P3_CONV) for (int i = vcu * 512 + tid; i < NG * 64 * 64; i += G * 512) ssm_apow_item(i, lam_re, lam_im, log_dt, ws + WS_APOW);
        constexpr int I_IN = (D / 64) * (DIN / 64), I_GLU = (DSSM / 64) * (DSSM / 64), I_OUT = (D / 64) * (D / 64), I_GU = MOE_FP8_GU ? (D / 128) * (2 * DFF / 32) : (D / 64) * (2 * DFF / 64), I_DN = MOE_FP8_DN ? (DFF / 128) * (D / 32) : (DFF / 64) * (D / 64);
        constexpr int NITEMS = I_IN + I_GLU + I_OUT + NE * I_GU + NE * I_DN;
        const int gu_defer = (G == 256) ? GU_DEFER : 0;
        const int nitems_p0 = (G == 256 && P3_CONV) ? (I_IN + I_GLU + I_OUT) : (NITEMS - gu_defer - (G == 256 ? DN_DEFER_P9 : 0));
        for (int it0 = gw; it0 < nitems_p0; it0 += NGW) {
            int r = (it0 < I_IN + I_GLU + I_OUT) ? it0 : it0 + gu_defer;
            if (r < I_IN) { p0_transpose_item<false>(w_in, D, DIN, WTIN, r, lane); continue; } r -= I_IN;
            if (r < I_GLU) { p0_transpose_item<false>(w_glu, DSSM, DSSM, WTGLU, r, lane); continue; } r -= I_GLU;
            if (r < I_OUT) { const int kb = r / (D / 64);
                p0_transpose_item<false>(w_out, D, D, WTOUT, r, lane, FUSE_MIXNORM ? (kb < 8 ? attn_out_norm : ssm_out_norm - DATT) : nullptr); continue; } r -= I_OUT;
            if (r < NE * I_GU) { const int e = r / I_GU;
                if constexpr (MOE_FP8_GU) p0_transpose_item_fp8<true>(w_gate_up + (size_t)e * D * 2 * DFF, D, 2 * DFF, (unsigned char*)WTGU + (size_t)e * 2 * DFF * D, r % I_GU, lane);
                else p0_transpose_item<true>(w_gate_up + (size_t)e * D * 2 * DFF, D, 2 * DFF, WTGU + (size_t)e * 2 * DFF * D, r % I_GU, lane);
                continue; } r -= NE * I_GU;
            { const int e = r / I_DN;
              if constexpr (MOE_FP8_DN) p0_transpose_item_fp8<false>(w_down + (size_t)e * DFF * D, DFF, D, (unsigned char*)WTDN + (size_t)e * D * DFF, r % I_DN, lane);
              else p0_transpose_item<false>(w_down + (size_t)e * DFF * D, DFF, D, WTDN + (size_t)e * D * DFF, r % I_DN, lane); }
        }
    }
    SEAM(P_PRO);
    if (IN(P_NORM1)) {
        for (int m0 = 8 * gw; m0 < T; m0 += 8 * NGW) { const int b = m0 / S; f32x4 gm[4], shv[4];
#pragma unroll
            for (int j = 0; j < 4; ++j) { const int c = 4 * lane + 256 * j; gm[j] = *(const f32x4*)(norm_mix + c) * (1.0f + *(const f32x4*)(MOD + b * 6 * D + D + c)); shv[j] = *(const f32x4*)(MOD + b * 6 * D + c); }
#pragma unroll 2
            for (int i = 0; i < 8; ++i) { const int m = m0 + i; const f32x4* xr = (const f32x4*)(x + (size_t)m * D) + lane; f32x4 v[4]; float ss = 0.f;
#pragma unroll
                for (int j = 0; j < 4; ++j) { v[j] = xr[64 * j]; ss += (v[j].x * v[j].x + v[j].y * v[j].y) + (v[j].z * v[j].z + v[j].w * v[j].w); }
                const float r = rsqrtf(wave_sum(ss) * (1.0f / D) + EPS); u32x2* o = (u32x2*)(H + (size_t)m * D) + lane;
#pragma unroll
                for (int j = 0; j < 4; ++j) { const f32x4 y = v[j] * r * gm[j] + shv[j]; u32x2 w; w.x = cvtpk(y.x, y.y); w.y = cvtpk(y.z, y.w); o[64 * j] = w; } } }
    }
    SEAM(P_NORM1);
    if (IN(P_INPROJ)) {
        constexpr int I_GU8 = (D / 128) * (2 * DFF / 32);
        const bool reshape = P2_RESHAPE && GU_DEFER_P2 > 0 && G == 256;
        const int Gg = reshape ? P2_GEMM_WGS : G;
        if (bx < Gg) {
            pg8::DenseOrder So{(const char*)H, (const char*)WTIN, T / 256, DIN / 256, Gg, bx, (size_t)256 * D * 2};
            pg8::EpiProj E{PROJ, DIN, b_in, (LAS float*)(lds + RSCR_OFF + 4096)};
            pg8::gemm_phase<pg8::EpiProj, pg8::DenseOrder, true, false>(lds + RING_OFF, D, So, E);
            if constexpr (GU_DEFER_P2 > 0 && !P2_RESHAPE) { if (G == 256 && bx >= 64) {
                for (int k = 0; k < DEFER_P2_PER_WAVE; ++k) { const int r = ((bx - 64) * 8 + wave) * DEFER_P2_PER_WAVE + k, e = r / I_GU8;
                    p0_transpose_item_fp8<true>(w_gate_up + (size_t)e * D * 2 * DFF, D, 2 * DFF, (unsigned char*)WTGU + (size_t)e * 2 * DFF * D, r % I_GU8, lane); } } }
        } else {
            const int nconv = (G - Gg) * 8;
            for (int r = (bx - Gg) * 8 + wave; r < GU_DEFER_P2; r += 2 * nconv) conv_pair(w_gate_up, D, 2 * DFF, (unsigned char*)WTGU, I_GU8, 1, r, r + nconv, r + nconv < GU_DEFER_P2, lane);
        }
    }
    SEAM(P_INPROJ);
    if (IN(P_MIX_A)) {
#if FAST_ATTN
        for (int u = bx; u < NB * 16 * NKV; u += G) attn_unit(lds + RING_OFF, u, tid, PROJ, q_norm, k_norm, sinks, ATT, FUSE_MIXNORM ? (float*)(ws + WS_MIXED) : nullptr);
#else
        for (int idx = bx * 512 + tid; idx < T * NH; idx += G * 512) attn_scores_item(idx, PROJ, q_norm, k_norm, SC);
#endif
#if FAST_SSM
        { constexpr int IGU = (D / 128) * (2 * DFF / 32), IDN = (DFF / 128) * (D / 32);
          const ConvStream cstr{w_gate_up, w_down, (unsigned char*)WTGU, (unsigned char*)WTDN, GU_DEFER, NE * IGU - GU_DEFER, NE * IDN - DN_DEFER_P9, 2048};
          const bool use_cs = (G == 256) && P3_CONV;
          for (int u = bx; u < NB * NG; u += G) ssm_unit(lds + RING_OFF, u, tid, PROJ, SSMT, c_re, c_im, d_skip, Gb, use_cs, cstr, ws + WS_APOW); }
#else
        if (wave == 0) for (int idx = bx * 64 + lane; idx < NB * NG * NST; idx += G * 64) ssm_scan_item(idx, PROJ, SSMT, XST);
#endif
    }
    SEAM(P_MIX_A);
    if (IN(P_MIX_B)) {
#if !FAST_ATTN
        for (int idx = bx * 512 + tid; idx < T * NH * HD; idx += G * 512) attn_out_item(idx, PROJ, SC, sinks, ATT);
#endif
#if !FAST_SSM
        for (int idx = bx * 512 + tid; idx < T * DSSM; idx += G * 512) ssm_out_item(idx, PROJ, XST, c_re, c_im, d_skip, Gb);
#endif
    }
#if !(FAST_ATTN && FAST_SSM)
    SEAM(P_MIX_B);
#endif
    if (IN(P_GLU)) {
        pg8::DenseOrder So{(const char*)Gb, (const char*)WTGLU, T / 256, DSSM / 256, G, bx, (size_t)256 * DSSM * 2};
        pg8::EpiGlu E{Gb, SSMG, b_glu, FUSE_MIXNORM ? (float*)(ws + WS_MIXED + MiB) : nullptr, (LAS float*)(lds + RSCR_OFF + 4096)};
        pg8::gemm_phase<pg8::EpiGlu, pg8::DenseOrder, true, false>(lds + RING_OFF, DSSM, So, E);
        if constexpr (GU_DEFER_P4 > 0) { if (G == 256 && bx >= 128) {
            constexpr int I_GU8 = (D / 128) * (2 * DFF / 32);
            for (int k = 0; k < DEFER_P4_PER_WAVE; k += 2) { const int r = GU_DEFER_P2 + ((bx - 128) * 8 + wave) * DEFER_P4_PER_WAVE + k;
                conv_pair(w_gate_up, D, 2 * DFF, (unsigned char*)WTGU, I_GU8, 1, r, r + 1, k + 1 < DEFER_P4_PER_WAVE, lane); } } }
    }
    SEAM(P_GLU);
    if (IN(P_MIXNORM) && !FUSE_MIXNORM) {
        const f32x4 ga0 = *(const f32x4*)(attn_out_norm + 8 * lane), ga1 = *(const f32x4*)(attn_out_norm + 8 * lane + 4), gs0 = *(const f32x4*)(ssm_out_norm + 8 * lane), gs1 = *(const f32x4*)(ssm_out_norm + 8 * lane + 4);
        for (int m0 = 2 * gw; m0 < T; m0 += 2 * NGW) {
            u32x4 a[2], q[2];
#pragma unroll
            for (int r = 0; r < 2; ++r) { a[r] = *((const u32x4*)(ATT + (size_t)(m0 + r) * DATT) + lane); q[r] = *((const u32x4*)(SSMG + (size_t)(m0 + r) * DSSM) + lane); }
#pragma unroll
            for (int r = 0; r < 2; ++r) {
                const float av[8] = {bflo(a[r].x), bfhi(a[r].x), bflo(a[r].y), bfhi(a[r].y), bflo(a[r].z), bfhi(a[r].z), bflo(a[r].w), bfhi(a[r].w)};
                const float sv[8] = {bflo(q[r].x), bfhi(q[r].x), bflo(q[r].y), bfhi(q[r].y), bflo(q[r].z), bfhi(q[r].z), bflo(q[r].w), bfhi(q[r].w)};
                float qa = 0.f, qs = 0.f;
#pragma unroll
                for (int i = 0; i < 8; ++i) { qa += av[i] * av[i]; qs += sv[i] * sv[i]; }
                const float ra = rsqrtf(wave_sum(qa) * (1.0f / DATT) + EPS), rs = rsqrtf(wave_sum(qs) * (1.0f / DSSM) + EPS);
                u32x4 oa, os;
                oa.x = pk2(av[0] * ra * ga0.x, av[1] * ra * ga0.y); oa.y = pk2(av[2] * ra * ga0.z, av[3] * ra * ga0.w); oa.z = pk2(av[4] * ra * ga1.x, av[5] * ra * ga1.y); oa.w = pk2(av[6] * ra * ga1.z, av[7] * ra * ga1.w);
                os.x = pk2(sv[0] * rs * gs0.x, sv[1] * rs * gs0.y); os.y = pk2(sv[2] * rs * gs0.z, sv[3] * rs * gs0.w); os.z = pk2(sv[4] * rs * gs1.x, sv[5] * rs * gs1.y); os.w = pk2(sv[6] * rs * gs1.z, sv[7] * rs * gs1.w);
                *((u32x4*)(MIXED + (size_t)(m0 + r) * D) + lane) = oa; *((u32x4*)(MIXED + (size_t)(m0 + r) * D + DATT) + lane) = os; } }
    }
    if (!FUSE_MIXNORM) SEAM(P_MIXNORM);
    if (IN(P_OUTPROJ)) {
        if constexpr (FUSE_MIXNORM) {
            pg8::MixOrder So{(const char*)ATT, (const char*)WTOUT, T / 256, D / 256, G, bx, (size_t)(WS_SSMG - WS_ATT)};
            pg8::EpiOut E{x, MOD, X1_DELTA ? (float*)(ws + WS_DELTA) : out, (const float*)(ws + WS_MIXED), (const float*)(ws + WS_MIXED + MiB), (LAS float*)(lds + RSCR_OFF), (LAS float*)(lds + RSCR_OFF + 4096)};
            pg8::gemm_phase<pg8::EpiOut, pg8::MixOrder, false, false>(lds + RING_OFF, D, So, E);
        } else {
            pg8::DenseOrder So{(const char*)MIXED, (const char*)WTOUT, T / 256, D / 256, G, bx, (size_t)256 * D * 2};
            pg8::EpiOut E{x, MOD, X1_DELTA ? (float*)(ws + WS_DELTA) : out, nullptr, nullptr, (LAS float*)(lds + RSCR_OFF), (LAS float*)(lds + RSCR_OFF + 4096)};
            pg8::gemm_phase<pg8::EpiOut, pg8::DenseOrder, false, false>(lds + RING_OFF, D, So, E);
        }
    }
    SEAM(P_OUTPROJ);
    if (IN(P_ROUTER)) {
        LAS float* wr = (LAS float*)(lds + RING_OFF); LAS int* lh = (LAS int*)(lds + LH_OFF);
        constexpr bool FR = FAST_ROUTER && MOE_FP8_GU, FS = FR && FAST_SORT && MOE_FP8_DN && YS_FP8;
        if constexpr (!FR) for (int c = tid; c < D; c += 512) {
            f32x4 wv[8];
#pragma unroll
            for (int k = 0; k < 8; ++k) wv[k] = *(const f32x4*)(w_router + (size_t)c * NE + 4 * k);
#pragma unroll
            for (int k = 0; k < 8; ++k) { wr[(4 * k + 0) * D + c] = wv[k].x; wr[(4 * k + 1) * D + c] = wv[k].y; wr[(4 * k + 2) * D + c] = wv[k].z; wr[(4 * k + 3) * D + c] = wv[k].w; } }
        if (tid < NE) lh[tid] = 0;
        __syncthreads();
        for (int vb = bx; vb < 256; vb += G) {
            if constexpr (FR) router_block_mfma(lds, vb, tid, wave, lane, X1_DELTA ? x : out, norm_ffn, MOD, b_router, ws + WS_WRI, lh, ws + WS_H8, TOPE, TOPW, X1_DELTA ? (const bf16*)(ws + WS_DELTA) : nullptr, FS ? (int*)(ws + WS_CNT) : nullptr, (int*)(ws + WS_TOKE), (float*)(ws + WS_WROWE), ROWPAIR, (X1_DELTA && X1_BF16) ? (bf16*)(ws + WS_X1B) : nullptr);
            else norm2_router_rows(vb, wave, lane, out, norm_ffn, MOD, b_router, wr, lh, (LAS float*)(lds + RSCR_OFF), MOE_FP8_GU ? (bf16*)nullptr : H, TOPE, TOPW, MOE_FP8_GU ? (unsigned char*)PROJ : nullptr);
            __syncthreads();
            if (!FS && tid < NE) { HIST[vb * NE + tid] = lh[tid]; lh[tid] = 0; }
            __syncthreads();
        }
    }
    SEAM(P_ROUTER);
    constexpr bool FSK = FAST_ROUTER && MOE_FP8_GU && FAST_SORT && MOE_FP8_DN && YS_FP8;
    if (IN(P_SORT) && !FSK) for (int vb = bx; vb < 256; vb += G) sort_block(vb, tid, (LAS int*)(lds + SORT_OFF), HIST, TOPE, TOPW, TOKROW, ROWPAIR, WROW, TILEE);
    if (!FSK) SEAM(P_SORT);
    LAS int* cbt = (LAS int*)(lds + TE_OFF + 2048);
    if (IN(P_GATEUP) || IN(P_DOWN) || (FSK && IN(P_COMBINE))) {
        LAS int* te = (LAS int*)(lds + TE_OFF);
        if constexpr (FSK) {
            if (wave == 0) { const int cv = (lane < NE) ? ((const int*)(ws + WS_CNT))[lane * CNT_STRIDE] : 0; int inc = ((cv + 255) >> 8) << 8;
#pragma unroll
                for (int o = 1; o < 32; o <<= 1) { const int t = __shfl_up(inc, o); if (lane >= o) inc += t; }
                if (lane < NE) { cbt[lane] = cv; cbt[33 + lane] = inc; } if (lane == 0) cbt[32] = 0; }
            __syncthreads();
            if (tid < NE) for (int ti = cbt[32 + tid] >> 8; ti < (cbt[33 + tid] >> 8); ++ti) te[ti] = tid;
        } else for (int i = tid; i < MAXTILES; i += 512) te[i] = TILEE[64 + i];
        __syncthreads();
    }
    if (IN(P_GATEUP)) {
        const LAS int* te = (const LAS int*)(lds + TE_OFF); const int ntiles = __builtin_amdgcn_readfirstlane(FSK ? (cbt[64] >> 8) : TILEE[0]);
        if constexpr (MOE_FP8_GU) {
            pg8::MoeOrder So{(const char*)(ws + WS_H8), (const char*)WTGU, FSK ? (const int*)(ws + WS_TOKE) : TOKROW, te, ntiles, 2 * DFF / 256, G, bx, (size_t)256 * D, (size_t)2 * DFF * D, FSK ? cbt : nullptr};
            pg8::EpiGateUp<MOE_FP8_DN != 0> E{(void*)ACT, b_gate_up, te, 1.0f / (W8_SCALE * H8_SCALE), (LAS float*)(lds + RSCR_OFF + 4096)};
            pg8::gemm_phase<pg8::EpiGateUp<MOE_FP8_DN != 0>, pg8::MoeOrder, true, true, true>(lds + RING_OFF, D / 2, So, E);
            if constexpr (DN_DEFER_P9 > 0) { if (G == 256) {
                constexpr int IDN8 = (DFF / 128) * (D / 32);
                const int rem = (ntiles * (2 * DFF / 256)) % G; const bool all = (rem == 0) || (G - rem < 64);
                const int n_idle = all ? G : G - rem, j = all ? bx : bx - rem;
                if (j >= 0) for (int r = NE * IDN8 - DN_DEFER_P9 + j * 8 + wave; r < NE * IDN8; r += 2 * n_idle * 8)
                    conv_pair(w_down, DFF, D, (unsigned char*)WTDN, IDN8, 0, r, r + n_idle * 8, r + n_idle * 8 < NE * IDN8, lane); } }
        } else {
            pg8::MoeOrder So{(const char*)H, (const char*)WTGU, TOKROW, te, ntiles, 2 * DFF / 256, G, bx, (size_t)256 * D * 2, (size_t)2 * DFF * D * 2};
            pg8::EpiGateUp<MOE_FP8_DN != 0> E{(void*)ACT, b_gate_up, te, 1.0f, (LAS float*)(lds + RSCR_OFF + 4096)};
            pg8::gemm_phase<pg8::EpiGateUp<MOE_FP8_DN != 0>, pg8::MoeOrder, true, true, false>(lds + RING_OFF, D, So, E);
        }
    }
    SEAM(P_GATEUP);
    if (IN(P_DOWN)) {
        const LAS int* te = (const LAS int*)(lds + TE_OFF); const int ntiles = __builtin_amdgcn_readfirstlane(FSK ? (cbt[64] >> 8) : TILEE[0]);
        if constexpr (MOE_FP8_DN) {
            pg8::MoeOrder So{(const char*)ACT, (const char*)WTDN, TOKROW, te, ntiles, D / 256, G, bx, (size_t)256 * DFF, (size_t)D * DFF};
            pg8::EpiDown<YS_FP8 != 0> E{(void*)YS, b_down, FSK ? (const float*)(ws + WS_WROWE) : WROW, te, 1.0f / (W8_SCALE * A8_SCALE), FSK ? cbt : nullptr, (LAS float*)(lds + RSCR_OFF + 4096), (const float*)(ws + WS_CTL)};
            pg8::gemm_phase<pg8::EpiDown<YS_FP8 != 0>, pg8::MoeOrder, true, false, true>(lds + RING_OFF, DFF / 2, So, E);
        } else {
            pg8::MoeOrder So{(const char*)ACT, (const char*)WTDN, TOKROW, te, ntiles, D / 256, G, bx, (size_t)256 * DFF * 2, (size_t)D * DFF * 2};
            pg8::EpiDown<YS_FP8 != 0> E{(void*)YS, b_down, WROW, te, 1.0f, nullptr, (LAS float*)(lds + RSCR_OFF + 4096), (const float*)(ws + WS_CTL)};
            pg8::gemm_phase<pg8::EpiDown<YS_FP8 != 0>, pg8::MoeOrder, true, false, false>(lds + RING_OFF, DFF, So, E);
        }
    }
    SEAM(P_DOWN);
    if (IN(P_COMBINE)) { if constexpr (YS_FP8) { for (int m = 2 * gw; m < T; m += 2 * NGW) combine_rows8x2(m, lane, out, MOD, (const unsigned char*)YS, ROWPAIR, (X1_DELTA && !X1_BF16) ? x : nullptr, X1_DELTA ? (const bf16*)(ws + (X1_BF16 ? WS_X1B : WS_DELTA)) : nullptr, FSK ? cbt : nullptr); } else { for (int m = gw; m < T; m += NGW) combine_row(m, lane, out, MOD, YS, ROWPAIR); } }
#undef IN
#undef SEAM
}

static int g_grid = 0;
static void mk_setup() {
    if (g_grid != 0) return;
    int dev = 0, cus = 0, per_cu = 0;
    if (hipGetDevice(&dev) != hipSuccess || hipDeviceGetAttribute(&cus, hipDeviceAttributeMultiprocessorCount, dev) != hipSuccess) { fprintf(stderr, "kernel_launch: device query failed\n"); g_grid = -1; return; }
    if (hipFuncSetAttribute((const void*)mk_fwd, hipFuncAttributeMaxDynamicSharedMemorySize, LDS_BYTES) != hipSuccess) { fprintf(stderr, "kernel_launch: hipFuncSetAttribute failed\n"); g_grid = -1; return; }
    if (hipOccupancyMaxActiveBlocksPerMultiprocessor(&per_cu, (const void*)mk_fwd, NWAVES * 64, LDS_BYTES) != hipSuccess || per_cu < 1) { fprintf(stderr, "kernel_launch: occupancy query says %d workgroups per CU\n", per_cu); (void)hipGetLastError(); g_grid = -1; return; }
    g_grid = cus;
    (void)hipFuncSetAttribute((const void*)k_norm2_router, hipFuncAttributeMaxDynamicSharedMemorySize, 32 * 1024 * 4 + 256 + 4096);
}
static void mk_launch(const Args& base, int lo, int hi, int li, hipStream_t stream) {
    Args a = base; a.ph_lo = lo; a.ph_hi = hi; a.li = li; a.pad = 0;
    hipLaunchKernelGGL(mk_fwd, dim3(g_grid), dim3(NWAVES * 64), LDS_BYTES, stream, a);
}

extern "C" void kernel_launch(void* const* d_in, const int* in_sizes, int n_in, void* d_out, int out_size, void* d_ws, size_t ws_size, hipStream_t stream) {
    if (n_in != 30 || out_size != T * D || ws_size < WS_END) { fprintf(stderr, "kernel_launch: unexpected shapes (n_in %d out %d ws %zu)\n", n_in, out_size, ws_size); return; }
    mk_setup(); if (g_grid < 0) return;
    Args base{};
    for (int i = 0; i < 30; ++i) base.in[i] = (const float*)d_in[i];
    base.out = (float*)d_out; base.ws = (unsigned char*)d_ws;
    (void)hipMemsetAsync((char*)d_ws + WS_CTL, 0, CTL_ZERO_BYTES, stream);
#if MK_MODE == 1
    mk_launch(base, 0, P_COUNT, 0, stream);
#else
    const float* x = (const float*)d_in[0]; const float* c = (const float*)d_in[1]; const float* w_ada = (const float*)d_in[2]; const float* b_ada = (const float*)d_in[3];
    const float* norm_mix = (const float*)d_in[4]; const float* w_in = (const float*)d_in[5]; const float* b_in = (const float*)d_in[6];
    const float* q_norm = (const float*)d_in[7]; const float* k_norm = (const float*)d_in[8]; const float* sinks = (const float*)d_in[9];
    const float* lam_re = (const float*)d_in[10]; const float* lam_im = (const float*)d_in[11]; const float* log_dt = (const float*)d_in[12];
    const float* b_re = (const float*)d_in[13]; const float* b_im = (const float*)d_in[14]; const float* c_re = (const float*)d_in[15]; const float* c_im = (const float*)d_in[16];
    const float* d_skip = (const float*)d_in[17]; const float* w_glu = (const float*)d_in[18]; const float* b_glu = (const float*)d_in[19];
    const float* attn_out_norm = (const float*)d_in[20]; const float* ssm_out_norm = (const float*)d_in[21]; const float* w_out = (const float*)d_in[22];
    const float* norm_ffn = (const float*)d_in[23]; const float* w_router = (const float*)d_in[24]; const float* b_router = (const float*)d_in[25];
    const float* w_gate_up = (const float*)d_in[26]; const float* b_gate_up = (const float*)d_in[27]; const float* w_down = (const float*)d_in[28]; const float* b_down = (const float*)d_in[29];
    unsigned char* ws = (unsigned char*)d_ws; float* out = (float*)d_out;
    float* MOD = (float*)(ws + WS_MOD); float* SSMT = (float*)(ws + WS_SSMT);
    bf16* WTIN = (bf16*)(ws + WS_WTIN); bf16* WTGLU = (bf16*)(ws + WS_WTGLU); bf16* WTOUT = (bf16*)(ws + WS_WTOUT); bf16* WTGU = (bf16*)(ws + WS_WTGU); bf16* WTDN = (bf16*)(ws + WS_WTDN);
    bf16* H = (bf16*)(ws + WS_H); bf16* PROJ = (bf16*)(ws + WS_PROJ); bf16* ATT = (bf16*)(ws + WS_ATT); bf16* Gb = (bf16*)(ws + WS_G); bf16* SSMG = (bf16*)(ws + WS_SSMG); bf16* MIXED = (bf16*)(ws + WS_MIXED);
    int* TOPE = (int*)(ws + WS_TOPE); float* TOPW = (float*)(ws + WS_TOPW); int* HIST = (int*)(ws + WS_HIST); int* TOKROW = (int*)(ws + WS_TOKROW); int* ROWPAIR = (int*)(ws + WS_ROWPAIR);
    float* WROW = (float*)(ws + WS_WROW); int* TILEE = (int*)(ws + WS_TILEE); bf16* ACT = (bf16*)(ws + WS_ACT); bf16* YS = (bf16*)(ws + WS_YS);
    float* XST = (float*)(ws + WS_XST); float* SC = (float*)(ws + WS_SC);
#ifndef REF_PRO
#define REF_PRO 1
#endif
#ifndef REF_NORM1
#define REF_NORM1 1
#endif
#ifndef REF_INPROJ
#define REF_INPROJ 1
#endif
#ifndef REF_MIX
#define REF_MIX 1
#endif
#ifndef REF_GLU
#define REF_GLU 1
#endif
#ifndef REF_MIXNORM
#define REF_MIXNORM 1
#endif
#ifndef REF_OUTPROJ
#define REF_OUTPROJ 1
#endif
#ifndef REF_ROUTER
#define REF_ROUTER 1
#endif
#ifndef REF_SORT
#define REF_SORT 1
#endif
#ifndef REF_GATEUP
#define REF_GATEUP 1
#endif
#ifndef REF_DOWN
#define REF_DOWN 1
#endif
#ifndef REF_COMBINE
#define REF_COMBINE 1
#endif
    int li = 0;
    if (REF_PRO) {
        hipLaunchKernelGGL(k_transpose_cvt, dim3(DIN / 32, D / 32, 1), dim3(32, 8), 0, stream, w_in, WTIN, D, DIN, 0);
        hipLaunchKernelGGL(k_transpose_cvt, dim3(DSSM / 32, DSSM / 32, 1), dim3(32, 8), 0, stream, w_glu, WTGLU, DSSM, DSSM, 0);
        hipLaunchKernelGGL(k_transpose_cvt, dim3(D / 32, D / 32, 1), dim3(32, 8), 0, stream, w_out, WTOUT, D, D, 0);
        hipLaunchKernelGGL(k_transpose_cvt, dim3(2 * DFF / 32, D / 32, NE), dim3(32, 8), 0, stream, w_gate_up, WTGU, D, 2 * DFF, 1);
        hipLaunchKernelGGL(k_transpose_cvt, dim3(D / 32, DFF / 32, NE), dim3(32, 8), 0, stream, w_down, WTDN, DFF, D, 0);
        hipLaunchKernelGGL(k_mod, dim3(6 * D / 256), dim3(256), 0, stream, c, w_ada, b_ada, MOD);
        hipLaunchKernelGGL(k_ssm_tables, dim3(NG * NST / 256), dim3(256), 0, stream, lam_re, lam_im, log_dt, b_re, b_im, SSMT);
    } else mk_launch(base, P_PRO, P_PRO + 1, li++, stream);
    if (REF_NORM1) hipLaunchKernelGGL(k_norm_mod, dim3(T / 4), dim3(256), 0, stream, x, norm_mix, (const float*)MOD, 0, D, H);
    else mk_launch(base, P_NORM1, P_NORM1 + 1, li++, stream);
    if (REF_INPROJ) { NEpiProj e{}; e.A = H; e.Bt = WTIN; e.bias = b_in; e.O = PROJ; hipLaunchKernelGGL(k_gemm_naive<NEpiProj>, dim3(T, DIN / 256), dim3(256), 0, stream, e, DIN, D); }
    else mk_launch(base, P_INPROJ, P_INPROJ + 1, li++, stream);
    if (REF_MIX) {
        hipLaunchKernelGGL(k_attn_scores, dim3(T * NH / 256), dim3(256), 0, stream, (const bf16*)PROJ, q_norm, k_norm, SC);
        hipLaunchKernelGGL(k_attn_out, dim3(T * NH * HD / 256), dim3(256), 0, stream, (const bf16*)PROJ, (const float*)SC, sinks, ATT);
        hipLaunchKernelGGL(k_ssm_scan, dim3(NB * NG * NST / 64), dim3(64), 0, stream, (const bf16*)PROJ, (const float*)SSMT, XST);
        hipLaunchKernelGGL(k_ssm_out, dim3(T * DSSM / 256), dim3(256), 0, stream, (const bf16*)PROJ, (const float*)XST, c_re, c_im, d_skip, Gb);
    } else { mk_launch(base, P_MIX_A, P_MIX_A + 1, li++, stream); mk_launch(base, P_MIX_B, P_MIX_B + 1, li++, stream); }
    if (REF_GLU) { NEpiGlu e{}; e.A = Gb; e.Bt = WTGLU; e.bias = b_glu; e.O = SSMG; hipLaunchKernelGGL(k_gemm_naive<NEpiGlu>, dim3(T, DSSM / 256), dim3(256), 0, stream, e, DSSM, DSSM); }
    else mk_launch(base, P_GLU, P_GLU + 1, li++, stream);
    if (REF_MIXNORM) hipLaunchKernelGGL(k_mixnorm, dim3(T / 4), dim3(256), 0, stream, (const bf16*)ATT, (const bf16*)SSMG, attn_out_norm, ssm_out_norm, MIXED);
    else mk_launch(base, P_MIXNORM, P_MIXNORM + 1, li++, stream);
    if (REF_OUTPROJ) { NEpiOut e{}; e.A = MIXED; e.Bt = WTOUT; e.x = x; e.mod = MOD; e.O = out; hipLaunchKernelGGL(k_gemm_naive<NEpiOut>, dim3(T, D / 256), dim3(256), 0, stream, e, D, D); }
    else mk_launch(base, P_OUTPROJ, P_OUTPROJ + 1, li++, stream);
    if (REF_ROUTER) hipLaunchKernelGGL(k_norm2_router, dim3(256), dim3(512), 32 * 1024 * 4 + 256 + 4096, stream, (const float*)out, norm_ffn, (const float*)MOD, w_router, b_router, H, TOPE, TOPW, HIST);
    else mk_launch(base, P_ROUTER, P_ROUTER + 1, li++, stream);
    if (REF_SORT) hipLaunchKernelGGL(k_sort, dim3(256), dim3(512), 0, stream, (const int*)HIST, (const int*)TOPE, (const float*)TOPW, TOKROW, ROWPAIR, WROW, TILEE);
    else mk_launch(base, P_SORT, P_SORT + 1, li++, stream);
    if (REF_GATEUP) { NEpiGU e{}; e.H = H; e.Wt = WTGU; e.bias = b_gate_up; e.tokrow = TOKROW; e.tilee = TILEE; e.ACT = ACT; hipLaunchKernelGGL(k_moe_gu_naive, dim3(MPAD, DFF / 256), dim3(256), 0, stream, e); }
    else mk_launch(base, P_GATEUP, P_GATEUP + 1, li++, stream);
    if (REF_DOWN) { NEpiDown e{}; e.ACT = ACT; e.Wt = WTDN; e.bias = b_down; e.wrow = WROW; e.tilee = TILEE; e.YS = YS; hipLaunchKernelGGL(k_gemm_naive<NEpiDown>, dim3(MPAD, D / 256), dim3(256), 0, stream, e, D, DFF); }
    else mk_launch(base, P_DOWN, P_DOWN + 1, li++, stream);
    if (REF_COMBINE) hipLaunchKernelGGL(k_combine, dim3(T / 4), dim3(256), 0, stream, out, (const float*)MOD, (const bf16*)YS, (const int*)ROWPAIR);
    else mk_launch(base, P_COMBINE, P_COMBINE + 1, li++, stream);
#endif
}
```

```cpp
#include <hip/hip_runtime.h>
#include <stdint.h>
#include <stdio.h>

#ifndef FAST_ATTN
#define FAST_ATTN 1
#endif
#ifndef FAST_SSM
#define FAST_SSM 1
#endif
#ifndef MOE_FP8_GU
#define MOE_FP8_GU 1
#endif
#ifndef MOE_FP8_DN
#define MOE_FP8_DN 1
#endif
#ifndef YS_FP8
#define YS_FP8 1
#endif
#ifndef P3_CONV
#define P3_CONV 0
#endif
#ifndef FUSE_MIXNORM
#define FUSE_MIXNORM 1
#endif
#ifndef X1_DELTA
#define X1_DELTA 1
#endif
#ifndef SSM_MFMA_CARRY
#define SSM_MFMA_CARRY 1
#endif
#ifndef X1_BF16
#define X1_BF16 1
#endif
#ifndef FAST_SORT
#define FAST_SORT 1
#endif
#ifndef FAST_ROUTER
#define FAST_ROUTER 1
#endif
#ifndef MK_MODE
#define MK_MODE 1
#endif

typedef unsigned short bf16;
typedef float f32x4 __attribute__((ext_vector_type(4)));
typedef float f32x2 __attribute__((ext_vector_type(2)));
typedef unsigned u32x4 __attribute__((ext_vector_type(4)));
typedef unsigned u32x2 __attribute__((ext_vector_type(2)));
typedef short bf16x8 __attribute__((ext_vector_type(8)));
typedef int i32x4 __attribute__((ext_vector_type(4)));
typedef int i32x8 __attribute__((ext_vector_type(8)));
constexpr float W8_SCALE = 32.0f, H8_SCALE = 4.0f, A8_SCALE = 4.0f, Y8_SCALE = 16.0f;
#define GAS __attribute__((address_space(1)))
#define LAS __attribute__((address_space(3)))

constexpr int D = 1024, NB = 8, S = 2048, T = NB * S;
constexpr int DATT = 512, HD = 64, NH = 8, NKV = 2, DKV = 128;
constexpr int DSSM = 512, SG = 16, NG = 32, NST = 64;
constexpr int DIN = 1280, NE = 32, TOPK = 4, DFF = 1024;
constexpr int QOFF = 0, KOFF = 512, VOFF = 640, UOFF = 768;
constexpr float EPS = 1e-6f;
constexpr int MAXTILES = 288, MPAD = MAXTILES * 256;

constexpr size_t MiB = 1u << 20;
constexpr size_t WS_CTL = 0, CTL_ZERO_BYTES = 256 * 1024;
constexpr size_t WS_MOD = 1 * MiB;
constexpr size_t WS_SSMT = 2 * MiB;
constexpr size_t WS_WTIN = 4 * MiB;
constexpr size_t WS_WTGLU = 7 * MiB;
constexpr size_t WS_WTOUT = 8 * MiB;
constexpr size_t WS_WTGU = 16 * MiB;
constexpr size_t WS_WTDN = 144 * MiB;
constexpr size_t WS_H = 208 * MiB;
constexpr size_t WS_PROJ = 240 * MiB;
constexpr size_t WS_ATT = 280 * MiB;
constexpr size_t WS_G = 296 * MiB;
constexpr size_t WS_SSMG = 312 * MiB;
constexpr size_t WS_MIXED = 328 * MiB;
constexpr size_t WS_TOPE = 360 * MiB;
constexpr size_t WS_TOPW = 361 * MiB;
constexpr size_t WS_HIST = 362 * MiB;
constexpr size_t WS_TOKROW = 363 * MiB;
constexpr size_t WS_ROWPAIR = 364 * MiB;
constexpr size_t WS_WROW = 365 * MiB;
constexpr size_t WS_TILEE = 366 * MiB;
constexpr size_t WS_CNT = 1024;
constexpr int CNT_STRIDE = 64;
constexpr size_t WS_TOKE = 332 * MiB;
constexpr size_t WS_WROWE = 336 * MiB;
constexpr size_t WS_APOW = 340 * MiB;
constexpr size_t WS_DELTA = 624 * MiB;
constexpr size_t WS_H8 = 660 * MiB;
constexpr size_t WS_WRI = 367 * MiB;
constexpr size_t WS_ACT = 368 * MiB;
constexpr size_t WS_YS = 512 * MiB;
constexpr size_t WS_XST = 368 * MiB;
constexpr size_t WS_SC = 624 * MiB;
constexpr size_t WS_X1B = 700 * MiB;
constexpr size_t WS_END = 740 * MiB;
constexpr int CW_BAR = 4096;

constexpr int ST_AR = 0, ST_AI = 64, ST_BR = 128, ST_BI = 128 + 1024, SSMT_STRIDE = 128 + 2048;

__host__ __device__ __forceinline__ int gu_row(int n) { const int j = n >> 1, half = n & 1; return (j >> 7) * 256 + half * 128 + (j & 127); }

__device__ __forceinline__ unsigned f2bf(float f) { unsigned u = __builtin_bit_cast(unsigned, f); return (u + 0x7fffu + ((u >> 16) & 1u)) >> 16; }
__device__ __forceinline__ float bf2f(unsigned b) { return __builtin_bit_cast(float, (b & 0xffffu) << 16); }
__device__ __forceinline__ unsigned pk2(float lo, float hi) { return f2bf(lo) | (f2bf(hi) << 16); }
__device__ __forceinline__ unsigned pk4_fp8(float a, float b, float c, float d) { unsigned w = 0u; w = __builtin_amdgcn_cvt_pk_fp8_f32(a, b, w, false); w = __builtin_amdgcn_cvt_pk_fp8_f32(c, d, w, true); return w; }
__device__ __forceinline__ float bflo(unsigned w) { return __builtin_bit_cast(float, w << 16); }
__device__ __forceinline__ float bfhi(unsigned w) { return __builtin_bit_cast(float, w & 0xffff0000u); }
__device__ __forceinline__ float wave_sum(float v) {
#pragma unroll
    for (int o = 1; o < 64; o <<= 1) v += __shfl_xor(v, o);
    return v;
}
__device__ __forceinline__ float sigmoidf_(float x) { return __builtin_amdgcn_rcpf(1.0f + __expf(-x)); }
__device__ __forceinline__ float gelu_tanh(float x) { const float u2 = 1.5957691216057308f * (x + 0.044715f * x * x * x); return x * sigmoidf_(u2); }
__device__ __forceinline__ float dot8(u32x4 a, u32x4 b, float acc) {
    acc = fmaf(bflo(a.x), bflo(b.x), acc); acc = fmaf(bfhi(a.x), bfhi(b.x), acc);
    acc = fmaf(bflo(a.y), bflo(b.y), acc); acc = fmaf(bfhi(a.y), bfhi(b.y), acc);
    acc = fmaf(bflo(a.z), bflo(b.z), acc); acc = fmaf(bfhi(a.z), bfhi(b.z), acc);
    acc = fmaf(bflo(a.w), bflo(b.w), acc); acc = fmaf(bfhi(a.w), bfhi(b.w), acc);
    return acc;
}

__device__ __forceinline__ void ssm_table_item(int i, const float* lam_re, const float* lam_im, const float* log_dt, const float* b_re, const float* b_im, float* tab) {
    const int g = i / NST, p = i % NST;
    const float lr = lam_re[i], li = lam_im[i], dt = expf(log_dt[g]);
    const float mag = expf(lr * dt), ang = li * dt;
    const float lbr = mag * cosf(ang), lbi = mag * sinf(ang);
    const float den = lr * lr + li * li;
    const float cr = ((lbr - 1.0f) * lr + lbi * li) / den, ci = (lbi * lr - (lbr - 1.0f) * li) / den;
    float* t = tab + (size_t)g * SSMT_STRIDE;
    t[ST_AR + p] = lbr; t[ST_AI + p] = lbi;
    for (int h = 0; h < SG; ++h) { const float br = b_re[(size_t)i * SG + h], bi = b_im[(size_t)i * SG + h];
        t[ST_BR + p * SG + h] = cr * br - ci * bi; t[ST_BI + p * SG + h] = cr * bi + ci * br; }
}
__device__ __forceinline__ void norm_mod_row(int row, int lane, const float* x, const float* gain, const float* mod, int sh_off, int sc_off, bf16* H) {
    const int b = row / S;
    const f32x4* xr = (const f32x4*)(x + (size_t)row * D) + lane;
    f32x4 v[4]; float s = 0.f;
#pragma unroll
    for (int j = 0; j < 4; ++j) { v[j] = xr[64 * j]; s += (v[j].x * v[j].x + v[j].y * v[j].y) + (v[j].z * v[j].z + v[j].w * v[j].w); }
    const float r = rsqrtf(wave_sum(s) * (1.0f / D) + EPS);
    u32x2* o = (u32x2*)(H + (size_t)row * D) + lane;
#pragma unroll
    for (int j = 0; j < 4; ++j) { const int c = 4 * lane + 256 * j;
        const f32x4 g = *(const f32x4*)(gain + c), sc = *(const f32x4*)(mod + b * 6 * D + sc_off + c), sh = *(const f32x4*)(mod + b * 6 * D + sh_off + c);
        f32x4 y; y.x = v[j].x * r * g.x * (1.f + sc.x) + sh.x; y.y = v[j].y * r * g.y * (1.f + sc.y) + sh.y; y.z = v[j].z * r * g.z * (1.f + sc.z) + sh.z; y.w = v[j].w * r * g.w * (1.f + sc.w) + sh.w;
        u32x2 w; w.x = pk2(y.x, y.y); w.y = pk2(y.z, y.w); o[64 * j] = w; }
}
__device__ __forceinline__ void mixnorm_row(int row, int lane, const bf16* ATT, const bf16* SSMG, const float* ga, const float* gs, bf16* MIXED) {
    const u32x4 a = *((const u32x4*)(ATT + (size_t)row * DATT) + lane), s = *((const u32x4*)(SSMG + (size_t)row * DSSM) + lane);
    const float av[8] = {bflo(a.x), bfhi(a.x), bflo(a.y), bfhi(a.y), bflo(a.z), bfhi(a.z), bflo(a.w), bfhi(a.w)};
    const float sv[8] = {bflo(s.x), bfhi(s.x), bflo(s.y), bfhi(s.y), bflo(s.z), bfhi(s.z), bflo(s.w), bfhi(s.w)};
    float qa = 0.f, qs = 0.f;
#pragma unroll
    for (int i = 0; i < 8; ++i) { qa += av[i] * av[i]; qs += sv[i] * sv[i]; }
    const float ra = rsqrtf(wave_sum(qa) * (1.0f / DATT) + EPS), rs = rsqrtf(wave_sum(qs) * (1.0f / DSSM) + EPS);
    const f32x4 ga0 = *(const f32x4*)(ga + 8 * lane), ga1 = *(const f32x4*)(ga + 8 * lane + 4), gs0 = *(const f32x4*)(gs + 8 * lane), gs1 = *(const f32x4*)(gs + 8 * lane + 4);
    u32x4 oa, os;
    oa.x = pk2(av[0] * ra * ga0.x, av[1] * ra * ga0.y); oa.y = pk2(av[2] * ra * ga0.z, av[3] * ra * ga0.w); oa.z = pk2(av[4] * ra * ga1.x, av[5] * ra * ga1.y); oa.w = pk2(av[6] * ra * ga1.z, av[7] * ra * ga1.w);
    os.x = pk2(sv[0] * rs * gs0.x, sv[1] * rs * gs0.y); os.y = pk2(sv[2] * rs * gs0.z, sv[3] * rs * gs0.w); os.z = pk2(sv[4] * rs * gs1.x, sv[5] * rs * gs1.y); os.w = pk2(sv[6] * rs * gs1.z, sv[7] * rs * gs1.w);
    *((u32x4*)(MIXED + (size_t)row * D) + lane) = oa; *((u32x4*)(MIXED + (size_t)row * D + DATT) + lane) = os;
}
__device__ __forceinline__ void combine_row(int row, int lane, float* out, const float* mod, const bf16* YS, const int* rowpair) {
    const int b = row / S; const int* rp = rowpair + (size_t)row * 4;
    const int r0 = rp[0], r1 = rp[1], r2 = rp[2], r3 = rp[3];
#pragma unroll
    for (int j = 0; j < 2; ++j) { const int c = 8 * lane + 512 * j;
        const u32x4 a = *(const u32x4*)(YS + (size_t)r0 * D + c), b2 = *(const u32x4*)(YS + (size_t)r1 * D + c), c2 = *(const u32x4*)(YS + (size_t)r2 * D + c), d2 = *(const u32x4*)(YS + (size_t)r3 * D + c);
        float y[8];
        y[0] = bflo(a.x) + bflo(b2.x) + bflo(c2.x) + bflo(d2.x); y[1] = bfhi(a.x) + bfhi(b2.x) + bfhi(c2.x) + bfhi(d2.x);
        y[2] = bflo(a.y) + bflo(b2.y) + bflo(c2.y) + bflo(d2.y); y[3] = bfhi(a.y) + bfhi(b2.y) + bfhi(c2.y) + bfhi(d2.y);
        y[4] = bflo(a.z) + bflo(b2.z) + bflo(c2.z) + bflo(d2.z); y[5] = bfhi(a.z) + bfhi(b2.z) + bfhi(c2.z) + bfhi(d2.z);
        y[6] = bflo(a.w) + bflo(b2.w) + bflo(c2.w) + bflo(d2.w); y[7] = bfhi(a.w) + bfhi(b2.w) + bfhi(c2.w) + bfhi(d2.w);
        float* op = out + (size_t)row * D + c; const float* g2 = mod + b * 6 * D + 5 * D + c;
        f32x4 o0 = *(f32x4*)op, o1 = *(f32x4*)(op + 4); const f32x4 g0 = *(const f32x4*)g2, g1 = *(const f32x4*)(g2 + 4);
        o0.x += g0.x * y[0]; o0.y += g0.y * y[1]; o0.z += g0.z * y[2]; o0.w += g0.w * y[3]; o1.x += g1.x * y[4]; o1.y += g1.y * y[5]; o1.z += g1.z * y[6]; o1.w += g1.w * y[7];
        *(f32x4*)op = o0; *(f32x4*)(op + 4) = o1; }
}
__device__ __forceinline__ void combine_row8(int row, int lane, float* out, const float* mod, const unsigned char* YS8, const int* rowpair) {
    const int b = row / S; const i32x4 rp = *(const i32x4*)(rowpair + (size_t)row * 4); const int c = 16 * lane;
    const u32x4 q0 = *(const u32x4*)(YS8 + (size_t)rp.x * D + c), q1 = *(const u32x4*)(YS8 + (size_t)rp.y * D + c), q2 = *(const u32x4*)(YS8 + (size_t)rp.z * D + c), q3 = *(const u32x4*)(YS8 + (size_t)rp.w * D + c);
    float* op = out + (size_t)row * D + c; const float* g2 = mod + b * 6 * D + 5 * D + c;
#pragma unroll
    for (int j = 0; j < 4; ++j) { const unsigned w0 = q0[j], w1 = q1[j], w2 = q2[j], w3 = q3[j];
        const f32x2 lo = __builtin_amdgcn_cvt_pk_f32_fp8(w0, false) + __builtin_amdgcn_cvt_pk_f32_fp8(w1, false) + __builtin_amdgcn_cvt_pk_f32_fp8(w2, false) + __builtin_amdgcn_cvt_pk_f32_fp8(w3, false);
        const f32x2 hi = __builtin_amdgcn_cvt_pk_f32_fp8(w0, true) + __builtin_amdgcn_cvt_pk_f32_fp8(w1, true) + __builtin_amdgcn_cvt_pk_f32_fp8(w2, true) + __builtin_amdgcn_cvt_pk_f32_fp8(w3, true);
        f32x4 o = *(f32x4*)(op + 4 * j); const f32x4 g = *(const f32x4*)(g2 + 4 * j);
        o.x += g.x * lo.x * (1.0f / Y8_SCALE); o.y += g.y * lo.y * (1.0f / Y8_SCALE); o.z += g.z * hi.x * (1.0f / Y8_SCALE); o.w += g.w * hi.y * (1.0f / Y8_SCALE);
        *(f32x4*)(op + 4 * j) = o; }
}
__device__ __forceinline__ void combine_rows8x2(int row, int lane, float* out, const float* mod, const unsigned char* YS8, const int* rowpair, const float* xin = nullptr, const bf16* delta = nullptr, const LAS int* cb = nullptr) {
    const int b = row / S, c = 16 * lane; i32x4 rp0 = *(const i32x4*)(rowpair + (size_t)row * 4), rp1 = *(const i32x4*)(rowpair + (size_t)row * 4 + 4);
    if (FAST_SORT && cb) {
#pragma unroll
        for (int k = 0; k < 4; ++k) { rp0[k] = (rp0[k] & 0xFFFFF) + cb[32 + (rp0[k] >> 20)]; rp1[k] = (rp1[k] & 0xFFFFF) + cb[32 + (rp1[k] >> 20)]; } }
    u32x4 q[2][4];
    q[0][0] = *(const u32x4*)(YS8 + (size_t)rp0.x * D + c); q[0][1] = *(const u32x4*)(YS8 + (size_t)rp0.y * D + c); q[0][2] = *(const u32x4*)(YS8 + (size_t)rp0.z * D + c); q[0][3] = *(const u32x4*)(YS8 + (size_t)rp0.w * D + c);
    q[1][0] = *(const u32x4*)(YS8 + (size_t)rp1.x * D + c); q[1][1] = *(const u32x4*)(YS8 + (size_t)rp1.y * D + c); q[1][2] = *(const u32x4*)(YS8 + (size_t)rp1.z * D + c); q[1][3] = *(const u32x4*)(YS8 + (size_t)rp1.w * D + c);
    const float* g2 = mod + b * 6 * D + 5 * D + c;
    f32x4 g[4], o[2][4];
#pragma unroll
    for (int j = 0; j < 4; ++j) { g[j] = *(const f32x4*)(g2 + 4 * j) * (1.0f / Y8_SCALE); const float* src = delta ? xin : out;
        if (src) { o[0][j] = *(const f32x4*)(src + (size_t)row * D + c + 4 * j); o[1][j] = *(const f32x4*)(src + (size_t)(row + 1) * D + c + 4 * j); } else { o[0][j] = (f32x4){0.f, 0.f, 0.f, 0.f}; o[1][j] = o[0][j]; } }
    if (delta) {
#pragma unroll
        for (int r = 0; r < 2; ++r) { const u32x4 d0 = *(const u32x4*)(delta + (size_t)(row + r) * D + c), d1 = *(const u32x4*)(delta + (size_t)(row + r) * D + c + 8);
            o[r][0] += (f32x4){bflo(d0.x), bfhi(d0.x), bflo(d0.y), bfhi(d0.y)}; o[r][1] += (f32x4){bflo(d0.z), bfhi(d0.z), bflo(d0.w), bfhi(d0.w)};
            o[r][2] += (f32x4){bflo(d1.x), bfhi(d1.x), bflo(d1.y), bfhi(d1.y)}; o[r][3] += (f32x4){bflo(d1.z), bfhi(d1.z), bflo(d1.w), bfhi(d1.w)}; } }
#pragma unroll
    for (int r = 0; r < 2; ++r)
#pragma unroll
        for (int j = 0; j < 4; ++j) { const unsigned w0 = q[r][0][j], w1 = q[r][1][j], w2 = q[r][2][j], w3 = q[r][3][j];
            const f32x2 lo = __builtin_amdgcn_cvt_pk_f32_fp8(w0, false) + __builtin_amdgcn_cvt_pk_f32_fp8(w1, false) + __builtin_amdgcn_cvt_pk_f32_fp8(w2, false) + __builtin_amdgcn_cvt_pk_f32_fp8(w3, false);
            const f32x2 hi = __builtin_amdgcn_cvt_pk_f32_fp8(w0, true) + __builtin_amdgcn_cvt_pk_f32_fp8(w1, true) + __builtin_amdgcn_cvt_pk_f32_fp8(w2, true) + __builtin_amdgcn_cvt_pk_f32_fp8(w3, true);
            f32x4 t = o[r][j]; t.x += g[j].x * lo.x; t.y += g[j].y * lo.y; t.z += g[j].z * hi.x; t.w += g[j].w * hi.y;
            *(f32x4*)(out + (size_t)(row + r) * D + c + 4 * j) = t; }
}
__device__ __forceinline__ void attn_scores_item(int idx, const bf16* PROJ, const float* qg, const float* kg, float* SC) {
    const int t = idx / NH, h = idx % NH, kvh = h / 4, b = t / S, tl = t % S;
    const bf16* q = PROJ + (size_t)t * DIN + QOFF + h * HD;
    float sq = 0.f;
    for (int d = 0; d < HD; ++d) { const float v = bf2f(q[d]); sq += v * v; }
    const float rq = rsqrtf(sq * (1.0f / HD) + EPS);
    for (int i = 0; i < 128; ++i) {
        const int sl = tl - 127 + i; float sc = -1e30f;
        if (sl >= 0) { const bf16* k = PROJ + (size_t)(b * S + sl) * DIN + KOFF + kvh * HD;
            float sk = 0.f, dt = 0.f;
            for (int d = 0; d < HD; ++d) { const float kv = bf2f(k[d]); sk += kv * kv; dt += bf2f(q[d]) * qg[d] * kv * kg[d]; }
            sc = dt * rq * rsqrtf(sk * (1.0f / HD) + EPS) * 0.125f; }
        SC[(size_t)idx * 128 + i] = sc; }
}
__device__ __forceinline__ void attn_out_item(int idx, const bf16* PROJ, const float* SC, const float* sinks, bf16* ATT) {
    const int d = idx % HD, th = idx / HD, h = th % NH, t = th / NH, kvh = h / 4, b = t / S, tl = t % S;
    const float* sc = SC + (size_t)th * 128; const float sink = sinks[h];
    float m = sink;
    for (int i = 0; i < 128; ++i) m = fmaxf(m, sc[i]);
    float den = __expf(sink - m), o = 0.f;
    for (int i = 0; i < 128; ++i) { const int sl = tl - 127 + i; if (sl < 0) continue;
        const float p = __expf(sc[i] - m); den += p; o += p * bf2f(PROJ[(size_t)(b * S + sl) * DIN + VOFF + kvh * HD + d]); }
    ATT[(size_t)t * DATT + h * HD + d] = (bf16)f2bf(o / den);
}
__device__ __forceinline__ void ssm_scan_item(int idx, const bf16* PROJ, const float* tab, float* XST) {
    const int p = idx % NST, g = (idx / NST) % NG, b = idx / (NST * NG);
    const float* tg = tab + (size_t)g * SSMT_STRIDE;
    const float ar = tg[ST_AR + p], ai = tg[ST_AI + p];
    float br[SG], bi[SG];
#pragma unroll
    for (int h = 0; h < SG; ++h) { br[h] = tg[ST_BR + p * SG + h]; bi[h] = tg[ST_BI + p * SG + h]; }
    float xr = 0.f, xi = 0.f;
    for (int t = 0; t < S; ++t) {
        const u32x4* up = (const u32x4*)(PROJ + (size_t)(b * S + t) * DIN + UOFF + g * SG);
        const u32x4 u0 = up[0], u1 = up[1];
        const float u[SG] = {bflo(u0.x), bfhi(u0.x), bflo(u0.y), bfhi(u0.y), bflo(u0.z), bfhi(u0.z), bflo(u0.w), bfhi(u0.w),
                             bflo(u1.x), bfhi(u1.x), bflo(u1.y), bfhi(u1.y), bflo(u1.z), bfhi(u1.z), bflo(u1.w), bfhi(u1.w)};
        float bur = 0.f, bui = 0.f;
#pragma unroll
        for (int h = 0; h < SG; ++h) { bur = fmaf(br[h], u[h], bur); bui = fmaf(bi[h], u[h], bui); }
        const float nr = ar * xr - ai * xi + bur, ni = ar * xi + ai * xr + bui; xr = nr; xi = ni;
        float* o = XST + (((size_t)(b * S + t) * NG + g) * NST + p) * 2; o[0] = xr; o[1] = xi;
    }
}
__device__ __forceinline__ void ssm_out_item(int idx, const bf16* PROJ, const float* XST, const float* c_re, const float* c_im, const float* d_skip, bf16* G) {
    const int ch = idx % DSSM, t = idx / DSSM, g = ch / SG, h = ch % SG;
    const float* x = XST + ((size_t)t * NG + g) * NST * 2; const float* cr = c_re + ((size_t)g * SG + h) * NST; const float* ci = c_im + ((size_t)g * SG + h) * NST;
    float y = 0.f;
    for (int p = 0; p < NST; ++p) y += cr[p] * x[2 * p] - ci[p] * x[2 * p + 1];
    y += d_skip[ch] * bf2f(PROJ[(size_t)t * DIN + UOFF + ch]);
    G[(size_t)t * DSSM + ch] = (bf16)f2bf(gelu_tanh(y));
}
__device__ __forceinline__ void norm2_router_rows(int blk, int wave, int lane, const float* x1, const float* gain, const float* mod, const float* b_router,
                                                  const LAS float* wr, LAS int* lh, LAS float* xs, bf16* H, int* tope, float* topw, unsigned char* H8 = nullptr) {
    const int b = (blk * 64) / S;
    f32x4 gm[4], sh[4];
#pragma unroll
    for (int j = 0; j < 4; ++j) { const int c = 4 * lane + 256 * j; const f32x4 g = *(const f32x4*)(gain + c), sc = *(const f32x4*)(mod + b * 6 * D + 4 * D + c);
        gm[j] = g * (1.0f + sc); sh[j] = *(const f32x4*)(mod + b * 6 * D + 3 * D + c); }
    const int my_e = lane >> 1; const float my_b = b_router[my_e];
    LAS float* lg = xs + wave * 128;
    LAS int* sel_e = (LAS int*)(xs + wave * 128 + 64);
    LAS float* sel_v = xs + wave * 128 + 72;
#pragma unroll 1
    for (int i = 0; i < 8; i += 2) {
        const int row0 = blk * 64 + wave * 8 + i;
        f32x4 v[2][4]; float ssq[2];
#pragma unroll
        for (int r = 0; r < 2; ++r) { const f32x4* xr = (const f32x4*)(x1 + (size_t)(row0 + r) * D) + lane; float s = 0.f;
#pragma unroll
            for (int j = 0; j < 4; ++j) { v[r][j] = xr[64 * j]; s += (v[r][j].x * v[r][j].x + v[r][j].y * v[r][j].y) + (v[r][j].z * v[r][j].z + v[r][j].w * v[r][j].w); }
            ssq[r] = s; }
#pragma unroll
        for (int o2 = 1; o2 < 64; o2 <<= 1) { ssq[0] += __shfl_xor(ssq[0], o2); asm volatile("" : "+v"(ssq[0])); ssq[1] += __shfl_xor(ssq[1], o2); asm volatile("" : "+v"(ssq[1])); }
#pragma unroll
        for (int r = 0; r < 2; ++r) { const float rs = rsqrtf(ssq[r] * (1.0f / D) + EPS); u32x2* o = (u32x2*)(H + (size_t)(row0 + r) * D) + lane;
#pragma unroll
            for (int j = 0; j < 4; ++j) { v[r][j] = v[r][j] * rs * gm[j] + sh[j]; if (H) { u32x2 w; w.x = pk2(v[r][j].x, v[r][j].y); w.y = pk2(v[r][j].z, v[r][j].w); o[64 * j] = w; }
                if (H8) *(unsigned*)(H8 + (size_t)(row0 + r) * D + 4 * lane + 256 * j) = pk4_fp8(v[r][j].x * H8_SCALE, v[r][j].y * H8_SCALE, v[r][j].z * H8_SCALE, v[r][j].w * H8_SCALE); } }
        float pe0[NE], pe1[NE];
#pragma unroll
        for (int e = 0; e < NE; ++e) { float a0 = 0.f, a1 = 0.f;
#pragma unroll
            for (int j = 0; j < 4; ++j) { const f32x4 w = *(const LAS f32x4*)(wr + e * D + 4 * lane + 256 * j);
                a0 += (v[0][j].x * w.x + v[0][j].y * w.y) + (v[0][j].z * w.z + v[0][j].w * w.w); asm volatile("" : "+v"(a0)); a1 += (v[1][j].x * w.x + v[1][j].y * w.y) + (v[1][j].z * w.z + v[1][j].w * w.w); asm volatile("" : "+v"(a1)); }
            pe0[e] = a0; pe1[e] = a1; }
#define BFLY(half, bit) { const bool up = (lane & (bit)) != 0; _Pragma("unroll") for (int k = 0; k < (half); ++k) { \
            const float k0 = up ? pe0[(half) + k] : pe0[k], s0 = up ? pe0[k] : pe0[(half) + k], k1 = up ? pe1[(half) + k] : pe1[k], s1 = up ? pe1[k] : pe1[(half) + k]; \
            pe0[k] = k0 + __shfl_xor(s0, (bit)); asm volatile("" : "+v"(pe0[k])); pe1[k] = k1 + __shfl_xor(s1, (bit)); asm volatile("" : "+v"(pe1[k])); } }
        BFLY(16, 32) BFLY(8, 16) BFLY(4, 8) BFLY(2, 4) BFLY(1, 2)
#undef BFLY
        const float l0 = pe0[0] + __shfl_xor(pe0[0], 1) + my_b, l1 = pe1[0] + __shfl_xor(pe1[0], 1) + my_b;
        if ((lane & 1) == 0) { lg[my_e] = l0; lg[32 + my_e] = l1; }
        asm volatile("s_waitcnt lgkmcnt(0)" ::: "memory");
        int rk0 = 0, rk1 = 0;
#pragma unroll
        for (int q = 0; q < 8; ++q) { const f32x4 a = *(const LAS f32x4*)(lg + 4 * q), c = *(const LAS f32x4*)(lg + 32 + 4 * q);
#pragma unroll
            for (int t = 0; t < 4; ++t) { const int e2 = 4 * q + t; rk0 += (a[t] > l0 || (a[t] == l0 && e2 < my_e)) ? 1 : 0; rk1 += (c[t] > l1 || (c[t] == l1 && e2 < my_e)) ? 1 : 0; } }
        if ((lane & 1) == 0) { if (rk0 < 4) { sel_e[rk0] = my_e; sel_v[rk0] = l0; } if (rk1 < 4) { sel_e[4 + rk1] = my_e; sel_v[4 + rk1] = l1; } }
        asm volatile("s_waitcnt lgkmcnt(0)" ::: "memory");
        if (lane < 2) { const i32x4 ee = *(const LAS i32x4*)(sel_e + 4 * lane); const f32x4 vv = *(const LAS f32x4*)(sel_v + 4 * lane);
            const int e0 = ee.x, e1 = ee.y, e2 = ee.z, e3 = ee.w;
            const float x1v = __expf(vv.y - vv.x), x2v = __expf(vv.z - vv.x), x3v = __expf(vv.w - vv.x), inv = 1.0f / (1.0f + x1v + x2v + x3v);
            int* te = tope + (size_t)(row0 + lane) * 4; float* tw = topw + (size_t)(row0 + lane) * 4;
            *(i32x4*)te = (i32x4){e0, e1, e2, e3}; *(f32x4*)tw = (f32x4){inv, x1v * inv, x2v * inv, x3v * inv};
            (void)__hip_atomic_fetch_add(&lh[e0], 1, __ATOMIC_RELAXED, __HIP_MEMORY_SCOPE_WORKGROUP); (void)__hip_atomic_fetch_add(&lh[e1], 1, __ATOMIC_RELAXED, __HIP_MEMORY_SCOPE_WORKGROUP);
            (void)__hip_atomic_fetch_add(&lh[e2], 1, __ATOMIC_RELAXED, __HIP_MEMORY_SCOPE_WORKGROUP); (void)__hip_atomic_fetch_add(&lh[e3], 1, __ATOMIC_RELAXED, __HIP_MEMORY_SCOPE_WORKGROUP); }
        asm volatile("s_waitcnt lgkmcnt(0)" ::: "memory");
    }
}
__device__ __forceinline__ void sort_block(int blk, int tid, LAS int* sm, const int* hist, const int* tope, const float* topw, int* tokrow, int* rowpair, float* wrow, int* tilee) {
    LAS int* tot = sm; LAS int* mine = sm + 32; LAS int* base = sm + 64; LAS int* es = sm + 128;
    { const int e = tid & 31, part = tid >> 5; int hv[16]; int a = 0, m = 0;
#pragma unroll
      for (int k = 0; k < 16; ++k) hv[k] = hist[(16 * part + k) * NE + e];
#pragma unroll
      for (int k = 0; k < 16; ++k) { a += hv[k]; if (16 * part + k < blk) m += hv[k]; }
      LAS int* pa = sm + 384; pa[part * 32 + e] = a; pa[512 + part * 32 + e] = m; }
    __syncthreads();
    if (tid < NE) { const LAS int* pa = sm + 384; int a = 0, m = 0;
#pragma unroll
        for (int p = 0; p < 16; ++p) { a += pa[p * 32 + tid]; m += pa[512 + p * 32 + tid]; } tot[tid] = a; mine[tid] = m; }
    __syncthreads();
    if (tid == 0) { int o = 0; for (int e = 0; e < NE; ++e) { base[e] = o; o += ((tot[e] + 255) >> 8) << 8; } base[NE] = o; }
    int my_e = 0, rank = 0;
    if (tid < 256) { my_e = tope[(size_t)(blk * 64) * 4 + tid]; const int lane = tid & 63, w = tid >> 6;
        const unsigned long long lt = (lane == 0) ? 0ull : (~0ull >> (64 - lane));
#pragma unroll 4
        for (int e = 0; e < NE; ++e) { const unsigned long long m = __ballot(my_e == e); if (my_e == e) rank = __popcll(m & lt); if (lane == 0) es[w * 32 + e] = __popcll(m); } }
    __syncthreads();
    if (tid < 256) { const int e = my_e, w = tid >> 6; for (int w2 = 0; w2 < w; ++w2) rank += es[w2 * 32 + e];
        const int pos = base[e] + mine[e] + rank, tok = blk * 64 + (tid >> 2);
        tokrow[pos] = tok; rowpair[(size_t)blk * 256 + tid] = pos; wrow[pos] = topw[(size_t)blk * 256 + tid]; }
    if (blk < NE) { const int e = blk; for (int r = base[e] + tot[e] + tid; r < base[e + 1]; r += 512) { tokrow[r] = 0; wrow[r] = 0.f; }
        for (int ti = (base[e] >> 8) + tid; ti < (base[e + 1] >> 8); ti += 512) tilee[64 + ti] = e; }
    if (blk == 0 && tid == 0) tilee[0] = base[NE] >> 8;
    __syncthreads();
}

__global__ void k_transpose_cvt(const float* __restrict__ W, bf16* __restrict__ WT, int K, int N, int perm_gu) {
    __shared__ float tile[32][33];
    const float* Wb = W + (size_t)blockIdx.z * K * N; bf16* WTb = WT + (size_t)blockIdx.z * K * N;
    const int n0 = blockIdx.x * 32, k0 = blockIdx.y * 32;
    for (int i = threadIdx.y; i < 32; i += 8) tile[i][threadIdx.x] = Wb[(size_t)(k0 + i) * N + n0 + threadIdx.x];
    __syncthreads();
    for (int i = threadIdx.y; i < 32; i += 8) { const int n = n0 + i, nr = perm_gu ? gu_row(n) : n; WTb[(size_t)nr * K + k0 + threadIdx.x] = (bf16)f2bf(tile[threadIdx.x][i]); }
}
__global__ void k_mod(const float* __restrict__ c, const float* __restrict__ w_ada, const float* __restrict__ b_ada, float* __restrict__ mod) {
    __shared__ float ca[NB][D];
    for (int i = threadIdx.x; i < NB * D; i += blockDim.x) { const float v = c[i]; ca[i / D][i % D] = v * sigmoidf_(v); }
    __syncthreads();
    const int j = blockIdx.x * blockDim.x + threadIdx.x;
    float acc[NB];
#pragma unroll
    for (int b = 0; b < NB; ++b) acc[b] = 0.f;
    for (int k = 0; k < D; ++k) { const float w = w_ada[(size_t)k * (6 * D) + j];
#pragma unroll
        for (int b = 0; b < NB; ++b) acc[b] = fmaf(ca[b][k], w, acc[b]); }
#pragma unroll
    for (int b = 0; b < NB; ++b) mod[b * 6 * D + j] = acc[b] + b_ada[j];
}
__global__ void k_ssm_tables(const float* lam_re, const float* lam_im, const float* log_dt, const float* b_re, const float* b_im, float* tab) {
    const int i = blockIdx.x * blockDim.x + threadIdx.x; if (i >= NG * NST) return;
    ssm_table_item(i, lam_re, lam_im, log_dt, b_re, b_im, tab);
}
__global__ void k_norm_mod(const float* x, const float* gain, const float* mod, int sh_off, int sc_off, bf16* H) {
    const int row = blockIdx.x * (blockDim.x / 64) + (threadIdx.x >> 6), lane = threadIdx.x & 63; if (row >= T) return;
    norm_mod_row(row, lane, x, gain, mod, sh_off, sc_off, H);
}
template <class Epi> __global__ void k_gemm_naive(Epi e, int N, int K) {
    const int n = blockIdx.y * blockDim.x + threadIdx.x, m = blockIdx.x; if (n >= N) return;
    if (!e.active(m)) return;
    const bf16* a = e.arow(m); const bf16* b = e.brow(m, n);
    float acc = 0.f;
    for (int k = 0; k < K; k += 8) acc = dot8(*(const u32x4*)(a + k), *(const u32x4*)(b + k), acc);
    e.store(m, n, acc);
}
struct NEpiProj { const bf16* A; const bf16* Bt; const float* bias; bf16* O;
    __device__ bool active(int) const { return true; }
    __device__ const bf16* arow(int m) const { return A + (size_t)m * D; }
    __device__ const bf16* brow(int, int n) const { return Bt + (size_t)n * D; }
    __device__ void store(int m, int n, float acc) const { O[(size_t)m * DIN + n] = (bf16)f2bf(acc + bias[n]); } };
struct NEpiGlu { const bf16* A; const bf16* Bt; const float* bias; bf16* O;
    __device__ bool active(int) const { return true; }
    __device__ const bf16* arow(int m) const { return A + (size_t)m * DSSM; }
    __device__ const bf16* brow(int, int n) const { return Bt + (size_t)n * DSSM; }
    __device__ void store(int m, int n, float acc) const { const float g = bf2f(A[(size_t)m * DSSM + n]); O[(size_t)m * DSSM + n] = (bf16)f2bf(g * sigmoidf_(acc + bias[n])); } };
struct NEpiOut { const bf16* A; const bf16* Bt; const float* x; const float* mod; float* O;
    __device__ bool active(int) const { return true; }
    __device__ const bf16* arow(int m) const { return A + (size_t)m * D; }
    __device__ const bf16* brow(int, int n) const { return Bt + (size_t)n * D; }
    __device__ void store(int m, int n, float acc) const { const int b = m / S; O[(size_t)m * D + n] = x[(size_t)m * D + n] + mod[b * 6 * D + 2 * D + n] * acc; } };
struct NEpiGU { const bf16* H; const bf16* Wt; const float* bias; const int* tokrow; const int* tilee; bf16* ACT; };
struct NEpiDown { const bf16* ACT; const bf16* Wt; const float* bias; const float* wrow; const int* tilee; bf16* YS;
    __device__ bool active(int m) const { return (m >> 8) < tilee[0]; }
    __device__ const bf16* arow(int m) const { return ACT + (size_t)m * DFF; }
    __device__ const bf16* brow(int m, int n) const { const int e = tilee[64 + (m >> 8)]; return Wt + ((size_t)e * D + n) * DFF; }
    __device__ void store(int m, int n, float acc) const { const int e = tilee[64 + (m >> 8)]; YS[(size_t)m * D + n] = (bf16)f2bf((acc + bias[e * D + n]) * wrow[m]); } };
__global__ void k_moe_gu_naive(NEpiGU e) {
    const int j = blockIdx.y * blockDim.x + threadIdx.x, m = blockIdx.x;
    if ((m >> 8) >= e.tilee[0]) return;
    const int ex = e.tilee[64 + (m >> 8)], t = e.tokrow[m];
    const bf16* a = e.H + (size_t)t * D; const bf16* b0 = e.Wt + ((size_t)ex * 2 * DFF + gu_row(2 * j)) * D; const bf16* b1 = e.Wt + ((size_t)ex * 2 * DFF + gu_row(2 * j + 1)) * D;
    float g = 0.f, u = 0.f;
    for (int k = 0; k < D; k += 8) { const u32x4 av = *(const u32x4*)(a + k); g = dot8(av, *(const u32x4*)(b0 + k), g); u = dot8(av, *(const u32x4*)(b1 + k), u); }
    g += e.bias[ex * 2 * DFF + 2 * j]; u += e.bias[ex * 2 * DFF + 2 * j + 1];
    g = fminf(g, 7.0f); u = fminf(fmaxf(u, -7.0f), 7.0f);
    e.ACT[(size_t)m * DFF + j] = (bf16)f2bf((u + 1.0f) * (g * sigmoidf_(1.702f * g)));
}
__global__ void k_attn_scores(const bf16* PROJ, const float* qg, const float* kg, float* SC) { const int idx = blockIdx.x * blockDim.x + threadIdx.x; if (idx < T * NH) attn_scores_item(idx, PROJ, qg, kg, SC); }
__global__ void k_attn_out(const bf16* PROJ, const float* SC, const float* sinks, bf16* ATT) { const int idx = blockIdx.x * blockDim.x + threadIdx.x; if (idx < T * NH * HD) attn_out_item(idx, PROJ, SC, sinks, ATT); }
__global__ void k_ssm_scan(const bf16* PROJ, const float* tab, float* XST) { const int idx = blockIdx.x * blockDim.x + threadIdx.x; if (idx < NB * NG * NST) ssm_scan_item(idx, PROJ, tab, XST); }
__global__ void k_ssm_out(const bf16* PROJ, const float* XST, const float* c_re, const float* c_im, const float* d_skip, bf16* G) { const int idx = blockIdx.x * blockDim.x + threadIdx.x; if (idx < T * DSSM) ssm_out_item(idx, PROJ, XST, c_re, c_im, d_skip, G); }
__global__ void k_mixnorm(const bf16* ATT, const bf16* SSMG, const float* ga, const float* gs, bf16* MIXED) {
    const int row = blockIdx.x * (blockDim.x / 64) + (threadIdx.x >> 6), lane = threadIdx.x & 63; if (row >= T) return;
    mixnorm_row(row, lane, ATT, SSMG, ga, gs, MIXED);
}
__global__ void __launch_bounds__(512) k_norm2_router(const float* x1, const float* gain, const float* mod, const float* w_router, const float* b_router, bf16* H, int* tope, float* topw, int* hist) {
    extern __shared__ __attribute__((aligned(16))) unsigned char smem[];
    LAS float* wr = (LAS float*)smem; LAS int* lh = (LAS int*)((LAS unsigned char*)smem + 32 * 1024 * 4);
    const int tid = threadIdx.x;
    for (int i = tid; i < D * NE; i += 512) { const int c = i / NE, e = i % NE; wr[e * D + c] = w_router[i]; }
    if (tid < NE) lh[tid] = 0;
    __syncthreads();
    norm2_router_rows(blockIdx.x, tid >> 6, tid & 63, x1, gain, mod, b_router, wr, lh, (LAS float*)((LAS unsigned char*)smem + 32 * 1024 * 4 + 256), H, tope, topw);
    __syncthreads();
    if (tid < NE) hist[blockIdx.x * NE + tid] = lh[tid];
}
__global__ void __launch_bounds__(512) k_sort(const int* hist, const int* tope, const float* topw, int* tokrow, int* rowpair, float* wrow, int* tilee) {
    __shared__ int sm[1408];
    sort_block(blockIdx.x, threadIdx.x, (LAS int*)sm, hist, tope, topw, tokrow, rowpair, wrow, tilee);
}
__global__ void k_combine(float* out, const float* mod, const bf16* YS, const int* rowpair) {
    const int row = blockIdx.x * (blockDim.x / 64) + (threadIdx.x >> 6), lane = threadIdx.x & 63; if (row >= T) return;
    combine_row(row, lane, out, mod, YS, rowpair);
}

namespace pg8 {
constexpr int BM = 256, BK = 64, HALF = 128, HTB = HALF * BK * 2  , STAGE_BYTES = 8 * HTB, NXCD = 8, WGM = 8;
__host__ __device__ __forceinline__ int lds_byte(int r, int c) { const int st = (r >> 4) * 2 + (c >> 5), rr = r & 15, cc = c & 31, ob = rr * 64 + cc * 2; return st * 1024 + (ob ^ (((ob >> 9) & 1) << 5)); }
__host__ __device__ __forceinline__ void stage_rc(int b, int& R, int& C) { const int st = b / 1024, sb = b % 1024, swz = sb ^ (((sb >> 9) & 1) << 5); R = (st >> 1) * 16 + swz / 64; C = (st & 1) * 32 + (swz % 64) / 2; }
__host__ __device__ __forceinline__ int perm32(int rho) { const int n = rho >> 4, i = rho & 15; return 8 * (i >> 2) + 4 * n + (i & 3); }
struct Unit { int pm, pn; };
__device__ __forceinline__ bool order_next(int nM, int nN, int G, int c, int i, Unit& u) {
    const int nwg = nM * nN; const long L = (long)i * G + c; if (L >= nwg) return false;
    int wgid = (int)L; { const int q = nwg / NXCD, r = nwg % NXCD, xcd = wgid % NXCD, off = wgid / NXCD; wgid = (xcd < r ? xcd * (q + 1) : r * (q + 1) + (xcd - r) * q) + off; }
    const int nig = WGM * nN, gid = wgid / nig, fm = gid * WGM, gsz = (nM - fm) < WGM ? (nM - fm) : WGM;
    u.pm = fm + ((wgid % nig) % gsz); u.pn = (wgid % nig) / gsz; return true;
}
struct DenseOrder {
    const char* A; const char* Bt; int nM, nN, G, c; size_t tstep;
    __device__ __forceinline__ bool next(int i, Unit& u) const { return order_next(nM, nN, G, c, i, u); }
    __device__ __forceinline__ const char* a_base(const Unit& u) const { return A + (size_t)u.pm * tstep; }
    __device__ __forceinline__ const char* b_base(const Unit& u) const { return Bt + (size_t)u.pn * tstep; }
    __device__ __forceinline__ int a_row(int) const { return 0; }
    __device__ __forceinline__ int ka(int K) const { return K; }
    __device__ __forceinline__ size_t a_koff(int t) const { return (size_t)t * (BK * 2); }
};
struct MixOrder {
    const char* A; const char* Bt; int nM, nN, G, c; size_t delta;
    __device__ __forceinline__ bool next(int i, Unit& u) const { return order_next(nM, nN, G, c, i, u); }
    __device__ __forceinline__ const char* a_base(const Unit& u) const { return A + (size_t)u.pm * (256 * 512 * 2); }
    __device__ __forceinline__ const char* b_base(const Unit& u) const { return Bt + (size_t)u.pn * (256 * 1024 * 2); }
    __device__ __forceinline__ int a_row(int) const { return 0; }
    __device__ __forceinline__ int ka(int) const { return 512; }
    __device__ __forceinline__ size_t a_koff(int t) const { return (size_t)(t & 7) * (BK * 2) + (size_t)(t >> 3) * delta; }
};
struct MoeOrder {
    const char* A; const char* Bt; const int* tokrow; const LAS int* te; int nM, nN, G, c; size_t tstep, estride; const LAS int* cb = nullptr;
    __device__ __forceinline__ bool next(int i, Unit& u) const { return order_next(nM, nN, G, c, i, u); }
    __device__ __forceinline__ const char* a_base(const Unit& u) const { return A + (size_t)u.pm * tstep; }
    __device__ __forceinline__ const char* b_base(const Unit& u) const { return Bt + (size_t)__builtin_amdgcn_readfirstlane(te[u.pm]) * estride + (size_t)u.pn * tstep; }
    __device__ __forceinline__ int a_row(int r) const { if (FAST_SORT && cb) { const int e = te[r >> 8], rin = r - cb[32 + e]; return rin < cb[e] ? tokrow[(size_t)e * T + rin] : 0; } return tokrow[r]; }
    __device__ __forceinline__ int ka(int K) const { return K; }
    __device__ __forceinline__ size_t a_koff(int t) const { return (size_t)t * (BK * 2); }
};
__device__ __forceinline__ unsigned cvt_pk_bf16(float lo, float hi) { unsigned r; asm volatile("v_cvt_pk_bf16_f32 %0, %1, %2" : "=v"(r) : "v"(lo), "v"(hi)); return r; }

__device__ __forceinline__ void dma_row256(const float* src, LAS float* dst) { if (threadIdx.x < 64) __builtin_amdgcn_global_load_lds((const unsigned*)(src + 4 * threadIdx.x), (LAS unsigned*)dst, 16, 0, 0); }
struct EpiProj {
    static constexpr bool PERM = true, MIDK = false, BEGIN = true;
    bf16* O; int ldc; const float* bias; LAS float* tb;
    __device__ __forceinline__ void begin(const Unit& u, int ui) const { dma_row256(bias + u.pn * BM, tb + (ui & 1) * 512); }
    __device__ __forceinline__ void operator()(const f32x4 (&acc)[2][2][4][2], const Unit& u, int wr, int wc, int fr, int fq, int ui) const {
        const int row0 = u.pm * BM + wr * 64 + fr, col0 = u.pn * BM + wc * 32 + 8 * fq;
        f32x4 bv[2][2];
#pragma unroll
        for (int bj = 0; bj < 2; ++bj)
#pragma unroll
            for (int n = 0; n < 2; ++n) bv[bj][n] = *(const LAS f32x4*)(tb + (ui & 1) * 512 + wc * 32 + 8 * fq + bj * HALF + 4 * n);
#pragma unroll
        for (int ai = 0; ai < 2; ++ai)
#pragma unroll
            for (int m = 0; m < 4; ++m) { bf16* rowp = O + (size_t)(row0 + ai * HALF + m * 16) * ldc + col0;
#pragma unroll
                for (int bj = 0; bj < 2; ++bj) { const f32x4 v0 = acc[ai][bj][m][0] + bv[bj][0], v1 = acc[ai][bj][m][1] + bv[bj][1];
                    u32x4 w; w.x = cvt_pk_bf16(v0[0], v0[1]); w.y = cvt_pk_bf16(v0[2], v0[3]); w.z = cvt_pk_bf16(v1[0], v1[1]); w.w = cvt_pk_bf16(v1[2], v1[3]);
                    *(u32x4*)(rowp + bj * HALF) = w; } }
    }
};
struct EpiGlu {
    static constexpr bool PERM = true, MIDK = false, BEGIN = true;
    const bf16* Gin; bf16* O; const float* bias; float* SQ; LAS float* tb;
    __device__ __forceinline__ void begin(const Unit& u, int ui) const { dma_row256(bias + u.pn * BM, tb + (ui & 1) * 512); }
    __device__ __forceinline__ void operator()(const f32x4 (&acc)[2][2][4][2], const Unit& u, int wr, int wc, int fr, int fq, int ui) const {
        const int row0 = u.pm * BM + wr * 64 + fr, col0 = u.pn * BM + wc * 32 + 8 * fq;
        f32x4 bv[2][2];
#pragma unroll
        for (int bj = 0; bj < 2; ++bj)
#pragma unroll
            for (int n = 0; n < 2; ++n) bv[bj][n] = *(const LAS f32x4*)(tb + (ui & 1) * 512 + wc * 32 + 8 * fq + bj * HALF + 4 * n);
#pragma unroll
        for (int ai = 0; ai < 2; ++ai) {
            u32x4 gin[4][2];
#pragma unroll
            for (int m = 0; m < 4; ++m)
#pragma unroll
                for (int bj = 0; bj < 2; ++bj) gin[m][bj] = *(const u32x4*)(Gin + (size_t)(row0 + ai * HALF + m * 16) * DSSM + col0 + bj * HALF);
#pragma unroll
            for (int m = 0; m < 4; ++m) { const int row = row0 + ai * HALF + m * 16; const size_t off = (size_t)row * DSSM + col0; float sq = 0.f;
#pragma unroll
                for (int bj = 0; bj < 2; ++bj) { const f32x4 z0 = acc[ai][bj][m][0] + bv[bj][0], z1 = acc[ai][bj][m][1] + bv[bj][1];
                    const u32x4 g = gin[m][bj];
                    const float p0 = bflo(g.x) * sigmoidf_(z0[0]), p1 = bfhi(g.x) * sigmoidf_(z0[1]), p2 = bflo(g.y) * sigmoidf_(z0[2]), p3 = bfhi(g.y) * sigmoidf_(z0[3]);
                    const float p4 = bflo(g.z) * sigmoidf_(z1[0]), p5 = bfhi(g.z) * sigmoidf_(z1[1]), p6 = bflo(g.w) * sigmoidf_(z1[2]), p7 = bfhi(g.w) * sigmoidf_(z1[3]);
                    sq += ((p0 * p0 + p1 * p1) + (p2 * p2 + p3 * p3)) + ((p4 * p4 + p5 * p5) + (p6 * p6 + p7 * p7));
                    u32x4 w; w.x = cvt_pk_bf16(p0, p1); w.y = cvt_pk_bf16(p2, p3); w.z = cvt_pk_bf16(p4, p5); w.w = cvt_pk_bf16(p6, p7);
                    *(u32x4*)(O + off + bj * HALF) = w; }
                if (SQ) { sq += __shfl_xor(sq, 16); sq += __shfl_xor(sq, 32); if (fq == 0) SQ[(size_t)row * 8 + u.pn * 4 + wc] = sq; } } }
    }
};
struct EpiOut {
    static constexpr bool PERM = X1_DELTA != 0, MIDK = FUSE_MIXNORM != 0, BEGIN = true;
    const float* x; const float* mod; float* O; const float* ASQ; const float* SSQ; LAS float* tbl; LAS float* tb;
    __device__ __forceinline__ float row_sum8(const float* p, int row) const { const f32x4 a = *(const f32x4*)(p + (size_t)row * 8), b = *(const f32x4*)(p + (size_t)row * 8 + 4); return ((a.x + a.y) + (a.z + a.w)) + ((b.x + b.y) + (b.z + b.w)); }
    __device__ __forceinline__ void begin(const Unit& u, int ui) const {
        if (X1_DELTA) { const int b = (u.pm * BM) / S; dma_row256(mod + b * 6 * D + 2 * D + u.pn * BM, tb + (ui & 1) * 512); }
        if constexpr (!MIDK) return;
        const int r = threadIdx.x; if (r < BM) { const int row = u.pm * BM + r;
            const float ra = rsqrtf(row_sum8(ASQ, row) * (1.0f / DATT) + EPS), rs = rsqrtf(row_sum8(SSQ, row) * (1.0f / DSSM) + EPS);
            *(LAS f32x2*)(tbl + (ui & 1) * 512 + 2 * r) = (f32x2){ra / rs, rs}; }
    }
    __device__ __forceinline__ void mid(f32x4 (&acc)[2][2][4][2], int ui, int wr, int fr) const {
#pragma unroll
        for (int ai = 0; ai < 2; ++ai)
#pragma unroll
            for (int m = 0; m < 4; ++m) { const float rho = tbl[(ui & 1) * 512 + 2 * (wr * 64 + fr + ai * HALF + m * 16)];
#pragma unroll
                for (int bj = 0; bj < 2; ++bj)
#pragma unroll
                    for (int n = 0; n < 2; ++n) acc[ai][bj][m][n] = acc[ai][bj][m][n] * rho; }
    }
    __device__ __forceinline__ void operator()(const f32x4 (&acc)[2][2][4][2], const Unit& u, int wr, int wc, int fr, int fq, int ui = 0) const {
        const int b = (u.pm * BM) / S;
        if constexpr (X1_DELTA) {
            const int col0 = u.pn * BM + wc * 32 + 8 * fq;
            f32x4 gv[2][2];
#pragma unroll
            for (int bj = 0; bj < 2; ++bj)
#pragma unroll
                for (int n = 0; n < 2; ++n) gv[bj][n] = *(const LAS f32x4*)(tb + (ui & 1) * 512 + wc * 32 + 8 * fq + bj * HALF + 4 * n);
#pragma unroll
            for (int ai = 0; ai < 2; ++ai)
#pragma unroll
                for (int m = 0; m < 4; ++m) { const int lr = wr * 64 + fr + ai * HALF + m * 16; bf16* rowp = (bf16*)O + (size_t)(u.pm * BM + lr) * D + col0;
                    const float rs = MIDK ? tbl[(ui & 1) * 512 + 2 * lr + 1] : 1.0f;
#pragma unroll
                    for (int bj = 0; bj < 2; ++bj) { const f32x4 v0 = gv[bj][0] * (acc[ai][bj][m][0] * rs), v1 = gv[bj][1] * (acc[ai][bj][m][1] * rs);
                        u32x4 w; w.x = cvt_pk_bf16(v0[0], v0[1]); w.y = cvt_pk_bf16(v0[2], v0[3]); w.z = cvt_pk_bf16(v1[0], v1[1]); w.w = cvt_pk_bf16(v1[2], v1[3]);
                        *(u32x4*)(rowp + bj * HALF) = w; } }
        } else {
        const int row0 = u.pm * BM + wr * 64 + fr, col0 = u.pn * BM + wc * 32 + 4 * fq;
        f32x4 gv[2][2];
#pragma unroll
        for (int bj = 0; bj < 2; ++bj)
#pragma unroll
            for (int n = 0; n < 2; ++n) gv[bj][n] = *(const f32x4*)(mod + b * 6 * D + 2 * D + col0 + bj * HALF + n * 16);
#pragma unroll
        for (int ai = 0; ai < 2; ++ai)
#pragma unroll
            for (int m = 0; m < 4; ++m) { const int lr = wr * 64 + fr + ai * HALF + m * 16; const size_t off = (size_t)(u.pm * BM + lr) * D + col0;
                const float rs = MIDK ? tbl[(ui & 1) * 512 + 2 * lr + 1] : 1.0f;
#pragma unroll
                for (int bj = 0; bj < 2; ++bj)
#pragma unroll
                    for (int n = 0; n < 2; ++n) { const f32x4 xv = __builtin_nontemporal_load((const f32x4*)(x + off + bj * HALF + n * 16)); *(f32x4*)(O + off + bj * HALF + n * 16) = xv + gv[bj][n] * (acc[ai][bj][m][n] * rs); } }
        }
    }
};
template <bool OUT8> struct EpiGateUp {
    static constexpr bool PERM = true, MIDK = false, BEGIN = true;
    void* ACTp; const float* bias; const LAS int* te; float ascale; LAS float* tb;
    __device__ __forceinline__ void begin(const Unit& u, int ui) const { const int e = __builtin_amdgcn_readfirstlane(te[u.pm]); dma_row256(bias + (size_t)e * 2 * DFF + 2 * (u.pn * HALF), tb + (ui & 1) * 512); }
    __device__ __forceinline__ void operator()(const f32x4 (&acc)[2][2][4][2], const Unit& u, int wr, int wc, int fr, int fq, int ui) const {
        const int row0 = u.pm * BM + wr * 64 + fr, ac0 = u.pn * HALF + wc * 32 + 8 * fq;
        const LAS float* bp = tb + (ui & 1) * 512 + 2 * (wc * 32 + 8 * fq);
        const f32x4 b0 = *(const LAS f32x4*)bp, b1 = *(const LAS f32x4*)(bp + 4), b2 = *(const LAS f32x4*)(bp + 8), b3 = *(const LAS f32x4*)(bp + 12);
        const float bg[8] = {b0[0], b0[2], b1[0], b1[2], b2[0], b2[2], b3[0], b3[2]}, bu[8] = {b0[1], b0[3], b1[1], b1[3], b2[1], b2[3], b3[1], b3[3]};
        const f32x2 asc2 = {ascale, ascale}, zc2 = {-1.702f * 1.4426950408889634f, -1.702f * 1.4426950408889634f}, one2 = {1.0f, 1.0f}, os2 = {OUT8 ? A8_SCALE : 1.0f, OUT8 ? A8_SCALE : 1.0f};
#pragma unroll
        for (int ai = 0; ai < 2; ++ai)
#pragma unroll
            for (int m = 0; m < 4; ++m) { float a[8];
#pragma unroll
                for (int k = 0; k < 8; k += 2) {
                    f32x2 g = (f32x2){acc[ai][0][m][k >> 2][k & 3], acc[ai][0][m][k >> 2][(k & 3) + 1]} * asc2 + (f32x2){bg[k], bg[k + 1]};
                    f32x2 up = (f32x2){acc[ai][1][m][k >> 2][k & 3], acc[ai][1][m][k >> 2][(k & 3) + 1]} * asc2 + (f32x2){bu[k], bu[k + 1]};
                    g.x = fminf(g.x, 7.0f); g.y = fminf(g.y, 7.0f); up.x = __builtin_amdgcn_fmed3f(up.x, -7.0f, 7.0f); up.y = __builtin_amdgcn_fmed3f(up.y, -7.0f, 7.0f);
                    const f32x2 z = g * zc2; f32x2 ex; ex.x = __builtin_amdgcn_exp2f(z.x); ex.y = __builtin_amdgcn_exp2f(z.y);
                    const f32x2 dn = ex + one2; f32x2 sg; sg.x = __builtin_amdgcn_rcpf(dn.x); sg.y = __builtin_amdgcn_rcpf(dn.y);
                    const f32x2 r2 = (up * os2 + os2) * (g * sg); a[k] = r2.x; a[k + 1] = r2.y; }
                const size_t off = (size_t)(row0 + ai * HALF + m * 16) * DFF + ac0;
                if constexpr (OUT8) { u32x2 w; w.x = pk4_fp8(a[0], a[1], a[2], a[3]); w.y = pk4_fp8(a[4], a[5], a[6], a[7]); *(u32x2*)((unsigned char*)ACTp + off) = w; }
                else { u32x4 w; w.x = cvt_pk_bf16(a[0], a[1]); w.y = cvt_pk_bf16(a[2], a[3]); w.z = cvt_pk_bf16(a[4], a[5]); w.w = cvt_pk_bf16(a[6], a[7]); *(u32x4*)((bf16*)ACTp + off) = w; } }
    }
};
template <bool OUT8> struct EpiDown {
    static constexpr bool PERM = true, MIDK = false, BEGIN = true;
    void* YSp; const float* bias; const float* wrow; const LAS int* te; float ascale; const LAS int* cb; LAS float* tb;
    const float* zero;
    __device__ __forceinline__ void begin(const Unit& u, int ui) const { const int t = threadIdx.x, e = __builtin_amdgcn_readfirstlane(te[u.pm]);
        dma_row256(bias + (size_t)e * D + u.pn * BM, tb + (ui & 1) * 512);
        if (t >= 64 && t < 320) { const int w4 = __builtin_amdgcn_readfirstlane((t >> 6) - 1), r = t - 64, row = u.pm * BM + r; const float* src;
            if (FAST_SORT && cb) { const int rin = row - cb[32 + e]; src = rin < cb[e] ? wrow + (size_t)e * T + rin : zero; } else src = wrow + row;
            __builtin_amdgcn_global_load_lds((const unsigned*)src, (LAS unsigned*)(tb + (ui & 1) * 512 + 256 + 64 * w4), 4, 0, 0); } }
    __device__ __forceinline__ void operator()(const f32x4 (&acc)[2][2][4][2], const Unit& u, int wr, int wc, int fr, int fq, int ui) const {
        const int row0 = u.pm * BM + wr * 64 + fr, col0 = u.pn * BM + wc * 32 + 8 * fq;
        f32x4 bv[2][2];
#pragma unroll
        for (int bj = 0; bj < 2; ++bj)
#pragma unroll
            for (int n = 0; n < 2; ++n) bv[bj][n] = *(const LAS f32x4*)(tb + (ui & 1) * 512 + wc * 32 + 8 * fq + bj * HALF + 4 * n);
        float wts[2][4];
#pragma unroll
        for (int ai = 0; ai < 2; ++ai)
#pragma unroll
            for (int m = 0; m < 4; ++m) wts[ai][m] = tb[(ui & 1) * 512 + 256 + wr * 64 + fr + ai * HALF + m * 16];
#pragma unroll
        for (int ai = 0; ai < 2; ++ai)
#pragma unroll
            for (int m = 0; m < 4; ++m) { const int row = row0 + ai * HALF + m * 16; const float wt = wts[ai][m] * (OUT8 ? Y8_SCALE : 1.0f); const size_t off = (size_t)row * D + col0;
#pragma unroll
                for (int bj = 0; bj < 2; ++bj) { const f32x4 v0 = (acc[ai][bj][m][0] * ascale + bv[bj][0]) * wt, v1 = (acc[ai][bj][m][1] * ascale + bv[bj][1]) * wt;
                    if constexpr (OUT8) { u32x2 w; w.x = pk4_fp8(v0[0], v0[1], v0[2], v0[3]); w.y = pk4_fp8(v1[0], v1[1], v1[2], v1[3]); *(u32x2*)((unsigned char*)YSp + off + bj * HALF) = w; }
                    else { u32x4 w; w.x = cvt_pk_bf16(v0[0], v0[1]); w.y = cvt_pk_bf16(v0[2], v0[3]); w.z = cvt_pk_bf16(v1[0], v1[1]); w.w = cvt_pk_bf16(v1[2], v1[3]); *(u32x4*)((bf16*)YSp + off + bj * HALF) = w; } } }
    }
};

template <class Epi, class Sched, bool ALIGN_EPI, bool GATHER, bool FP8 = false>
__device__ __forceinline__ void gemm_phase(LAS unsigned char* lds, const int K, const Sched& S, const Epi& E) {
    const int tid = threadIdx.x, wid = __builtin_amdgcn_readfirstlane(tid >> 6), lane = tid & 63, wr = wid >> 2, wc = wid & 3, fr = lane & 15, fq = lane >> 4;
    const int nt = K / BK;
    int Rr[2], Cc[2]; unsigned voffA[2], voffB[2];
#pragma unroll
    for (int i = 0; i < 2; ++i) { int R, C; stage_rc(tid * 16 + i * 8192, R, C); const int Rb = Epi::PERM ? ((R & ~31) + perm32(R & 31)) : R;
        Rr[i] = R; Cc[i] = C; voffA[i] = (unsigned)(R * S.ka(K) + C) * 2u; voffB[i] = (unsigned)(Rb * K + C) * 2u; }
    const size_t kstep = (size_t)(BK * 2);
    const size_t hstep = (size_t)HALF * K * 2;
    const size_t hstepA = (size_t)HALF * S.ka(K) * 2;
    const unsigned ldsw = (unsigned)wid * 1024u;
    const int aoff = lds_byte(wr * 64 + fr, fq * 8), boff = lds_byte(wc * 32 + fr, fq * 8);
#define PG8_SA(b, h) (((b) * 2 + (h)) * HTB)
#define PG8_SB(b, h) ((4 + (b) * 2 + (h)) * HTB)
#define PG8_STAGE(bufoff, gbase, voff) do { _Pragma("unroll") for (int _i = 0; _i < 2; ++_i) \
        __builtin_amdgcn_global_load_lds((const unsigned*)((const char*)(gbase) + (voff)[_i]), (LAS unsigned*)(lds + (bufoff) + ldsw + _i * 8192), 16, 0, 0); } while (0)
#define PG8_STAGE_A(bufoff, ab, koff, h, g0, g1) do { if constexpr (GATHER) { if ((h) == 0) PG8_STAGE(bufoff, (ab) + (koff), g0); else PG8_STAGE(bufoff, (ab) + (koff), g1); } \
        else { PG8_STAGE(bufoff, (ab) + (koff) + (h) * hstepA, voffA); } } while (0)
#define PG8_LDA(dst, b, h) do { if constexpr (FP8) { _Pragma("unroll") for (int m = 0; m < 4; ++m) dst##8[m] = __builtin_shufflevector(*(const LAS i32x4*)(lds + PG8_SA(b, h) + aoff + m * 2048), *(const LAS i32x4*)(lds + PG8_SA(b, h) + aoff + m * 2048 + 1024), 0, 1, 2, 3, 4, 5, 6, 7); } \
        else { _Pragma("unroll") for (int m = 0; m < 4; ++m) _Pragma("unroll") for (int k = 0; k < 2; ++k) dst[m][k] = *(const LAS bf16x8*)(lds + PG8_SA(b, h) + aoff + m * 2048 + k * 1024); } } while (0)
#define PG8_LDB(dst, b, h) do { if constexpr (FP8) { _Pragma("unroll") for (int n = 0; n < 2; ++n) dst##8[n] = __builtin_shufflevector(*(const LAS i32x4*)(lds + PG8_SB(b, h) + boff + n * 2048), *(const LAS i32x4*)(lds + PG8_SB(b, h) + boff + n * 2048 + 1024), 0, 1, 2, 3, 4, 5, 6, 7); } \
        else { _Pragma("unroll") for (int n = 0; n < 2; ++n) _Pragma("unroll") for (int k = 0; k < 2; ++k) dst[n][k] = *(const LAS bf16x8*)(lds + PG8_SB(b, h) + boff + n * 2048 + k * 1024); } } while (0)
#define PG8_CAT8(x) __builtin_shufflevector(__builtin_bit_cast(i32x4, (x)[0]), __builtin_bit_cast(i32x4, (x)[1]), 0, 1, 2, 3, 4, 5, 6, 7)
#define PG8_MMA(ai, bj, At, Bt) do { __builtin_amdgcn_s_setprio(1); if constexpr (FP8) { _Pragma("unroll") for (int m = 0; m < 4; ++m) _Pragma("unroll") for (int n = 0; n < 2; ++n) \
        asm volatile("v_mfma_scale_f32_16x16x128_f8f6f4 %0, %1, %2, %0, %3, %3 op_sel_hi:[0,0,0]" : "+v"(acc[ai][bj][m][n]) : "v"(Bt##8[n]), "v"(At##8[m]), "v"(one8)); } \
      else { _Pragma("unroll") for (int m = 0; m < 4; ++m) _Pragma("unroll") for (int n = 0; n < 2; ++n) _Pragma("unroll") for (int k = 0; k < 2; ++k) \
        acc[ai][bj][m][n] = __builtin_amdgcn_mfma_f32_16x16x32_bf16(Bt[n][k], At[m][k], acc[ai][bj][m][n], 0, 0, 0); } __builtin_amdgcn_s_setprio(0); } while (0)
#define PG8_WAIT_V(n) asm volatile("s_waitcnt vmcnt(" #n ")" ::: "memory")
#define PG8_WAIT_L(n) asm volatile("s_waitcnt lgkmcnt(" #n ")" ::: "memory")
#define PG8_BAR __builtin_amdgcn_s_barrier()
#define PG8_SCHED __builtin_amdgcn_sched_barrier(0)
#define PG8_GOFF(U, o0, o1) do { if constexpr (GATHER) { _Pragma("unroll") for (int _i = 0; _i < 2; ++_i) { \
        o0[_i] = (unsigned)(S.a_row((U).pm * BM + Rr[_i]) * K + Cc[_i]) * 2u; o1[_i] = (unsigned)(S.a_row((U).pm * BM + HALF + Rr[_i]) * K + Cc[_i]) * 2u; } } } while (0)
    Unit cur, nxt; int ui = 0;
    if (!S.next(0, cur)) return;
    f32x4 acc[2][2][4][2];
#pragma unroll
    for (int a = 0; a < 2; ++a)
#pragma unroll
        for (int b = 0; b < 2; ++b)
#pragma unroll
            for (int m = 0; m < 4; ++m)
#pragma unroll
                for (int n = 0; n < 2; ++n) acc[a][b][m][n] = (f32x4){0.f, 0.f, 0.f, 0.f};
    const int one8 = 0x7f7f7f7f;
    bf16x8 At[4][2], B0[2][2], B1[2][2]; i32x8 At8[4], B08[2], B18[2];
    unsigned cg0[2] = {0u, 0u}, cg1[2] = {0u, 0u}, ng0[2] = {0u, 0u}, ng1[2] = {0u, 0u};
    const char* cA = GATHER ? S.A : S.a_base(cur); const char* cB = S.b_base(cur);
    PG8_GOFF(cur, cg0, cg1);
    PG8_STAGE(PG8_SB(0, 0), cB, voffB); PG8_STAGE(PG8_SB(0, 1), cB + hstep, voffB); PG8_STAGE_A(PG8_SA(0, 0), cA, 0, 0, cg0, cg1); PG8_STAGE_A(PG8_SA(0, 1), cA, 0, 1, cg0, cg1);
    if constexpr (Epi::BEGIN) E.begin(cur, 0);
    if (wr == 1) PG8_BAR;
    PG8_WAIT_V(2); PG8_BAR;
    PG8_STAGE(PG8_SB(1, 0), cB + kstep, voffB); PG8_STAGE_A(PG8_SA(1, 0), cA, S.a_koff(1), 0, cg0, cg1); PG8_STAGE(PG8_SB(1, 1), cB + hstep + kstep, voffB);
    PG8_WAIT_V(6); PG8_BAR;
    for (;;) {
        const bool has_next = S.next(ui + 1, nxt);
        const char* nA = has_next ? (GATHER ? S.A : S.a_base(nxt)) : cA; const char* nB = has_next ? S.b_base(nxt) : cB;
        if constexpr (GATHER) { if (has_next) { PG8_GOFF(nxt, ng0, ng1); } else { ng0[0] = cg0[0]; ng0[1] = cg0[1]; ng1[0] = cg1[0]; ng1[1] = cg1[1]; } }
#pragma unroll 1
        for (int t = 0; t < nt; t += 2) {
            const bool last = (t == nt - 2);
            if constexpr (Epi::MIDK) { if (t == nt / 2) E.mid(acc, ui, wr, fr); }
            const size_t k1 = S.a_koff(t + 1);
            const char* a2 = last ? nA : cA; const char* b2 = last ? nB : cB + (size_t)(t + 2) * kstep;
            const size_t k2 = last ? S.a_koff(0) : S.a_koff(t + 2), k3 = last ? S.a_koff(1) : S.a_koff(t + 3);
            const char* b3 = b2 + kstep;
            unsigned s0[2], s1[2];
            if constexpr (GATHER) { s0[0] = last ? ng0[0] : cg0[0]; s0[1] = last ? ng0[1] : cg0[1]; s1[0] = last ? ng1[0] : cg1[0]; s1[1] = last ? ng1[1] : cg1[1]; } else { s0[0] = s0[1] = s1[0] = s1[1] = 0u; }
            PG8_LDB(B0, 0, 0); PG8_LDB(B1, 0, 1); PG8_SCHED; PG8_LDA(At, 0, 0); PG8_STAGE_A(PG8_SA(1, 1), cA, k1, 1, cg0, cg1);
            PG8_WAIT_V(8); PG8_WAIT_L(0); PG8_BAR; PG8_MMA(0, 0, At, B0); PG8_MMA(0, 1, At, B1); PG8_BAR; PG8_SCHED;
            PG8_LDA(At, 0, 1); PG8_STAGE(PG8_SB(0, 0), b2, voffB); PG8_STAGE(PG8_SB(0, 1), b2 + hstep, voffB); PG8_STAGE_A(PG8_SA(0, 0), a2, k2, 0, s0, s1);
            PG8_WAIT_V(8); PG8_WAIT_L(0); PG8_BAR; PG8_MMA(1, 0, At, B0); PG8_MMA(1, 1, At, B1); PG8_BAR; PG8_SCHED;
            PG8_LDB(B0, 1, 0); PG8_LDB(B1, 1, 1); PG8_SCHED; PG8_LDA(At, 1, 0); PG8_STAGE_A(PG8_SA(0, 1), a2, k2, 1, s0, s1);
            PG8_WAIT_V(8); PG8_WAIT_L(0); PG8_BAR; PG8_MMA(0, 0, At, B0); PG8_MMA(0, 1, At, B1); PG8_BAR; PG8_SCHED;
            PG8_LDA(At, 1, 1); PG8_STAGE(PG8_SB(1, 0), b3, voffB); PG8_STAGE(PG8_SB(1, 1), b3 + hstep, voffB); PG8_STAGE_A(PG8_SA(1, 0), a2, k3, 0, s0, s1);
            PG8_WAIT_V(8); PG8_WAIT_L(0); PG8_BAR; PG8_MMA(1, 0, At, B0); PG8_MMA(1, 1, At, B1); PG8_BAR; PG8_SCHED;
        }
        if constexpr (ALIGN_EPI) { if (wr == 0) PG8_BAR; }
        if constexpr (FP8) asm volatile("s_nop 15\n\ts_nop 15" ::: "memory");
        E(acc, cur, wr, wc, fr, fq, ui);
        if (!has_next) break;
#pragma unroll
        for (int a = 0; a < 2; ++a)
#pragma unroll
            for (int b = 0; b < 2; ++b)
#pragma unroll
                for (int m = 0; m < 4; ++m)
#pragma unroll
                    for (int n = 0; n < 2; ++n) acc[a][b][m][n] = (f32x4){0.f, 0.f, 0.f, 0.f};
        cur = nxt; cA = nA; cB = nB; ++ui;
        if constexpr (Epi::BEGIN) E.begin(cur, ui);
        if constexpr (GATHER) { cg0[0] = ng0[0]; cg0[1] = ng0[1]; cg1[0] = ng1[0]; cg1[1] = ng1[1]; }
        if constexpr (ALIGN_EPI) { if (wr == 1) PG8_BAR; }
    }
    PG8_WAIT_V(0);
    if constexpr (!ALIGN_EPI) { if (wr == 0) PG8_BAR; }
    PG8_BAR;
#undef PG8_SA
#undef PG8_SB
#undef PG8_STAGE
#undef PG8_STAGE_A
#undef PG8_LDA
#undef PG8_LDB
#undef PG8_MMA
#undef PG8_CAT8
#undef PG8_WAIT_V
#undef PG8_WAIT_L
#undef PG8_BAR
#undef PG8_SCHED
#undef PG8_GOFF
}
}

#ifndef BAR_ACQUIRE
#define BAR_ACQUIRE 0
#endif
#define XB_TMO      128
#define XB_XCNT(j)  (256  + 64 * (j))
#define XB_XSUB(j)  (1280 + 64 * (j))
#define XB_XGEN(j)  (2304 + 64 * (j))
#define XB_TOP      3328
#define XB_TOPGEN   3392
#define XCD_BAR_WORDS 3456
#define XB_SPIN_CAP (1u << 18)

__device__ __forceinline__ unsigned xb_ld(unsigned* p)              { return __hip_atomic_load(p, __ATOMIC_RELAXED, __HIP_MEMORY_SCOPE_AGENT); }
__device__ __forceinline__ unsigned xb_add(unsigned* p, unsigned v) { return __hip_atomic_fetch_add(p, v, __ATOMIC_RELAXED, __HIP_MEMORY_SCOPE_AGENT); }
__device__ __forceinline__ unsigned xb_xcc_id() { return (unsigned)__builtin_amdgcn_s_getreg((3 << 11) | 20) & 0xFu; }
#define XB_SPIN(cond, bar) do { unsigned _sp = 0; while (cond) { __builtin_amdgcn_s_sleep(1); \
    if ((++_sp & 255u) == 0u) { if (xb_ld(&(bar)[XB_TMO])) break; if (_sp > XB_SPIN_CAP) { atomicAdd(&(bar)[XB_TMO], 1u); break; } } } } while (0)

struct XcdBarrier {
    unsigned* bar; unsigned x;
    volatile LAS unsigned* st;
};
__device__ __forceinline__ XcdBarrier xcd_barrier_post(unsigned* bar, volatile LAS unsigned* st) {
    XcdBarrier b; b.bar = bar; b.x = xb_xcc_id(); b.st = st;
    if (threadIdx.x == 0) (void)xb_add(&bar[XB_XCNT(b.x)], 1u);
    return b;
}
__device__ __forceinline__ void xcd_barrier_complete(unsigned* bar, unsigned x, unsigned& nloc, unsigned& nx) {
    const unsigned G = gridDim.x * gridDim.y * gridDim.z;
    unsigned sum, cnt, mine, sp = 0u;
    for (;;) {
        sum = 0u; cnt = 0u; mine = 0u;
#pragma unroll
        for (unsigned j = 0; j < 16; ++j) { const unsigned c = xb_ld(&bar[XB_XCNT(j)]); sum += c; cnt += (c > 0u) ? 1u : 0u; mine = (j == x) ? c : mine; }
        if (sum == G) break;
        __builtin_amdgcn_s_sleep(1);
        if ((++sp & 255u) == 0u) { if (xb_ld(&bar[XB_TMO])) break; if (sp > XB_SPIN_CAP) { atomicAdd(&bar[XB_TMO], 1u); break; } }
    }
    nloc = mine > 0u ? mine : 1u; nx = cnt > 0u ? cnt : 1u;
}
__device__ __forceinline__ void xcd_barrier(const XcdBarrier& b) {
    asm volatile("s_waitcnt vmcnt(0)" ::: "memory");
    __syncthreads();
    if (threadIdx.x == 0) {
        unsigned* bar = b.bar;
        __builtin_amdgcn_s_waitcnt(0);
        unsigned nloc = b.st[0], nx = b.st[1];
        if (nloc == 0u) { xcd_barrier_complete(bar, b.x, nloc, nx); b.st[0] = nloc; b.st[1] = nx; }
        const unsigned old = xb_add(&bar[XB_XSUB(b.x)], 1u);
        const unsigned gen = old / nloc;
        if (old + 1u == (gen + 1u) * nloc) {
            __builtin_amdgcn_fence(__ATOMIC_RELEASE, "agent");
            asm volatile("s_waitcnt vmcnt(0)" ::: "memory");
            const unsigned og = xb_add(&bar[XB_TOP], 1u);
            const unsigned tg = og / nx;
            if (og + 1u == (tg + 1u) * nx) xb_add(&bar[XB_TOPGEN], 1u);
            else XB_SPIN(xb_ld(&bar[XB_TOPGEN]) == tg, bar);
            if (BAR_ACQUIRE) __builtin_amdgcn_fence(__ATOMIC_ACQUIRE, "agent");
            xb_add(&bar[XB_XGEN(b.x)], 1u);
            if (BAR_ACQUIRE) asm volatile("s_waitcnt vmcnt(0)" ::: "memory");
        } else {
            XB_SPIN(xb_ld(&bar[XB_XGEN(b.x)]) == gen, bar);
            if (BAR_ACQUIRE) __builtin_amdgcn_fence(__ATOMIC_ACQUIRE, "agent");
            asm volatile("s_waitcnt vmcnt(0)" ::: "memory");
        }
    }
    __syncthreads();
}


__device__ __forceinline__ bf16x8 as_bf16x8(u32x4 v) { return __builtin_bit_cast(bf16x8, v); }
typedef __bf16 bf16x2_t __attribute__((ext_vector_type(2)));
__device__ __forceinline__ unsigned cvtpk(float lo, float hi) { const f32x2 v = {lo, hi}; const bf16x2_t b = __builtin_convertvector(v, bf16x2_t); return __builtin_bit_cast(unsigned, b); }
#define LDS_FENCE() asm volatile("s_waitcnt lgkmcnt(0)" ::: "memory")
__device__ __forceinline__ float fma_s(float a, float b, float c) { float r; asm("v_fma_f32 %0, %1, %2, %3" : "=v"(r) : "v"(a), "v"(b), "v"(c)); return r; }

constexpr int KN_PITCH = 144, VT_PITCH = 528;
constexpr int ATT_KN_OFF = 0, ATT_VT_OFF = 256 * KN_PITCH, ATT_LDS_BYTES = ATT_VT_OFF + 64 * VT_PITCH;
__device__ __forceinline__ void attn_unit(LAS unsigned char* lds, int unit, int tid, const bf16* PROJ, const float* qg, const float* kg, const float* sinks, bf16* ATT, float* ATTSQ = nullptr) {
    const int lane = tid & 63, wave = __builtin_amdgcn_readfirstlane(tid >> 6), l15 = lane & 15, q4 = lane >> 4;
    const int kvh = unit & 1, n = (unit >> 1) & 15, b = unit >> 5;
    const int tok0 = b * S + n * 128;
    {
        const int c = tid & 7; const f32x4 g0 = *(const f32x4*)(kg + 8 * c), g1 = *(const f32x4*)(kg + 8 * c + 4);
        const int vkey = tid & 255; const bool vvalid = (n > 0) || (vkey >= 128);
        u32x4 kraw[4], vraw[4];
#pragma unroll
        for (int j = 0; j < 4; ++j) { const int key = (tid >> 3) + 64 * j; const bool valid = (n > 0) || (key >= 128);
            kraw[j] = (u32x4){0u, 0u, 0u, 0u}; if (valid) kraw[j] = *(const u32x4*)(PROJ + (size_t)(tok0 - 128 + key) * DIN + KOFF + kvh * HD + 8 * c);
            vraw[j] = (u32x4){0u, 0u, 0u, 0u}; if (vvalid) vraw[j] = *(const u32x4*)(PROJ + (size_t)(tok0 - 128 + vkey) * DIN + VOFF + kvh * HD + 8 * ((tid >> 8) + 2 * j)); }
#pragma unroll
        for (int j = 0; j < 4; ++j) { const int key = (tid >> 3) + 64 * j; const u32x4 raw = kraw[j];
            const float f[8] = {bflo(raw.x), bfhi(raw.x), bflo(raw.y), bfhi(raw.y), bflo(raw.z), bfhi(raw.z), bflo(raw.w), bfhi(raw.w)};
            float ss = 0.f;
#pragma unroll
            for (int i = 0; i < 8; ++i) ss += f[i] * f[i];
            ss += __shfl_xor(ss, 1); ss += __shfl_xor(ss, 2); ss += __shfl_xor(ss, 4);
            const float r = rsqrtf(ss * (1.0f / HD) + EPS);
            u32x4 w; w.x = cvtpk(f[0] * r * g0.x, f[1] * r * g0.y); w.y = cvtpk(f[2] * r * g0.z, f[3] * r * g0.w); w.z = cvtpk(f[4] * r * g1.x, f[5] * r * g1.y); w.w = cvtpk(f[6] * r * g1.z, f[7] * r * g1.w);
            *(LAS u32x4*)(lds + ATT_KN_OFF + key * KN_PITCH + c * 16) = w; }
#pragma unroll
        for (int j = 0; j < 4; ++j) { const int cc = (tid >> 8) + 2 * j; const u32x4 raw = vraw[j];
            LAS unsigned short* vt = (LAS unsigned short*)(lds + ATT_VT_OFF + (8 * cc) * VT_PITCH + vkey * 2);
            vt[0 * (VT_PITCH / 2)] = (unsigned short)(raw.x & 0xffffu); vt[1 * (VT_PITCH / 2)] = (unsigned short)(raw.x >> 16);
            vt[2 * (VT_PITCH / 2)] = (unsigned short)(raw.y & 0xffffu); vt[3 * (VT_PITCH / 2)] = (unsigned short)(raw.y >> 16);
            vt[4 * (VT_PITCH / 2)] = (unsigned short)(raw.z & 0xffffu); vt[5 * (VT_PITCH / 2)] = (unsigned short)(raw.z >> 16);
            vt[6 * (VT_PITCH / 2)] = (unsigned short)(raw.w & 0xffffu); vt[7 * (VT_PITCH / 2)] = (unsigned short)(raw.w >> 16); }
    }
    __syncthreads();
    const int g = wave >> 1, h = kvh * 4 + g, qi0 = 64 * (wave & 1);
    const float sink = sinks[h];
    const f32x4 gq00 = *(const f32x4*)(qg + 8 * q4), gq01 = *(const f32x4*)(qg + 8 * q4 + 4), gq10 = *(const f32x4*)(qg + 32 + 8 * q4), gq11 = *(const f32x4*)(qg + 32 + 8 * q4 + 4);
    u32x4 qn0, qn1;
    { const size_t tq0 = (size_t)(tok0 + qi0 + l15); qn0 = *(const u32x4*)(PROJ + tq0 * DIN + QOFF + h * HD + 8 * q4); qn1 = *(const u32x4*)(PROJ + tq0 * DIN + QOFF + h * HD + 32 + 8 * q4); }
#pragma unroll 1
    for (int qt = 0; qt < 4; ++qt) {
        const int q0 = qi0 + 16 * qt, qi = q0 + l15; const size_t tq = (size_t)(tok0 + qi);
        const u32x4 r0 = qn0, r1 = qn1;
        { const size_t tqn = (size_t)(tok0 + qi0 + 16 * ((qt + 1) & 3) + l15); qn0 = *(const u32x4*)(PROJ + tqn * DIN + QOFF + h * HD + 8 * q4); qn1 = *(const u32x4*)(PROJ + tqn * DIN + QOFF + h * HD + 32 + 8 * q4); }
        const float f0[8] = {bflo(r0.x), bfhi(r0.x), bflo(r0.y), bfhi(r0.y), bflo(r0.z), bfhi(r0.z), bflo(r0.w), bfhi(r0.w)};
        const float f1[8] = {bflo(r1.x), bfhi(r1.x), bflo(r1.y), bfhi(r1.y), bflo(r1.z), bfhi(r1.z), bflo(r1.w), bfhi(r1.w)};
        float ss = 0.f;
#pragma unroll
        for (int i = 0; i < 8; ++i) ss += f0[i] * f0[i] + f1[i] * f1[i];
        ss += __shfl_xor(ss, 16); ss += __shfl_xor(ss, 32);
        const float rq = rsqrtf(ss * (1.0f / HD) + EPS) * 0.125f;
        u32x4 w0, w1;
        w0.x = cvtpk(f0[0] * rq * gq00.x, f0[1] * rq * gq00.y); w0.y = cvtpk(f0[2] * rq * gq00.z, f0[3] * rq * gq00.w); w0.z = cvtpk(f0[4] * rq * gq01.x, f0[5] * rq * gq01.y); w0.w = cvtpk(f0[6] * rq * gq01.z, f0[7] * rq * gq01.w);
        w1.x = cvtpk(f1[0] * rq * gq10.x, f1[1] * rq * gq10.y); w1.y = cvtpk(f1[2] * rq * gq10.z, f1[3] * rq * gq10.w); w1.z = cvtpk(f1[4] * rq * gq11.x, f1[5] * rq * gq11.y); w1.w = cvtpk(f1[6] * rq * gq11.z, f1[7] * rq * gq11.w);
        const bf16x8 bq0 = as_bf16x8(w0), bq1 = as_bf16x8(w1);
        const int kt0 = ((q0 >> 4) >> 1) * 2;
        f32x4 s[10];
#pragma unroll
        for (int i = 0; i < 10; ++i) { const LAS unsigned char* kp = lds + ATT_KN_OFF + (16 * (kt0 + i) + l15) * KN_PITCH + 16 * q4;
            const bf16x8 a0 = *(const LAS bf16x8*)kp, a1 = *(const LAS bf16x8*)(kp + 64);
            f32x4 z = (f32x4){0.f, 0.f, 0.f, 0.f};
            z = __builtin_amdgcn_mfma_f32_16x16x32_bf16(a0, bq0, z, 0, 0, 0); s[i] = __builtin_amdgcn_mfma_f32_16x16x32_bf16(a1, bq1, z, 0, 0, 0); }
        float m = sink;
#pragma unroll
        for (int i = 0; i < 10; ++i)
#pragma unroll
            for (int r = 0; r < 4; ++r) { const int kj = 16 * (kt0 + i) + 4 * q4 + r; const bool valid = (kj < 128) ? ((kj > qi) && (n > 0)) : ((kj - 128) <= qi);
                const float v = valid ? s[i][r] : -1e30f; s[i][r] = v; m = fmaxf(m, v); }
        m = fmaxf(m, __shfl_xor(m, 16)); m = fmaxf(m, __shfl_xor(m, 32));
        float den = 0.f;
#pragma unroll
        for (int i = 0; i < 10; ++i)
#pragma unroll
            for (int r = 0; r < 4; ++r) { const float p = __expf(s[i][r] - m); s[i][r] = p; den += p; }
        den += __shfl_xor(den, 16); den += __shfl_xor(den, 32); den += __expf(sink - m);
        f32x4 o[4];
#pragma unroll
        for (int dt = 0; dt < 4; ++dt) o[dt] = (f32x4){0.f, 0.f, 0.f, 0.f};
#pragma unroll
        for (int ks = 0; ks < 5; ++ks) { u32x4 pw; pw.x = cvtpk(s[2 * ks][0], s[2 * ks][1]); pw.y = cvtpk(s[2 * ks][2], s[2 * ks][3]); pw.z = cvtpk(s[2 * ks + 1][0], s[2 * ks + 1][1]); pw.w = cvtpk(s[2 * ks + 1][2], s[2 * ks + 1][3]);
            const bf16x8 bp = as_bf16x8(pw); const int keyb = 16 * kt0 + 32 * ks + 4 * q4;
#pragma unroll
            for (int dt = 0; dt < 4; ++dt) { const LAS unsigned char* vp = lds + ATT_VT_OFF + (16 * dt + l15) * VT_PITCH + keyb * 2;
                const u32x2 lo = *(const LAS u32x2*)vp, hi = *(const LAS u32x2*)(vp + 32);
                u32x4 av; av.x = lo.x; av.y = lo.y; av.z = hi.x; av.w = hi.y;
                o[dt] = __builtin_amdgcn_mfma_f32_16x16x32_bf16(as_bf16x8(av), bp, o[dt], 0, 0, 0); } }
        const float inv = 1.0f / den; float osq = 0.f;
#pragma unroll
        for (int dt = 0; dt < 4; ++dt) { const float o0 = o[dt][0] * inv, o1 = o[dt][1] * inv, o2 = o[dt][2] * inv, o3 = o[dt][3] * inv; osq += (o0 * o0 + o1 * o1) + (o2 * o2 + o3 * o3);
            u32x2 w; w.x = cvtpk(o0, o1); w.y = cvtpk(o2, o3);
            *(u32x2*)(ATT + tq * DATT + h * HD + 16 * dt + 4 * q4) = w; }
        if (ATTSQ) { osq += __shfl_xor(osq, 16); osq += __shfl_xor(osq, 32); if (q4 == 0) ATTSQ[tq * NH + h] = osq; }
    }
    __syncthreads();
}


__device__ __forceinline__ void ssm_apow_item(int i, const float* lam_re, const float* lam_im, const float* log_dt, unsigned char* APOW) {
    const int lane = i & 63, f = (i >> 6) & 63, g = i >> 12, ks = f & 7, rt = f >> 3, st = rt >> 1, c = rt & 1, fr = lane & 15, fq = lane >> 4, p = 16 * st + fr;
    const float dt = expf(log_dt[g]), lrd = lam_re[g * NST + p] * dt, lid = lam_im[g * NST + p] * dt;
    float v[8];
#pragma unroll
    for (int j = 0; j < 8; ++j) { const int t = 32 * ks + 16 * (j >> 2) + 4 * fq + (j & 3); const float k = (float)(255 - t), m = __expf(lrd * k), a = __builtin_amdgcn_fractf(lid * 0.15915494309189535f * k);
        v[j] = m * (c ? __builtin_amdgcn_sinf(a) : __builtin_amdgcn_cosf(a)); }
    u32x4 w; w.x = cvtpk(v[0], v[1]); w.y = cvtpk(v[2], v[3]); w.z = cvtpk(v[4], v[5]); w.w = cvtpk(v[6], v[7]);
    *(u32x4*)(APOW + (size_t)i * 16) = w;
}
struct Tr8 { const float* src; unsigned char* dst; int N, K, n0, k0, isgu, pad; };
__device__ __forceinline__ void tr8_setup(Tr8& t, const float* W, int K, int N, unsigned char* WT, int item, int lane, int isgu) {
    const int nblk = N / 32, kb = item / nblk, nb = item % nblk, q = lane & 7, o = lane >> 3;
    t.k0 = 128 * kb + 16 * o; t.n0 = 32 * nb + 4 * q; t.N = N; t.K = K; t.isgu = isgu; t.src = W + (size_t)t.k0 * N + t.n0; t.dst = WT; t.pad = 0;
}
__device__ __forceinline__ void tr8_load(const Tr8& t, f32x4 (&v)[16]) {
#pragma unroll
    for (int j = 0; j < 16; ++j) v[j] = __builtin_nontemporal_load((const f32x4*)(t.src + (size_t)j * t.N));
}
__device__ __forceinline__ void tr8_store(const Tr8& t, const f32x4 (&v)[16]) {
#pragma unroll
    for (int i = 0; i < 4; ++i) { const int nr = t.isgu ? gu_row(t.n0 + i) : (t.n0 + i);
        u32x4 a; a.x = pk4_fp8(v[0][i] * W8_SCALE, v[1][i] * W8_SCALE, v[2][i] * W8_SCALE, v[3][i] * W8_SCALE); a.y = pk4_fp8(v[4][i] * W8_SCALE, v[5][i] * W8_SCALE, v[6][i] * W8_SCALE, v[7][i] * W8_SCALE);
        a.z = pk4_fp8(v[8][i] * W8_SCALE, v[9][i] * W8_SCALE, v[10][i] * W8_SCALE, v[11][i] * W8_SCALE); a.w = pk4_fp8(v[12][i] * W8_SCALE, v[13][i] * W8_SCALE, v[14][i] * W8_SCALE, v[15][i] * W8_SCALE);
        __builtin_nontemporal_store(a, (u32x4*)(t.dst + (size_t)nr * t.K + t.k0)); }
}
struct ConvStream { const float* w_gu; const float* w_dn; unsigned char* wt_gu; unsigned char* wt_dn; int gu_first, n_gu, n_dn, stride; };

constexpr int SSM_BU_PITCH = 132, SSM_BU_BYTES = 16 * SSM_BU_PITCH * 4, SSM_X_PITCH = 272, SSM_WAVE_BYTES = SSM_BU_BYTES + 16 * SSM_X_PITCH, SSM_XEND_OFF = 8 * SSM_WAVE_BYTES, SSM_LDS_BYTES = SSM_XEND_OFF + 8 * 64 * 8;
__device__ __forceinline__ void ssm_unit(LAS unsigned char* lds, int unit, int tid, const bf16* PROJ, const float* tab, const float* c_re, const float* c_im, const float* d_skip, bf16* Gout, const bool has_cs, const ConvStream cs, const unsigned char* APOW = nullptr) {
    const int lane = tid & 63, wave = __builtin_amdgcn_readfirstlane(tid >> 6), l15 = lane & 15, q4 = lane >> 4;
    const int g = unit & 31, b = unit >> 5;
    if constexpr (SSM_MFMA_CARRY && !P3_CONV) {
        const unsigned char* gsrc = APOW + (size_t)g * 65536 + (size_t)wave * 8192 + lane * 16;
#pragma unroll
        for (int c4 = 0; c4 < 2; ++c4) { const unsigned* gp = (const unsigned*)(gsrc + c4 * 4096); LAS unsigned* lp = (LAS unsigned*)(lds + wave * 8192 + c4 * 4096);
            __builtin_amdgcn_global_load_lds(gp, lp, 16, 0, 0); __builtin_amdgcn_global_load_lds(gp, lp, 16, 1024, 0); __builtin_amdgcn_global_load_lds(gp, lp, 16, 2048, 0); __builtin_amdgcn_global_load_lds(gp, lp, 16, 3072, 0); } }
    Tr8 ct; ct.src = nullptr; ct.dst = nullptr; ct.N = ct.K = ct.n0 = ct.k0 = ct.isgu = ct.pad = 0; f32x4 cv[16]; bool cpend = false; int cq = unit * 8 + wave;
#pragma unroll
    for (int j = 0; j < 16; ++j) cv[j] = (f32x4){0.f, 0.f, 0.f, 0.f};
#define SSM_CONV_STEP() do { if (has_cs) { if (cpend) tr8_store(ct, cv); \
        constexpr int IGU = (D / 128) * (2 * DFF / 32), IDN = (DFF / 128) * (D / 32); cpend = cq < cs.n_gu + cs.n_dn; \
        { const bool isgu = cq < cs.n_gu || !cpend; const int r = !cpend ? 0 : (isgu ? cs.gu_first + cq : cq - cs.n_gu), e = r / (isgu ? IGU : IDN), it = r % (isgu ? IGU : IDN); \
          if (isgu) tr8_setup(ct, cs.w_gu + (size_t)e * D * 2 * DFF, D, 2 * DFF, cs.wt_gu + (size_t)e * 2 * DFF * D, it, lane, 1); \
          else tr8_setup(ct, cs.w_dn + (size_t)e * DFF * D, DFF, D, cs.wt_dn + (size_t)e * D * DFF, it, lane, 0); } \
        tr8_load(ct, cv); cq += cs.stride; } } while (0)
    const float* tg = tab + (size_t)g * SSMT_STRIDE;
    const float ar = tg[ST_AR + lane], ai = tg[ST_AI + lane], nai = -ai;
    bf16x8 bb[8];
#define SSM_SETUP_BB() do { _Pragma("unroll") for (int nt = 0; nt < 8; ++nt) { u32x4 w = (u32x4){0u, 0u, 0u, 0u}; \
        if (q4 < 2) { const int p = 8 * nt + (l15 >> 1); const float* src = tg + ((l15 & 1) ? ST_BI : ST_BR) + p * SG + 8 * q4; const f32x4 v0 = *(const f32x4*)src, v1 = *(const f32x4*)(src + 4); \
            w.x = cvtpk(v0.x, v0.y); w.y = cvtpk(v0.z, v0.w); w.z = cvtpk(v1.x, v1.y); w.w = cvtpk(v1.z, v1.w); } \
        bb[nt] = as_bf16x8(w); } } while (0)
    if constexpr (!(SSM_MFMA_CARRY && !P3_CONV)) SSM_SETUP_BB();
    bf16x8 cm[4];
#pragma unroll
    for (int ks = 0; ks < 4; ++ks) { const int pb = 16 * ks + 4 * q4; const f32x4 cr = *(const f32x4*)(c_re + ((size_t)g * SG + l15) * NST + pb), ci = *(const f32x4*)(c_im + ((size_t)g * SG + l15) * NST + pb);
        u32x4 w; w.x = cvtpk(cr.x, -ci.x); w.y = cvtpk(cr.y, -ci.y); w.z = cvtpk(cr.z, -ci.z); w.w = cvtpk(cr.w, -ci.w); cm[ks] = as_bf16x8(w); }
    LAS float* BU = (LAS float*)(lds + wave * SSM_WAVE_BYTES); LAS unsigned char* XT = lds + wave * SSM_WAVE_BYTES + SSM_BU_BYTES;
    LAS f32x2* xend = (LAS f32x2*)(lds + SSM_XEND_OFF);
    const bf16* ubase = PROJ + (size_t)(b * S) * DIN + UOFF + g * SG;
    const int tseg = 256 * wave;
    float xr = 0.f, xi = 0.f;
#define SSM_LOAD_U(dst, t0) do { dst = (u32x4){0u, 0u, 0u, 0u}; if (q4 < 2) dst = *(const u32x4*)(ubase + (size_t)((t0) + l15) * DIN + 8 * q4); } while (0)
#define SSM_BU_TILE(araw) do { const bf16x8 afr = as_bf16x8(araw); \
        _Pragma("unroll") for (int nt = 0; nt < 8; ++nt) { const f32x4 d = __builtin_amdgcn_mfma_f32_16x16x32_bf16(afr, bb[nt], (f32x4){0.f, 0.f, 0.f, 0.f}, 0, 0, 0); \
            _Pragma("unroll") for (int r = 0; r < 4; ++r) BU[(4 * q4 + r) * SSM_BU_PITCH + 16 * nt + l15] = d[r]; } LDS_FENCE(); } while (0)
    u32x4 ucur, unext, unn; SSM_LOAD_U(ucur, tseg); SSM_LOAD_U(unext, tseg + 16);
    if constexpr (SSM_MFMA_CARRY && !P3_CONV) {
        u32x4 idw = (u32x4){0u, 0u, 0u, 0u};
        { const int m = l15 - 8 * q4; const unsigned one = (m & 1) ? 0x3F800000u : 0x00003F80u;
          if (q4 < 2 && m >= 0 && m < 8) { idw.x = (m >> 1) == 0 ? one : 0u; idw.y = (m >> 1) == 1 ? one : 0u; idw.z = (m >> 1) == 2 ? one : 0u; idw.w = (m >> 1) == 3 ? one : 0u; } }
        const bf16x8 ident = as_bf16x8(idw);
        f32x4 V[8]; u32x4 na, nb;
#pragma unroll
        for (int rt = 0; rt < 8; ++rt) V[rt] = (f32x4){0.f, 0.f, 0.f, 0.f};
        asm volatile("s_waitcnt vmcnt(0)" ::: "memory");
        __syncthreads();
#pragma unroll 2
        for (int ks = 0; ks < 8; ++ks) {
            SSM_LOAD_U(na, tseg + 16 * ((2 * ks + 2) & 15)); SSM_LOAD_U(nb, tseg + 16 * ((2 * ks + 3) & 15));
            u32x4 afc[8];
#pragma unroll
            for (int rt = 0; rt < 8; ++rt) afc[rt] = *(const LAS u32x4*)(lds + (rt * 8 + ks) * 1024 + lane * 16);
            const f32x4 d0 = __builtin_amdgcn_mfma_f32_16x16x32_bf16(as_bf16x8(ucur), ident, (f32x4){0.f, 0.f, 0.f, 0.f}, 0, 0, 0), d1 = __builtin_amdgcn_mfma_f32_16x16x32_bf16(as_bf16x8(unext), ident, (f32x4){0.f, 0.f, 0.f, 0.f}, 0, 0, 0);
            u32x4 utw; utw.x = cvtpk(d0[0], d0[1]); utw.y = cvtpk(d0[2], d0[3]); utw.z = cvtpk(d1[0], d1[1]); utw.w = cvtpk(d1[2], d1[3]);
            const bf16x8 ut = as_bf16x8(utw);
#pragma unroll
            for (int rt = 0; rt < 8; ++rt) V[rt] = __builtin_amdgcn_mfma_f32_16x16x32_bf16(as_bf16x8(afc[rt]), ut, V[rt], 0, 0, 0);
            ucur = na; unext = nb; }
        __syncthreads();
        float bre[4][4], bim[4][4];
#pragma unroll
        for (int st = 0; st < 4; ++st)
#pragma unroll
            for (int i = 0; i < 4; ++i) { const int p = 16 * st + 4 * q4 + i; bre[st][i] = bf2f(f2bf(tg[ST_BR + p * SG + l15])); bim[st][i] = bf2f(f2bf(tg[ST_BI + p * SG + l15])); }
        LAS f32x2* PP = (LAS f32x2*)(lds + wave * SSM_WAVE_BYTES);
#pragma unroll
        for (int st = 0; st < 4; ++st)
#pragma unroll
            for (int i = 0; i < 4; ++i) { const float vr = V[2 * st][i], vi = V[2 * st + 1][i], br = bre[st][i], bi = bim[st][i];
                PP[(16 * st + 4 * q4 + i) * 18 + l15] = (f32x2){br * vr - bi * vi, br * vi + bi * vr}; }
        LDS_FENCE();
        { float sr = 0.f, si = 0.f;
#pragma unroll
          for (int q = 0; q < 8; ++q) { const f32x4 v = *(const LAS f32x4*)(PP + lane * 18 + 2 * q); sr += v.x + v.z; si += v.y + v.w; }
          xr = sr; xi = si; }
        LDS_FENCE();
    } else {
#pragma unroll 1
    for (int tile4 = 0; tile4 < 16; tile4 += 4) {
#pragma unroll
      for (int ti = 0; ti < 4; ++ti) { const int tile = tile4 + ti; SSM_LOAD_U(unn, tseg + 16 * ((tile + 2) & 15)); if (ti == 0) SSM_CONV_STEP(); SSM_BU_TILE(ucur); ucur = unext; unext = unn;
#pragma unroll
        for (int tt = 0; tt < 16; ++tt) { const f32x2 bu = *(const LAS f32x2*)(BU + tt * SSM_BU_PITCH + 2 * lane); const float nr = fma_s(ar, xr, fma_s(nai, xi, bu.x)), ni = fma_s(ar, xi, fma_s(ai, xr, bu.y)); xr = nr; xi = ni; }
        LDS_FENCE(); } }
    }
    xend[wave * 64 + lane] = (f32x2){xr, xi};
    __syncthreads();
    { float pr = ar, pi = ai;
#pragma unroll
      for (int i = 0; i < 8; ++i) { const float nr = pr * pr - pi * pi, ni = 2.0f * pr * pi; pr = nr; pi = ni; }
      xr = 0.f; xi = 0.f;
      for (int w2 = 0; w2 < wave; ++w2) { const f32x2 e = xend[w2 * 64 + lane]; const float npi = -pi; const float nr = fma_s(pr, xr, fma_s(npi, xi, e.x)), ni = fma_s(pr, xi, fma_s(pi, xr, e.y)); xr = nr; xi = ni; } }
    const f32x4 dsk = *(const f32x4*)(d_skip + g * SG + 4 * q4);
    if constexpr (SSM_MFMA_CARRY && !P3_CONV) SSM_SETUP_BB();
    u32x2 uucur = *(const u32x2*)(ubase + (size_t)(tseg + l15) * DIN + 4 * q4), uunext = *(const u32x2*)(ubase + (size_t)(tseg + 16 + l15) * DIN + 4 * q4), uunn;
#pragma unroll 1
    for (int tile4 = 0; tile4 < 16; tile4 += 4) {
#pragma unroll
      for (int ti = 0; ti < 4; ++ti) { const int tile = tile4 + ti; const int t0 = tseg + 16 * tile; SSM_LOAD_U(unn, tseg + 16 * ((tile + 2) & 15)); uunn = *(const u32x2*)(ubase + (size_t)(tseg + 16 * ((tile + 2) & 15) + l15) * DIN + 4 * q4); if (ti == 0) SSM_CONV_STEP(); SSM_BU_TILE(ucur); ucur = unext; unext = unn;
        f32x2 buv[16];
#pragma unroll
        for (int tt = 0; tt < 16; ++tt) buv[tt] = *(const LAS f32x2*)(BU + tt * SSM_BU_PITCH + 2 * lane);
#pragma unroll
        for (int tt = 0; tt < 16; ++tt) { const f32x2 bu = buv[tt]; const float nr = fma_s(ar, xr, fma_s(nai, xi, bu.x)), ni = fma_s(ar, xi, fma_s(ai, xr, bu.y)); xr = nr; xi = ni;
            *(LAS unsigned*)(XT + tt * SSM_X_PITCH + 4 * lane) = cvtpk(xr, xi); }
        LDS_FENCE();
        f32x4 y = (f32x4){0.f, 0.f, 0.f, 0.f};
#pragma unroll
        for (int ks = 0; ks < 4; ++ks) { const bf16x8 bx = *(const LAS bf16x8*)(XT + l15 * SSM_X_PITCH + (32 * ks + 8 * q4) * 2); y = __builtin_amdgcn_mfma_f32_16x16x32_bf16(cm[ks], bx, y, 0, 0, 0); }
        const size_t t = (size_t)(t0 + l15); const u32x2 uu = uucur; uucur = uunext; uunext = uunn;
        const float y0 = gelu_tanh(y[0] + dsk.x * bflo(uu.x)), y1 = gelu_tanh(y[1] + dsk.y * bfhi(uu.x)), y2 = gelu_tanh(y[2] + dsk.z * bflo(uu.y)), y3 = gelu_tanh(y[3] + dsk.w * bfhi(uu.y));
        u32x2 w; w.x = cvtpk(y0, y1); w.y = cvtpk(y2, y3);
        *(u32x2*)(Gout + ((size_t)(b * S) + t) * DSSM + g * SG + 4 * q4) = w;
        LDS_FENCE(); } }
#undef SSM_BU_TILE
#undef SSM_SETUP_BB
#undef SSM_LOAD_U
#undef SSM_CONV_STEP
    if (has_cs && cpend) tr8_store(ct, cv);
    __syncthreads();
}

constexpr int NWAVES = 8;
constexpr int RING_OFF = 0, RING_BYTES = 131072;
constexpr int LDSCTL_OFF = RING_BYTES;
constexpr int MISC_OFF = LDSCTL_OFF + 320;
constexpr int LH_OFF = LDSCTL_OFF + 512;
constexpr int SORT_OFF = RING_OFF;
constexpr int RSCR_OFF = LDSCTL_OFF + 8192;
constexpr int TE_OFF = LDSCTL_OFF + 4096;
constexpr int LDS_BYTES = 147456;
#define LDS_WAIT() asm volatile("s_waitcnt lgkmcnt(0)" ::: "memory")
#ifndef DEFER_P4_N
#define DEFER_P4_N 4
#endif
#ifndef DEFER_P2_N
#define DEFER_P2_N 5
#endif
#ifndef DN_DEFER_P9_N
#define DN_DEFER_P9_N 3072
#endif
constexpr int DN_DEFER_P9 = (MOE_FP8_GU && MOE_FP8_DN) ? DN_DEFER_P9_N : 0;
constexpr int DEFER_P2_PER_WAVE = MOE_FP8_GU ? DEFER_P2_N : 0, DEFER_P4_PER_WAVE = MOE_FP8_GU ? DEFER_P4_N : 0;
#ifndef P2_RESHAPE
#define P2_RESHAPE 1
#endif
#ifndef P2_CONV_N
#define P2_CONV_N 10
#endif
constexpr int P2_GEMM_WGS = 160;
constexpr int GU_DEFER_P2 = (P2_RESHAPE && MOE_FP8_GU) ? (256 - P2_GEMM_WGS) * 8 * P2_CONV_N : 192 * 8 * DEFER_P2_PER_WAVE, GU_DEFER_P4 = 128 * 8 * DEFER_P4_PER_WAVE, GU_DEFER = GU_DEFER_P2 + GU_DEFER_P4;
enum Phase { P_PRO = 0, P_NORM1, P_INPROJ, P_MIX_A, P_MIX_B, P_GLU, P_MIXNORM, P_OUTPROJ, P_ROUTER, P_SORT, P_GATEUP, P_DOWN, P_COMBINE, P_COUNT };

__device__ __forceinline__ void router_image_item(int i, const float* w_router, unsigned char* WRI) {
    const int lane = i & 63, rest = i >> 6, hl = rest & 1, nt = (rest >> 1) & 1, ks = (rest >> 2) & 3, w = rest >> 4, fr = lane & 15, fq = lane >> 4;
    const float* src = w_router + (size_t)(128 * w + 32 * ks + 8 * fq) * NE + 16 * nt + fr;
    float v[8];
#pragma unroll
    for (int j = 0; j < 8; ++j) v[j] = src[j * NE];
    u32x4 p;
#pragma unroll
    for (int j = 0; j < 4; ++j) { float a = v[2 * j], b = v[2 * j + 1]; unsigned hi = cvtpk(a, b); if (hl) { a -= bflo(hi); b -= bfhi(hi); hi = cvtpk(a, b); } p[j] = hi; }
    *(u32x4*)(WRI + (size_t)i * 16) = p;
}
__device__ __forceinline__ void router_block_mfma(LAS unsigned char* lds, int blk, int tid, int wave, int lane, const float* x1, const float* gain, const float* mod, const float* b_router,
                                                  const unsigned char* WRI, LAS int* lh, unsigned char* H8, int* tope, float* topw, const bf16* delta = nullptr, int* cnt = nullptr, int* toke = nullptr, float* wrowe = nullptr, int* paire = nullptr, bf16* x1b = nullptr) {
    asm volatile("" : "+v"(lane), "+v"(tid));
    const int b = (blk * 64) / S, fr = lane & 15, fq = lane >> 4;
    LAS unsigned char* Wl = lds + RING_OFF + wave * 16384;
    LAS float* gsh = (LAS float*)(lds + RSCR_OFF);
    LAS float* ssqx = (LAS float*)(lds + TE_OFF);
    LAS int* sel_e = (LAS int*)(lds + TE_OFF + 2048);
    LAS float* sel_v = (LAS float*)(lds + TE_OFF + 3072);
    LAS float* lg = (LAS float*)(lds + RING_OFF + 8192);
    { const unsigned char* gsrc = WRI + (size_t)wave * 16384 + lane * 16;
#pragma unroll
      for (int c4 = 0; c4 < 4; ++c4) { const unsigned* gp = (const unsigned*)(gsrc + c4 * 4096); LAS unsigned* lp = (LAS unsigned*)(Wl + c4 * 4096);
          __builtin_amdgcn_global_load_lds(gp, lp, 16, 0, 0); __builtin_amdgcn_global_load_lds(gp, lp, 16, 1024, 0); __builtin_amdgcn_global_load_lds(gp, lp, 16, 2048, 0); __builtin_amdgcn_global_load_lds(gp, lp, 16, 3072, 0); } }
    f32x4 xv[4][4][2];
    const float* xb = x1 + (size_t)(blk * 64 + fr) * D + 128 * wave + 8 * fq;
#pragma unroll
    for (int m = 0; m < 4; ++m)
#pragma unroll
        for (int ks = 0; ks < 4; ++ks) { xv[m][ks][0] = *(const f32x4*)(xb + (size_t)(16 * m) * D + 32 * ks); xv[m][ks][1] = *(const f32x4*)(xb + (size_t)(16 * m) * D + 32 * ks + 4); }
    if (delta) {
        const bf16* db = delta + (size_t)(blk * 64 + fr) * D + 128 * wave + 8 * fq; u32x4 dv[4][4];
#pragma unroll
        for (int m = 0; m < 4; ++m)
#pragma unroll
            for (int ks = 0; ks < 4; ++ks) dv[m][ks] = *(const u32x4*)(db + (size_t)(16 * m) * D + 32 * ks);
#pragma unroll
        for (int m = 0; m < 4; ++m)
#pragma unroll
            for (int ks = 0; ks < 4; ++ks) { const u32x4 d = dv[m][ks];
                xv[m][ks][0] += (f32x4){bflo(d.x), bfhi(d.x), bflo(d.y), bfhi(d.y)}; xv[m][ks][1] += (f32x4){bflo(d.z), bfhi(d.z), bflo(d.w), bfhi(d.w)}; } }
    if (x1b) { bf16* xo = x1b + (size_t)(blk * 64 + fr) * D + 128 * wave + 8 * fq;
#pragma unroll
        for (int m = 0; m < 4; ++m)
#pragma unroll
            for (int ks = 0; ks < 4; ++ks) { const f32x4 a = xv[m][ks][0], c2 = xv[m][ks][1]; u32x4 w; w.x = cvtpk(a.x, a.y); w.y = cvtpk(a.z, a.w); w.z = cvtpk(c2.x, c2.y); w.w = cvtpk(c2.z, c2.w);
                *(u32x4*)(xo + (size_t)(16 * m) * D + 32 * ks) = w; } }
    if (lane < 32) { const int c = 128 * wave + 4 * lane; const f32x4 g = *(const f32x4*)(gain + c), sc = *(const f32x4*)(mod + b * 6 * D + 4 * D + c);
        *(LAS f32x4*)(gsh + c) = g * (1.0f + sc); *(LAS f32x4*)(gsh + 1024 + c) = *(const f32x4*)(mod + b * 6 * D + 3 * D + c); }
    float ss[4];
#pragma unroll
    for (int m = 0; m < 4; ++m) { float a = 0.f;
#pragma unroll
        for (int ks = 0; ks < 4; ++ks)
#pragma unroll
            for (int h = 0; h < 2; ++h) { const f32x4 v = xv[m][ks][h]; a += (v.x * v.x + v.y * v.y) + (v.z * v.z + v.w * v.w); }
        a += __shfl_xor(a, 16); a += __shfl_xor(a, 32); ss[m] = a; }
    if (fq == 0) {
#pragma unroll
        for (int m = 0; m < 4; ++m) ssqx[(16 * m + fr) * 8 + wave] = ss[m]; }
    asm volatile("s_waitcnt vmcnt(0)" ::: "memory");
    __syncthreads();
    float r[4];
#pragma unroll
    for (int m = 0; m < 4; ++m) { const f32x4 a = *(const LAS f32x4*)(ssqx + (16 * m + fr) * 8), c = *(const LAS f32x4*)(ssqx + (16 * m + fr) * 8 + 4);
        r[m] = rsqrtf((((a.x + a.y) + (a.z + a.w)) + ((c.x + c.y) + (c.z + c.w))) * (1.0f / D) + EPS); }
    f32x4 acc[4][2];
#pragma unroll
    for (int m = 0; m < 4; ++m)
#pragma unroll
        for (int nt = 0; nt < 2; ++nt) acc[m][nt] = (f32x4){0.f, 0.f, 0.f, 0.f};
#pragma unroll
    for (int ks = 0; ks < 4; ++ks) { const int kk = 128 * wave + 32 * ks + 8 * fq;
        const f32x4 g0 = *(const LAS f32x4*)(gsh + kk), g1 = *(const LAS f32x4*)(gsh + kk + 4), s0 = *(const LAS f32x4*)(gsh + 1024 + kk), s1 = *(const LAS f32x4*)(gsh + 1024 + kk + 4);
        bf16x8 Wh[2], Wo[2];
#pragma unroll
        for (int nt = 0; nt < 2; ++nt) { Wh[nt] = *(const LAS bf16x8*)(Wl + ((ks * 2 + nt) * 2 + 0) * 1024 + lane * 16); Wo[nt] = *(const LAS bf16x8*)(Wl + ((ks * 2 + nt) * 2 + 1) * 1024 + lane * 16); }
#pragma unroll
        for (int m = 0; m < 4; ++m) { const f32x4 h0 = xv[m][ks][0] * r[m] * g0 + s0, h1 = xv[m][ks][1] * r[m] * g1 + s1;
            u32x2 w8; w8.x = pk4_fp8(h0.x * H8_SCALE, h0.y * H8_SCALE, h0.z * H8_SCALE, h0.w * H8_SCALE); w8.y = pk4_fp8(h1.x * H8_SCALE, h1.y * H8_SCALE, h1.z * H8_SCALE, h1.w * H8_SCALE);
            *(u32x2*)(H8 + (size_t)(blk * 64 + 16 * m + fr) * D + kk) = w8;
            u32x4 hi, lo;
            hi.x = cvtpk(h0.x, h0.y); hi.y = cvtpk(h0.z, h0.w); hi.z = cvtpk(h1.x, h1.y); hi.w = cvtpk(h1.z, h1.w);
            lo.x = cvtpk(h0.x - bflo(hi.x), h0.y - bfhi(hi.x)); lo.y = cvtpk(h0.z - bflo(hi.y), h0.w - bfhi(hi.y)); lo.z = cvtpk(h1.x - bflo(hi.z), h1.y - bfhi(hi.z)); lo.w = cvtpk(h1.z - bflo(hi.w), h1.w - bfhi(hi.w));
            const bf16x8 Xh = __builtin_bit_cast(bf16x8, hi), Xl = __builtin_bit_cast(bf16x8, lo);
#pragma unroll
            for (int nt = 0; nt < 2; ++nt) { acc[m][nt] = __builtin_amdgcn_mfma_f32_16x16x32_bf16(Wo[nt], Xh, acc[m][nt], 0, 0, 0); acc[m][nt] = __builtin_amdgcn_mfma_f32_16x16x32_bf16(Wh[nt], Xl, acc[m][nt], 0, 0, 0);
                acc[m][nt] = __builtin_amdgcn_mfma_f32_16x16x32_bf16(Wh[nt], Xh, acc[m][nt], 0, 0, 0); } } }
    { LAS float* part = (LAS float*)Wl;
#pragma unroll
      for (int m = 0; m < 4; ++m)
#pragma unroll
          for (int nt = 0; nt < 2; ++nt) *(LAS f32x4*)(part + (16 * m + fr) * 32 + 16 * nt + 4 * fq) = acc[m][nt]; }
    __syncthreads();
    { const int row = tid >> 3, eg = tid & 7; f32x4 sum = *(const f32x4*)(b_router + 4 * eg);
#pragma unroll
      for (int w2 = 0; w2 < 8; ++w2) sum += *(const LAS f32x4*)(lds + RING_OFF + w2 * 16384 + (row * 32 + 4 * eg) * 4);
      *(LAS f32x4*)(lg + row * 32 + 4 * eg) = sum; }
    __syncthreads();
    { const int row = 8 * wave + (lane >> 3), eg = lane & 7; const LAS float* lgr = lg + row * 32;
      const f32x4 mine = *(const LAS f32x4*)(lgr + 4 * eg); const int e0m = 4 * eg;
      int rk0 = 0, rk1 = 0, rk2 = 0, rk3 = 0;
#pragma unroll
      for (int q = 0; q < 8; ++q) { const f32x4 a = *(const LAS f32x4*)(lgr + 4 * q);
#pragma unroll
          for (int t = 0; t < 4; ++t) { const int e2 = 4 * q + t; const float av = a[t];
              rk0 += (av > mine.x || (av == mine.x && e2 < e0m + 0)) ? 1 : 0; rk1 += (av > mine.y || (av == mine.y && e2 < e0m + 1)) ? 1 : 0;
              rk2 += (av > mine.z || (av == mine.z && e2 < e0m + 2)) ? 1 : 0; rk3 += (av > mine.w || (av == mine.w && e2 < e0m + 3)) ? 1 : 0; } }
      if (rk0 < 4) { sel_e[row * 4 + rk0] = e0m + 0; sel_v[row * 4 + rk0] = mine.x; }
      if (rk1 < 4) { sel_e[row * 4 + rk1] = e0m + 1; sel_v[row * 4 + rk1] = mine.y; }
      if (rk2 < 4) { sel_e[row * 4 + rk2] = e0m + 2; sel_v[row * 4 + rk2] = mine.z; }
      if (rk3 < 4) { sel_e[row * 4 + rk3] = e0m + 3; sel_v[row * 4 + rk3] = mine.w; }
      asm volatile("s_waitcnt lgkmcnt(0)" ::: "memory");
      if (eg == 0) { const i32x4 ee = *(const LAS i32x4*)(sel_e + row * 4); const f32x4 vv = *(const LAS f32x4*)(sel_v + row * 4);
          const float x1v = __expf(vv.y - vv.x), x2v = __expf(vv.z - vv.x), x3v = __expf(vv.w - vv.x), inv = 1.0f / (1.0f + x1v + x2v + x3v);
          const size_t g = (size_t)(blk * 64 + row) * 4;
          if (cnt) *(LAS f32x4*)(sel_v + row * 4) = (f32x4){inv, x1v * inv, x2v * inv, x3v * inv};
          else { *(i32x4*)(tope + g) = ee; *(f32x4*)(topw + g) = (f32x4){inv, x1v * inv, x2v * inv, x3v * inv}; }
          (void)__hip_atomic_fetch_add(&lh[ee.x], 1, __ATOMIC_RELAXED, __HIP_MEMORY_SCOPE_WORKGROUP); (void)__hip_atomic_fetch_add(&lh[ee.y], 1, __ATOMIC_RELAXED, __HIP_MEMORY_SCOPE_WORKGROUP);
          (void)__hip_atomic_fetch_add(&lh[ee.z], 1, __ATOMIC_RELAXED, __HIP_MEMORY_SCOPE_WORKGROUP); (void)__hip_atomic_fetch_add(&lh[ee.w], 1, __ATOMIC_RELAXED, __HIP_MEMORY_SCOPE_WORKGROUP); }
      asm volatile("s_waitcnt lgkmcnt(0)" ::: "memory"); }
    if (cnt) {
        LAS int* offs = (LAS int*)ssqx; LAS int* es = (LAS int*)ssqx + 32;
        __syncthreads();
        if (tid < NE) { offs[tid] = __hip_atomic_fetch_add(cnt + tid * CNT_STRIDE, lh[tid], __ATOMIC_RELAXED, __HIP_MEMORY_SCOPE_AGENT); lh[tid] = 0; }
        int my_e = 0, rank = 0;
        if (tid < 256) { my_e = sel_e[tid]; const unsigned long long lt = (lane == 0) ? 0ull : (~0ull >> (64 - lane));
#pragma unroll 4
            for (int e = 0; e < NE; ++e) { const unsigned long long mk = __ballot(my_e == e); if (my_e == e) rank = __popcll(mk & lt); if (lane == 0) es[wave * 32 + e] = __popcll(mk); } }
        __syncthreads();
        if (tid < 256) { for (int w2 = 0; w2 < wave; ++w2) rank += es[w2 * 32 + my_e];
            const int slot = offs[my_e] + rank;
            toke[(size_t)my_e * T + slot] = blk * 64 + (tid >> 2); wrowe[(size_t)my_e * T + slot] = sel_v[tid]; paire[(size_t)blk * 256 + tid] = slot | (my_e << 20); }
    }
}

struct Args { const float* in[30]; float* out; unsigned char* ws; int ph_lo, ph_hi, li, pad; };

template <bool GU> __device__ __forceinline__ void p0_transpose_item(const float* W, int K, int N, bf16* WT, int item, int lane, const float* kscale = nullptr) {
    const int nblk = N / 64, kb = item / nblk, nb = item % nblk, q = lane & 15, o = lane >> 4, k0 = 64 * kb + 16 * o, n0 = 64 * nb + 4 * q;
    const float* src = W + (size_t)k0 * N + n0;
    f32x4 v[16];
#pragma unroll
    for (int j = 0; j < 16; ++j) v[j] = *(const f32x4*)(src + (size_t)j * N);
    if (kscale) {
#pragma unroll
        for (int j = 0; j < 16; ++j) v[j] = v[j] * kscale[k0 + j]; }
#pragma unroll
    for (int i = 0; i < 4; ++i) { const int nr = GU ? gu_row(n0 + i) : (n0 + i);
        u32x4 a, b;
        a.x = cvtpk(v[0][i], v[1][i]); a.y = cvtpk(v[2][i], v[3][i]); a.z = cvtpk(v[4][i], v[5][i]); a.w = cvtpk(v[6][i], v[7][i]);
        b.x = cvtpk(v[8][i], v[9][i]); b.y = cvtpk(v[10][i], v[11][i]); b.z = cvtpk(v[12][i], v[13][i]); b.w = cvtpk(v[14][i], v[15][i]);
        u32x4* dst = (u32x4*)(WT + (size_t)nr * K + k0); dst[0] = a; dst[1] = b; }
}

template <bool GU> __device__ __forceinline__ void p0_transpose_item_fp8(const float* W, int K, int N, unsigned char* WT, int item, int lane) {
    const int nblk = N / 32, kb = item / nblk, nb = item % nblk, q = lane & 7, o = lane >> 3, k0 = 128 * kb + 16 * o, n0 = 32 * nb + 4 * q;
    const float* src = W + (size_t)k0 * N + n0;
    f32x4 v[16];
#pragma unroll
    for (int j = 0; j < 16; ++j) v[j] = __builtin_nontemporal_load((const f32x4*)(src + (size_t)j * N)) * W8_SCALE;
#pragma unroll
    for (int i = 0; i < 4; ++i) { const int nr = GU ? gu_row(n0 + i) : (n0 + i);
        u32x4 a; a.x = pk4_fp8(v[0][i], v[1][i], v[2][i], v[3][i]); a.y = pk4_fp8(v[4][i], v[5][i], v[6][i], v[7][i]); a.z = pk4_fp8(v[8][i], v[9][i], v[10][i], v[11][i]); a.w = pk4_fp8(v[12][i], v[13][i], v[14][i], v[15][i]);
        __builtin_nontemporal_store(a, (u32x4*)(WT + (size_t)nr * K + k0)); }
}

__global__ void __launch_bounds__(NWAVES * 64, 2) mk_fwd(Args args) {
    extern __shared__ __attribute__((aligned(16))) unsigned char lds_raw[];
    LAS unsigned char* lds = (LAS unsigned char*)lds_raw;
    const int tid = threadIdx.x, lane = tid & 63, wave = __builtin_amdgcn_readfirstlane(tid >> 6);
    const int G = gridDim.x, bx = blockIdx.x, vcu = (G % 8 == 0) ? (bx % 8) * (G / 8) + bx / 8 : bx;
    const int gw = vcu * NWAVES + wave, NGW = G * NWAVES;
    unsigned char* ws = args.ws;
    const float* x = args.in[0]; const float* c_in = args.in[1]; const float* w_ada = args.in[2]; const float* b_ada = args.in[3];
    const float* norm_mix = args.in[4]; const float* w_in = args.in[5]; const float* b_in = args.in[6];
    const float* q_norm = args.in[7]; const float* k_norm = args.in[8]; const float* sinks = args.in[9];
    const float* lam_re = args.in[10]; const float* lam_im = args.in[11]; const float* log_dt = args.in[12];
    const float* b_re = args.in[13]; const float* b_im = args.in[14]; const float* c_re = args.in[15]; const float* c_im = args.in[16];
    const float* d_skip = args.in[17]; const float* w_glu = args.in[18]; const float* b_glu = args.in[19];
    const float* attn_out_norm = args.in[20]; const float* ssm_out_norm = args.in[21]; const float* w_out = args.in[22];
    const float* norm_ffn = args.in[23]; const float* w_router = args.in[24]; const float* b_router = args.in[25];
    const float* w_gate_up = args.in[26]; const float* b_gate_up = args.in[27]; const float* w_down = args.in[28]; const float* b_down = args.in[29];
    float* out = args.out;
    float* MOD = (float*)(ws + WS_MOD); float* SSMT = (float*)(ws + WS_SSMT);
    bf16* WTIN = (bf16*)(ws + WS_WTIN); bf16* WTGLU = (bf16*)(ws + WS_WTGLU); bf16* WTOUT = (bf16*)(ws + WS_WTOUT); bf16* WTGU = (bf16*)(ws + WS_WTGU); bf16* WTDN = (bf16*)(ws + WS_WTDN);
    bf16* H = (bf16*)(ws + WS_H); bf16* PROJ = (bf16*)(ws + WS_PROJ); bf16* ATT = (bf16*)(ws + WS_ATT); bf16* Gb = (bf16*)(ws + WS_G); bf16* SSMG = (bf16*)(ws + WS_SSMG); bf16* MIXED = (bf16*)(ws + WS_MIXED);
    int* TOPE = (int*)(ws + WS_TOPE); float* TOPW = (float*)(ws + WS_TOPW); int* HIST = (int*)(ws + WS_HIST); int* TOKROW = (int*)(ws + WS_TOKROW); int* ROWPAIR = (int*)(ws + WS_ROWPAIR);
    float* WROW = (float*)(ws + WS_WROW); int* TILEE = (int*)(ws + WS_TILEE); bf16* ACT = (bf16*)(ws + WS_ACT); bf16* YS = (bf16*)(ws + WS_YS);
    float* XST = (float*)(ws + WS_XST); float* SC = (float*)(ws + WS_SC);

    for (int u = tid; u < (LDS_BYTES - LDSCTL_OFF) / 4; u += NWAVES * 64) ((LAS unsigned*)(lds + LDSCTL_OFF))[u] = 0u;
    __syncthreads();
    volatile LAS unsigned* MISC = (volatile LAS unsigned*)(lds + MISC_OFF);
    XcdBarrier bar = xcd_barrier_post((unsigned*)(ws + WS_CTL) + CW_BAR + args.li * XCD_BAR_WORDS, MISC + 8);
    const int lo = args.ph_lo, hi = args.ph_hi;
#define IN(k) (lo <= (k) && (k) < hi)
#define SEAM(k) do { if (IN(k) && IN((k) + 1)) xcd_barrier(bar); } while (0)

    if (IN(P_PRO)) {
        if (vcu < 96) {
            LAS float* ca = (LAS float*)(lds + RING_OFF);
            LAS float* red = (LAS float*)(lds + RING_OFF + 32768);
            for (int k = tid; k < D; k += 512) { float cv8[NB];
#pragma unroll
                for (int b = 0; b < NB; ++b) { const float v = c_in[b * D + k]; cv8[b] = v * sigmoidf_(v); }
                *(LAS f32x4*)(ca + k * 8) = (f32x4){cv8[0], cv8[1], cv8[2], cv8[3]}; *(LAS f32x4*)(ca + k * 8 + 4) = (f32x4){cv8[4], cv8[5], cv8[6], cv8[7]}; }
            __syncthreads();
            float acc[NB];
#pragma unroll
            for (int b = 0; b < NB; ++b) acc[b] = 0.f;
            const float* wp = w_ada + (size_t)(128 * wave) * (6 * D) + 64 * vcu + lane;
#pragma unroll 1
            for (int k0 = 0; k0 < 128; k0 += 64) {
                float wv[64];
#pragma unroll
                for (int j = 0; j < 64; ++j) wv[j] = __builtin_nontemporal_load(wp + (size_t)(k0 + j) * (6 * D));
#pragma unroll
                for (int j = 0; j < 64; ++j) { const float w = wv[j]; const f32x4 c0 = *(const LAS f32x4*)(ca + (128 * wave + k0 + j) * 8), c1 = *(const LAS f32x4*)(ca + (128 * wave + k0 + j) * 8 + 4);
                    acc[0] = fmaf(c0.x, w, acc[0]); acc[1] = fmaf(c0.y, w, acc[1]); acc[2] = fmaf(c0.z, w, acc[2]); acc[3] = fmaf(c0.w, w, acc[3]);
                    acc[4] = fmaf(c1.x, w, acc[4]); acc[5] = fmaf(c1.y, w, acc[5]); acc[6] = fmaf(c1.z, w, acc[6]); acc[7] = fmaf(c1.w, w, acc[7]); } }
#pragma unroll
            for (int b = 0; b < NB; ++b) red[(wave * 8 + b) * 64 + lane] = acc[b];
            __syncthreads();
            { float s = b_ada[64 * vcu + lane];
#pragma unroll
              for (int w2 = 0; w2 < 8; ++w2) s += red[(w2 * 8 + wave) * 64 + lane];
              MOD[wave * 6 * D + 64 * vcu + lane] = s; }
            __syncthreads();
        } else if (vcu < 100) { const int i = (vcu - 96) * 512 + tid; ssm_table_item(i, lam_re, lam_im, log_dt, b_re, b_im, SSMT); }
        else if (FAST_ROUTER && MOE_FP8_GU && vcu < 116) router_image_item((vcu - 100) * 512 + tid, w_router, ws + WS_WRI);
        if constexpr (SSM_MFMA_CARRY && !P3_CONV) for (int i = vcu * 512 + tid; i < NG * 64 * 64; i += G * 512) ssm_apow_item(i, lam_re, lam_im, log_dt, ws + WS_APOW);
        constexpr int I_IN = (D / 64) * (DIN / 64), I_GLU = (DSSM / 64) * (DSSM / 64), I_OUT = (D / 64) * (D / 64), I_GU = MOE_FP8_GU ? (D / 128) * (2 * DFF / 32) : (D / 64) * (2 * DFF / 64), I_DN = MOE_FP8_DN ? (DFF / 128) * (D / 32) : (DFF / 64) * (D / 64);
        constexpr int NITEMS = I_IN + I_GLU + I_OUT + NE * I_GU + NE * I_DN;
        const int gu_defer = (G == 256) ? GU_DEFER : 0;
        const int nitems_p0 = (G == 256 && P3_CONV) ? (I_IN + I_GLU + I_OUT) : (NITEMS - gu_defer - (G == 256 ? DN_DEFER_P9 : 0));
        for (int it0 = gw; it0 < nitems_p0; it0 += NGW) {
            int r = (it0 < I_IN + I_GLU + I_OUT) ? it0 : it0 + gu_defer;
            if (r < I_IN) { p0_transpose_item<false>(w_in, D, DIN, WTIN, r, lane); continue; } r -= I_IN;
            if (r < I_GLU) { p0_transpose_item<false>(w_glu, DSSM, DSSM, WTGLU, r, lane); continue; } r -= I_GLU;
            if (r < I_OUT) { const int kb = r / (D / 64);
                p0_transpose_item<false>(w_out, D, D, WTOUT, r, lane, FUSE_MIXNORM ? (kb < 8 ? attn_out_norm : ssm_out_norm - DATT) : nullptr); continue; } r -= I_OUT;
            if (r < NE * I_GU) { const int e = r / I_GU;
                if constexpr (MOE_FP8_GU) p0_transpose_item_fp8<true>(w_gate_up + (size_t)e * D * 2 * DFF, D, 2 * DFF, (unsigned char*)WTGU + (size_t)e * 2 * DFF * D, r % I_GU, lane);
                else p0_transpose_item<true>(w_gate_up + (size_t)e * D * 2 * DFF, D, 2 * DFF, WTGU + (size_t)e * 2 * DFF * D, r % I_GU, lane);
                continue; } r -= NE * I_GU;
            { const int e = r / I_DN;
              if constexpr (MOE_FP8_DN) p0_transpose_item_fp8<false>(w_down + (size_t)e * DFF * D, DFF, D, (unsigned char*)WTDN + (size_t)e * D * DFF, r % I_DN, lane);
              else p0_transpose_item<false>(w_down + (size_t)e * DFF * D, DFF, D, WTDN + (size_t)e * D * DFF, r % I_DN, lane); }
        }
    }
    SEAM(P_PRO);
    if (IN(P_NORM1)) {
        for (int m0 = 8 * gw; m0 < T; m0 += 8 * NGW) { const int b = m0 / S; f32x4 gm[4], shv[4];
#pragma unroll
            for (int j = 0; j < 4; ++j) { const int c = 4 * lane + 256 * j; gm[j] = *(const f32x4*)(norm_mix + c) * (1.0f + *(const f32x4*)(MOD + b * 6 * D + D + c)); shv[j] = *(const f32x4*)(MOD + b * 6 * D + c); }
#pragma unroll 2
            for (int i = 0; i < 8; ++i) { const int m = m0 + i; const f32x4* xr = (const f32x4*)(x + (size_t)m * D) + lane; f32x4 v[4]; float ss = 0.f;
#pragma unroll
                for (int j = 0; j < 4; ++j) { v[j] = xr[64 * j]; ss += (v[j].x * v[j].x + v[j].y * v[j].y) + (v[j].z * v[j].z + v[j].w * v[j].w); }
                const float r = rsqrtf(wave_sum(ss) * (1.0f / D) + EPS); u32x2* o = (u32x2*)(H + (size_t)m * D) + lane;
#pragma unroll
                for (int j = 0; j < 4; ++j) { const f32x4 y = v[j] * r * gm[j] + shv[j]; u32x2 w; w.x = cvtpk(y.x, y.y); w.y = cvtpk(y.z, y.w); o[64 * j] = w; } } }
    }
    SEAM(P_NORM1);
    if (IN(P_INPROJ)) {
        constexpr int I_GU8 = (D / 128) * (2 * DFF / 32);
        const bool reshape = P2_RESHAPE && GU_DEFER_P2 > 0 && G == 256;
        const int Gg = reshape ? P2_GEMM_WGS : G;
        if (bx < Gg) {
            pg8::DenseOrder So{(const char*)H, (const char*)WTIN, T / 256, DIN / 256, Gg, bx, (size_t)256 * D * 2};
            pg8::EpiProj E{PROJ, DIN, b_in, (LAS float*)(lds + RSCR_OFF + 4096)};
            pg8::gemm_phase<pg8::EpiProj, pg8::DenseOrder, true, false>(lds + RING_OFF, D, So, E);
            if constexpr (GU_DEFER_P2 > 0 && !P2_RESHAPE) { if (G == 256 && bx >= 64) {
                for (int k = 0; k < DEFER_P2_PER_WAVE; ++k) { const int r = ((bx - 64) * 8 + wave) * DEFER_P2_PER_WAVE + k, e = r / I_GU8;
                    p0_transpose_item_fp8<true>(w_gate_up + (size_t)e * D * 2 * DFF, D, 2 * DFF, (unsigned char*)WTGU + (size_t)e * 2 * DFF * D, r % I_GU8, lane); } } }
        } else {
            const int nconv = (G - Gg) * 8;
            for (int r = (bx - Gg) * 8 + wave; r < GU_DEFER_P2; r += nconv) { const int e = r / I_GU8;
                p0_transpose_item_fp8<true>(w_gate_up + (size_t)e * D * 2 * DFF, D, 2 * DFF, (unsigned char*)WTGU + (size_t)e * 2 * DFF * D, r % I_GU8, lane); }
        }
    }
    SEAM(P_INPROJ);
    if (IN(P_MIX_A)) {
#if FAST_ATTN
        for (int u = bx; u < NB * 16 * NKV; u += G) attn_unit(lds + RING_OFF, u, tid, PROJ, q_norm, k_norm, sinks, ATT, FUSE_MIXNORM ? (float*)(ws + WS_MIXED) : nullptr);
#else
        for (int idx = bx * 512 + tid; idx < T * NH; idx += G * 512) attn_scores_item(idx, PROJ, q_norm, k_norm, SC);
#endif
#if FAST_SSM
        { constexpr int IGU = (D / 128) * (2 * DFF / 32), IDN = (DFF / 128) * (D / 32);
          const ConvStream cstr{w_gate_up, w_down, (unsigned char*)WTGU, (unsigned char*)WTDN, GU_DEFER, NE * IGU - GU_DEFER, NE * IDN - DN_DEFER_P9, 2048};
          const bool use_cs = (G == 256) && P3_CONV;
          for (int u = bx; u < NB * NG; u += G) ssm_unit(lds + RING_OFF, u, tid, PROJ, SSMT, c_re, c_im, d_skip, Gb, use_cs, cstr, ws + WS_APOW); }
#else
        if (wave == 0) for (int idx = bx * 64 + lane; idx < NB * NG * NST; idx += G * 64) ssm_scan_item(idx, PROJ, SSMT, XST);
#endif
    }
    SEAM(P_MIX_A);
    if (IN(P_MIX_B)) {
#if !FAST_ATTN
        for (int idx = bx * 512 + tid; idx < T * NH * HD; idx += G * 512) attn_out_item(idx, PROJ, SC, sinks, ATT);
#endif
#if !FAST_SSM
        for (int idx = bx * 512 + tid; idx < T * DSSM; idx += G * 512) ssm_out_item(idx, PROJ, XST, c_re, c_im, d_skip, Gb);
#endif
    }
#if !(FAST_ATTN && FAST_SSM)
    SEAM(P_MIX_B);
#endif
    if (IN(P_GLU)) {
        pg8::DenseOrder So{(const char*)Gb, (const char*)WTGLU, T / 256, DSSM / 256, G, bx, (size_t)256 * DSSM * 2};
        pg8::EpiGlu E{Gb, SSMG, b_glu, FUSE_MIXNORM ? (float*)(ws + WS_MIXED + MiB) : nullptr, (LAS float*)(lds + RSCR_OFF + 4096)};
        pg8::gemm_phase<pg8::EpiGlu, pg8::DenseOrder, true, false>(lds + RING_OFF, DSSM, So, E);
        if constexpr (GU_DEFER_P4 > 0) { if (G == 256 && bx >= 128) {
            constexpr int I_GU8 = (D / 128) * (2 * DFF / 32);
            for (int k = 0; k < DEFER_P4_PER_WAVE; ++k) { const int r = GU_DEFER_P2 + ((bx - 128) * 8 + wave) * DEFER_P4_PER_WAVE + k, e = r / I_GU8;
                p0_transpose_item_fp8<true>(w_gate_up + (size_t)e * D * 2 * DFF, D, 2 * DFF, (unsigned char*)WTGU + (size_t)e * 2 * DFF * D, r % I_GU8, lane); } } }
    }
    SEAM(P_GLU);
    if (IN(P_MIXNORM) && !FUSE_MIXNORM) {
        const f32x4 ga0 = *(const f32x4*)(attn_out_norm + 8 * lane), ga1 = *(const f32x4*)(attn_out_norm + 8 * lane + 4), gs0 = *(const f32x4*)(ssm_out_norm + 8 * lane), gs1 = *(const f32x4*)(ssm_out_norm + 8 * lane + 4);
        for (int m0 = 2 * gw; m0 < T; m0 += 2 * NGW) {
            u32x4 a[2], q[2];
#pragma unroll
            for (int r = 0; r < 2; ++r) { a[r] = *((const u32x4*)(ATT + (size_t)(m0 + r) * DATT) + lane); q[r] = *((const u32x4*)(SSMG + (size_t)(m0 + r) * DSSM) + lane); }
#pragma unroll
            for (int r = 0; r < 2; ++r) {
                const float av[8] = {bflo(a[r].x), bfhi(a[r].x), bflo(a[r].y), bfhi(a[r].y), bflo(a[r].z), bfhi(a[r].z), bflo(a[r].w), bfhi(a[r].w)};
                const float sv[8] = {bflo(q[r].x), bfhi(q[r].x), bflo(q[r].y), bfhi(q[r].y), bflo(q[r].z), bfhi(q[r].z), bflo(q[r].w), bfhi(q[r].w)};
                float qa = 0.f, qs = 0.f;
#pragma unroll
                for (int i = 0; i < 8; ++i) { qa += av[i] * av[i]; qs += sv[i] * sv[i]; }
                const float ra = rsqrtf(wave_sum(qa) * (1.0f / DATT) + EPS), rs = rsqrtf(wave_sum(qs) * (1.0f / DSSM) + EPS);
                u32x4 oa, os;
                oa.x = pk2(av[0] * ra * ga0.x, av[1] * ra * ga0.y); oa.y = pk2(av[2] * ra * ga0.z, av[3] * ra * ga0.w); oa.z = pk2(av[4] * ra * ga1.x, av[5] * ra * ga1.y); oa.w = pk2(av[6] * ra * ga1.z, av[7] * ra * ga1.w);
                os.x = pk2(sv[0] * rs * gs0.x, sv[1] * rs * gs0.y); os.y = pk2(sv[2] * rs * gs0.z, sv[3] * rs * gs0.w); os.z = pk2(sv[4] * rs * gs1.x, sv[5] * rs * gs1.y); os.w = pk2(sv[6] * rs * gs1.z, sv[7] * rs * gs1.w);
                *((u32x4*)(MIXED + (size_t)(m0 + r) * D) + lane) = oa; *((u32x4*)(MIXED + (size_t)(m0 + r) * D + DATT) + lane) = os; } }
    }
    if (!FUSE_MIXNORM) SEAM(P_MIXNORM);
    if (IN(P_OUTPROJ)) {
        if constexpr (FUSE_MIXNORM) {
            pg8::MixOrder So{(const char*)ATT, (const char*)WTOUT, T / 256, D / 256, G, bx, (size_t)(WS_SSMG - WS_ATT)};
            pg8::EpiOut E{x, MOD, X1_DELTA ? (float*)(ws + WS_DELTA) : out, (const float*)(ws + WS_MIXED), (const float*)(ws + WS_MIXED + MiB), (LAS float*)(lds + RSCR_OFF), (LAS float*)(lds + RSCR_OFF + 4096)};
            pg8::gemm_phase<pg8::EpiOut, pg8::MixOrder, false, false>(lds + RING_OFF, D, So, E);
        } else {
            pg8::DenseOrder So{(const char*)MIXED, (const char*)WTOUT, T / 256, D / 256, G, bx, (size_t)256 * D * 2};
            pg8::EpiOut E{x, MOD, X1_DELTA ? (float*)(ws + WS_DELTA) : out, nullptr, nullptr, (LAS float*)(lds + RSCR_OFF), (LAS float*)(lds + RSCR_OFF + 4096)};
            pg8::gemm_phase<pg8::EpiOut, pg8::DenseOrder, false, false>(lds + RING_OFF, D, So, E);
        }
    }
    SEAM(P_OUTPROJ);
    if (IN(P_ROUTER)) {
        LAS float* wr = (LAS float*)(lds + RING_OFF); LAS int* lh = (LAS int*)(lds + LH_OFF);
        constexpr bool FR = FAST_ROUTER && MOE_FP8_GU, FS = FR && FAST_SORT && MOE_FP8_DN && YS_FP8;
        if constexpr (!FR) for (int c = tid; c < D; c += 512) {
            f32x4 wv[8];
#pragma unroll
            for (int k = 0; k < 8; ++k) wv[k] = *(const f32x4*)(w_router + (size_t)c * NE + 4 * k);
#pragma unroll
            for (int k = 0; k < 8; ++k) { wr[(4 * k + 0) * D + c] = wv[k].x; wr[(4 * k + 1) * D + c] = wv[k].y; wr[(4 * k + 2) * D + c] = wv[k].z; wr[(4 * k + 3) * D + c] = wv[k].w; } }
        if (tid < NE) lh[tid] = 0;
        __syncthreads();
        for (int vb = bx; vb < 256; vb += G) {
            if constexpr (FR) router_block_mfma(lds, vb, tid, wave, lane, X1_DELTA ? x : out, norm_ffn, MOD, b_router, ws + WS_WRI, lh, ws + WS_H8, TOPE, TOPW, X1_DELTA ? (const bf16*)(ws + WS_DELTA) : nullptr, FS ? (int*)(ws + WS_CNT) : nullptr, (int*)(ws + WS_TOKE), (float*)(ws + WS_WROWE), ROWPAIR, (X1_DELTA && X1_BF16) ? (bf16*)(ws + WS_X1B) : nullptr);
            else norm2_router_rows(vb, wave, lane, out, norm_ffn, MOD, b_router, wr, lh, (LAS float*)(lds + RSCR_OFF), MOE_FP8_GU ? (bf16*)nullptr : H, TOPE, TOPW, MOE_FP8_GU ? (unsigned char*)PROJ : nullptr);
            __syncthreads();
            if (!FS && tid < NE) { HIST[vb * NE + tid] = lh[tid]; lh[tid] = 0; }
            __syncthreads();
        }
    }
    SEAM(P_ROUTER);
    constexpr bool FSK = FAST_ROUTER && MOE_FP8_GU && FAST_SORT && MOE_FP8_DN && YS_FP8;
    if (IN(P_SORT) && !FSK) for (int vb = bx; vb < 256; vb += G) sort_block(vb, tid, (LAS int*)(lds + SORT_OFF), HIST, TOPE, TOPW, TOKROW, ROWPAIR, WROW, TILEE);
    if (!FSK) SEAM(P_SORT);
    LAS int* cbt = (LAS int*)(lds + TE_OFF + 2048);
    if (IN(P_GATEUP) || IN(P_DOWN) || (FSK && IN(P_COMBINE))) {
        LAS int* te = (LAS int*)(lds + TE_OFF);
        if constexpr (FSK) {
            if (wave == 0) { const int cv = (lane < NE) ? ((const int*)(ws + WS_CNT))[lane * CNT_STRIDE] : 0; int inc = ((cv + 255) >> 8) << 8;
#pragma unroll
                for (int o = 1; o < 32; o <<= 1) { const int t = __shfl_up(inc, o); if (lane >= o) inc += t; }
                if (lane < NE) { cbt[lane] = cv; cbt[33 + lane] = inc; } if (lane == 0) cbt[32] = 0; }
            __syncthreads();
            if (tid < NE) for (int ti = cbt[32 + tid] >> 8; ti < (cbt[33 + tid] >> 8); ++ti) te[ti] = tid;
        } else for (int i = tid; i < MAXTILES; i += 512) te[i] = TILEE[64 + i];
        __syncthreads();
    }
    if (IN(P_GATEUP)) {
        const LAS int* te = (const LAS int*)(lds + TE_OFF); const int ntiles = __builtin_amdgcn_readfirstlane(FSK ? (cbt[64] >> 8) : TILEE[0]);
        if constexpr (MOE_FP8_GU) {
            pg8::MoeOrder So{(const char*)(ws + WS_H8), (const char*)WTGU, FSK ? (const int*)(ws + WS_TOKE) : TOKROW, te, ntiles, 2 * DFF / 256, G, bx, (size_t)256 * D, (size_t)2 * DFF * D, FSK ? cbt : nullptr};
            pg8::EpiGateUp<MOE_FP8_DN != 0> E{(void*)ACT, b_gate_up, te, 1.0f / (W8_SCALE * H8_SCALE), (LAS float*)(lds + RSCR_OFF + 4096)};
            pg8::gemm_phase<pg8::EpiGateUp<MOE_FP8_DN != 0>, pg8::MoeOrder, true, true, true>(lds + RING_OFF, D / 2, So, E);
            if constexpr (DN_DEFER_P9 > 0) { if (G == 256) {
                constexpr int IDN8 = (DFF / 128) * (D / 32);
                const int rem = (ntiles * (2 * DFF / 256)) % G; const bool all = (rem == 0) || (G - rem < 64);
                const int n_idle = all ? G : G - rem, j = all ? bx : bx - rem;
                if (j >= 0) for (int r = NE * IDN8 - DN_DEFER_P9 + j * 8 + wave; r < NE * IDN8; r += n_idle * 8) { const int e = r / IDN8;
                    p0_transpose_item_fp8<false>(w_down + (size_t)e * DFF * D, DFF, D, (unsigned char*)WTDN + (size_t)e * D * DFF, r % IDN8, lane); } } }
        } else {
            pg8::MoeOrder So{(const char*)H, (const char*)WTGU, TOKROW, te, ntiles, 2 * DFF / 256, G, bx, (size_t)256 * D * 2, (size_t)2 * DFF * D * 2};
            pg8::EpiGateUp<MOE_FP8_DN != 0> E{(void*)ACT, b_gate_up, te, 1.0f, (LAS float*)(lds + RSCR_OFF + 4096)};
            pg8::gemm_phase<pg8::EpiGateUp<MOE_FP8_DN != 0>, pg8::MoeOrder, true, true, false>(lds + RING_OFF, D, So, E);
        }
    }
    SEAM(P_GATEUP);
    if (IN(P_DOWN)) {
        const LAS int* te = (const LAS int*)(lds + TE_OFF); const int ntiles = __builtin_amdgcn_readfirstlane(FSK ? (cbt[64] >> 8) : TILEE[0]);
        if constexpr (MOE_FP8_DN) {
            pg8::MoeOrder So{(const char*)ACT, (const char*)WTDN, TOKROW, te, ntiles, D / 256, G, bx, (size_t)256 * DFF, (size_t)D * DFF};
            pg8::EpiDown<YS_FP8 != 0> E{(void*)YS, b_down, FSK ? (const float*)(ws + WS_WROWE) : WROW, te, 1.0f / (W8_SCALE * A8_SCALE), FSK ? cbt : nullptr, (LAS float*)(lds + RSCR_OFF + 4096), (const float*)(ws + WS_CTL)};
            pg8::gemm_phase<pg8::EpiDown<YS_FP8 != 0>, pg8::MoeOrder, true, false, true>(lds + RING_OFF, DFF / 2, So, E);
        } else {
            pg8::MoeOrder So{(const char*)ACT, (const char*)WTDN, TOKROW, te, ntiles, D / 256, G, bx, (size_t)256 * DFF * 2, (size_t)D * DFF * 2};
            pg8::EpiDown<YS_FP8 != 0> E{(void*)YS, b_down, WROW, te, 1.0f, nullptr, (LAS float*)(lds + RSCR_OFF + 4096), (const float*)(ws + WS_CTL)};
            pg8::gemm_phase<pg8::EpiDown<YS_FP8 != 0>, pg8::MoeOrder, true, false, false>(lds + RING_OFF, DFF, So, E);
        }
    }
    SEAM(P_DOWN);
    if (IN(P_COMBINE)) { if constexpr (YS_FP8) { for (int m = 2 * gw; m < T; m += 2 * NGW) combine_rows8x2(m, lane, out, MOD, (const unsigned char*)YS, ROWPAIR, (X1_DELTA && !X1_BF16) ? x : nullptr, X1_DELTA ? (const bf16*)(ws + (X1_BF16 ? WS_X1B : WS_DELTA)) : nullptr, FSK ? cbt : nullptr); } else { for (int m = gw; m < T; m += NGW) combine_row(m, lane, out, MOD, YS, ROWPAIR); } }
#undef IN
#undef SEAM
}

static int g_grid = 0;
static void mk_setup() {
    if (g_grid != 0) return;
    int dev = 0, cus = 0, per_cu = 0;
    if (hipGetDevice(&dev) != hipSuccess || hipDeviceGetAttribute(&cus, hipDeviceAttributeMultiprocessorCount, dev) != hipSuccess) { fprintf(stderr, "kernel_launch: device query failed\n"); g_grid = -1; return; }
    if (hipFuncSetAttribute((const void*)mk_fwd, hipFuncAttributeMaxDynamicSharedMemorySize, LDS_BYTES) != hipSuccess) { fprintf(stderr, "kernel_launch: hipFuncSetAttribute failed\n"); g_grid = -1; return; }
    if (hipOccupancyMaxActiveBlocksPerMultiprocessor(&per_cu, (const void*)mk_fwd, NWAVES * 64, LDS_BYTES) != hipSuccess || per_cu < 1) { fprintf(stderr, "kernel_launch: occupancy query says %d workgroups per CU\n", per_cu); (void)hipGetLastError(); g_grid = -1; return; }
    g_grid = cus;
    (void)hipFuncSetAttribute((const void*)k_norm2_router, hipFuncAttributeMaxDynamicSharedMemorySize, 32 * 1024 * 4 + 256 + 4096);
}
static void mk_launch(const Args& base, int lo, int hi, int li, hipStream_t stream) {
    Args a = base; a.ph_lo = lo; a.ph_hi = hi; a.li = li; a.pad = 0;
    hipLaunchKernelGGL(mk_fwd, dim3(g_grid), dim3(NWAVES * 64), LDS_BYTES, stream, a);
}

extern "C" void kernel_launch(void* const* d_in, const int* in_sizes, int n_in, void* d_out, int out_size, void* d_ws, size_t ws_size, hipStream_t stream) {
    if (n_in != 30 || out_size != T * D || ws_size < WS_END) { fprintf(stderr, "kernel_launch: unexpected shapes (n_in %d out %d ws %zu)\n", n_in, out_size, ws_size); return; }
    mk_setup(); if (g_grid < 0) return;
    Args base{};
    for (int i = 0; i < 30; ++i) base.in[i] = (const float*)d_in[i];
    base.out = (float*)d_out; base.ws = (unsigned char*)d_ws;
    (void)hipMemsetAsync((char*)d_ws + WS_CTL, 0, CTL_ZERO_BYTES, stream);
#if MK_MODE == 1
    mk_launch(base, 0, P_COUNT, 0, stream);
#else
    const float* x = (const float*)d_in[0]; const float* c = (const float*)d_in[1]; const float* w_ada = (const float*)d_in[2]; const float* b_ada = (const float*)d_in[3];
    const float* norm_mix = (const float*)d_in[4]; const float* w_in = (const float*)d_in[5]; const float* b_in = (const float*)d_in[6];
    const float* q_norm = (const float*)d_in[7]; const float* k_norm = (const float*)d_in[8]; const float* sinks = (const float*)d_in[9];
    const float* lam_re = (const float*)d_in[10]; const float* lam_im = (const float*)d_in[11]; const float* log_dt = (const float*)d_in[12];
    const float* b_re = (const float*)d_in[13]; const float* b_im = (const float*)d_in[14]; const float* c_re = (const float*)d_in[15]; const float* c_im = (const float*)d_in[16];
    const float* d_skip = (const float*)d_in[17]; const float* w_glu = (const float*)d_in[18]; const float* b_glu = (const float*)d_in[19];
    const float* attn_out_norm = (const float*)d_in[20]; const float* ssm_out_norm = (const float*)d_in[21]; const float* w_out = (const float*)d_in[22];
    const float* norm_ffn = (const float*)d_in[23]; const float* w_router = (const float*)d_in[24]; const float* b_router = (const float*)d_in[25];
    const float* w_gate_up = (const float*)d_in[26]; const float* b_gate_up = (const float*)d_in[27]; const float* w_down = (const float*)d_in[28]; const float* b_down = (const float*)d_in[29];
    unsigned char* ws = (unsigned char*)d_ws; float* out = (float*)d_out;
    float* MOD = (float*)(ws + WS_MOD); float* SSMT = (float*)(ws + WS_SSMT);
    bf16* WTIN = (bf16*)(ws + WS_WTIN); bf16* WTGLU = (bf16*)(ws + WS_WTGLU); bf16* WTOUT = (bf16*)(ws + WS_WTOUT); bf16* WTGU = (bf16*)(ws + WS_WTGU); bf16* WTDN = (bf16*)(ws + WS_WTDN);
    bf16* H = (bf16*)(ws + WS_H); bf16* PROJ = (bf16*)(ws + WS_PROJ); bf16* ATT = (bf16*)(ws + WS_ATT); bf16* Gb = (bf16*)(ws + WS_G); bf16* SSMG = (bf16*)(ws + WS_SSMG); bf16* MIXED = (bf16*)(ws + WS_MIXED);
    int* TOPE = (int*)(ws + WS_TOPE); float* TOPW = (float*)(ws + WS_TOPW); int* HIST = (int*)(ws + WS_HIST); int* TOKROW = (int*)(ws + WS_TOKROW); int* ROWPAIR = (int*)(ws + WS_ROWPAIR);
    float* WROW = (float*)(ws + WS_WROW); int* TILEE = (int*)(ws + WS_TILEE); bf16* ACT = (bf16*)(ws + WS_ACT); bf16* YS = (bf16*)(ws + WS_YS);
    float* XST = (float*)(ws + WS_XST); float* SC = (float*)(ws + WS_SC);
#ifndef REF_PRO
#define REF_PRO 1
#endif
#ifndef REF_NORM1
#define REF_NORM1 1
#endif
#ifndef REF_INPROJ
#define REF_INPROJ 1
#endif
#ifndef REF_MIX
#define REF_MIX 1
#endif
#ifndef REF_GLU
#define REF_GLU 1
#endif
#ifndef REF_MIXNORM
#define REF_MIXNORM 1
#endif
#ifndef REF_OUTPROJ
#define REF_OUTPROJ 1
#endif
#ifndef REF_ROUTER
#define REF_ROUTER 1
#endif
#ifndef REF_SORT
#define REF_SORT 1
#endif
#ifndef REF_GATEUP
#define REF_GATEUP 1
#endif
#ifndef REF_DOWN
#define REF_DOWN 1
#endif
#ifndef REF_COMBINE
#define REF_COMBINE 1
#endif
    int li = 0;
    if (REF_PRO) {
        hipLaunchKernelGGL(k_transpose_cvt, dim3(DIN / 32, D / 32, 1), dim3(32, 8), 0, stream, w_in, WTIN, D, DIN, 0);
        hipLaunchKernelGGL(k_transpose_cvt, dim3(DSSM / 32, DSSM / 32, 1), dim3(32, 8), 0, stream, w_glu, WTGLU, DSSM, DSSM, 0);
        hipLaunchKernelGGL(k_transpose_cvt, dim3(D / 32, D / 32, 1), dim3(32, 8), 0, stream, w_out, WTOUT, D, D, 0);
        hipLaunchKernelGGL(k_transpose_cvt, dim3(2 * DFF / 32, D / 32, NE), dim3(32, 8), 0, stream, w_gate_up, WTGU, D, 2 * DFF, 1);
        hipLaunchKernelGGL(k_transpose_cvt, dim3(D / 32, DFF / 32, NE), dim3(32, 8), 0, stream, w_down, WTDN, DFF, D, 0);
        hipLaunchKernelGGL(k_mod, dim3(6 * D / 256), dim3(256), 0, stream, c, w_ada, b_ada, MOD);
        hipLaunchKernelGGL(k_ssm_tables, dim3(NG * NST / 256), dim3(256), 0, stream, lam_re, lam_im, log_dt, b_re, b_im, SSMT);
    } else mk_launch(base, P_PRO, P_PRO + 1, li++, stream);
    if (REF_NORM1) hipLaunchKernelGGL(k_norm_mod, dim3(T / 4), dim3(256), 0, stream, x, norm_mix, (const float*)MOD, 0, D, H);
    else mk_launch(base, P_NORM1, P_NORM1 + 1, li++, stream);
    if (REF_INPROJ) { NEpiProj e{}; e.A = H; e.Bt = WTIN; e.bias = b_in; e.O = PROJ; hipLaunchKernelGGL(k_gemm_naive<NEpiProj>, dim3(T, DIN / 256), dim3(256), 0, stream, e, DIN, D); }
    else mk_launch(base, P_INPROJ, P_INPROJ + 1, li++, stream);
    if (REF_MIX) {
        hipLaunchKernelGGL(k_attn_scores, dim3(T * NH / 256), dim3(256), 0, stream, (const bf16*)PROJ, q_norm, k_norm, SC);
        hipLaunchKernelGGL(k_attn_out, dim3(T * NH * HD / 256), dim3(256), 0, stream, (const bf16*)PROJ, (const float*)SC, sinks, ATT);
        hipLaunchKernelGGL(k_ssm_scan, dim3(NB * NG * NST / 64), dim3(64), 0, stream, (const bf16*)PROJ, (const float*)SSMT, XST);
        hipLaunchKernelGGL(k_ssm_out, dim3(T * DSSM / 256), dim3(256), 0, stream, (const bf16*)PROJ, (const float*)XST, c_re, c_im, d_skip, Gb);
    } else { mk_launch(base, P_MIX_A, P_MIX_A + 1, li++, stream); mk_launch(base, P_MIX_B, P_MIX_B + 1, li++, stream); }
    if (REF_GLU) { NEpiGlu e{}; e.A = Gb; e.Bt = WTGLU; e.bias = b_glu; e.O = SSMG; hipLaunchKernelGGL(k_gemm_naive<NEpiGlu>, dim3(T, DSSM / 256), dim3(256), 0, stream, e, DSSM, DSSM); }
    else mk_launch(base, P_GLU, P_GLU + 1, li++, stream);
    if (REF_MIXNORM) hipLaunchKernelGGL(k_mixnorm, dim3(T / 4), dim3(256), 0, stream, (const bf16*)ATT, (const bf16*)SSMG, attn_out_norm, ssm_out_norm, MIXED);
    else mk_launch(base, P_MIXNORM, P_MIXNORM + 1, li++, stream);
    if (REF_OUTPROJ) { NEpiOut e{}; e.A = MIXED; e.Bt = WTOUT; e.x = x; e.mod = MOD; e.O = out; hipLaunchKernelGGL(k_gemm_naive<NEpiOut>, dim3(T, D / 256), dim3(256), 0, stream, e, D, D); }
    else mk_launch(base, P_OUTPROJ, P_OUTPROJ + 1, li++, stream);
    if (REF_ROUTER) hipLaunchKernelGGL(k_norm2_router, dim3(256), dim3(512), 32 * 1024 * 4 + 256 + 4096, stream, (const float*)out, norm_ffn, (const float*)MOD, w_router, b_router, H, TOPE, TOPW, HIST);
    else mk_launch(base, P_ROUTER, P_ROUTER + 1, li++, stream);
    if (REF_SORT) hipLaunchKernelGGL(k_sort, dim3(256), dim3(512), 0, stream, (const int*)HIST, (const int*)TOPE, (const float*)TOPW, TOKROW, ROWPAIR, WROW, TILEE);
    else mk_launch(base, P_SORT, P_SORT + 1, li++, stream);
    if (REF_GATEUP) { NEpiGU e{}; e.H = H; e.Wt = WTGU; e.bias = b_gate_up; e.tokrow = TOKROW; e.tilee = TILEE; e.ACT = ACT; hipLaunchKernelGGL(k_moe_gu_naive, dim3(MPAD, DFF / 256), dim3(256), 0, stream, e); }
    else mk_launch(base, P_GATEUP, P_GATEUP + 1, li++, stream);
    if (REF_DOWN) { NEpiDown e{}; e.ACT = ACT; e.Wt = WTDN; e.bias = b_down; e.wrow = WROW; e.tilee = TILEE; e.YS = YS; hipLaunchKernelGGL(k_gemm_naive<NEpiDown>, dim3(MPAD, D / 256), dim3(256), 0, stream, e, D, DFF); }
    else mk_launch(base, P_DOWN, P_DOWN + 1, li++, stream);
    if (REF_COMBINE) hipLaunchKernelGGL(k_combine, dim3(T / 4), dim3(256), 0, stream, out, (const float*)MOD, (const bf16*)YS, (const int*)ROWPAIR);
    else mk_launch(base, P_COMBINE, P_COMBINE + 1, li++, stream);
#endif
}
```

```cpp
#include <hip/hip_runtime.h>
#include <stdint.h>
#include <stdio.h>

#ifndef FAST_ATTN
#define FAST_ATTN 1
#endif
#ifndef FAST_SSM
#define FAST_SSM 1
#endif
#ifndef MOE_FP8_GU
#define MOE_FP8_GU 1
#endif
#ifndef MOE_FP8_DN
#define MOE_FP8_DN 1
#endif
#ifndef YS_FP8
#define YS_FP8 1
#endif
#ifndef P3_CONV
#define P3_CONV 0
#endif
#ifndef FUSE_MIXNORM
#define FUSE_MIXNORM 1
#endif
#ifndef X1_DELTA
#define X1_DELTA 1
#endif
#ifndef SSM_MFMA_CARRY
#define SSM_MFMA_CARRY 1
#endif
#ifndef X1_BF16
#define X1_BF16 1
#endif
#ifndef FAST_SORT
#define FAST_SORT 1
#endif
#ifndef FAST_ROUTER
#define FAST_ROUTER 1
#endif
#ifndef MK_MODE
#define MK_MODE 1
#endif

typedef unsigned short bf16;
typedef float f32x4 __attribute__((ext_vector_type(4)));
typedef float f32x2 __attribute__((ext_vector_type(2)));
typedef unsigned u32x4 __attribute__((ext_vector_type(4)));
typedef unsigned u32x2 __attribute__((ext_vector_type(2)));
typedef short bf16x8 __attribute__((ext_vector_type(8)));
typedef int i32x4 __attribute__((ext_vector_type(4)));
typedef int i32x8 __attribute__((ext_vector_type(8)));
constexpr float W8_SCALE = 32.0f, H8_SCALE = 4.0f, A8_SCALE = 4.0f, Y8_SCALE = 16.0f;
#define GAS __attribute__((address_space(1)))
#define LAS __attribute__((address_space(3)))

constexpr int D = 1024, NB = 8, S = 2048, T = NB * S;
constexpr int DATT = 512, HD = 64, NH = 8, NKV = 2, DKV = 128;
constexpr int DSSM = 512, SG = 16, NG = 32, NST = 64;
constexpr int DIN = 1280, NE = 32, TOPK = 4, DFF = 1024;
constexpr int QOFF = 0, KOFF = 512, VOFF = 640, UOFF = 768;
constexpr float EPS = 1e-6f;
constexpr int MAXTILES = 288, MPAD = MAXTILES * 256;

constexpr size_t MiB = 1u << 20;
constexpr size_t WS_CTL = 0, CTL_ZERO_BYTES = 256 * 1024;
constexpr size_t WS_MOD = 1 * MiB;
constexpr size_t WS_SSMT = 2 * MiB;
constexpr size_t WS_WTIN = 4 * MiB;
constexpr size_t WS_WTGLU = 7 * MiB;
constexpr size_t WS_WTOUT = 8 * MiB;
constexpr size_t WS_WTGU = 16 * MiB;
constexpr size_t WS_WTDN = 144 * MiB;
constexpr size_t WS_H = 208 * MiB;
constexpr size_t WS_PROJ = 240 * MiB;
constexpr size_t WS_ATT = 280 * MiB;
constexpr size_t WS_G = 296 * MiB;
constexpr size_t WS_SSMG = 312 * MiB;
constexpr size_t WS_MIXED = 328 * MiB;
constexpr size_t WS_TOPE = 360 * MiB;
constexpr size_t WS_TOPW = 361 * MiB;
constexpr size_t WS_HIST = 362 * MiB;
constexpr size_t WS_TOKROW = 363 * MiB;
constexpr size_t WS_ROWPAIR = 364 * MiB;
constexpr size_t WS_WROW = 365 * MiB;
constexpr size_t WS_TILEE = 366 * MiB;
constexpr size_t WS_CNT = 1024;
constexpr int CNT_STRIDE = 64;
constexpr size_t WS_TOKE = 332 * MiB;
constexpr size_t WS_WROWE = 336 * MiB;
constexpr size_t WS_APOW = 340 * MiB;
constexpr size_t WS_DELTA = 624 * MiB;
constexpr size_t WS_H8 = 660 * MiB;
constexpr size_t WS_WRI = 367 * MiB;
constexpr size_t WS_ACT = 368 * MiB;
constexpr size_t WS_YS = 512 * MiB;
constexpr size_t WS_XST = 368 * MiB;
constexpr size_t WS_SC = 624 * MiB;
constexpr size_t WS_X1B = 700 * MiB;
constexpr size_t WS_END = 740 * MiB;
constexpr int CW_BAR = 4096;

constexpr int ST_AR = 0, ST_AI = 64, ST_BR = 128, ST_BI = 128 + 1024, SSMT_STRIDE = 128 + 2048;

__host__ __device__ __forceinline__ int gu_row(int n) { const int j = n >> 1, half = n & 1; return (j >> 7) * 256 + half * 128 + (j & 127); }

__device__ __forceinline__ unsigned f2bf(float f) { unsigned u = __builtin_bit_cast(unsigned, f); return (u + 0x7fffu + ((u >> 16) & 1u)) >> 16; }
__device__ __forceinline__ float bf2f(unsigned b) { return __builtin_bit_cast(float, (b & 0xffffu) << 16); }
__device__ __forceinline__ unsigned pk2(float lo, float hi) { return f2bf(lo) | (f2bf(hi) << 16); }
__device__ __forceinline__ unsigned pk4_fp8(float a, float b, float c, float d) { unsigned w = 0u; w = __builtin_amdgcn_cvt_pk_fp8_f32(a, b, w, false); w = __builtin_amdgcn_cvt_pk_fp8_f32(c, d, w, true); return w; }
__device__ __forceinline__ float bflo(unsigned w) { return __builtin_bit_cast(float, w << 16); }
__device__ __forceinline__ float bfhi(unsigned w) { return __builtin_bit_cast(float, w & 0xffff0000u); }
__device__ __forceinline__ float wave_sum(float v) {
#pragma unroll
    for (int o = 1; o < 64; o <<= 1) v += __shfl_xor(v, o);
    return v;
}
__device__ __forceinline__ float sigmoidf_(float x) { return __builtin_amdgcn_rcpf(1.0f + __expf(-x)); }
__device__ __forceinline__ float gelu_tanh(float x) { const float u2 = 1.5957691216057308f * (x + 0.044715f * x * x * x); return x * sigmoidf_(u2); }
__device__ __forceinline__ float dot8(u32x4 a, u32x4 b, float acc) {
    acc = fmaf(bflo(a.x), bflo(b.x), acc); acc = fmaf(bfhi(a.x), bfhi(b.x), acc);
    acc = fmaf(bflo(a.y), bflo(b.y), acc); acc = fmaf(bfhi(a.y), bfhi(b.y), acc);
    acc = fmaf(bflo(a.z), bflo(b.z), acc); acc = fmaf(bfhi(a.z), bfhi(b.z), acc);
    acc = fmaf(bflo(a.w), bflo(b.w), acc); acc = fmaf(bfhi(a.w), bfhi(b.w), acc);
    return acc;
}

__device__ __forceinline__ void ssm_table_item(int i, const float* lam_re, const float* lam_im, const float* log_dt, const float* b_re, const float* b_im, float* tab) {
    const int g = i / NST, p = i % NST;
    const float lr = lam_re[i], li = lam_im[i], dt = expf(log_dt[g]);
    const float mag = expf(lr * dt), ang = li * dt;
    const float lbr = mag * cosf(ang), lbi = mag * sinf(ang);
    const float den = lr * lr + li * li;
    const float cr = ((lbr - 1.0f) * lr + lbi * li) / den, ci = (lbi * lr - (lbr - 1.0f) * li) / den;
    float* t = tab + (size_t)g * SSMT_STRIDE;
    t[ST_AR + p] = lbr; t[ST_AI + p] = lbi;
    for (int h = 0; h < SG; ++h) { const float br = b_re[(size_t)i * SG + h], bi = b_im[(size_t)i * SG + h];
        t[ST_BR + p * SG + h] = cr * br - ci * bi; t[ST_BI + p * SG + h] = cr * bi + ci * br; }
}
__device__ __forceinline__ void norm_mod_row(int row, int lane, const float* x, const float* gain, const float* mod, int sh_off, int sc_off, bf16* H) {
    const int b = row / S;
    const f32x4* xr = (const f32x4*)(x + (size_t)row * D) + lane;
    f32x4 v[4]; float s = 0.f;
#pragma unroll
    for (int j = 0; j < 4; ++j) { v[j] = xr[64 * j]; s += (v[j].x * v[j].x + v[j].y * v[j].y) + (v[j].z * v[j].z + v[j].w * v[j].w); }
    const float r = rsqrtf(wave_sum(s) * (1.0f / D) + EPS);
    u32x2* o = (u32x2*)(H + (size_t)row * D) + lane;
#pragma unroll
    for (int j = 0; j < 4; ++j) { const int c = 4 * lane + 256 * j;
        const f32x4 g = *(const f32x4*)(gain + c), sc = *(const f32x4*)(mod + b * 6 * D + sc_off + c), sh = *(const f32x4*)(mod + b * 6 * D + sh_off + c);
        f32x4 y; y.x = v[j].x * r * g.x * (1.f + sc.x) + sh.x; y.y = v[j].y * r * g.y * (1.f + sc.y) + sh.y; y.z = v[j].z * r * g.z * (1.f + sc.z) + sh.z; y.w = v[j].w * r * g.w * (1.f + sc.w) + sh.w;
        u32x2 w; w.x = pk2(y.x, y.y); w.y = pk2(y.z, y.w); o[64 * j] = w; }
}
__device__ __forceinline__ void mixnorm_row(int row, int lane, const bf16* ATT, const bf16* SSMG, const float* ga, const float* gs, bf16* MIXED) {
    const u32x4 a = *((const u32x4*)(ATT + (size_t)row * DATT) + lane), s = *((const u32x4*)(SSMG + (size_t)row * DSSM) + lane);
    const float av[8] = {bflo(a.x), bfhi(a.x), bflo(a.y), bfhi(a.y), bflo(a.z), bfhi(a.z), bflo(a.w), bfhi(a.w)};
    const float sv[8] = {bflo(s.x), bfhi(s.x), bflo(s.y), bfhi(s.y), bflo(s.z), bfhi(s.z), bflo(s.w), bfhi(s.w)};
    float qa = 0.f, qs = 0.f;
#pragma unroll
    for (int i = 0; i < 8; ++i) { qa += av[i] * av[i]; qs += sv[i] * sv[i]; }
    const float ra = rsqrtf(wave_sum(qa) * (1.0f / DATT) + EPS), rs = rsqrtf(wave_sum(qs) * (1.0f / DSSM) + EPS);
    const f32x4 ga0 = *(const f32x4*)(ga + 8 * lane), ga1 = *(const f32x4*)(ga + 8 * lane + 4), gs0 = *(const f32x4*)(gs + 8 * lane), gs1 = *(const f32x4*)(gs + 8 * lane + 4);
    u32x4 oa, os;
    oa.x = pk2(av[0] * ra * ga0.x, av[1] * ra * ga0.y); oa.y = pk2(av[2] * ra * ga0.z, av[3] * ra * ga0.w); oa.z = pk2(av[4] * ra * ga1.x, av[5] * ra * ga1.y); oa.w = pk2(av[6] * ra * ga1.z, av[7] * ra * ga1.w);
    os.x = pk2(sv[0] * rs * gs0.x, sv[1] * rs * gs0.y); os.y = pk2(sv[2] * rs * gs0.z, sv[3] * rs * gs0.w); os.z = pk2(sv[4] * rs * gs1.x, sv[5] * rs * gs1.y); os.w = pk2(sv[6] * rs * gs1.z, sv[7] * rs * gs1.w);
    *((u32x4*)(MIXED + (size_t)row * D) + lane) = oa; *((u32x4*)(MIXED + (size_t)row * D + DATT) + lane) = os;
}
__device__ __forceinline__ void combine_row(int row, int lane, float* out, const float* mod, const bf16* YS, const int* rowpair) {
    const int b = row / S; const int* rp = rowpair + (size_t)row * 4;
    const int r0 = rp[0], r1 = rp[1], r2 = rp[2], r3 = rp[3];
#pragma unroll
    for (int j = 0; j < 2; ++j) { const int c = 8 * lane + 512 * j;
        const u32x4 a = *(const u32x4*)(YS + (size_t)r0 * D + c), b2 = *(const u32x4*)(YS + (size_t)r1 * D + c), c2 = *(const u32x4*)(YS + (size_t)r2 * D + c), d2 = *(const u32x4*)(YS + (size_t)r3 * D + c);
        float y[8];
        y[0] = bflo(a.x) + bflo(b2.x) + bflo(c2.x) + bflo(d2.x); y[1] = bfhi(a.x) + bfhi(b2.x) + bfhi(c2.x) + bfhi(d2.x);
        y[2] = bflo(a.y) + bflo(b2.y) + bflo(c2.y) + bflo(d2.y); y[3] = bfhi(a.y) + bfhi(b2.y) + bfhi(c2.y) + bfhi(d2.y);
        y[4] = bflo(a.z) + bflo(b2.z) + bflo(c2.z) + bflo(d2.z); y[5] = bfhi(a.z) + bfhi(b2.z) + bfhi(c2.z) + bfhi(d2.z);
        y[6] = bflo(a.w) + bflo(b2.w) + bflo(c2.w) + bflo(d2.w); y[7] = bfhi(a.w) + bfhi(b2.w) + bfhi(c2.w) + bfhi(d2.w);
        float* op = out + (size_t)row * D + c; const float* g2 = mod + b * 6 * D + 5 * D + c;
        f32x4 o0 = *(f32x4*)op, o1 = *(f32x4*)(op + 4); const f32x4 g0 = *(const f32x4*)g2, g1 = *(const f32x4*)(g2 + 4);
        o0.x += g0.x * y[0]; o0.y += g0.y * y[1]; o0.z += g0.z * y[2]; o0.w += g0.w * y[3]; o1.x += g1.x * y[4]; o1.y += g1.y * y[5]; o1.z += g1.z * y[6]; o1.w += g1.w * y[7];
        *(f32x4*)op = o0; *(f32x4*)(op + 4) = o1; }
}
__device__ __forceinline__ void combine_row8(int row, int lane, float* out, const float* mod, const unsigned char* YS8, const int* rowpair) {
    const int b = row / S; const i32x4 rp = *(const i32x4*)(rowpair + (size_t)row * 4); const int c = 16 * lane;
    const u32x4 q0 = *(const u32x4*)(YS8 + (size_t)rp.x * D + c), q1 = *(const u32x4*)(YS8 + (size_t)rp.y * D + c), q2 = *(const u32x4*)(YS8 + (size_t)rp.z * D + c), q3 = *(const u32x4*)(YS8 + (size_t)rp.w * D + c);
    float* op = out + (size_t)row * D + c; const float* g2 = mod + b * 6 * D + 5 * D + c;
#pragma unroll
    for (int j = 0; j < 4; ++j) { const unsigned w0 = q0[j], w1 = q1[j], w2 = q2[j], w3 = q3[j];
        const f32x2 lo = __builtin_amdgcn_cvt_pk_f32_fp8(w0, false) + __builtin_amdgcn_cvt_pk_f32_fp8(w1, false) + __builtin_amdgcn_cvt_pk_f32_fp8(w2, false) + __builtin_amdgcn_cvt_pk_f32_fp8(w3, false);
        const f32x2 hi = __builtin_amdgcn_cvt_pk_f32_fp8(w0, true) + __builtin_amdgcn_cvt_pk_f32_fp8(w1, true) + __builtin_amdgcn_cvt_pk_f32_fp8(w2, true) + __builtin_amdgcn_cvt_pk_f32_fp8(w3, true);
        f32x4 o = *(f32x4*)(op + 4 * j); const f32x4 g = *(const f32x4*)(g2 + 4 * j);
        o.x += g.x * lo.x * (1.0f / Y8_SCALE); o.y += g.y * lo.y * (1.0f / Y8_SCALE); o.z += g.z * hi.x * (1.0f / Y8_SCALE); o.w += g.w * hi.y * (1.0f / Y8_SCALE);
        *(f32x4*)(op + 4 * j) = o; }
}
__device__ __forceinline__ void combine_rows8x2(int row, int lane, float* out, const float* mod, const unsigned char* YS8, const int* rowpair, const float* xin = nullptr, const bf16* delta = nullptr, const LAS int* cb = nullptr) {
    const int b = row / S, c = 16 * lane; i32x4 rp0 = *(const i32x4*)(rowpair + (size_t)row * 4), rp1 = *(const i32x4*)(rowpair + (size_t)row * 4 + 4);
    if (FAST_SORT && cb) {
#pragma unroll
        for (int k = 0; k < 4; ++k) { rp0[k] = (rp0[k] & 0xFFFFF) + cb[32 + (rp0[k] >> 20)]; rp1[k] = (rp1[k] & 0xFFFFF) + cb[32 + (rp1[k] >> 20)]; } }
    u32x4 q[2][4];
    q[0][0] = *(const u32x4*)(YS8 + (size_t)rp0.x * D + c); q[0][1] = *(const u32x4*)(YS8 + (size_t)rp0.y * D + c); q[0][2] = *(const u32x4*)(YS8 + (size_t)rp0.z * D + c); q[0][3] = *(const u32x4*)(YS8 + (size_t)rp0.w * D + c);
    q[1][0] = *(const u32x4*)(YS8 + (size_t)rp1.x * D + c); q[1][1] = *(const u32x4*)(YS8 + (size_t)rp1.y * D + c); q[1][2] = *(const u32x4*)(YS8 + (size_t)rp1.z * D + c); q[1][3] = *(const u32x4*)(YS8 + (size_t)rp1.w * D + c);
    const float* g2 = mod + b * 6 * D + 5 * D + c;
    f32x4 g[4], o[2][4];
#pragma unroll
    for (int j = 0; j < 4; ++j) { g[j] = *(const f32x4*)(g2 + 4 * j) * (1.0f / Y8_SCALE); const float* src = delta ? xin : out;
        if (src) { o[0][j] = *(const f32x4*)(src + (size_t)row * D + c + 4 * j); o[1][j] = *(const f32x4*)(src + (size_t)(row + 1) * D + c + 4 * j); } else { o[0][j] = (f32x4){0.f, 0.f, 0.f, 0.f}; o[1][j] = o[0][j]; } }
    if (delta) {
#pragma unroll
        for (int r = 0; r < 2; ++r) { const u32x4 d0 = *(const u32x4*)(delta + (size_t)(row + r) * D + c), d1 = *(const u32x4*)(delta + (size_t)(row + r) * D + c + 8);
            o[r][0] += (f32x4){bflo(d0.x), bfhi(d0.x), bflo(d0.y), bfhi(d0.y)}; o[r][1] += (f32x4){bflo(d0.z), bfhi(d0.z), bflo(d0.w), bfhi(d0.w)};
            o[r][2] += (f32x4){bflo(d1.x), bfhi(d1.x), bflo(d1.y), bfhi(d1.y)}; o[r][3] += (f32x4){bflo(d1.z), bfhi(d1.z), bflo(d1.w), bfhi(d1.w)}; } }
#pragma unroll
    for (int r = 0; r < 2; ++r)
#pragma unroll
        for (int j = 0; j < 4; ++j) { const unsigned w0 = q[r][0][j], w1 = q[r][1][j], w2 = q[r][2][j], w3 = q[r][3][j];
            const f32x2 lo = __builtin_amdgcn_cvt_pk_f32_fp8(w0, false) + __builtin_amdgcn_cvt_pk_f32_fp8(w1, false) + __builtin_amdgcn_cvt_pk_f32_fp8(w2, false) + __builtin_amdgcn_cvt_pk_f32_fp8(w3, false);
            const f32x2 hi = __builtin_amdgcn_cvt_pk_f32_fp8(w0, true) + __builtin_amdgcn_cvt_pk_f32_fp8(w1, true) + __builtin_amdgcn_cvt_pk_f32_fp8(w2, true) + __builtin_amdgcn_cvt_pk_f32_fp8(w3, true);
            f32x4 t = o[r][j]; t.x += g[j].x * lo.x; t.y += g[j].y * lo.y; t.z += g[j].z * hi.x; t.w += g[j].w * hi.y;
            *(f32x4*)(out + (size_t)(row + r) * D + c + 4 * j) = t; }
}
__device__ __forceinline__ void attn_scores_item(int idx, const bf16* PROJ, const float* qg, const float* kg, float* SC) {
    const int t = idx / NH, h = idx % NH, kvh = h / 4, b = t / S, tl = t % S;
    const bf16* q = PROJ + (size_t)t * DIN + QOFF + h * HD;
    float sq = 0.f;
    for (int d = 0; d < HD; ++d) { const float v = bf2f(q[d]); sq += v * v; }
    const float rq = rsqrtf(sq * (1.0f / HD) + EPS);
    for (int i = 0; i < 128; ++i) {
        const int sl = tl - 127 + i; float sc = -1e30f;
        if (sl >= 0) { const bf16* k = PROJ + (size_t)(b * S + sl) * DIN + KOFF + kvh * HD;
            float sk = 0.f, dt = 0.f;
            for (int d = 0; d < HD; ++d) { const float kv = bf2f(k[d]); sk += kv * kv; dt += bf2f(q[d]) * qg[d] * kv * kg[d]; }
            sc = dt * rq * rsqrtf(sk * (1.0f / HD) + EPS) * 0.125f; }
        SC[(size_t)idx * 128 + i] = sc; }
}
__device__ __forceinline__ void attn_out_item(int idx, const bf16* PROJ, const float* SC, const float* sinks, bf16* ATT) {
    const int d = idx % HD, th = idx / HD, h = th % NH, t = th / NH, kvh = h / 4, b = t / S, tl = t % S;
    const float* sc = SC + (size_t)th * 128; const float sink = sinks[h];
    float m = sink;
    for (int i = 0; i < 128; ++i) m = fmaxf(m, sc[i]);
    float den = __expf(sink - m), o = 0.f;
    for (int i = 0; i < 128; ++i) { const int sl = tl - 127 + i; if (sl < 0) continue;
        const float p = __expf(sc[i] - m); den += p; o += p * bf2f(PROJ[(size_t)(b * S + sl) * DIN + VOFF + kvh * HD + d]); }
    ATT[(size_t)t * DATT + h * HD + d] = (bf16)f2bf(o / den);
}
__device__ __forceinline__ void ssm_scan_item(int idx, const bf16* PROJ, const float* tab, float* XST) {
    const int p = idx % NST, g = (idx / NST) % NG, b = idx / (NST * NG);
    const float* tg = tab + (size_t)g * SSMT_STRIDE;
    const float ar = tg[ST_AR + p], ai = tg[ST_AI + p];
    float br[SG], bi[SG];
#pragma unroll
    for (int h = 0; h < SG; ++h) { br[h] = tg[ST_BR + p * SG + h]; bi[h] = tg[ST_BI + p * SG + h]; }
    float xr = 0.f, xi = 0.f;
    for (int t = 0; t < S; ++t) {
        const u32x4* up = (const u32x4*)(PROJ + (size_t)(b * S + t) * DIN + UOFF + g * SG);
        const u32x4 u0 = up[0], u1 = up[1];
        const float u[SG] = {bflo(u0.x), bfhi(u0.x), bflo(u0.y), bfhi(u0.y), bflo(u0.z), bfhi(u0.z), bflo(u0.w), bfhi(u0.w),
                             bflo(u1.x), bfhi(u1.x), bflo(u1.y), bfhi(u1.y), bflo(u1.z), bfhi(u1.z), bflo(u1.w), bfhi(u1.w)};
        float bur = 0.f, bui = 0.f;
#pragma unroll
        for (int h = 0; h < SG; ++h) { bur = fmaf(br[h], u[h], bur); bui = fmaf(bi[h], u[h], bui); }
        const float nr = ar * xr - ai * xi + bur, ni = ar * xi + ai * xr + bui; xr = nr; xi = ni;
        float* o = XST + (((size_t)(b * S + t) * NG + g) * NST + p) * 2; o[0] = xr; o[1] = xi;
    }
}
__device__ __forceinline__ void ssm_out_item(int idx, const bf16* PROJ, const float* XST, const float* c_re, const float* c_im, const float* d_skip, bf16* G) {
    const int ch = idx % DSSM, t = idx / DSSM, g = ch / SG, h = ch % SG;
    const float* x = XST + ((size_t)t * NG + g) * NST * 2; const float* cr = c_re + ((size_t)g * SG + h) * NST; const float* ci = c_im + ((size_t)g * SG + h) * NST;
    float y = 0.f;
    for (int p = 0; p < NST; ++p) y += cr[p] * x[2 * p] - ci[p] * x[2 * p + 1];
    y += d_skip[ch] * bf2f(PROJ[(size_t)t * DIN + UOFF + ch]);
    G[(size_t)t * DSSM + ch] = (bf16)f2bf(gelu_tanh(y));
}
__device__ __forceinline__ void norm2_router_rows(int blk, int wave, int lane, const float* x1, const float* gain, const float* mod, const float* b_router,
                                                  const LAS float* wr, LAS int* lh, LAS float* xs, bf16* H, int* tope, float* topw, unsigned char* H8 = nullptr) {
    const int b = (blk * 64) / S;
    f32x4 gm[4], sh[4];
#pragma unroll
    for (int j = 0; j < 4; ++j) { const int c = 4 * lane + 256 * j; const f32x4 g = *(const f32x4*)(gain + c), sc = *(const f32x4*)(mod + b * 6 * D + 4 * D + c);
        gm[j] = g * (1.0f + sc); sh[j] = *(const f32x4*)(mod + b * 6 * D + 3 * D + c); }
    const int my_e = lane >> 1; const float my_b = b_router[my_e];
    LAS float* lg = xs + wave * 128;
    LAS int* sel_e = (LAS int*)(xs + wave * 128 + 64);
    LAS float* sel_v = xs + wave * 128 + 72;
#pragma unroll 1
    for (int i = 0; i < 8; i += 2) {
        const int row0 = blk * 64 + wave * 8 + i;
        f32x4 v[2][4]; float ssq[2];
#pragma unroll
        for (int r = 0; r < 2; ++r) { const f32x4* xr = (const f32x4*)(x1 + (size_t)(row0 + r) * D) + lane; float s = 0.f;
#pragma unroll
            for (int j = 0; j < 4; ++j) { v[r][j] = xr[64 * j]; s += (v[r][j].x * v[r][j].x + v[r][j].y * v[r][j].y) + (v[r][j].z * v[r][j].z + v[r][j].w * v[r][j].w); }
            ssq[r] = s; }
#pragma unroll
        for (int o2 = 1; o2 < 64; o2 <<= 1) { ssq[0] += __shfl_xor(ssq[0], o2); asm volatile("" : "+v"(ssq[0])); ssq[1] += __shfl_xor(ssq[1], o2); asm volatile("" : "+v"(ssq[1])); }
#pragma unroll
        for (int r = 0; r < 2; ++r) { const float rs = rsqrtf(ssq[r] * (1.0f / D) + EPS); u32x2* o = (u32x2*)(H + (size_t)(row0 + r) * D) + lane;
#pragma unroll
            for (int j = 0; j < 4; ++j) { v[r][j] = v[r][j] * rs * gm[j] + sh[j]; if (H) { u32x2 w; w.x = pk2(v[r][j].x, v[r][j].y); w.y = pk2(v[r][j].z, v[r][j].w); o[64 * j] = w; }
                if (H8) *(unsigned*)(H8 + (size_t)(row0 + r) * D + 4 * lane + 256 * j) = pk4_fp8(v[r][j].x * H8_SCALE, v[r][j].y * H8_SCALE, v[r][j].z * H8_SCALE, v[r][j].w * H8_SCALE); } }
        float pe0[NE], pe1[NE];
#pragma unroll
        for (int e = 0; e < NE; ++e) { float a0 = 0.f, a1 = 0.f;
#pragma unroll
            for (int j = 0; j < 4; ++j) { const f32x4 w = *(const LAS f32x4*)(wr + e * D + 4 * lane + 256 * j);
                a0 += (v[0][j].x * w.x + v[0][j].y * w.y) + (v[0][j].z * w.z + v[0][j].w * w.w); asm volatile("" : "+v"(a0)); a1 += (v[1][j].x * w.x + v[1][j].y * w.y) + (v[1][j].z * w.z + v[1][j].w * w.w); asm volatile("" : "+v"(a1)); }
            pe0[e] = a0; pe1[e] = a1; }
#define BFLY(half, bit) { const bool up = (lane & (bit)) != 0; _Pragma("unroll") for (int k = 0; k < (half); ++k) { \
            const float k0 = up ? pe0[(half) + k] : pe0[k], s0 = up ? pe0[k] : pe0[(half) + k], k1 = up ? pe1[(half) + k] : pe1[k], s1 = up ? pe1[k] : pe1[(half) + k]; \
            pe0[k] = k0 + __shfl_xor(s0, (bit)); asm volatile("" : "+v"(pe0[k])); pe1[k] = k1 + __shfl_xor(s1, (bit)); asm volatile("" : "+v"(pe1[k])); } }
        BFLY(16, 32) BFLY(8, 16) BFLY(4, 8) BFLY(2, 4) BFLY(1, 2)
#undef BFLY
        const float l0 = pe0[0] + __shfl_xor(pe0[0], 1) + my_b, l1 = pe1[0] + __shfl_xor(pe1[0], 1) + my_b;
        if ((lane & 1) == 0) { lg[my_e] = l0; lg[32 + my_e] = l1; }
        asm volatile("s_waitcnt lgkmcnt(0)" ::: "memory");
        int rk0 = 0, rk1 = 0;
#pragma unroll
        for (int q = 0; q < 8; ++q) { const f32x4 a = *(const LAS f32x4*)(lg + 4 * q), c = *(const LAS f32x4*)(lg + 32 + 4 * q);
#pragma unroll
            for (int t = 0; t < 4; ++t) { const int e2 = 4 * q + t; rk0 += (a[t] > l0 || (a[t] == l0 && e2 < my_e)) ? 1 : 0; rk1 += (c[t] > l1 || (c[t] == l1 && e2 < my_e)) ? 1 : 0; } }
        if ((lane & 1) == 0) { if (rk0 < 4) { sel_e[rk0] = my_e; sel_v[rk0] = l0; } if (rk1 < 4) { sel_e[4 + rk1] = my_e; sel_v[4 + rk1] = l1; } }
        asm volatile("s_waitcnt lgkmcnt(0)" ::: "memory");
        if (lane < 2) { const i32x4 ee = *(const LAS i32x4*)(sel_e + 4 * lane); const f32x4 vv = *(const LAS f32x4*)(sel_v + 4 * lane);
            const int e0 = ee.x, e1 = ee.y, e2 = ee.z, e3 = ee.w;
            const float x1v = __expf(vv.y - vv.x), x2v = __expf(vv.z - vv.x), x3v = __expf(vv.w - vv.x), inv = 1.0f / (1.0f + x1v + x2v + x3v);
            int* te = tope + (size_t)(row0 + lane) * 4; float* tw = topw + (size_t)(row0 + lane) * 4;
            *(i32x4*)te = (i32x4){e0, e1, e2, e3}; *(f32x4*)tw = (f32x4){inv, x1v * inv, x2v * inv, x3v * inv};
            (void)__hip_atomic_fetch_add(&lh[e0], 1, __ATOMIC_RELAXED, __HIP_MEMORY_SCOPE_WORKGROUP); (void)__hip_atomic_fetch_add(&lh[e1], 1, __ATOMIC_RELAXED, __HIP_MEMORY_SCOPE_WORKGROUP);
            (void)__hip_atomic_fetch_add(&lh[e2], 1, __ATOMIC_RELAXED, __HIP_MEMORY_SCOPE_WORKGROUP); (void)__hip_atomic_fetch_add(&lh[e3], 1, __ATOMIC_RELAXED, __HIP_MEMORY_SCOPE_WORKGROUP); }
        asm volatile("s_waitcnt lgkmcnt(0)" ::: "memory");
    }
}
__device__ __forceinline__ void sort_block(int blk, int tid, LAS int* sm, const int* hist, const int* tope, const float* topw, int* tokrow, int* rowpair, float* wrow, int* tilee) {
    LAS int* tot = sm; LAS int* mine = sm + 32; LAS int* base = sm + 64; LAS int* es = sm + 128;
    { const int e = tid & 31, part = tid >> 5; int hv[16]; int a = 0, m = 0;
#pragma unroll
      for (int k = 0; k < 16; ++k) hv[k] = hist[(16 * part + k) * NE + e];
#pragma unroll
      for (int k = 0; k < 16; ++k) { a += hv[k]; if (16 * part + k < blk) m += hv[k]; }
      LAS int* pa = sm + 384; pa[part * 32 + e] = a; pa[512 + part * 32 + e] = m; }
    __syncthreads();
    if (tid < NE) { const LAS int* pa = sm + 384; int a = 0, m = 0;
#pragma unroll
        for (int p = 0; p < 16; ++p) { a += pa[p * 32 + tid]; m += pa[512 + p * 32 + tid]; } tot[tid] = a; mine[tid] = m; }
    __syncthreads();
    if (tid == 0) { int o = 0; for (int e = 0; e < NE; ++e) { base[e] = o; o += ((tot[e] + 255) >> 8) << 8; } base[NE] = o; }
    int my_e = 0, rank = 0;
    if (tid < 256) { my_e = tope[(size_t)(blk * 64) * 4 + tid]; const int lane = tid & 63, w = tid >> 6;
        const unsigned long long lt = (lane == 0) ? 0ull : (~0ull >> (64 - lane));
#pragma unroll 4
        for (int e = 0; e < NE; ++e) { const unsigned long long m = __ballot(my_e == e); if (my_e == e) rank = __popcll(m & lt); if (lane == 0) es[w * 32 + e] = __popcll(m); } }
    __syncthreads();
    if (tid < 256) { const int e = my_e, w = tid >> 6; for (int w2 = 0; w2 < w; ++w2) rank += es[w2 * 32 + e];
        const int pos = base[e] + mine[e] + rank, tok = blk * 64 + (tid >> 2);
        tokrow[pos] = tok; rowpair[(size_t)blk * 256 + tid] = pos; wrow[pos] = topw[(size_t)blk * 256 + tid]; }
    if (blk < NE) { const int e = blk; for (int r = base[e] + tot[e] + tid; r < base[e + 1]; r += 512) { tokrow[r] = 0; wrow[r] = 0.f; }
        for (int ti = (base[e] >> 8) + tid; ti < (base[e + 1] >> 8); ti += 512) tilee[64 + ti] = e; }
    if (blk == 0 && tid == 0) tilee[0] = base[NE] >> 8;
    __syncthreads();
}

__global__ void k_transpose_cvt(const float* __restrict__ W, bf16* __restrict__ WT, int K, int N, int perm_gu) {
    __shared__ float tile[32][33];
    const float* Wb = W + (size_t)blockIdx.z * K * N; bf16* WTb = WT + (size_t)blockIdx.z * K * N;
    const int n0 = blockIdx.x * 32, k0 = blockIdx.y * 32;
    for (int i = threadIdx.y; i < 32; i += 8) tile[i][threadIdx.x] = Wb[(size_t)(k0 + i) * N + n0 + threadIdx.x];
    __syncthreads();
    for (int i = threadIdx.y; i < 32; i += 8) { const int n = n0 + i, nr = perm_gu ? gu_row(n) : n; WTb[(size_t)nr * K + k0 + threadIdx.x] = (bf16)f2bf(tile[threadIdx.x][i]); }
}
__global__ void k_mod(const float* __restrict__ c, const float* __restrict__ w_ada, const float* __restrict__ b_ada, float* __restrict__ mod) {
    __shared__ float ca[NB][D];
    for (int i = threadIdx.x; i < NB * D; i += blockDim.x) { const float v = c[i]; ca[i / D][i % D] = v * sigmoidf_(v); }
    __syncthreads();
    const int j = blockIdx.x * blockDim.x + threadIdx.x;
    float acc[NB];
#pragma unroll
    for (int b = 0; b < NB; ++b) acc[b] = 0.f;
    for (int k = 0; k < D; ++k) { const float w = w_ada[(size_t)k * (6 * D) + j];
#pragma unroll
        for (int b = 0; b < NB; ++b) acc[b] = fmaf(ca[b][k], w, acc[b]); }
#pragma unroll
    for (int b = 0; b < NB; ++b) mod[b * 6 * D + j] = acc[b] + b_ada[j];
}
__global__ void k_ssm_tables(const float* lam_re, const float* lam_im, const float* log_dt, const float* b_re, const float* b_im, float* tab) {
    const int i = blockIdx.x * blockDim.x + threadIdx.x; if (i >= NG * NST) return;
    ssm_table_item(i, lam_re, lam_im, log_dt, b_re, b_im, tab);
}
__global__ void k_norm_mod(const float* x, const float* gain, const float* mod, int sh_off, int sc_off, bf16* H) {
    const int row = blockIdx.x * (blockDim.x / 64) + (threadIdx.x >> 6), lane = threadIdx.x & 63; if (row >= T) return;
    norm_mod_row(row, lane, x, gain, mod, sh_off, sc_off, H);
}
template <class Epi> __global__ void k_gemm_naive(Epi e, int N, int K) {
    const int n = blockIdx.y * blockDim.x + threadIdx.x, m = blockIdx.x; if (n >= N) return;
    if (!e.active(m)) return;
    const bf16* a = e.arow(m); const bf16* b = e.brow(m, n);
    float acc = 0.f;
    for (int k = 0; k < K; k += 8) acc = dot8(*(const u32x4*)(a + k), *(const u32x4*)(b + k), acc);
    e.store(m, n, acc);
}
struct NEpiProj { const bf16* A; const bf16* Bt; const float* bias; bf16* O;
    __device__ bool active(int) const { return true; }
    __device__ const bf16* arow(int m) const { return A + (size_t)m * D; }
    __device__ const bf16* brow(int, int n) const { return Bt + (size_t)n * D; }
    __device__ void store(int m, int n, float acc) const { O[(size_t)m * DIN + n] = (bf16)f2bf(acc + bias[n]); } };
struct NEpiGlu { const bf16* A; const bf16* Bt; const float* bias; bf16* O;
    __device__ bool active(int) const { return true; }
    __device__ const bf16* arow(int m) const { return A + (size_t)m * DSSM; }
    __device__ const bf16* brow(int, int n) const { return Bt + (size_t)n * DSSM; }
    __device__ void store(int m, int n, float acc) const { const float g = bf2f(A[(size_t)m * DSSM + n]); O[(size_t)m * DSSM + n] = (bf16)f2bf(g * sigmoidf_(acc + bias[n])); } };
struct NEpiOut { const bf16* A; const bf16* Bt; const float* x; const float* mod; float* O;
    __device__ bool active(int) const { return true; }
    __device__ const bf16* arow(int m) const { return A + (size_t)m * D; }
    __device__ const bf16* brow(int, int n) const { return Bt + (size_t)n * D; }
    __device__ void store(int m, int n, float acc) const { const int b = m / S; O[(size_t)m * D + n] = x[(size_t)m * D + n] + mod[b * 6 * D + 2 * D + n] * acc; } };
struct NEpiGU { const bf16* H; const bf16* Wt; const float* bias; const int* tokrow; const int* tilee; bf16* ACT; };
struct NEpiDown { const bf16* ACT; const bf16* Wt; const float* bias; const float* wrow; const int* tilee; bf16* YS;
    __device__ bool active(int m) const { return (m >> 8) < tilee[0]; }
    __device__ const bf16* arow(int m) const { return ACT + (size_t)m * DFF; }
    __device__ const bf16* brow(int m, int n) const { const int e = tilee[64 + (m >> 8)]; return Wt + ((size_t)e * D + n) * DFF; }
    __device__ void store(int m, int n, float acc) const { const int e = tilee[64 + (m >> 8)]; YS[(size_t)m * D + n] = (bf16)f2bf((acc + bias[e * D + n]) * wrow[m]); } };
__global__ void k_moe_gu_naive(NEpiGU e) {
    const int j = blockIdx.y * blockDim.x + threadIdx.x, m = blockIdx.x;
    if ((m >> 8) >= e.tilee[0]) return;
    const int ex = e.tilee[64 + (m >> 8)], t = e.tokrow[m];
    const bf16* a = e.H + (size_t)t * D; const bf16* b0 = e.Wt + ((size_t)ex * 2 * DFF + gu_row(2 * j)) * D; const bf16* b1 = e.Wt + ((size_t)ex * 2 * DFF + gu_row(2 * j + 1)) * D;
    float g = 0.f, u = 0.f;
    for (int k = 0; k < D; k += 8) { const u32x4 av = *(const u32x4*)(a + k); g = dot8(av, *(const u32x4*)(b0 + k), g); u = dot8(av, *(const u32x4*)(b1 + k), u); }
    g += e.bias[ex * 2 * DFF + 2 * j]; u += e.bias[ex * 2 * DFF + 2 * j + 1];
    g = fminf(g, 7.0f); u = fminf(fmaxf(u, -7.0f), 7.0f);
    e.ACT[(size_t)m * DFF + j] = (bf16)f2bf((u + 1.0f) * (g * sigmoidf_(1.702f * g)));
}
__global__ void k_attn_scores(const bf16* PROJ, const float* qg, const float* kg, float* SC) { const int idx = blockIdx.x * blockDim.x + threadIdx.x; if (idx < T * NH) attn_scores_item(idx, PROJ, qg, kg, SC); }
__global__ void k_attn_out(const bf16* PROJ, const float* SC, const float* sinks, bf16* ATT) { const int idx = blockIdx.x * blockDim.x + threadIdx.x; if (idx < T * NH * HD) attn_out_item(idx, PROJ, SC, sinks, ATT); }
__global__ void k_ssm_scan(const bf16* PROJ, const float* tab, float* XST) { const int idx = blockIdx.x * blockDim.x + threadIdx.x; if (idx < NB * NG * NST) ssm_scan_item(idx, PROJ, tab, XST); }
__global__ void k_ssm_out(const bf16* PROJ, const float* XST, const float* c_re, const float* c_im, const float* d_skip, bf16* G) { const int idx = blockIdx.x * blockDim.x + threadIdx.x; if (idx < T * DSSM) ssm_out_item(idx, PROJ, XST, c_re, c_im, d_skip, G); }
__global__ void k_mixnorm(const bf16* ATT, const bf16* SSMG, const float* ga, const float* gs, bf16* MIXED) {
    const int row = blockIdx.x * (blockDim.x / 64) + (threadIdx.x >> 6), lane = threadIdx.x & 63; if (row >= T) return;
    mixnorm_row(row, lane, ATT, SSMG, ga, gs, MIXED);
}
__global__ void __launch_bounds__(512) k_norm2_router(const float* x1, const float* gain, const float* mod, const float* w_router, const float* b_router, bf16* H, int* tope, float* topw, int* hist) {
    extern __shared__ __attribute__((aligned(16))) unsigned char smem[];
    LAS float* wr = (LAS float*)smem; LAS int* lh = (LAS int*)((LAS unsigned char*)smem + 32 * 1024 * 4);
    const int tid = threadIdx.x;
    for (int i = tid; i < D * NE; i += 512) { const int c = i / NE, e = i % NE; wr[e * D + c] = w_router[i]; }
    if (tid < NE) lh[tid] = 0;
    __syncthreads();
    norm2_router_rows(blockIdx.x, tid >> 6, tid & 63, x1, gain, mod, b_router, wr, lh, (LAS float*)((LAS unsigned char*)smem + 32 * 1024 * 4 + 256), H, tope, topw);
    __syncthreads();
    if (tid < NE) hist[blockIdx.x * NE + tid] = lh[tid];
}
__global__ void __launch_bounds__(512) k_sort(const int* hist, const int* tope, const float* topw, int* tokrow, int* rowpair, float* wrow, int* tilee) {
    __shared__ int sm[1408];
    sort_block(blockIdx.x, threadIdx.x, (LAS int*)sm, hist, tope, topw, tokrow, rowpair, wrow, tilee);
}
__global__ void k_combine(float* out, const float* mod, const bf16* YS, const int* rowpair) {
    const int row = blockIdx.x * (blockDim.x / 64) + (threadIdx.x >> 6), lane = threadIdx.x & 63; if (row >= T) return;
    combine_row(row, lane, out, mod, YS, rowpair);
}

namespace pg8 {
constexpr int BM = 256, BK = 64, HALF = 128, HTB = HALF * BK * 2  , STAGE_BYTES = 8 * HTB, NXCD = 8, WGM = 8;
__host__ __device__ __forceinline__ int lds_byte(int r, int c) { const int st = (r >> 4) * 2 + (c >> 5), rr = r & 15, cc = c & 31, ob = rr * 64 + cc * 2; return st * 1024 + (ob ^ (((ob >> 9) & 1) << 5)); }
__host__ __device__ __forceinline__ void stage_rc(int b, int& R, int& C) { const int st = b / 1024, sb = b % 1024, swz = sb ^ (((sb >> 9) & 1) << 5); R = (st >> 1) * 16 + swz / 64; C = (st & 1) * 32 + (swz % 64) / 2; }
__host__ __device__ __forceinline__ int perm32(int rho) { const int n = rho >> 4, i = rho & 15; return 8 * (i >> 2) + 4 * n + (i & 3); }
struct Unit { int pm, pn; };
__device__ __forceinline__ bool order_next(int nM, int nN, int G, int c, int i, Unit& u) {
    const int nwg = nM * nN; const long L = (long)i * G + c; if (L >= nwg) return false;
    int wgid = (int)L; { const int q = nwg / NXCD, r = nwg % NXCD, xcd = wgid % NXCD, off = wgid / NXCD; wgid = (xcd < r ? xcd * (q + 1) : r * (q + 1) + (xcd - r) * q) + off; }
    const int nig = WGM * nN, gid = wgid / nig, fm = gid * WGM, gsz = (nM - fm) < WGM ? (nM - fm) : WGM;
    u.pm = fm + ((wgid % nig) % gsz); u.pn = (wgid % nig) / gsz; return true;
}
struct DenseOrder {
    const char* A; const char* Bt; int nM, nN, G, c; size_t tstep;
    __device__ __forceinline__ bool next(int i, Unit& u) const { return order_next(nM, nN, G, c, i, u); }
    __device__ __forceinline__ const char* a_base(const Unit& u) const { return A + (size_t)u.pm * tstep; }
    __device__ __forceinline__ const char* b_base(const Unit& u) const { return Bt + (size_t)u.pn * tstep; }
    __device__ __forceinline__ int a_row(int) const { return 0; }
    __device__ __forceinline__ int ka(int K) const { return K; }
    __device__ __forceinline__ size_t a_koff(int t) const { return (size_t)t * (BK * 2); }
};
struct MixOrder {
    const char* A; const char* Bt; int nM, nN, G, c; size_t delta;
    __device__ __forceinline__ bool next(int i, Unit& u) const { return order_next(nM, nN, G, c, i, u); }
    __device__ __forceinline__ const char* a_base(const Unit& u) const { return A + (size_t)u.pm * (256 * 512 * 2); }
    __device__ __forceinline__ const char* b_base(const Unit& u) const { return Bt + (size_t)u.pn * (256 * 1024 * 2); }
    __device__ __forceinline__ int a_row(int) const { return 0; }
    __device__ __forceinline__ int ka(int) const { return 512; }
    __device__ __forceinline__ size_t a_koff(int t) const { return (size_t)(t & 7) * (BK * 2) + (size_t)(t >> 3) * delta; }
};
struct MoeOrder {
    const char* A; const char* Bt; const int* tokrow; const LAS int* te; int nM, nN, G, c; size_t tstep, estride; const LAS int* cb = nullptr;
    __device__ __forceinline__ bool next(int i, Unit& u) const { return order_next(nM, nN, G, c, i, u); }
    __device__ __forceinline__ const char* a_base(const Unit& u) const { return A + (size_t)u.pm * tstep; }
    __device__ __forceinline__ const char* b_base(const Unit& u) const { return Bt + (size_t)__builtin_amdgcn_readfirstlane(te[u.pm]) * estride + (size_t)u.pn * tstep; }
    __device__ __forceinline__ int a_row(int r) const { if (FAST_SORT && cb) { const int e = te[r >> 8], rin = r - cb[32 + e]; return rin < cb[e] ? tokrow[(size_t)e * T + rin] : 0; } return tokrow[r]; }
    __device__ __forceinline__ int ka(int K) const { return K; }
    __device__ __forceinline__ size_t a_koff(int t) const { return (size_t)t * (BK * 2); }
};
__device__ __forceinline__ unsigned cvt_pk_bf16(float lo, float hi) { unsigned r; asm volatile("v_cvt_pk_bf16_f32 %0, %1, %2" : "=v"(r) : "v"(lo), "v"(hi)); return r; }

__device__ __forceinline__ void dma_row256(const float* src, LAS float* dst) { if (threadIdx.x < 64) __builtin_amdgcn_global_load_lds((const unsigned*)(src + 4 * threadIdx.x), (LAS unsigned*)dst, 16, 0, 0); }
struct EpiProj {
    static constexpr bool PERM = true, MIDK = false, BEGIN = true;
    bf16* O; int ldc; const float* bias; LAS float* tb;
    __device__ __forceinline__ void begin(const Unit& u, int ui) const { dma_row256(bias + u.pn * BM, tb + (ui & 1) * 512); }
    __device__ __forceinline__ void operator()(const f32x4 (&acc)[2][2][4][2], const Unit& u, int wr, int wc, int fr, int fq, int ui) const {
        const int row0 = u.pm * BM + wr * 64 + fr, col0 = u.pn * BM + wc * 32 + 8 * fq;
        f32x4 bv[2][2];
#pragma unroll
        for (int bj = 0; bj < 2; ++bj)
#pragma unroll
            for (int n = 0; n < 2; ++n) bv[bj][n] = *(const LAS f32x4*)(tb + (ui & 1) * 512 + wc * 32 + 8 * fq + bj * HALF + 4 * n);
#pragma unroll
        for (int ai = 0; ai < 2; ++ai)
#pragma unroll
            for (int m = 0; m < 4; ++m) { bf16* rowp = O + (size_t)(row0 + ai * HALF + m * 16) * ldc + col0;
#pragma unroll
                for (int bj = 0; bj < 2; ++bj) { const f32x4 v0 = acc[ai][bj][m][0] + bv[bj][0], v1 = acc[ai][bj][m][1] + bv[bj][1];
                    u32x4 w; w.x = cvt_pk_bf16(v0[0], v0[1]); w.y = cvt_pk_bf16(v0[2], v0[3]); w.z = cvt_pk_bf16(v1[0], v1[1]); w.w = cvt_pk_bf16(v1[2], v1[3]);
                    *(u32x4*)(rowp + bj * HALF) = w; } }
    }
};
struct EpiGlu {
    static constexpr bool PERM = true, MIDK = false, BEGIN = true;
    const bf16* Gin; bf16* O; const float* bias; float* SQ; LAS float* tb;
    __device__ __forceinline__ void begin(const Unit& u, int ui) const { dma_row256(bias + u.pn * BM, tb + (ui & 1) * 512); }
    __device__ __forceinline__ void operator()(const f32x4 (&acc)[2][2][4][2], const Unit& u, int wr, int wc, int fr, int fq, int ui) const {
        const int row0 = u.pm * BM + wr * 64 + fr, col0 = u.pn * BM + wc * 32 + 8 * fq;
        f32x4 bv[2][2];
#pragma unroll
        for (int bj = 0; bj < 2; ++bj)
#pragma unroll
            for (int n = 0; n < 2; ++n) bv[bj][n] = *(const LAS f32x4*)(tb + (ui & 1) * 512 + wc * 32 + 8 * fq + bj * HALF + 4 * n);
#pragma unroll
        for (int ai = 0; ai < 2; ++ai) {
            u32x4 gin[4][2];
#pragma unroll
            for (int m = 0; m < 4; ++m)
#pragma unroll
                for (int bj = 0; bj < 2; ++bj) gin[m][bj] = *(const u32x4*)(Gin + (size_t)(row0 + ai * HALF + m * 16) * DSSM + col0 + bj * HALF);
#pragma unroll
            for (int m = 0; m < 4; ++m) { const int row = row0 + ai * HALF + m * 16; const size_t off = (size_t)row * DSSM + col0; float sq = 0.f;
#pragma unroll
                for (int bj = 0; bj < 2; ++bj) { const f32x4 z0 = acc[ai][bj][m][0] + bv[bj][0], z1 = acc[ai][bj][m][1] + bv[bj][1];
                    const u32x4 g = gin[m][bj];
                    const float p0 = bflo(g.x) * sigmoidf_(z0[0]), p1 = bfhi(g.x) * sigmoidf_(z0[1]), p2 = bflo(g.y) * sigmoidf_(z0[2]), p3 = bfhi(g.y) * sigmoidf_(z0[3]);
                    const float p4 = bflo(g.z) * sigmoidf_(z1[0]), p5 = bfhi(g.z) * sigmoidf_(z1[1]), p6 = bflo(g.w) * sigmoidf_(z1[2]), p7 = bfhi(g.w) * sigmoidf_(z1[3]);
                    sq += ((p0 * p0 + p1 * p1) + (p2 * p2 + p3 * p3)) + ((p4 * p4 + p5 * p5) + (p6 * p6 + p7 * p7));
                    u32x4 w; w.x = cvt_pk_bf16(p0, p1); w.y = cvt_pk_bf16(p2, p3); w.z = cvt_pk_bf16(p4, p5); w.w = cvt_pk_bf16(p6, p7);
                    *(u32x4*)(O + off + bj * HALF) = w; }
                if (SQ) { sq += __shfl_xor(sq, 16); sq += __shfl_xor(sq, 32); if (fq == 0) SQ[(size_t)row * 8 + u.pn * 4 + wc] = sq; } } }
    }
};
struct EpiOut {
    static constexpr bool PERM = X1_DELTA != 0, MIDK = FUSE_MIXNORM != 0, BEGIN = true;
    const float* x; const float* mod; float* O; const float* ASQ; const float* SSQ; LAS float* tbl; LAS float* tb;
    __device__ __forceinline__ float row_sum8(const float* p, int row) const { const f32x4 a = *(const f32x4*)(p + (size_t)row * 8), b = *(const f32x4*)(p + (size_t)row * 8 + 4); return ((a.x + a.y) + (a.z + a.w)) + ((b.x + b.y) + (b.z + b.w)); }
    __device__ __forceinline__ void begin(const Unit& u, int ui) const {
        if (X1_DELTA) { const int b = (u.pm * BM) / S; dma_row256(mod + b * 6 * D + 2 * D + u.pn * BM, tb + (ui & 1) * 512); }
        if constexpr (!MIDK) return;
        const int r = threadIdx.x; if (r < BM) { const int row = u.pm * BM + r;
            const float ra = rsqrtf(row_sum8(ASQ, row) * (1.0f / DATT) + EPS), rs = rsqrtf(row_sum8(SSQ, row) * (1.0f / DSSM) + EPS);
            *(LAS f32x2*)(tbl + (ui & 1) * 512 + 2 * r) = (f32x2){ra / rs, rs}; }
    }
    __device__ __forceinline__ void mid(f32x4 (&acc)[2][2][4][2], int ui, int wr, int fr) const {
#pragma unroll
        for (int ai = 0; ai < 2; ++ai)
#pragma unroll
            for (int m = 0; m < 4; ++m) { const float rho = tbl[(ui & 1) * 512 + 2 * (wr * 64 + fr + ai * HALF + m * 16)];
#pragma unroll
                for (int bj = 0; bj < 2; ++bj)
#pragma unroll
                    for (int n = 0; n < 2; ++n) acc[ai][bj][m][n] = acc[ai][bj][m][n] * rho; }
    }
    __device__ __forceinline__ void operator()(const f32x4 (&acc)[2][2][4][2], const Unit& u, int wr, int wc, int fr, int fq, int ui = 0) const {
        const int b = (u.pm * BM) / S;
        if constexpr (X1_DELTA) {
            const int col0 = u.pn * BM + wc * 32 + 8 * fq;
            f32x4 gv[2][2];
#pragma unroll
            for (int bj = 0; bj < 2; ++bj)
#pragma unroll
                for (int n = 0; n < 2; ++n) gv[bj][n] = *(const LAS f32x4*)(tb + (ui & 1) * 512 + wc * 32 + 8 * fq + bj * HALF + 4 * n);
#pragma unroll
            for (int ai = 0; ai < 2; ++ai)
#pragma unroll
                for (int m = 0; m < 4; ++m) { const int lr = wr * 64 + fr + ai * HALF + m * 16; bf16* rowp = (bf16*)O + (size_t)(u.pm * BM + lr) * D + col0;
                    const float rs = MIDK ? tbl[(ui & 1) * 512 + 2 * lr + 1] : 1.0f;
#pragma unroll
                    for (int bj = 0; bj < 2; ++bj) { const f32x4 v0 = gv[bj][0] * (acc[ai][bj][m][0] * rs), v1 = gv[bj][1] * (acc[ai][bj][m][1] * rs);
                        u32x4 w; w.x = cvt_pk_bf16(v0[0], v0[1]); w.y = cvt_pk_bf16(v0[2], v0[3]); w.z = cvt_pk_bf16(v1[0], v1[1]); w.w = cvt_pk_bf16(v1[2], v1[3]);
                        *(u32x4*)(rowp + bj * HALF) = w; } }
        } else {
        const int row0 = u.pm * BM + wr * 64 + fr, col0 = u.pn * BM + wc * 32 + 4 * fq;
        f32x4 gv[2][2];
#pragma unroll
        for (int bj = 0; bj < 2; ++bj)
#pragma unroll
            for (int n = 0; n < 2; ++n) gv[bj][n] = *(const f32x4*)(mod + b * 6 * D + 2 * D + col0 + bj * HALF + n * 16);
#pragma unroll
        for (int ai = 0; ai < 2; ++ai)
#pragma unroll
            for (int m = 0; m < 4; ++m) { const int lr = wr * 64 + fr + ai * HALF + m * 16; const size_t off = (size_t)(u.pm * BM + lr) * D + col0;
                const float rs = MIDK ? tbl[(ui & 1) * 512 + 2 * lr + 1] : 1.0f;
#pragma unroll
                for (int bj = 0; bj < 2; ++bj)
#pragma unroll
                    for (int n = 0; n < 2; ++n) { const f32x4 xv = __builtin_nontemporal_load((const f32x4*)(x + off + bj * HALF + n * 16)); *(f32x4*)(O + off + bj * HALF + n * 16) = xv + gv[bj][n] * (acc[ai][bj][m][n] * rs); } }
        }
    }
};
template <bool OUT8> struct EpiGateUp {
    static constexpr bool PERM = true, MIDK = false, BEGIN = true;
    void* ACTp; const float* bias; const LAS int* te; float ascale; LAS float* tb;
    __device__ __forceinline__ void begin(const Unit& u, int ui) const { const int e = __builtin_amdgcn_readfirstlane(te[u.pm]); dma_row256(bias + (size_t)e * 2 * DFF + 2 * (u.pn * HALF), tb + (ui & 1) * 512); }
    __device__ __forceinline__ void operator()(const f32x4 (&acc)[2][2][4][2], const Unit& u, int wr, int wc, int fr, int fq, int ui) const {
        const int row0 = u.pm * BM + wr * 64 + fr, ac0 = u.pn * HALF + wc * 32 + 8 * fq;
        const LAS float* bp = tb + (ui & 1) * 512 + 2 * (wc * 32 + 8 * fq);
        const f32x4 b0 = *(const LAS f32x4*)bp, b1 = *(const LAS f32x4*)(bp + 4), b2 = *(const LAS f32x4*)(bp + 8), b3 = *(const LAS f32x4*)(bp + 12);
        const float bg[8] = {b0[0], b0[2], b1[0], b1[2], b2[0], b2[2], b3[0], b3[2]}, bu[8] = {b0[1], b0[3], b1[1], b1[3], b2[1], b2[3], b3[1], b3[3]};
        const f32x2 asc2 = {ascale, ascale}, zc2 = {-1.702f * 1.4426950408889634f, -1.702f * 1.4426950408889634f}, one2 = {1.0f, 1.0f}, os2 = {OUT8 ? A8_SCALE : 1.0f, OUT8 ? A8_SCALE : 1.0f};
#pragma unroll
        for (int ai = 0; ai < 2; ++ai)
#pragma unroll
            for (int m = 0; m < 4; ++m) { float a[8];
#pragma unroll
                for (int k = 0; k < 8; k += 2) {
                    f32x2 g = (f32x2){acc[ai][0][m][k >> 2][k & 3], acc[ai][0][m][k >> 2][(k & 3) + 1]} * asc2 + (f32x2){bg[k], bg[k + 1]};
                    f32x2 up = (f32x2){acc[ai][1][m][k >> 2][k & 3], acc[ai][1][m][k >> 2][(k & 3) + 1]} * asc2 + (f32x2){bu[k], bu[k + 1]};
                    g.x = fminf(g.x, 7.0f); g.y = fminf(g.y, 7.0f); up.x = __builtin_amdgcn_fmed3f(up.x, -7.0f, 7.0f); up.y = __builtin_amdgcn_fmed3f(up.y, -7.0f, 7.0f);
                    const f32x2 z = g * zc2; f32x2 ex; ex.x = __builtin_amdgcn_exp2f(z.x); ex.y = __builtin_amdgcn_exp2f(z.y);
                    const f32x2 dn = ex + one2; f32x2 sg; sg.x = __builtin_amdgcn_rcpf(dn.x); sg.y = __builtin_amdgcn_rcpf(dn.y);
                    const f32x2 r2 = (up * os2 + os2) * (g * sg); a[k] = r2.x; a[k + 1] = r2.y; }
                const size_t off = (size_t)(row0 + ai * HALF + m * 16) * DFF + ac0;
                if constexpr (OUT8) { u32x2 w; w.x = pk4_fp8(a[0], a[1], a[2], a[3]); w.y = pk4_fp8(a[4], a[5], a[6], a[7]); *(u32x2*)((unsigned char*)ACTp + off) = w; }
                else { u32x4 w; w.x = cvt_pk_bf16(a[0], a[1]); w.y = cvt_pk_bf16(a[2], a[3]); w.z = cvt_pk_bf16(a[4], a[5]); w.w = cvt_pk_bf16(a[6], a[7]); *(u32x4*)((bf16*)ACTp + off) = w; } }
    }
};
template <bool OUT8> struct EpiDown {
    static constexpr bool PERM = true, MIDK = false, BEGIN = true;
    void* YSp; const float* bias; const float* wrow; const LAS int* te; float ascale; const LAS int* cb; LAS float* tb;
    const float* zero;
    __device__ __forceinline__ void begin(const Unit& u, int ui) const { const int t = threadIdx.x, e = __builtin_amdgcn_readfirstlane(te[u.pm]);
        dma_row256(bias + (size_t)e * D + u.pn * BM, tb + (ui & 1) * 512);
        if (t >= 64 && t < 320) { const int w4 = __builtin_amdgcn_readfirstlane((t >> 6) - 1), r = t - 64, row = u.pm * BM + r; const float* src;
            if (FAST_SORT && cb) { const int rin = row - cb[32 + e]; src = rin < cb[e] ? wrow + (size_t)e * T + rin : zero; } else src = wrow + row;
            __builtin_amdgcn_global_load_lds((const unsigned*)src, (LAS unsigned*)(tb + (ui & 1) * 512 + 256 + 64 * w4), 4, 0, 0); } }
    __device__ __forceinline__ void operator()(const f32x4 (&acc)[2][2][4][2], const Unit& u, int wr, int wc, int fr, int fq, int ui) const {
        const int row0 = u.pm * BM + wr * 64 + fr, col0 = u.pn * BM + wc * 32 + 8 * fq;
        f32x4 bv[2][2];
#pragma unroll
        for (int bj = 0; bj < 2; ++bj)
#pragma unroll
            for (int n = 0; n < 2; ++n) bv[bj][n] = *(const LAS f32x4*)(tb + (ui & 1) * 512 + wc * 32 + 8 * fq + bj * HALF + 4 * n);
        float wts[2][4];
#pragma unroll
        for (int ai = 0; ai < 2; ++ai)
#pragma unroll
            for (int m = 0; m < 4; ++m) wts[ai][m] = tb[(ui & 1) * 512 + 256 + wr * 64 + fr + ai * HALF + m * 16];
#pragma unroll
        for (int ai = 0; ai < 2; ++ai)
#pragma unroll
            for (int m = 0; m < 4; ++m) { const int row = row0 + ai * HALF + m * 16; const float wt = wts[ai][m] * (OUT8 ? Y8_SCALE : 1.0f); const size_t off = (size_t)row * D + col0;
#pragma unroll
                for (int bj = 0; bj < 2; ++bj) { const f32x4 v0 = (acc[ai][bj][m][0] * ascale + bv[bj][0]) * wt, v1 = (acc[ai][bj][m][1] * ascale + bv[bj][1]) * wt;
                    if constexpr (OUT8) { u32x2 w; w.x = pk4_fp8(v0[0], v0[1], v0[2], v0[3]); w.y = pk4_fp8(v1[0], v1[1], v1[2], v1[3]); *(u32x2*)((unsigned char*)YSp + off + bj * HALF) = w; }
                    else { u32x4 w; w.x = cvt_pk_bf16(v0[0], v0[1]); w.y = cvt_pk_bf16(v0[2], v0[3]); w.z = cvt_pk_bf16(v1[0], v1[1]); w.w = cvt_pk_bf16(v1[2], v1[3]); *(u32x4*)((bf16*)YSp + off + bj * HALF) = w; } } }
    }
};

template <class Epi, class Sched, bool ALIGN_EPI, bool GATHER, bool FP8 = false>
__device__ __forceinline__ void gemm_phase(LAS unsigned char* lds, const int K, const Sched& S, const Epi& E) {
    const int tid = threadIdx.x, wid = __builtin_amdgcn_readfirstlane(tid >> 6), lane = tid & 63, wr = wid >> 2, wc = wid & 3, fr = lane & 15, fq = lane >> 4;
    const int nt = K / BK;
    int Rr[2], Cc[2]; unsigned voffA[2], voffB[2];
#pragma unroll
    for (int i = 0; i < 2; ++i) { int R, C; stage_rc(tid * 16 + i * 8192, R, C); const int Rb = Epi::PERM ? ((R & ~31) + perm32(R & 31)) : R;
        Rr[i] = R; Cc[i] = C; voffA[i] = (unsigned)(R * S.ka(K) + C) * 2u; voffB[i] = (unsigned)(Rb * K + C) * 2u; }
    const size_t kstep = (size_t)(BK * 2);
    const size_t hstep = (size_t)HALF * K * 2;
    const size_t hstepA = (size_t)HALF * S.ka(K) * 2;
    const unsigned ldsw = (unsigned)wid * 1024u;
    const int aoff = lds_byte(wr * 64 + fr, fq * 8), boff = lds_byte(wc * 32 + fr, fq * 8);
#define PG8_SA(b, h) (((b) * 2 + (h)) * HTB)
#define PG8_SB(b, h) ((4 + (b) * 2 + (h)) * HTB)
#define PG8_STAGE(bufoff, gbase, voff) do { _Pragma("unroll") for (int _i = 0; _i < 2; ++_i) \
        __builtin_amdgcn_global_load_lds((const unsigned*)((const char*)(gbase) + (voff)[_i]), (LAS unsigned*)(lds + (bufoff) + ldsw + _i * 8192), 16, 0, 0); } while (0)
#define PG8_STAGE_A(bufoff, ab, koff, h, g0, g1) do { if constexpr (GATHER) { if ((h) == 0) PG8_STAGE(bufoff, (ab) + (koff), g0); else PG8_STAGE(bufoff, (ab) + (koff), g1); } \
        else { PG8_STAGE(bufoff, (ab) + (koff) + (h) * hstepA, voffA); } } while (0)
#define PG8_LDA(dst, b, h) do { if constexpr (FP8) { _Pragma("unroll") for (int m = 0; m < 4; ++m) dst##8[m] = __builtin_shufflevector(*(const LAS i32x4*)(lds + PG8_SA(b, h) + aoff + m * 2048), *(const LAS i32x4*)(lds + PG8_SA(b, h) + aoff + m * 2048 + 1024), 0, 1, 2, 3, 4, 5, 6, 7); } \
        else { _Pragma("unroll") for (int m = 0; m < 4; ++m) _Pragma("unroll") for (int k = 0; k < 2; ++k) dst[m][k] = *(const LAS bf16x8*)(lds + PG8_SA(b, h) + aoff + m * 2048 + k * 1024); } } while (0)
#define PG8_LDB(dst, b, h) do { if constexpr (FP8) { _Pragma("unroll") for (int n = 0; n < 2; ++n) dst##8[n] = __builtin_shufflevector(*(const LAS i32x4*)(lds + PG8_SB(b, h) + boff + n * 2048), *(const LAS i32x4*)(lds + PG8_SB(b, h) + boff + n * 2048 + 1024), 0, 1, 2, 3, 4, 5, 6, 7); } \
        else { _Pragma("unroll") for (int n = 0; n < 2; ++n) _Pragma("unroll") for (int k = 0; k < 2; ++k) dst[n][k] = *(const LAS bf16x8*)(lds + PG8_SB(b, h) + boff + n * 2048 + k * 1024); } } while (0)
#define PG8_CAT8(x) __builtin_shufflevector(__builtin_bit_cast(i32x4, (x)[0]), __builtin_bit_cast(i32x4, (x)[1]), 0, 1, 2, 3, 4, 5, 6, 7)
#define PG8_MMA(ai, bj, At, Bt) do { __builtin_amdgcn_s_setprio(1); if constexpr (FP8) { _Pragma("unroll") for (int m = 0; m < 4; ++m) _Pragma("unroll") for (int n = 0; n < 2; ++n) \
        asm volatile("v_mfma_scale_f32_16x16x128_f8f6f4 %0, %1, %2, %0, %3, %3 op_sel_hi:[0,0,0]" : "+v"(acc[ai][bj][m][n]) : "v"(Bt##8[n]), "v"(At##8[m]), "v"(one8)); } \
      else { _Pragma("unroll") for (int m = 0; m < 4; ++m) _Pragma("unroll") for (int n = 0; n < 2; ++n) _Pragma("unroll") for (int k = 0; k < 2; ++k) \
        acc[ai][bj][m][n] = __builtin_amdgcn_mfma_f32_16x16x32_bf16(Bt[n][k], At[m][k], acc[ai][bj][m][n], 0, 0, 0); } __builtin_amdgcn_s_setprio(0); } while (0)
#define PG8_WAIT_V(n) asm volatile("s_waitcnt vmcnt(" #n ")" ::: "memory")
#define PG8_WAIT_L(n) asm volatile("s_waitcnt lgkmcnt(" #n ")" ::: "memory")
#define PG8_BAR __builtin_amdgcn_s_barrier()
#define PG8_SCHED __builtin_amdgcn_sched_barrier(0)
#define PG8_GOFF(U, o0, o1) do { if constexpr (GATHER) { _Pragma("unroll") for (int _i = 0; _i < 2; ++_i) { \
        o0[_i] = (unsigned)(S.a_row((U).pm * BM + Rr[_i]) * K + Cc[_i]) * 2u; o1[_i] = (unsigned)(S.a_row((U).pm * BM + HALF + Rr[_i]) * K + Cc[_i]) * 2u; } } } while (0)
    Unit cur, nxt; int ui = 0;
    if (!S.next(0, cur)) return;
    f32x4 acc[2][2][4][2];
#pragma unroll
    for (int a = 0; a < 2; ++a)
#pragma unroll
        for (int b = 0; b < 2; ++b)
#pragma unroll
            for (int m = 0; m < 4; ++m)
#pragma unroll
                for (int n = 0; n < 2; ++n) acc[a][b][m][n] = (f32x4){0.f, 0.f, 0.f, 0.f};
    const int one8 = 0x7f7f7f7f;
    bf16x8 At[4][2], B0[2][2], B1[2][2]; i32x8 At8[4], B08[2], B18[2];
    unsigned cg0[2] = {0u, 0u}, cg1[2] = {0u, 0u}, ng0[2] = {0u, 0u}, ng1[2] = {0u, 0u};
    const char* cA = GATHER ? S.A : S.a_base(cur); const char* cB = S.b_base(cur);
    PG8_GOFF(cur, cg0, cg1);
    PG8_STAGE(PG8_SB(0, 0), cB, voffB); PG8_STAGE(PG8_SB(0, 1), cB + hstep, voffB); PG8_STAGE_A(PG8_SA(0, 0), cA, 0, 0, cg0, cg1); PG8_STAGE_A(PG8_SA(0, 1), cA, 0, 1, cg0, cg1);
    if constexpr (Epi::BEGIN) E.begin(cur, 0);
    if (wr == 1) PG8_BAR;
    PG8_WAIT_V(2); PG8_BAR;
    PG8_STAGE(PG8_SB(1, 0), cB + kstep, voffB); PG8_STAGE_A(PG8_SA(1, 0), cA, S.a_koff(1), 0, cg0, cg1); PG8_STAGE(PG8_SB(1, 1), cB + hstep + kstep, voffB);
    PG8_WAIT_V(6); PG8_BAR;
    for (;;) {
        const bool has_next = S.next(ui + 1, nxt);
        const char* nA = has_next ? (GATHER ? S.A : S.a_base(nxt)) : cA; const char* nB = has_next ? S.b_base(nxt) : cB;
        if constexpr (GATHER) { if (has_next) { PG8_GOFF(nxt, ng0, ng1); } else { ng0[0] = cg0[0]; ng0[1] = cg0[1]; ng1[0] = cg1[0]; ng1[1] = cg1[1]; } }
#pragma unroll 1
        for (int t = 0; t < nt; t += 2) {
            const bool last = (t == nt - 2);
            if constexpr (Epi::MIDK) { if (t == nt / 2) E.mid(acc, ui, wr, fr); }
            const size_t k1 = S.a_koff(t + 1);
            const char* a2 = last ? nA : cA; const char* b2 = last ? nB : cB + (size_t)(t + 2) * kstep;
            const size_t k2 = last ? S.a_koff(0) : S.a_koff(t + 2), k3 = last ? S.a_koff(1) : S.a_koff(t + 3);
            const char* b3 = b2 + kstep;
            unsigned s0[2], s1[2];
            if constexpr (GATHER) { s0[0] = last ? ng0[0] : cg0[0]; s0[1] = last ? ng0[1] : cg0[1]; s1[0] = last ? ng1[0] : cg1[0]; s1[1] = last ? ng1[1] : cg1[1]; } else { s0[0] = s0[1] = s1[0] = s1[1] = 0u; }
            PG8_LDB(B0, 0, 0); PG8_LDB(B1, 0, 1); PG8_SCHED; PG8_LDA(At, 0, 0); PG8_STAGE_A(PG8_SA(1, 1), cA, k1, 1, cg0, cg1);
            PG8_WAIT_V(8); PG8_WAIT_L(0); PG8_BAR; PG8_MMA(0, 0, At, B0); PG8_MMA(0, 1, At, B1); PG8_BAR; PG8_SCHED;
            PG8_LDA(At, 0, 1); PG8_STAGE(PG8_SB(0, 0), b2, voffB); PG8_STAGE(PG8_SB(0, 1), b2 + hstep, voffB); PG8_STAGE_A(PG8_SA(0, 0), a2, k2, 0, s0, s1);
            PG8_WAIT_V(8); PG8_WAIT_L(0); PG8_BAR; PG8_MMA(1, 0, At, B0); PG8_MMA(1, 1, At, B1); PG8_BAR; PG8_SCHED;
            PG8_LDB(B0, 1, 0); PG8_LDB(B1, 1, 1); PG8_SCHED; PG8_LDA(At, 1, 0); PG8_STAGE_A(PG8_SA(0, 1), a2, k2, 1, s0, s1);
            PG8_WAIT_V(8); PG8_WAIT_L(0); PG8_BAR; PG8_MMA(0, 0, At, B0); PG8_MMA(0, 1, At, B1); PG8_BAR; PG8_SCHED;
            PG8_LDA(At, 1, 1); PG8_STAGE(PG8_SB(1, 0), b3, voffB); PG8_STAGE(PG8_SB(1, 1), b3 + hstep, voffB); PG8_STAGE_A(PG8_SA(1, 0), a2, k3, 0, s0, s1);
            PG8_WAIT_V(8); PG8_WAIT_L(0); PG8_BAR; PG8_MMA(1, 0, At, B0); PG8_MMA(1, 1, At, B1); PG8_BAR; PG8_SCHED;
        }
        if constexpr (ALIGN_EPI) { if (wr == 0) PG8_BAR; }
        if constexpr (FP8) asm volatile("s_nop 15\n\ts_nop 15" ::: "memory");
        E(acc, cur, wr, wc, fr, fq, ui);
        if (!has_next) break;
#pragma unroll
        for (int a = 0; a < 2; ++a)
#pragma unroll
            for (int b = 0; b < 2; ++b)
#pragma unroll
                for (int m = 0; m < 4; ++m)
#pragma unroll
                    for (int n = 0; n < 2; ++n) acc[a][b][m][n] = (f32x4){0.f, 0.f, 0.f, 0.f};
        cur = nxt; cA = nA; cB = nB; ++ui;
        if constexpr (Epi::BEGIN) E.begin(cur, ui);
        if constexpr (GATHER) { cg0[0] = ng0[0]; cg0[1] = ng0[1]; cg1[0] = ng1[0]; cg1[1] = ng1[1]; }
        if constexpr (ALIGN_EPI) { if (wr == 1) PG8_BAR; }
    }
    PG8_WAIT_V(0);
    if constexpr (!ALIGN_EPI) { if (wr == 0) PG8_BAR; }
    PG8_BAR;
#undef PG8_SA
#undef PG8_SB
#undef PG8_STAGE
#undef PG8_STAGE_A
#undef PG8_LDA
#undef PG8_LDB
#undef PG8_MMA
#undef PG8_CAT8
#undef PG8_WAIT_V
#undef PG8_WAIT_L
#undef PG8_BAR
#undef PG8_SCHED
#undef PG8_GOFF
}
}

#ifndef BAR_ACQUIRE
#define BAR_ACQUIRE 0
#endif
#define XB_TMO      128
#define XB_XCNT(j)  (256  + 64 * (j))
#define XB_XSUB(j)  (1280 + 64 * (j))
#define XB_XGEN(j)  (2304 + 64 * (j))
#define XB_TOP      3328
#define XB_TOPGEN   3392
#define XCD_BAR_WORDS 3456
#define XB_SPIN_CAP (1u << 18)

__device__ __forceinline__ unsigned xb_ld(unsigned* p)              { return __hip_atomic_load(p, __ATOMIC_RELAXED, __HIP_MEMORY_SCOPE_AGENT); }
__device__ __forceinline__ unsigned xb_add(unsigned* p, unsigned v) { return __hip_atomic_fetch_add(p, v, __ATOMIC_RELAXED, __HIP_MEMORY_SCOPE_AGENT); }
__device__ __forceinline__ unsigned xb_xcc_id() { return (unsigned)__builtin_amdgcn_s_getreg((3 << 11) | 20) & 0xFu; }
#define XB_SPIN(cond, bar) do { unsigned _sp = 0; while (cond) { __builtin_amdgcn_s_sleep(1); \
    if ((++_sp & 255u) == 0u) { if (xb_ld(&(bar)[XB_TMO])) break; if (_sp > XB_SPIN_CAP) { atomicAdd(&(bar)[XB_TMO], 1u); break; } } } } while (0)

struct XcdBarrier {
    unsigned* bar; unsigned x;
    volatile LAS unsigned* st;
};
__device__ __forceinline__ XcdBarrier xcd_barrier_post(unsigned* bar, volatile LAS unsigned* st) {
    XcdBarrier b; b.bar = bar; b.x = xb_xcc_id(); b.st = st;
    if (threadIdx.x == 0) (void)xb_add(&bar[XB_XCNT(b.x)], 1u);
    return b;
}
__device__ __forceinline__ void xcd_barrier_complete(unsigned* bar, unsigned x, unsigned& nloc, unsigned& nx) {
    const unsigned G = gridDim.x * gridDim.y * gridDim.z;
    unsigned sum, cnt, mine, sp = 0u;
    for (;;) {
        sum = 0u; cnt = 0u; mine = 0u;
#pragma unroll
        for (unsigned j = 0; j < 16; ++j) { const unsigned c = xb_ld(&bar[XB_XCNT(j)]); sum += c; cnt += (c > 0u) ? 1u : 0u; mine = (j == x) ? c : mine; }
        if (sum == G) break;
        __builtin_amdgcn_s_sleep(1);
        if ((++sp & 255u) == 0u) { if (xb_ld(&bar[XB_TMO])) break; if (sp > XB_SPIN_CAP) { atomicAdd(&bar[XB_TMO], 1u); break; } }
    }
    nloc = mine > 0u ? mine : 1u; nx = cnt > 0u ? cnt : 1u;
}
__device__ __forceinline__ void xcd_barrier(const XcdBarrier& b) {
    asm volatile("s_waitcnt vmcnt(0)" ::: "memory");
    __syncthreads();
    if (threadIdx.x == 0) {
        unsigned* bar = b.bar;
        __builtin_amdgcn_s_waitcnt(0);
        unsigned nloc = b.st[0], nx = b.st[1];
        if (nloc == 0u) { xcd_barrier_complete(bar, b.x, nloc, nx); b.st[0] = nloc; b.st[1] = nx; }
        const unsigned old = xb_add(&bar[XB_XSUB(b.x)], 1u);
        const unsigned gen = old / nloc;
        if (old + 1u == (gen + 1u) * nloc) {
            __builtin_amdgcn_fence(__ATOMIC_RELEASE, "agent");
            asm volatile("s_waitcnt vmcnt(0)" ::: "memory");
            (void)xb_add(&bar[XB_TOP], 1u);
        }
        XB_SPIN(xb_ld(&bar[XB_TOP]) < (gen + 1u) * nx, bar);
        if (BAR_ACQUIRE) __builtin_amdgcn_fence(__ATOMIC_ACQUIRE, "agent");
        asm volatile("s_waitcnt vmcnt(0)" ::: "memory");
    }
    __syncthreads();
}


__device__ __forceinline__ bf16x8 as_bf16x8(u32x4 v) { return __builtin_bit_cast(bf16x8, v); }
typedef __bf16 bf16x2_t __attribute__((ext_vector_type(2)));
__device__ __forceinline__ unsigned cvtpk(float lo, float hi) { const f32x2 v = {lo, hi}; const bf16x2_t b = __builtin_convertvector(v, bf16x2_t); return __builtin_bit_cast(unsigned, b); }
#define LDS_FENCE() asm volatile("s_waitcnt lgkmcnt(0)" ::: "memory")
__device__ __forceinline__ float fma_s(float a, float b, float c) { float r; asm("v_fma_f32 %0, %1, %2, %3" : "=v"(r) : "v"(a), "v"(b), "v"(c)); return r; }

constexpr int KN_PITCH = 144, VT_PITCH = 528;
constexpr int ATT_KN_OFF = 0, ATT_VT_OFF = 256 * KN_PITCH, ATT_LDS_BYTES = ATT_VT_OFF + 64 * VT_PITCH;
__device__ __forceinline__ void attn_unit(LAS unsigned char* lds, int unit, int tid, const bf16* PROJ, const float* qg, const float* kg, const float* sinks, bf16* ATT, float* ATTSQ = nullptr) {
    const int lane = tid & 63, wave = __builtin_amdgcn_readfirstlane(tid >> 6), l15 = lane & 15, q4 = lane >> 4;
    const int kvh = unit & 1, n = (unit >> 1) & 15, b = unit >> 5;
    const int tok0 = b * S + n * 128;
    {
        const int c = tid & 7; const f32x4 g0 = *(const f32x4*)(kg + 8 * c), g1 = *(const f32x4*)(kg + 8 * c + 4);
        const int vkey = tid & 255; const bool vvalid = (n > 0) || (vkey >= 128);
        u32x4 kraw[4], vraw[4];
#pragma unroll
        for (int j = 0; j < 4; ++j) { const int key = (tid >> 3) + 64 * j; const bool valid = (n > 0) || (key >= 128);
            kraw[j] = (u32x4){0u, 0u, 0u, 0u}; if (valid) kraw[j] = *(const u32x4*)(PROJ + (size_t)(tok0 - 128 + key) * DIN + KOFF + kvh * HD + 8 * c);
            vraw[j] = (u32x4){0u, 0u, 0u, 0u}; if (vvalid) vraw[j] = *(const u32x4*)(PROJ + (size_t)(tok0 - 128 + vkey) * DIN + VOFF + kvh * HD + 8 * ((tid >> 8) + 2 * j)); }
#pragma unroll
        for (int j = 0; j < 4; ++j) { const int key = (tid >> 3) + 64 * j; const u32x4 raw = kraw[j];
            const float f[8] = {bflo(raw.x), bfhi(raw.x), bflo(raw.y), bfhi(raw.y), bflo(raw.z), bfhi(raw.z), bflo(raw.w), bfhi(raw.w)};
            float ss = 0.f;
#pragma unroll
            for (int i = 0; i < 8; ++i) ss += f[i] * f[i];
            ss += __shfl_xor(ss, 1); ss += __shfl_xor(ss, 2); ss += __shfl_xor(ss, 4);
            const float r = rsqrtf(ss * (1.0f / HD) + EPS);
            u32x4 w; w.x = cvtpk(f[0] * r * g0.x, f[1] * r * g0.y); w.y = cvtpk(f[2] * r * g0.z, f[3] * r * g0.w); w.z = cvtpk(f[4] * r * g1.x, f[5] * r * g1.y); w.w = cvtpk(f[6] * r * g1.z, f[7] * r * g1.w);
            *(LAS u32x4*)(lds + ATT_KN_OFF + key * KN_PITCH + c * 16) = w; }
#pragma unroll
        for (int j = 0; j < 4; ++j) { const int cc = (tid >> 8) + 2 * j; const u32x4 raw = vraw[j];
            LAS unsigned short* vt = (LAS unsigned short*)(lds + ATT_VT_OFF + (8 * cc) * VT_PITCH + vkey * 2);
            vt[0 * (VT_PITCH / 2)] = (unsigned short)(raw.x & 0xffffu); vt[1 * (VT_PITCH / 2)] = (unsigned short)(raw.x >> 16);
            vt[2 * (VT_PITCH / 2)] = (unsigned short)(raw.y & 0xffffu); vt[3 * (VT_PITCH / 2)] = (unsigned short)(raw.y >> 16);
            vt[4 * (VT_PITCH / 2)] = (unsigned short)(raw.z & 0xffffu); vt[5 * (VT_PITCH / 2)] = (unsigned short)(raw.z >> 16);
            vt[6 * (VT_PITCH / 2)] = (unsigned short)(raw.w & 0xffffu); vt[7 * (VT_PITCH / 2)] = (unsigned short)(raw.w >> 16); }
    }
    __syncthreads();
    const int g = wave >> 1, h = kvh * 4 + g, qi0 = 64 * (wave & 1);
    const float sink = sinks[h];
    const f32x4 gq00 = *(const f32x4*)(qg + 8 * q4), gq01 = *(const f32x4*)(qg + 8 * q4 + 4), gq10 = *(const f32x4*)(qg + 32 + 8 * q4), gq11 = *(const f32x4*)(qg + 32 + 8 * q4 + 4);
    u32x4 qn0, qn1;
    { const size_t tq0 = (size_t)(tok0 + qi0 + l15); qn0 = *(const u32x4*)(PROJ + tq0 * DIN + QOFF + h * HD + 8 * q4); qn1 = *(const u32x4*)(PROJ + tq0 * DIN + QOFF + h * HD + 32 + 8 * q4); }
#pragma unroll 1
    for (int qt = 0; qt < 4; ++qt) {
        const int q0 = qi0 + 16 * qt, qi = q0 + l15; const size_t tq = (size_t)(tok0 + qi);
        const u32x4 r0 = qn0, r1 = qn1;
        { const size_t tqn = (size_t)(tok0 + qi0 + 16 * ((qt + 1) & 3) + l15); qn0 = *(const u32x4*)(PROJ + tqn * DIN + QOFF + h * HD + 8 * q4); qn1 = *(const u32x4*)(PROJ + tqn * DIN + QOFF + h * HD + 32 + 8 * q4); }
        const float f0[8] = {bflo(r0.x), bfhi(r0.x), bflo(r0.y), bfhi(r0.y), bflo(r0.z), bfhi(r0.z), bflo(r0.w), bfhi(r0.w)};
        const float f1[8] = {bflo(r1.x), bfhi(r1.x), bflo(r1.y), bfhi(r1.y), bflo(r1.z), bfhi(r1.z), bflo(r1.w), bfhi(r1.w)};
        float ss = 0.f;
#pragma unroll
        for (int i = 0; i < 8; ++i) ss += f0[i] * f0[i] + f1[i] * f1[i];
        ss += __shfl_xor(ss, 16); ss += __shfl_xor(ss, 32);
        const float rq = rsqrtf(ss * (1.0f / HD) + EPS) * 0.125f;
        u32x4 w0, w1;
        w0.x = cvtpk(f0[0] * rq * gq00.x, f0[1] * rq * gq00.y); w0.y = cvtpk(f0[2] * rq * gq00.z, f0[3] * rq * gq00.w); w0.z = cvtpk(f0[4] * rq * gq01.x, f0[5] * rq * gq01.y); w0.w = cvtpk(f0[6] * rq * gq01.z, f0[7] * rq * gq01.w);
        w1.x = cvtpk(f1[0] * rq * gq10.x, f1[1] * rq * gq10.y); w1.y = cvtpk(f1[2] * rq * gq10.z, f1[3] * rq * gq10.w); w1.z = cvtpk(f1[4] * rq * gq11.x, f1[5] * rq * gq11.y); w1.w = cvtpk(f1[6] * rq * gq11.z, f1[7] * rq * gq11.w);
        const bf16x8 bq0 = as_bf16x8(w0), bq1 = as_bf16x8(w1);
        const int kt0 = ((q0 >> 4) >> 1) * 2;
        f32x4 s[10];
#pragma unroll
        for (int i = 0; i < 10; ++i) { const LAS unsigned char* kp = lds + ATT_KN_OFF + (16 * (kt0 + i) + l15) * KN_PITCH + 16 * q4;
            const bf16x8 a0 = *(const LAS bf16x8*)kp, a1 = *(const LAS bf16x8*)(kp + 64);
            f32x4 z = (f32x4){0.f, 0.f, 0.f, 0.f};
            z = __builtin_amdgcn_mfma_f32_16x16x32_bf16(a0, bq0, z, 0, 0, 0); s[i] = __builtin_amdgcn_mfma_f32_16x16x32_bf16(a1, bq1, z, 0, 0, 0); }
        float m = sink;
#pragma unroll
        for (int i = 0; i < 10; ++i)
#pragma unroll
            for (int r = 0; r < 4; ++r) { const int kj = 16 * (kt0 + i) + 4 * q4 + r; const bool valid = (kj < 128) ? ((kj > qi) && (n > 0)) : ((kj - 128) <= qi);
                const float v = valid ? s[i][r] : -1e30f; s[i][r] = v; m = fmaxf(m, v); }
        m = fmaxf(m, __shfl_xor(m, 16)); m = fmaxf(m, __shfl_xor(m, 32));
        float den = 0.f;
#pragma unroll
        for (int i = 0; i < 10; ++i)
#pragma unroll
            for (int r = 0; r < 4; ++r) { const float p = __expf(s[i][r] - m); s[i][r] = p; den += p; }
        den += __shfl_xor(den, 16); den += __shfl_xor(den, 32); den += __expf(sink - m);
        f32x4 o[4];
#pragma unroll
        for (int dt = 0; dt < 4; ++dt) o[dt] = (f32x4){0.f, 0.f, 0.f, 0.f};
#pragma unroll
        for (int ks = 0; ks < 5; ++ks) { u32x4 pw; pw.x = cvtpk(s[2 * ks][0], s[2 * ks][1]); pw.y = cvtpk(s[2 * ks][2], s[2 * ks][3]); pw.z = cvtpk(s[2 * ks + 1][0], s[2 * ks + 1][1]); pw.w = cvtpk(s[2 * ks + 1][2], s[2 * ks + 1][3]);
            const bf16x8 bp = as_bf16x8(pw); const int keyb = 16 * kt0 + 32 * ks + 4 * q4;
#pragma unroll
            for (int dt = 0; dt < 4; ++dt) { const LAS unsigned char* vp = lds + ATT_VT_OFF + (16 * dt + l15) * VT_PITCH + keyb * 2;
                const u32x2 lo = *(const LAS u32x2*)vp, hi = *(const LAS u32x2*)(vp + 32);
                u32x4 av; av.x = lo.x; av.y = lo.y; av.z = hi.x; av.w = hi.y;
                o[dt] = __builtin_amdgcn_mfma_f32_16x16x32_bf16(as_bf16x8(av), bp, o[dt], 0, 0, 0); } }
        const float inv = 1.0f / den; float osq = 0.f;
#pragma unroll
        for (int dt = 0; dt < 4; ++dt) { const float o0 = o[dt][0] * inv, o1 = o[dt][1] * inv, o2 = o[dt][2] * inv, o3 = o[dt][3] * inv; osq += (o0 * o0 + o1 * o1) + (o2 * o2 + o3 * o3);
            u32x2 w; w.x = cvtpk(o0, o1); w.y = cvtpk(o2, o3);
            *(u32x2*)(ATT + tq * DATT + h * HD + 16 * dt + 4 * q4) = w; }
        if (ATTSQ) { osq += __shfl_xor(osq, 16); osq += __shfl_xor(osq, 32); if (q4 == 0) ATTSQ[tq * NH + h] = osq; }
    }
    __syncthreads();
}


__device__ __forceinline__ void ssm_apow_item(int i, const float* lam_re, const float* lam_im, const float* log_dt, unsigned char* APOW) {
    const int lane = i & 63, f = (i >> 6) & 63, g = i >> 12, ks = f & 7, rt = f >> 3, st = rt >> 1, c = rt & 1, fr = lane & 15, fq = lane >> 4, p = 16 * st + fr;
    const float dt = expf(log_dt[g]), lrd = lam_re[g * NST + p] * dt, lid = lam_im[g * NST + p] * dt;
    float v[8];
#pragma unroll
    for (int j = 0; j < 8; ++j) { const int t = 32 * ks + 16 * (j >> 2) + 4 * fq + (j & 3); const float k = (float)(255 - t), m = __expf(lrd * k), a = __builtin_amdgcn_fractf(lid * 0.15915494309189535f * k);
        v[j] = m * (c ? __builtin_amdgcn_sinf(a) : __builtin_amdgcn_cosf(a)); }
    u32x4 w; w.x = cvtpk(v[0], v[1]); w.y = cvtpk(v[2], v[3]); w.z = cvtpk(v[4], v[5]); w.w = cvtpk(v[6], v[7]);
    *(u32x4*)(APOW + (size_t)i * 16) = w;
}
struct Tr8 { const float* src; unsigned char* dst; int N, K, n0, k0, isgu, pad; };
__device__ __forceinline__ void tr8_setup(Tr8& t, const float* W, int K, int N, unsigned char* WT, int item, int lane, int isgu) {
    const int nblk = N / 32, kb = item / nblk, nb = item % nblk, q = lane & 7, o = lane >> 3;
    t.k0 = 128 * kb + 16 * o; t.n0 = 32 * nb + 4 * q; t.N = N; t.K = K; t.isgu = isgu; t.src = W + (size_t)t.k0 * N + t.n0; t.dst = WT; t.pad = 0;
}
__device__ __forceinline__ void tr8_load(const Tr8& t, f32x4 (&v)[16]) {
#pragma unroll
    for (int j = 0; j < 16; ++j) v[j] = __builtin_nontemporal_load((const f32x4*)(t.src + (size_t)j * t.N));
}
__device__ __forceinline__ void tr8_store(const Tr8& t, const f32x4 (&v)[16]) {
#pragma unroll
    for (int i = 0; i < 4; ++i) { const int nr = t.isgu ? gu_row(t.n0 + i) : (t.n0 + i);
        u32x4 a; a.x = pk4_fp8(v[0][i] * W8_SCALE, v[1][i] * W8_SCALE, v[2][i] * W8_SCALE, v[3][i] * W8_SCALE); a.y = pk4_fp8(v[4][i] * W8_SCALE, v[5][i] * W8_SCALE, v[6][i] * W8_SCALE, v[7][i] * W8_SCALE);
        a.z = pk4_fp8(v[8][i] * W8_SCALE, v[9][i] * W8_SCALE, v[10][i] * W8_SCALE, v[11][i] * W8_SCALE); a.w = pk4_fp8(v[12][i] * W8_SCALE, v[13][i] * W8_SCALE, v[14][i] * W8_SCALE, v[15][i] * W8_SCALE);
        __builtin_nontemporal_store(a, (u32x4*)(t.dst + (size_t)nr * t.K + t.k0)); }
}
struct ConvStream { const float* w_gu; const float* w_dn; unsigned char* wt_gu; unsigned char* wt_dn; int gu_first, n_gu, n_dn, stride; };

constexpr int SSM_BU_PITCH = 132, SSM_BU_BYTES = 16 * SSM_BU_PITCH * 4, SSM_X_PITCH = 272, SSM_WAVE_BYTES = SSM_BU_BYTES + 16 * SSM_X_PITCH, SSM_XEND_OFF = 8 * SSM_WAVE_BYTES, SSM_LDS_BYTES = SSM_XEND_OFF + 8 * 64 * 8;
__device__ __forceinline__ void ssm_unit(LAS unsigned char* lds, int unit, int tid, const bf16* PROJ, const float* tab, const float* c_re, const float* c_im, const float* d_skip, bf16* Gout, const bool has_cs, const ConvStream cs, const unsigned char* APOW = nullptr) {
    const int lane = tid & 63, wave = __builtin_amdgcn_readfirstlane(tid >> 6), l15 = lane & 15, q4 = lane >> 4;
    const int g = unit & 31, b = unit >> 5;
    if constexpr (SSM_MFMA_CARRY && !P3_CONV) {
        const unsigned char* gsrc = APOW + (size_t)g * 65536 + (size_t)wave * 8192 + lane * 16;
#pragma unroll
        for (int c4 = 0; c4 < 2; ++c4) { const unsigned* gp = (const unsigned*)(gsrc + c4 * 4096); LAS unsigned* lp = (LAS unsigned*)(lds + wave * 8192 + c4 * 4096);
            __builtin_amdgcn_global_load_lds(gp, lp, 16, 0, 0); __builtin_amdgcn_global_load_lds(gp, lp, 16, 1024, 0); __builtin_amdgcn_global_load_lds(gp, lp, 16, 2048, 0); __builtin_amdgcn_global_load_lds(gp, lp, 16, 3072, 0); } }
    Tr8 ct; ct.src = nullptr; ct.dst = nullptr; ct.N = ct.K = ct.n0 = ct.k0 = ct.isgu = ct.pad = 0; f32x4 cv[16]; bool cpend = false; int cq = unit * 8 + wave;
#pragma unroll
    for (int j = 0; j < 16; ++j) cv[j] = (f32x4){0.f, 0.f, 0.f, 0.f};
#define SSM_CONV_STEP() do { if (has_cs) { if (cpend) tr8_store(ct, cv); \
        constexpr int IGU = (D / 128) * (2 * DFF / 32), IDN = (DFF / 128) * (D / 32); cpend = cq < cs.n_gu + cs.n_dn; \
        { const bool isgu = cq < cs.n_gu || !cpend; const int r = !cpend ? 0 : (isgu ? cs.gu_first + cq : cq - cs.n_gu), e = r / (isgu ? IGU : IDN), it = r % (isgu ? IGU : IDN); \
          if (isgu) tr8_setup(ct, cs.w_gu + (size_t)e * D * 2 * DFF, D, 2 * DFF, cs.wt_gu + (size_t)e * 2 * DFF * D, it, lane, 1); \
          else tr8_setup(ct, cs.w_dn + (size_t)e * DFF * D, DFF, D, cs.wt_dn + (size_t)e * D * DFF, it, lane, 0); } \
        tr8_load(ct, cv); cq += cs.stride; } } while (0)
    const float* tg = tab + (size_t)g * SSMT_STRIDE;
    const float ar = tg[ST_AR + lane], ai = tg[ST_AI + lane], nai = -ai;
    bf16x8 bb[8];
#define SSM_SETUP_BB() do { _Pragma("unroll") for (int nt = 0; nt < 8; ++nt) { u32x4 w = (u32x4){0u, 0u, 0u, 0u}; \
        if (q4 < 2) { const int p = 8 * nt + (l15 >> 1); const float* src = tg + ((l15 & 1) ? ST_BI : ST_BR) + p * SG + 8 * q4; const f32x4 v0 = *(const f32x4*)src, v1 = *(const f32x4*)(src + 4); \
            w.x = cvtpk(v0.x, v0.y); w.y = cvtpk(v0.z, v0.w); w.z = cvtpk(v1.x, v1.y); w.w = cvtpk(v1.z, v1.w); } \
        bb[nt] = as_bf16x8(w); } } while (0)
    if constexpr (!(SSM_MFMA_CARRY && !P3_CONV)) SSM_SETUP_BB();
    bf16x8 cm[4];
#pragma unroll
    for (int ks = 0; ks < 4; ++ks) { const int pb = 16 * ks + 4 * q4; const f32x4 cr = *(const f32x4*)(c_re + ((size_t)g * SG + l15) * NST + pb), ci = *(const f32x4*)(c_im + ((size_t)g * SG + l15) * NST + pb);
        u32x4 w; w.x = cvtpk(cr.x, -ci.x); w.y = cvtpk(cr.y, -ci.y); w.z = cvtpk(cr.z, -ci.z); w.w = cvtpk(cr.w, -ci.w); cm[ks] = as_bf16x8(w); }
    LAS float* BU = (LAS float*)(lds + wave * SSM_WAVE_BYTES); LAS unsigned char* XT = lds + wave * SSM_WAVE_BYTES + SSM_BU_BYTES;
    LAS f32x2* xend = (LAS f32x2*)(lds + SSM_XEND_OFF);
    const bf16* ubase = PROJ + (size_t)(b * S) * DIN + UOFF + g * SG;
    const int tseg = 256 * wave;
    float xr = 0.f, xi = 0.f;
#define SSM_LOAD_U(dst, t0) do { dst = (u32x4){0u, 0u, 0u, 0u}; if (q4 < 2) dst = *(const u32x4*)(ubase + (size_t)((t0) + l15) * DIN + 8 * q4); } while (0)
#define SSM_BU_TILE(araw) do { const bf16x8 afr = as_bf16x8(araw); \
        _Pragma("unroll") for (int nt = 0; nt < 8; ++nt) { const f32x4 d = __builtin_amdgcn_mfma_f32_16x16x32_bf16(afr, bb[nt], (f32x4){0.f, 0.f, 0.f, 0.f}, 0, 0, 0); \
            _Pragma("unroll") for (int r = 0; r < 4; ++r) BU[(4 * q4 + r) * SSM_BU_PITCH + 16 * nt + l15] = d[r]; } LDS_FENCE(); } while (0)
    u32x4 ucur, unext, unn; SSM_LOAD_U(ucur, tseg); SSM_LOAD_U(unext, tseg + 16);
    if constexpr (SSM_MFMA_CARRY && !P3_CONV) {
        u32x4 idw = (u32x4){0u, 0u, 0u, 0u};
        { const int m = l15 - 8 * q4; const unsigned one = (m & 1) ? 0x3F800000u : 0x00003F80u;
          if (q4 < 2 && m >= 0 && m < 8) { idw.x = (m >> 1) == 0 ? one : 0u; idw.y = (m >> 1) == 1 ? one : 0u; idw.z = (m >> 1) == 2 ? one : 0u; idw.w = (m >> 1) == 3 ? one : 0u; } }
        const bf16x8 ident = as_bf16x8(idw);
        f32x4 V[8]; u32x4 na, nb;
#pragma unroll
        for (int rt = 0; rt < 8; ++rt) V[rt] = (f32x4){0.f, 0.f, 0.f, 0.f};
        asm volatile("s_waitcnt vmcnt(0)" ::: "memory");
        __syncthreads();
#pragma unroll 2
        for (int ks = 0; ks < 8; ++ks) {
            SSM_LOAD_U(na, tseg + 16 * ((2 * ks + 2) & 15)); SSM_LOAD_U(nb, tseg + 16 * ((2 * ks + 3) & 15));
            u32x4 afc[8];
#pragma unroll
            for (int rt = 0; rt < 8; ++rt) afc[rt] = *(const LAS u32x4*)(lds + (rt * 8 + ks) * 1024 + lane * 16);
            const f32x4 d0 = __builtin_amdgcn_mfma_f32_16x16x32_bf16(as_bf16x8(ucur), ident, (f32x4){0.f, 0.f, 0.f, 0.f}, 0, 0, 0), d1 = __builtin_amdgcn_mfma_f32_16x16x32_bf16(as_bf16x8(unext), ident, (f32x4){0.f, 0.f, 0.f, 0.f}, 0, 0, 0);
            u32x4 utw; utw.x = cvtpk(d0[0], d0[1]); utw.y = cvtpk(d0[2], d0[3]); utw.z = cvtpk(d1[0], d1[1]); utw.w = cvtpk(d1[2], d1[3]);
            const bf16x8 ut = as_bf16x8(utw);
#pragma unroll
            for (int rt = 0; rt < 8; ++rt) V[rt] = __builtin_amdgcn_mfma_f32_16x16x32_bf16(as_bf16x8(afc[rt]), ut, V[rt], 0, 0, 0);
            ucur = na; unext = nb; }
        __syncthreads();
        float bre[4][4], bim[4][4];
#pragma unroll
        for (int st = 0; st < 4; ++st)
#pragma unroll
            for (int i = 0; i < 4; ++i) { const int p = 16 * st + 4 * q4 + i; bre[st][i] = bf2f(f2bf(tg[ST_BR + p * SG + l15])); bim[st][i] = bf2f(f2bf(tg[ST_BI + p * SG + l15])); }
        LAS f32x2* PP = (LAS f32x2*)(lds + wave * SSM_WAVE_BYTES);
#pragma unroll
        for (int st = 0; st < 4; ++st)
#pragma unroll
            for (int i = 0; i < 4; ++i) { const float vr = V[2 * st][i], vi = V[2 * st + 1][i], br = bre[st][i], bi = bim[st][i];
                PP[(16 * st + 4 * q4 + i) * 18 + l15] = (f32x2){br * vr - bi * vi, br * vi + bi * vr}; }
        LDS_FENCE();
        { float sr = 0.f, si = 0.f;
#pragma unroll
          for (int q = 0; q < 8; ++q) { const f32x4 v = *(const LAS f32x4*)(PP + lane * 18 + 2 * q); sr += v.x + v.z; si += v.y + v.w; }
          xr = sr; xi = si; }
        LDS_FENCE();
    } else {
#pragma unroll 1
    for (int tile4 = 0; tile4 < 16; tile4 += 4) {
#pragma unroll
      for (int ti = 0; ti < 4; ++ti) { const int tile = tile4 + ti; SSM_LOAD_U(unn, tseg + 16 * ((tile + 2) & 15)); if (ti == 0) SSM_CONV_STEP(); SSM_BU_TILE(ucur); ucur = unext; unext = unn;
#pragma unroll
        for (int tt = 0; tt < 16; ++tt) { const f32x2 bu = *(const LAS f32x2*)(BU + tt * SSM_BU_PITCH + 2 * lane); const float nr = fma_s(ar, xr, fma_s(nai, xi, bu.x)), ni = fma_s(ar, xi, fma_s(ai, xr, bu.y)); xr = nr; xi = ni; }
        LDS_FENCE(); } }
    }
    xend[wave * 64 + lane] = (f32x2){xr, xi};
    __syncthreads();
    { float pr = ar, pi = ai;
#pragma unroll
      for (int i = 0; i < 8; ++i) { const float nr = pr * pr - pi * pi, ni = 2.0f * pr * pi; pr = nr; pi = ni; }
      xr = 0.f; xi = 0.f;
      for (int w2 = 0; w2 < wave; ++w2) { const f32x2 e = xend[w2 * 64 + lane]; const float npi = -pi; const float nr = fma_s(pr, xr, fma_s(npi, xi, e.x)), ni = fma_s(pr, xi, fma_s(pi, xr, e.y)); xr = nr; xi = ni; } }
    const f32x4 dsk = *(const f32x4*)(d_skip + g * SG + 4 * q4);
    if constexpr (SSM_MFMA_CARRY && !P3_CONV) SSM_SETUP_BB();
    u32x2 uucur = *(const u32x2*)(ubase + (size_t)(tseg + l15) * DIN + 4 * q4), uunext = *(const u32x2*)(ubase + (size_t)(tseg + 16 + l15) * DIN + 4 * q4), uunn;
#pragma unroll 1
    for (int tile4 = 0; tile4 < 16; tile4 += 4) {
#pragma unroll
      for (int ti = 0; ti < 4; ++ti) { const int tile = tile4 + ti; const int t0 = tseg + 16 * tile; SSM_LOAD_U(unn, tseg + 16 * ((tile + 2) & 15)); uunn = *(const u32x2*)(ubase + (size_t)(tseg + 16 * ((tile + 2) & 15) + l15) * DIN + 4 * q4); if (ti == 0) SSM_CONV_STEP(); SSM_BU_TILE(ucur); ucur = unext; unext = unn;
        f32x2 buv[16];
#pragma unroll
        for (int tt = 0; tt < 16; ++tt) buv[tt] = *(const LAS f32x2*)(BU + tt * SSM_BU_PITCH + 2 * lane);
#pragma unroll
        for (int tt = 0; tt < 16; ++tt) { const f32x2 bu = buv[tt]; const float nr = fma_s(ar, xr, fma_s(nai, xi, bu.x)), ni = fma_s(ar, xi, fma_s(ai, xr, bu.y)); xr = nr; xi = ni;
            *(LAS unsigned*)(XT + tt * SSM_X_PITCH + 4 * lane) = cvtpk(xr, xi); }
        LDS_FENCE();
        f32x4 y = (f32x4){0.f, 0.f, 0.f, 0.f};
#pragma unroll
        for (int ks = 0; ks < 4; ++ks) { const bf16x8 bx = *(const LAS bf16x8*)(XT + l15 * SSM_X_PITCH + (32 * ks + 8 * q4) * 2); y = __builtin_amdgcn_mfma_f32_16x16x32_bf16(cm[ks], bx, y, 0, 0, 0); }
        const size_t t = (size_t)(t0 + l15); const u32x2 uu = uucur; uucur = uunext; uunext = uunn;
        const float y0 = gelu_tanh(y[0] + dsk.x * bflo(uu.x)), y1 = gelu_tanh(y[1] + dsk.y * bfhi(uu.x)), y2 = gelu_tanh(y[2] + dsk.z * bflo(uu.y)), y3 = gelu_tanh(y[3] + dsk.w * bfhi(uu.y));
        u32x2 w; w.x = cvtpk(y0, y1); w.y = cvtpk(y2, y3);
        *(u32x2*)(Gout + ((size_t)(b * S) + t) * DSSM + g * SG + 4 * q4) = w;
        LDS_FENCE(); } }
#undef SSM_BU_TILE
#undef SSM_SETUP_BB
#undef SSM_LOAD_U
#undef SSM_CONV_STEP
    if (has_cs && cpend) tr8_store(ct, cv);
    __syncthreads();
}

constexpr int NWAVES = 8;
constexpr int RING_OFF = 0, RING_BYTES = 131072;
constexpr int LDSCTL_OFF = RING_BYTES;
constexpr int MISC_OFF = LDSCTL_OFF + 320;
constexpr int LH_OFF = LDSCTL_OFF + 512;
constexpr int SORT_OFF = RING_OFF;
constexpr int RSCR_OFF = LDSCTL_OFF + 8192;
constexpr int TE_OFF = LDSCTL_OFF + 4096;
constexpr int LDS_BYTES = 147456;
#define LDS_WAIT() asm volatile("s_waitcnt lgkmcnt(0)" ::: "memory")
#ifndef DEFER_P4_N
#define DEFER_P4_N 4
#endif
#ifndef DEFER_P2_N
#define DEFER_P2_N 5
#endif
#ifndef DN_DEFER_P9_N
#define DN_DEFER_P9_N 3072
#endif
constexpr int DN_DEFER_P9 = (MOE_FP8_GU && MOE_FP8_DN) ? DN_DEFER_P9_N : 0;
constexpr int DEFER_P2_PER_WAVE = MOE_FP8_GU ? DEFER_P2_N : 0, DEFER_P4_PER_WAVE = MOE_FP8_GU ? DEFER_P4_N : 0;
#ifndef P2_RESHAPE
#define P2_RESHAPE 1
#endif
#ifndef P2_CONV_N
#define P2_CONV_N 10
#endif
constexpr int P2_GEMM_WGS = 160;
constexpr int GU_DEFER_P2 = (P2_RESHAPE && MOE_FP8_GU) ? (256 - P2_GEMM_WGS) * 8 * P2_CONV_N : 192 * 8 * DEFER_P2_PER_WAVE, GU_DEFER_P4 = 128 * 8 * DEFER_P4_PER_WAVE, GU_DEFER = GU_DEFER_P2 + GU_DEFER_P4;
enum Phase { P_PRO = 0, P_NORM1, P_INPROJ, P_MIX_A, P_MIX_B, P_GLU, P_MIXNORM, P_OUTPROJ, P_ROUTER, P_SORT, P_GATEUP, P_DOWN, P_COMBINE, P_COUNT };

__device__ __forceinline__ void router_image_item(int i, const float* w_router, unsigned char* WRI) {
    const int lane = i & 63, rest = i >> 6, hl = rest & 1, nt = (rest >> 1) & 1, ks = (rest >> 2) & 3, w = rest >> 4, fr = lane & 15, fq = lane >> 4;
    const float* src = w_router + (size_t)(128 * w + 32 * ks + 8 * fq) * NE + 16 * nt + fr;
    float v[8];
#pragma unroll
    for (int j = 0; j < 8; ++j) v[j] = src[j * NE];
    u32x4 p;
#pragma unroll
    for (int j = 0; j < 4; ++j) { float a = v[2 * j], b = v[2 * j + 1]; unsigned hi = cvtpk(a, b); if (hl) { a -= bflo(hi); b -= bfhi(hi); hi = cvtpk(a, b); } p[j] = hi; }
    *(u32x4*)(WRI + (size_t)i * 16) = p;
}
__device__ __forceinline__ void router_block_mfma(LAS unsigned char* lds, int blk, int tid, int wave, int lane, const float* x1, const float* gain, const float* mod, const float* b_router,
                                                  const unsigned char* WRI, LAS int* lh, unsigned char* H8, int* tope, float* topw, const bf16* delta = nullptr, int* cnt = nullptr, int* toke = nullptr, float* wrowe = nullptr, int* paire = nullptr, bf16* x1b = nullptr) {
    asm volatile("" : "+v"(lane), "+v"(tid));
    const int b = (blk * 64) / S, fr = lane & 15, fq = lane >> 4;
    LAS unsigned char* Wl = lds + RING_OFF + wave * 16384;
    LAS float* gsh = (LAS float*)(lds + RSCR_OFF);
    LAS float* ssqx = (LAS float*)(lds + TE_OFF);
    LAS int* sel_e = (LAS int*)(lds + TE_OFF + 2048);
    LAS float* sel_v = (LAS float*)(lds + TE_OFF + 3072);
    LAS float* lg = (LAS float*)(lds + RING_OFF + 8192);
    { const unsigned char* gsrc = WRI + (size_t)wave * 16384 + lane * 16;
#pragma unroll
      for (int c4 = 0; c4 < 4; ++c4) { const unsigned* gp = (const unsigned*)(gsrc + c4 * 4096); LAS unsigned* lp = (LAS unsigned*)(Wl + c4 * 4096);
          __builtin_amdgcn_global_load_lds(gp, lp, 16, 0, 0); __builtin_amdgcn_global_load_lds(gp, lp, 16, 1024, 0); __builtin_amdgcn_global_load_lds(gp, lp, 16, 2048, 0); __builtin_amdgcn_global_load_lds(gp, lp, 16, 3072, 0); } }
    f32x4 xv[4][4][2];
    const float* xb = x1 + (size_t)(blk * 64 + fr) * D + 128 * wave + 8 * fq;
#pragma unroll
    for (int m = 0; m < 4; ++m)
#pragma unroll
        for (int ks = 0; ks < 4; ++ks) { xv[m][ks][0] = *(const f32x4*)(xb + (size_t)(16 * m) * D + 32 * ks); xv[m][ks][1] = *(const f32x4*)(xb + (size_t)(16 * m) * D + 32 * ks + 4); }
    if (delta) {
        const bf16* db = delta + (size_t)(blk * 64 + fr) * D + 128 * wave + 8 * fq; u32x4 dv[4][4];
#pragma unroll
        for (int m = 0; m < 4; ++m)
#pragma unroll
            for (int ks = 0; ks < 4; ++ks) dv[m][ks] = *(const u32x4*)(db + (size_t)(16 * m) * D + 32 * ks);
#pragma unroll
        for (int m = 0; m < 4; ++m)
#pragma unroll
            for (int ks = 0; ks < 4; ++ks) { const u32x4 d = dv[m][ks];
                xv[m][ks][0] += (f32x4){bflo(d.x), bfhi(d.x), bflo(d.y), bfhi(d.y)}; xv[m][ks][1] += (f32x4){bflo(d.z), bfhi(d.z), bflo(d.w), bfhi(d.w)}; } }
    if (x1b) { bf16* xo = x1b + (size_t)(blk * 64 + fr) * D + 128 * wave + 8 * fq;
#pragma unroll
        for (int m = 0; m < 4; ++m)
#pragma unroll
            for (int ks = 0; ks < 4; ++ks) { const f32x4 a = xv[m][ks][0], c2 = xv[m][ks][1]; u32x4 w; w.x = cvtpk(a.x, a.y); w.y = cvtpk(a.z, a.w); w.z = cvtpk(c2.x, c2.y); w.w = cvtpk(c2.z, c2.w);
                *(u32x4*)(xo + (size_t)(16 * m) * D + 32 * ks) = w; } }
    if (lane < 32) { const int c = 128 * wave + 4 * lane; const f32x4 g = *(const f32x4*)(gain + c), sc = *(const f32x4*)(mod + b * 6 * D + 4 * D + c);
        *(LAS f32x4*)(gsh + c) = g * (1.0f + sc); *(LAS f32x4*)(gsh + 1024 + c) = *(const f32x4*)(mod + b * 6 * D + 3 * D + c); }
    float ss[4];
#pragma unroll
    for (int m = 0; m < 4; ++m) { float a = 0.f;
#pragma unroll
        for (int ks = 0; ks < 4; ++ks)
#pragma unroll
            for (int h = 0; h < 2; ++h) { const f32x4 v = xv[m][ks][h]; a += (v.x * v.x + v.y * v.y) + (v.z * v.z + v.w * v.w); }
        a += __shfl_xor(a, 16); a += __shfl_xor(a, 32); ss[m] = a; }
    if (fq == 0) {
#pragma unroll
        for (int m = 0; m < 4; ++m) ssqx[(16 * m + fr) * 8 + wave] = ss[m]; }
    asm volatile("s_waitcnt vmcnt(0)" ::: "memory");
    __syncthreads();
    float r[4];
#pragma unroll
    for (int m = 0; m < 4; ++m) { const f32x4 a = *(const LAS f32x4*)(ssqx + (16 * m + fr) * 8), c = *(const LAS f32x4*)(ssqx + (16 * m + fr) * 8 + 4);
        r[m] = rsqrtf((((a.x + a.y) + (a.z + a.w)) + ((c.x + c.y) + (c.z + c.w))) * (1.0f / D) + EPS); }
    f32x4 acc[4][2];
#pragma unroll
    for (int m = 0; m < 4; ++m)
#pragma unroll
        for (int nt = 0; nt < 2; ++nt) acc[m][nt] = (f32x4){0.f, 0.f, 0.f, 0.f};
#pragma unroll
    for (int ks = 0; ks < 4; ++ks) { const int kk = 128 * wave + 32 * ks + 8 * fq;
        const f32x4 g0 = *(const LAS f32x4*)(gsh + kk), g1 = *(const LAS f32x4*)(gsh + kk + 4), s0 = *(const LAS f32x4*)(gsh + 1024 + kk), s1 = *(const LAS f32x4*)(gsh + 1024 + kk + 4);
        bf16x8 Wh[2], Wo[2];
#pragma unroll
        for (int nt = 0; nt < 2; ++nt) { Wh[nt] = *(const LAS bf16x8*)(Wl + ((ks * 2 + nt) * 2 + 0) * 1024 + lane * 16); Wo[nt] = *(const LAS bf16x8*)(Wl + ((ks * 2 + nt) * 2 + 1) * 1024 + lane * 16); }
#pragma unroll
        for (int m = 0; m < 4; ++m) { const f32x4 h0 = xv[m][ks][0] * r[m] * g0 + s0, h1 = xv[m][ks][1] * r[m] * g1 + s1;
            u32x2 w8; w8.x = pk4_fp8(h0.x * H8_SCALE, h0.y * H8_SCALE, h0.z * H8_SCALE, h0.w * H8_SCALE); w8.y = pk4_fp8(h1.x * H8_SCALE, h1.y * H8_SCALE, h1.z * H8_SCALE, h1.w * H8_SCALE);
            *(u32x2*)(H8 + (size_t)(blk * 64 + 16 * m + fr) * D + kk) = w8;
            u32x4 hi, lo;
            hi.x = cvtpk(h0.x, h0.y); hi.y = cvtpk(h0.z, h0.w); hi.z = cvtpk(h1.x, h1.y); hi.w = cvtpk(h1.z, h1.w);
            lo.x = cvtpk(h0.x - bflo(hi.x), h0.y - bfhi(hi.x)); lo.y = cvtpk(h0.z - bflo(hi.y), h0.w - bfhi(hi.y)); lo.z = cvtpk(h1.x - bflo(hi.z), h1.y - bfhi(hi.z)); lo.w = cvtpk(h1.z - bflo(hi.w), h1.w - bfhi(hi.w));
            const bf16x8 Xh = __builtin_bit_cast(bf16x8, hi), Xl = __builtin_bit_cast(bf16x8, lo);
#pragma unroll
            for (int nt = 0; nt < 2; ++nt) { acc[m][nt] = __builtin_amdgcn_mfma_f32_16x16x32_bf16(Wo[nt], Xh, acc[m][nt], 0, 0, 0); acc[m][nt] = __builtin_amdgcn_mfma_f32_16x16x32_bf16(Wh[nt], Xl, acc[m][nt], 0, 0, 0);
                acc[m][nt] = __builtin_amdgcn_mfma_f32_16x16x32_bf16(Wh[nt], Xh, acc[m][nt], 0, 0, 0); } } }
    { LAS float* part = (LAS float*)Wl;
#pragma unroll
      for (int m = 0; m < 4; ++m)
#pragma unroll
          for (int nt = 0; nt < 2; ++nt) *(LAS f32x4*)(part + (16 * m + fr) * 32 + 16 * nt + 4 * fq) = acc[m][nt]; }
    __syncthreads();
    { const int row = tid >> 3, eg = tid & 7; f32x4 sum = *(const f32x4*)(b_router + 4 * eg);
#pragma unroll
      for (int w2 = 0; w2 < 8; ++w2) sum += *(const LAS f32x4*)(lds + RING_OFF + w2 * 16384 + (row * 32 + 4 * eg) * 4);
      *(LAS f32x4*)(lg + row * 32 + 4 * eg) = sum; }
    __syncthreads();
    { const int row = 8 * wave + (lane >> 3), eg = lane & 7; const LAS float* lgr = lg + row * 32;
      const f32x4 mine = *(const LAS f32x4*)(lgr + 4 * eg); const int e0m = 4 * eg;
      int rk0 = 0, rk1 = 0, rk2 = 0, rk3 = 0;
#pragma unroll
      for (int q = 0; q < 8; ++q) { const f32x4 a = *(const LAS f32x4*)(lgr + 4 * q);
#pragma unroll
          for (int t = 0; t < 4; ++t) { const int e2 = 4 * q + t; const float av = a[t];
              rk0 += (av > mine.x || (av == mine.x && e2 < e0m + 0)) ? 1 : 0; rk1 += (av > mine.y || (av == mine.y && e2 < e0m + 1)) ? 1 : 0;
              rk2 += (av > mine.z || (av == mine.z && e2 < e0m + 2)) ? 1 : 0; rk3 += (av > mine.w || (av == mine.w && e2 < e0m + 3)) ? 1 : 0; } }
      if (rk0 < 4) { sel_e[row * 4 + rk0] = e0m + 0; sel_v[row * 4 + rk0] = mine.x; }
      if (rk1 < 4) { sel_e[row * 4 + rk1] = e0m + 1; sel_v[row * 4 + rk1] = mine.y; }
      if (rk2 < 4) { sel_e[row * 4 + rk2] = e0m + 2; sel_v[row * 4 + rk2] = mine.z; }
      if (rk3 < 4) { sel_e[row * 4 + rk3] = e0m + 3; sel_v[row * 4 + rk3] = mine.w; }
      asm volatile("s_waitcnt lgkmcnt(0)" ::: "memory");
      if (eg == 0) { const i32x4 ee = *(const LAS i32x4*)(sel_e + row * 4); const f32x4 vv = *(const LAS f32x4*)(sel_v + row * 4);
          const float x1v = __expf(vv.y - vv.x), x2v = __expf(vv.z - vv.x), x3v = __expf(vv.w - vv.x), inv = 1.0f / (1.0f + x1v + x2v + x3v);
          const size_t g = (size_t)(blk * 64 + row) * 4;
          if (cnt) *(LAS f32x4*)(sel_v + row * 4) = (f32x4){inv, x1v * inv, x2v * inv, x3v * inv};
          else { *(i32x4*)(tope + g) = ee; *(f32x4*)(topw + g) = (f32x4){inv, x1v * inv, x2v * inv, x3v * inv}; }
          (void)__hip_atomic_fetch_add(&lh[ee.x], 1, __ATOMIC_RELAXED, __HIP_MEMORY_SCOPE_WORKGROUP); (void)__hip_atomic_fetch_add(&lh[ee.y], 1, __ATOMIC_RELAXED, __HIP_MEMORY_SCOPE_WORKGROUP);
          (void)__hip_atomic_fetch_add(&lh[ee.z], 1, __ATOMIC_RELAXED, __HIP_MEMORY_SCOPE_WORKGROUP); (void)__hip_atomic_fetch_add(&lh[ee.w], 1, __ATOMIC_RELAXED, __HIP_MEMORY_SCOPE_WORKGROUP); }
      asm volatile("s_waitcnt lgkmcnt(0)" ::: "memory"); }
    if (cnt) {
        LAS int* offs = (LAS int*)ssqx; LAS int* es = (LAS int*)ssqx + 32;
        __syncthreads();
        if (tid < NE) { offs[tid] = __hip_atomic_fetch_add(cnt + tid * CNT_STRIDE, lh[tid], __ATOMIC_RELAXED, __HIP_MEMORY_SCOPE_AGENT); lh[tid] = 0; }
        int my_e = 0, rank = 0;
        if (tid < 256) { my_e = sel_e[tid]; const unsigned long long lt = (lane == 0) ? 0ull : (~0ull >> (64 - lane));
#pragma unroll 4
            for (int e = 0; e < NE; ++e) { const unsigned long long mk = __ballot(my_e == e); if (my_e == e) rank = __popcll(mk & lt); if (lane == 0) es[wave * 32 + e] = __popcll(mk); } }
        __syncthreads();
        if (tid < 256) { for (int w2 = 0; w2 < wave; ++w2) rank += es[w2 * 32 + my_e];
            const int slot = offs[my_e] + rank;
            toke[(size_t)my_e * T + slot] = blk * 64 + (tid >> 2); wrowe[(size_t)my_e * T + slot] = sel_v[tid]; paire[(size_t)blk * 256 + tid] = slot | (my_e << 20); }
    }
}

struct Args { const float* in[30]; float* out; unsigned char* ws; int ph_lo, ph_hi, li, pad; };

template <bool GU> __device__ __forceinline__ void p0_transpose_item(const float* W, int K, int N, bf16* WT, int item, int lane, const float* kscale = nullptr) {
    const int nblk = N / 64, kb = item / nblk, nb = item % nblk, q = lane & 15, o = lane >> 4, k0 = 64 * kb + 16 * o, n0 = 64 * nb + 4 * q;
    const float* src = W + (size_t)k0 * N + n0;
    f32x4 v[16];
#pragma unroll
    for (int j = 0; j < 16; ++j) v[j] = *(const f32x4*)(src + (size_t)j * N);
    if (kscale) {
#pragma unroll
        for (int j = 0; j < 16; ++j) v[j] = v[j] * kscale[k0 + j]; }
#pragma unroll
    for (int i = 0; i < 4; ++i) { const int nr = GU ? gu_row(n0 + i) : (n0 + i);
        u32x4 a, b;
        a.x = cvtpk(v[0][i], v[1][i]); a.y = cvtpk(v[2][i], v[3][i]); a.z = cvtpk(v[4][i], v[5][i]); a.w = cvtpk(v[6][i], v[7][i]);
        b.x = cvtpk(v[8][i], v[9][i]); b.y = cvtpk(v[10][i], v[11][i]); b.z = cvtpk(v[12][i], v[13][i]); b.w = cvtpk(v[14][i], v[15][i]);
        u32x4* dst = (u32x4*)(WT + (size_t)nr * K + k0); dst[0] = a; dst[1] = b; }
}

template <bool GU> __device__ __forceinline__ void p0_transpose_item_fp8(const float* W, int K, int N, unsigned char* WT, int item, int lane) {
    const int nblk = N / 32, kb = item / nblk, nb = item % nblk, q = lane & 7, o = lane >> 3, k0 = 128 * kb + 16 * o, n0 = 32 * nb + 4 * q;
    const float* src = W + (size_t)k0 * N + n0;
    f32x4 v[16];
#pragma unroll
    for (int j = 0; j < 16; ++j) v[j] = __builtin_nontemporal_load((const f32x4*)(src + (size_t)j * N)) * W8_SCALE;
#pragma unroll
    for (int i = 0; i < 4; ++i) { const int nr = GU ? gu_row(n0 + i) : (n0 + i);
        u32x4 a; a.x = pk4_fp8(v[0][i], v[1][i], v[2][i], v[3][i]); a.y = pk4_fp8(v[4][i], v[5][i], v[6][i], v[7][i]); a.z = pk4_fp8(v[8][i], v[9][i], v[10][i], v[11][i]); a.w = pk4_fp8(v[12][i], v[13][i], v[14][i], v[15][i]);
        __builtin_nontemporal_store(a, (u32x4*)(WT + (size_t)nr * K + k0)); }
}

__global__ void __launch_bounds__(NWAVES * 64, 2) mk_fwd(Args args) {
    extern __shared__ __attribute__((aligned(16))) unsigned char lds_raw[];
    LAS unsigned char* lds = (LAS unsigned char*)lds_raw;
    const int tid = threadIdx.x, lane = tid & 63, wave = __builtin_amdgcn_readfirstlane(tid >> 6);
    const int G = gridDim.x, bx = blockIdx.x, vcu = (G % 8 == 0) ? (bx % 8) * (G / 8) + bx / 8 : bx;
    const int gw = vcu * NWAVES + wave, NGW = G * NWAVES;
    unsigned char* ws = args.ws;
    const float* x = args.in[0]; const float* c_in = args.in[1]; const float* w_ada = args.in[2]; const float* b_ada = args.in[3];
    const float* norm_mix = args.in[4]; const float* w_in = args.in[5]; const float* b_in = args.in[6];
    const float* q_norm = args.in[7]; const float* k_norm = args.in[8]; const float* sinks = args.in[9];
    const float* lam_re = args.in[10]; const float* lam_im = args.in[11]; const float* log_dt = args.in[12];
    const float* b_re = args.in[13]; const float* b_im = args.in[14]; const float* c_re = args.in[15]; const float* c_im = args.in[16];
    const float* d_skip = args.in[17]; const float* w_glu = args.in[18]; const float* b_glu = args.in[19];
    const float* attn_out_norm = args.in[20]; const float* ssm_out_norm = args.in[21]; const float* w_out = args.in[22];
    const float* norm_ffn = args.in[23]; const float* w_router = args.in[24]; const float* b_router = args.in[25];
    const float* w_gate_up = args.in[26]; const float* b_gate_up = args.in[27]; const float* w_down = args.in[28]; const float* b_down = args.in[29];
    float* out = args.out;
    float* MOD = (float*)(ws + WS_MOD); float* SSMT = (float*)(ws + WS_SSMT);
    bf16* WTIN = (bf16*)(ws + WS_WTIN); bf16* WTGLU = (bf16*)(ws + WS_WTGLU); bf16* WTOUT = (bf16*)(ws + WS_WTOUT); bf16* WTGU = (bf16*)(ws + WS_WTGU); bf16* WTDN = (bf16*)(ws + WS_WTDN);
    bf16* H = (bf16*)(ws + WS_H); bf16* PROJ = (bf16*)(ws + WS_PROJ); bf16* ATT = (bf16*)(ws + WS_ATT); bf16* Gb = (bf16*)(ws + WS_G); bf16* SSMG = (bf16*)(ws + WS_SSMG); bf16* MIXED = (bf16*)(ws + WS_MIXED);
    int* TOPE = (int*)(ws + WS_TOPE); float* TOPW = (float*)(ws + WS_TOPW); int* HIST = (int*)(ws + WS_HIST); int* TOKROW = (int*)(ws + WS_TOKROW); int* ROWPAIR = (int*)(ws + WS_ROWPAIR);
    float* WROW = (float*)(ws + WS_WROW); int* TILEE = (int*)(ws + WS_TILEE); bf16* ACT = (bf16*)(ws + WS_ACT); bf16* YS = (bf16*)(ws + WS_YS);
    float* XST = (float*)(ws + WS_XST); float* SC = (float*)(ws + WS_SC);

    for (int u = tid; u < (LDS_BYTES - LDSCTL_OFF) / 4; u += NWAVES * 64) ((LAS unsigned*)(lds + LDSCTL_OFF))[u] = 0u;
    __syncthreads();
    volatile LAS unsigned* MISC = (volatile LAS unsigned*)(lds + MISC_OFF);
    XcdBarrier bar = xcd_barrier_post((unsigned*)(ws + WS_CTL) + CW_BAR + args.li * XCD_BAR_WORDS, MISC + 8);
    const int lo = args.ph_lo, hi = args.ph_hi;
#define IN(k) (lo <= (k) && (k) < hi)
#define SEAM(k) do { if (IN(k) && IN((k) + 1)) xcd_barrier(bar); } while (0)

    if (IN(P_PRO)) {
        if (vcu < 96) {
            LAS float* ca = (LAS float*)(lds + RING_OFF);
            LAS float* red = (LAS float*)(lds + RING_OFF + 32768);
            for (int k = tid; k < D; k += 512) { float cv8[NB];
#pragma unroll
                for (int b = 0; b < NB; ++b) { const float v = c_in[b * D + k]; cv8[b] = v * sigmoidf_(v); }
                *(LAS f32x4*)(ca + k * 8) = (f32x4){cv8[0], cv8[1], cv8[2], cv8[3]}; *(LAS f32x4*)(ca + k * 8 + 4) = (f32x4){cv8[4], cv8[5], cv8[6], cv8[7]}; }
            __syncthreads();
            float acc[NB];
#pragma unroll
            for (int b = 0; b < NB; ++b) acc[b] = 0.f;
            const float* wp = w_ada + (size_t)(128 * wave) * (6 * D) + 64 * vcu + lane;
#pragma unroll 1
            for (int k0 = 0; k0 < 128; k0 += 64) {
                float wv[64];
#pragma unroll
                for (int j = 0; j < 64; ++j) wv[j] = __builtin_nontemporal_load(wp + (size_t)(k0 + j) * (6 * D));
#pragma unroll
                for (int j = 0; j < 64; ++j) { const float w = wv[j]; const f32x4 c0 = *(const LAS f32x4*)(ca + (128 * wave + k0 + j) * 8), c1 = *(const LAS f32x4*)(ca + (128 * wave + k0 + j) * 8 + 4);
                    acc[0] = fmaf(c0.x, w, acc[0]); acc[1] = fmaf(c0.y, w, acc[1]); acc[2] = fmaf(c0.z, w, acc[2]); acc[3] = fmaf(c0.w, w, acc[3]);
                    acc[4] = fmaf(c1.x, w, acc[4]); acc[5] = fmaf(c1.y, w, acc[5]); acc[6] = fmaf(c1.z, w, acc[6]); acc[7] = fmaf(c1.w, w, acc[7]); } }
#pragma unroll
            for (int b = 0; b < NB; ++b) red[(wave * 8 + b) * 64 + lane] = acc[b];
            __syncthreads();
            { float s = b_ada[64 * vcu + lane];
#pragma unroll
              for (int w2 = 0; w2 < 8; ++w2) s += red[(w2 * 8 + wave) * 64 + lane];
              MOD[wave * 6 * D + 64 * vcu + lane] = s; }
            __syncthreads();
        } else if (vcu < 100) { const int i = (vcu - 96) * 512 + tid; ssm_table_item(i, lam_re, lam_im, log_dt, b_re, b_im, SSMT); }
        else if (FAST_ROUTER && MOE_FP8_GU && vcu < 116) router_image_item((vcu - 100) * 512 + tid, w_router, ws + WS_WRI);
        if constexpr (SSM_MFMA_CARRY && !P3_CONV) for (int i = vcu * 512 + tid; i < NG * 64 * 64; i += G * 512) ssm_apow_item(i, lam_re, lam_im, log_dt, ws + WS_APOW);
        constexpr int I_IN = (D / 64) * (DIN / 64), I_GLU = (DSSM / 64) * (DSSM / 64), I_OUT = (D / 64) * (D / 64), I_GU = MOE_FP8_GU ? (D / 128) * (2 * DFF / 32) : (D / 64) * (2 * DFF / 64), I_DN = MOE_FP8_DN ? (DFF / 128) * (D / 32) : (DFF / 64) * (D / 64);
        constexpr int NITEMS = I_IN + I_GLU + I_OUT + NE * I_GU + NE * I_DN;
        const int gu_defer = (G == 256) ? GU_DEFER : 0;
        const int nitems_p0 = (G == 256 && P3_CONV) ? (I_IN + I_GLU + I_OUT) : (NITEMS - gu_defer - (G == 256 ? DN_DEFER_P9 : 0));
        for (int it0 = gw; it0 < nitems_p0; it0 += NGW) {
            int r = (it0 < I_IN + I_GLU + I_OUT) ? it0 : it0 + gu_defer;
            if (r < I_IN) { p0_transpose_item<false>(w_in, D, DIN, WTIN, r, lane); continue; } r -= I_IN;
            if (r < I_GLU) { p0_transpose_item<false>(w_glu, DSSM, DSSM, WTGLU, r, lane); continue; } r -= I_GLU;
            if (r < I_OUT) { const int kb = r / (D / 64);
                p0_transpose_item<false>(w_out, D, D, WTOUT, r, lane, FUSE_MIXNORM ? (kb < 8 ? attn_out_norm : ssm_out_norm - DATT) : nullptr); continue; } r -= I_OUT;
            if (r < NE * I_GU) { const int e = r / I_GU;
                if constexpr (MOE_FP8_GU) p0_transpose_item_fp8<true>(w_gate_up + (size_t)e * D * 2 * DFF, D, 2 * DFF, (unsigned char*)WTGU + (size_t)e * 2 * DFF * D, r % I_GU, lane);
                else p0_transpose_item<true>(w_gate_up + (size_t)e * D * 2 * DFF, D, 2 * DFF, WTGU + (size_t)e * 2 * DFF * D, r % I_GU, lane);
                continue; } r -= NE * I_GU;
            { const int e = r / I_DN;
              if constexpr (MOE_FP8_DN) p0_transpose_item_fp8<false>(w_down + (size_t)e * DFF * D, DFF, D, (unsigned char*)WTDN + (size_t)e * D * DFF, r % I_DN, lane);
              else p0_transpose_item<false>(w_down + (size_t)e * DFF * D, DFF, D, WTDN + (size_t)e * D * DFF, r % I_DN, lane); }
        }
    }
    SEAM(P_PRO);
    if (IN(P_NORM1)) {
        for (int m0 = 8 * gw; m0 < T; m0 += 8 * NGW) { const int b = m0 / S; f32x4 gm[4], shv[4];
#pragma unroll
            for (int j = 0; j < 4; ++j) { const int c = 4 * lane + 256 * j; gm[j] = *(const f32x4*)(norm_mix + c) * (1.0f + *(const f32x4*)(MOD + b * 6 * D + D + c)); shv[j] = *(const f32x4*)(MOD + b * 6 * D + c); }
#pragma unroll 2
            for (int i = 0; i < 8; ++i) { const int m = m0 + i; const f32x4* xr = (const f32x4*)(x + (size_t)m * D) + lane; f32x4 v[4]; float ss = 0.f;
#pragma unroll
                for (int j = 0; j < 4; ++j) { v[j] = xr[64 * j]; ss += (v[j].x * v[j].x + v[j].y * v[j].y) + (v[j].z * v[j].z + v[j].w * v[j].w); }
                const float r = rsqrtf(wave_sum(ss) * (1.0f / D) + EPS); u32x2* o = (u32x2*)(H + (size_t)m * D) + lane;
#pragma unroll
                for (int j = 0; j < 4; ++j) { const f32x4 y = v[j] * r * gm[j] + shv[j]; u32x2 w; w.x = cvtpk(y.x, y.y); w.y = cvtpk(y.z, y.w); o[64 * j] = w; } } }
    }
    SEAM(P_NORM1);
    if (IN(P_INPROJ)) {
        constexpr int I_GU8 = (D / 128) * (2 * DFF / 32);
        const bool reshape = P2_RESHAPE && GU_DEFER_P2 > 0 && G == 256;
        const int Gg = reshape ? P2_GEMM_WGS : G;
        if (bx < Gg) {
            pg8::DenseOrder So{(const char*)H, (const char*)WTIN, T / 256, DIN / 256, Gg, bx, (size_t)256 * D * 2};
            pg8::EpiProj E{PROJ, DIN, b_in, (LAS float*)(lds + RSCR_OFF + 4096)};
            pg8::gemm_phase<pg8::EpiProj, pg8::DenseOrder, true, false>(lds + RING_OFF, D, So, E);
            if constexpr (GU_DEFER_P2 > 0 && !P2_RESHAPE) { if (G == 256 && bx >= 64) {
                for (int k = 0; k < DEFER_P2_PER_WAVE; ++k) { const int r = ((bx - 64) * 8 + wave) * DEFER_P2_PER_WAVE + k, e = r / I_GU8;
                    p0_transpose_item_fp8<true>(w_gate_up + (size_t)e * D * 2 * DFF, D, 2 * DFF, (unsigned char*)WTGU + (size_t)e * 2 * DFF * D, r % I_GU8, lane); } } }
        } else {
            const int nconv = (G - Gg) * 8;
            for (int r = (bx - Gg) * 8 + wave; r < GU_DEFER_P2; r += nconv) { const int e = r / I_GU8;
                p0_transpose_item_fp8<true>(w_gate_up + (size_t)e * D * 2 * DFF, D, 2 * DFF, (unsigned char*)WTGU + (size_t)e * 2 * DFF * D, r % I_GU8, lane); }
        }
    }
    SEAM(P_INPROJ);
    if (IN(P_MIX_A)) {
#if FAST_ATTN
        for (int u = bx; u < NB * 16 * NKV; u += G) attn_unit(lds + RING_OFF, u, tid, PROJ, q_norm, k_norm, sinks, ATT, FUSE_MIXNORM ? (float*)(ws + WS_MIXED) : nullptr);
#else
        for (int idx = bx * 512 + tid; idx < T * NH; idx += G * 512) attn_scores_item(idx, PROJ, q_norm, k_norm, SC);
#endif
#if FAST_SSM
        { constexpr int IGU = (D / 128) * (2 * DFF / 32), IDN = (DFF / 128) * (D / 32);
          const ConvStream cstr{w_gate_up, w_down, (unsigned char*)WTGU, (unsigned char*)WTDN, GU_DEFER, NE * IGU - GU_DEFER, NE * IDN - DN_DEFER_P9, 2048};
          const bool use_cs = (G == 256) && P3_CONV;
          for (int u = bx; u < NB * NG; u += G) ssm_unit(lds + RING_OFF, u, tid, PROJ, SSMT, c_re, c_im, d_skip, Gb, use_cs, cstr, ws + WS_APOW); }
#else
        if (wave == 0) for (int idx = bx * 64 + lane; idx < NB * NG * NST; idx += G * 64) ssm_scan_item(idx, PROJ, SSMT, XST);
#endif
    }
    SEAM(P_MIX_A);
    if (IN(P_MIX_B)) {
#if !FAST_ATTN
        for (int idx = bx * 512 + tid; idx < T * NH * HD; idx += G * 512) attn_out_item(idx, PROJ, SC, sinks, ATT);
#endif
#if !FAST_SSM
        for (int idx = bx * 512 + tid; idx < T * DSSM; idx += G * 512) ssm_out_item(idx, PROJ, XST, c_re, c_im, d_skip, Gb);
#endif
    }
#if !(FAST_ATTN && FAST_SSM)
    SEAM(P_MIX_B);
#endif
    if (IN(P_GLU)) {
        pg8::DenseOrder So{(const char*)Gb, (const char*)WTGLU, T / 256, DSSM / 256, G, bx, (size_t)256 * DSSM * 2};
        pg8::EpiGlu E{Gb, SSMG, b_glu, FUSE_MIXNORM ? (float*)(ws + WS_MIXED + MiB) : nullptr, (LAS float*)(lds + RSCR_OFF + 4096)};
        pg8::gemm_phase<pg8::EpiGlu, pg8::DenseOrder, true, false>(lds + RING_OFF, DSSM, So, E);
        if constexpr (GU_DEFER_P4 > 0) { if (G == 256 && bx >= 128) {
            constexpr int I_GU8 = (D / 128) * (2 * DFF / 32);
            for (int k = 0; k < DEFER_P4_PER_WAVE; ++k) { const int r = GU_DEFER_P2 + ((bx - 128) * 8 + wave) * DEFER_P4_PER_WAVE + k, e = r / I_GU8;
                p0_transpose_item_fp8<true>(w_gate_up + (size_t)e * D * 2 * DFF, D, 2 * DFF, (unsigned char*)WTGU + (size_t)e * 2 * DFF * D, r % I_GU8, lane); } } }
    }
    SEAM(P_GLU);
    if (IN(P_MIXNORM) && !FUSE_MIXNORM) {
        const f32x4 ga0 = *(const f32x4*)(attn_out_norm + 8 * lane), ga1 = *(const f32x4*)(attn_out_norm + 8 * lane + 4), gs0 = *(const f32x4*)(ssm_out_norm + 8 * lane), gs1 = *(const f32x4*)(ssm_out_norm + 8 * lane + 4);
        for (int m0 = 2 * gw; m0 < T; m0 += 2 * NGW) {
            u32x4 a[2], q[2];
#pragma unroll
            for (int r = 0; r < 2; ++r) { a[r] = *((const u32x4*)(ATT + (size_t)(m0 + r) * DATT) + lane); q[r] = *((const u32x4*)(SSMG + (size_t)(m0 + r) * DSSM) + lane); }
#pragma unroll
            for (int r = 0; r < 2; ++r) {
                const float av[8] = {bflo(a[r].x), bfhi(a[r].x), bflo(a[r].y), bfhi(a[r].y), bflo(a[r].z), bfhi(a[r].z), bflo(a[r].w), bfhi(a[r].w)};
                const float sv[8] = {bflo(q[r].x), bfhi(q[r].x), bflo(q[r].y), bfhi(q[r].y), bflo(q[r].z), bfhi(q[r].z), bflo(q[r].w), bfhi(q[r].w)};
                float qa = 0.f, qs = 0.f;
#pragma unroll
                for (int i = 0; i < 8; ++i) { qa += av[i] * av[i]; qs += sv[i] * sv[i]; }
                const float ra = rsqrtf(wave_sum(qa) * (1.0f / DATT) + EPS), rs = rsqrtf(wave_sum(qs) * (1.0f / DSSM) + EPS);
                u32x4 oa, os;
                oa.x = pk2(av[0] * ra * ga0.x, av[1] * ra * ga0.y); oa.y = pk2(av[2] * ra * ga0.z, av[3] * ra * ga0.w); oa.z = pk2(av[4] * ra * ga1.x, av[5] * ra * ga1.y); oa.w = pk2(av[6] * ra * ga1.z, av[7] * ra * ga1.w);
                os.x = pk2(sv[0] * rs * gs0.x, sv[1] * rs * gs0.y); os.y = pk2(sv[2] * rs * gs0.z, sv[3] * rs * gs0.w); os.z = pk2(sv[4] * rs * gs1.x, sv[5] * rs * gs1.y); os.w = pk2(sv[6] * rs * gs1.z, sv[7] * rs * gs1.w);
                *((u32x4*)(MIXED + (size_t)(m0 + r) * D) + lane) = oa; *((u32x4*)(MIXED + (size_t)(m0 + r) * D + DATT) + lane) = os; } }
    }
    if (!FUSE_MIXNORM) SEAM(P_MIXNORM);
    if (IN(P_OUTPROJ)) {
        if constexpr (FUSE_MIXNORM) {
            pg8::MixOrder So{(const char*)ATT, (const char*)WTOUT, T / 256, D / 256, G, bx, (size_t)(WS_SSMG - WS_ATT)};
            pg8::EpiOut E{x, MOD, X1_DELTA ? (float*)(ws + WS_DELTA) : out, (const float*)(ws + WS_MIXED), (const float*)(ws + WS_MIXED + MiB), (LAS float*)(lds + RSCR_OFF), (LAS float*)(lds + RSCR_OFF + 4096)};
            pg8::gemm_phase<pg8::EpiOut, pg8::MixOrder, false, false>(lds + RING_OFF, D, So, E);
        } else {
            pg8::DenseOrder So{(const char*)MIXED, (const char*)WTOUT, T / 256, D / 256, G, bx, (size_t)256 * D * 2};
            pg8::EpiOut E{x, MOD, X1_DELTA ? (float*)(ws + WS_DELTA) : out, nullptr, nullptr, (LAS float*)(lds + RSCR_OFF), (LAS float*)(lds + RSCR_OFF + 4096)};
            pg8::gemm_phase<pg8::EpiOut, pg8::DenseOrder, false, false>(lds + RING_OFF, D, So, E);
        }
    }
    SEAM(P_OUTPROJ);
    if (IN(P_ROUTER)) {
        LAS float* wr = (LAS float*)(lds + RING_OFF); LAS int* lh = (LAS int*)(lds + LH_OFF);
        constexpr bool FR = FAST_ROUTER && MOE_FP8_GU, FS = FR && FAST_SORT && MOE_FP8_DN && YS_FP8;
        if constexpr (!FR) for (int c = tid; c < D; c += 512) {
            f32x4 wv[8];
#pragma unroll
            for (int k = 0; k < 8; ++k) wv[k] = *(const f32x4*)(w_router + (size_t)c * NE + 4 * k);
#pragma unroll
            for (int k = 0; k < 8; ++k) { wr[(4 * k + 0) * D + c] = wv[k].x; wr[(4 * k + 1) * D + c] = wv[k].y; wr[(4 * k + 2) * D + c] = wv[k].z; wr[(4 * k + 3) * D + c] = wv[k].w; } }
        if (tid < NE) lh[tid] = 0;
        __syncthreads();
        for (int vb = bx; vb < 256; vb += G) {
            if constexpr (FR) router_block_mfma(lds, vb, tid, wave, lane, X1_DELTA ? x : out, norm_ffn, MOD, b_router, ws + WS_WRI, lh, ws + WS_H8, TOPE, TOPW, X1_DELTA ? (const bf16*)(ws + WS_DELTA) : nullptr, FS ? (int*)(ws + WS_CNT) : nullptr, (int*)(ws + WS_TOKE), (float*)(ws + WS_WROWE), ROWPAIR, (X1_DELTA && X1_BF16) ? (bf16*)(ws + WS_X1B) : nullptr);
            else norm2_router_rows(vb, wave, lane, out, norm_ffn, MOD, b_router, wr, lh, (LAS float*)(lds + RSCR_OFF), MOE_FP8_GU ? (bf16*)nullptr : H, TOPE, TOPW, MOE_FP8_GU ? (unsigned char*)PROJ : nullptr);
            __syncthreads();
            if (!FS && tid < NE) { HIST[vb * NE + tid] = lh[tid]; lh[tid] = 0; }
            __syncthreads();
        }
    }
    SEAM(P_ROUTER);
    constexpr bool FSK = FAST_ROUTER && MOE_FP8_GU && FAST_SORT && MOE_FP8_DN && YS_FP8;
    if (IN(P_SORT) && !FSK) for (int vb = bx; vb < 256; vb += G) sort_block(vb, tid, (LAS int*)(lds + SORT_OFF), HIST, TOPE, TOPW, TOKROW, ROWPAIR, WROW, TILEE);
    if (!FSK) SEAM(P_SORT);
    LAS int* cbt = (LAS int*)(lds + TE_OFF + 2048);
    if (IN(P_GATEUP) || IN(P_DOWN) || (FSK && IN(P_COMBINE))) {
        LAS int* te = (LAS int*)(lds + TE_OFF);
        if constexpr (FSK) {
            if (wave == 0) { const int cv = (lane < NE) ? ((const int*)(ws + WS_CNT))[lane * CNT_STRIDE] : 0; int inc = ((cv + 255) >> 8) << 8;
#pragma unroll
                for (int o = 1; o < 32; o <<= 1) { const int t = __shfl_up(inc, o); if (lane >= o) inc += t; }
                if (lane < NE) { cbt[lane] = cv; cbt[33 + lane] = inc; } if (lane == 0) cbt[32] = 0; }
            __syncthreads();
            if (tid < NE) for (int ti = cbt[32 + tid] >> 8; ti < (cbt[33 + tid] >> 8); ++ti) te[ti] = tid;
        } else for (int i = tid; i < MAXTILES; i += 512) te[i] = TILEE[64 + i];
        __syncthreads();
    }
    if (IN(P_GATEUP)) {
        const LAS int* te = (const LAS int*)(lds + TE_OFF); const int ntiles = __builtin_amdgcn_readfirstlane(FSK ? (cbt[64] >> 8) : TILEE[0]);
        if constexpr (MOE_FP8_GU) {
            pg8::MoeOrder So{(const char*)(ws + WS_H8), (const char*)WTGU, FSK ? (const int*)(ws + WS_TOKE) : TOKROW, te, ntiles, 2 * DFF / 256, G, bx, (size_t)256 * D, (size_t)2 * DFF * D, FSK ? cbt : nullptr};
            pg8::EpiGateUp<MOE_FP8_DN != 0> E{(void*)ACT, b_gate_up, te, 1.0f / (W8_SCALE * H8_SCALE), (LAS float*)(lds + RSCR_OFF + 4096)};
            pg8::gemm_phase<pg8::EpiGateUp<MOE_FP8_DN != 0>, pg8::MoeOrder, true, true, true>(lds + RING_OFF, D / 2, So, E);
            if constexpr (DN_DEFER_P9 > 0) { if (G == 256) {
                constexpr int IDN8 = (DFF / 128) * (D / 32);
                const int rem = (ntiles * (2 * DFF / 256)) % G; const bool all = (rem == 0) || (G - rem < 64);
                const int n_idle = all ? G : G - rem, j = all ? bx : bx - rem;
                if (j >= 0) for (int r = NE * IDN8 - DN_DEFER_P9 + j * 8 + wave; r < NE * IDN8; r += n_idle * 8) { const int e = r / IDN8;
                    p0_transpose_item_fp8<false>(w_down + (size_t)e * DFF * D, DFF, D, (unsigned char*)WTDN + (size_t)e * D * DFF, r % IDN8, lane); } } }
        } else {
            pg8::MoeOrder So{(const char*)H, (const char*)WTGU, TOKROW, te, ntiles, 2 * DFF / 256, G, bx, (size_t)256 * D * 2, (size_t)2 * DFF * D * 2};
            pg8::EpiGateUp<MOE_FP8_DN != 0> E{(void*)ACT, b_gate_up, te, 1.0f, (LAS float*)(lds + RSCR_OFF + 4096)};
            pg8::gemm_phase<pg8::EpiGateUp<MOE_FP8_DN != 0>, pg8::MoeOrder, true, true, false>(lds + RING_OFF, D, So, E);
        }
    }
    SEAM(P_GATEUP);
    if (IN(P_DOWN)) {
        const LAS int* te = (const LAS int*)(lds + TE_OFF); const int ntiles = __builtin_amdgcn_readfirstlane(FSK ? (cbt[64] >> 8) : TILEE[0]);
        if constexpr (MOE_FP8_DN) {
            pg8::MoeOrder So{(const char*)ACT, (const char*)WTDN, TOKROW, te, ntiles, D / 256, G, bx, (size_t)256 * DFF, (size_t)D * DFF};
            pg8::EpiDown<YS_FP8 != 0> E{(void*)YS, b_down, FSK ? (const float*)(ws + WS_WROWE) : WROW, te, 1.0f / (W8_SCALE * A8_SCALE), FSK ? cbt : nullptr, (LAS float*)(lds + RSCR_OFF + 4096), (const float*)(ws + WS_CTL)};
            pg8::gemm_phase<pg8::EpiDown<YS_FP8 != 0>, pg8::MoeOrder, true, false, true>(lds + RING_OFF, DFF / 2, So, E);
        } else {
            pg8::MoeOrder So{(const char*)ACT, (const char*)WTDN, TOKROW, te, ntiles, D / 256, G, bx, (size_t)256 * DFF * 2, (size_t)D * DFF * 2};
            pg8::EpiDown<YS_FP8 != 0> E{(void*)YS, b_down, WROW, te, 1.0f, nullptr, (LAS float*)(lds + RSCR_OFF + 4096), (const float*)(ws + WS_CTL)};
            pg8::gemm_phase<pg8::EpiDown<YS_FP8 != 0>, pg8::MoeOrder, true, false, false>(lds + RING_OFF, DFF, So, E);
        }
    }
    SEAM(P_DOWN);
    if (IN(P_COMBINE)) { if constexpr (YS_FP8) { for (int m = 2 * gw; m < T; m += 2 * NGW) combine_rows8x2(m, lane, out, MOD, (const unsigned char*)YS, ROWPAIR, (X1_DELTA && !X1_BF16) ? x : nullptr, X1_DELTA ? (const bf16*)(ws + (X1_BF16 ? WS_X1B : WS_DELTA)) : nullptr, FSK ? cbt : nullptr); } else { for (int m = gw; m < T; m += NGW) combine_row(m, lane, out, MOD, YS, ROWPAIR); } }
#undef IN
#undef SEAM
}

static int g_grid = 0;
static void mk_setup() {
    if (g_grid != 0) return;
    int dev = 0, cus = 0, per_cu = 0;
    if (hipGetDevice(&dev) != hipSuccess || hipDeviceGetAttribute(&cus, hipDeviceAttributeMultiprocessorCount, dev) != hipSuccess) { fprintf(stderr, "kernel_launch: device query failed\n"); g_grid = -1; return; }
    if (hipFuncSetAttribute((const void*)mk_fwd, hipFuncAttributeMaxDynamicSharedMemorySize, LDS_BYTES) != hipSuccess) { fprintf(stderr, "kernel_launch: hipFuncSetAttribute failed\n"); g_grid = -1; return; }
    if (hipOccupancyMaxActiveBlocksPerMultiprocessor(&per_cu, (const void*)mk_fwd, NWAVES * 64, LDS_BYTES) != hipSuccess || per_cu < 1) { fprintf(stderr, "kernel_launch: occupancy query says %d workgroups per CU\n", per_cu); (void)hipGetLastError(); g_grid = -1; return; }
    g_grid = cus;
    (void)hipFuncSetAttribute((const void*)k_norm2_router, hipFuncAttributeMaxDynamicSharedMemorySize, 32 * 1024 * 4 + 256 + 4096);
}
static void mk_launch(const Args& base, int lo, int hi, int li, hipStream_t stream) {
    Args a = base; a.ph_lo = lo; a.ph_hi = hi; a.li = li; a.pad = 0;
    hipLaunchKernelGGL(mk_fwd, dim3(g_grid), dim3(NWAVES * 64), LDS_BYTES, stream, a);
}

extern "C" void kernel_launch(void* const* d_in, const int* in_sizes, int n_in, void* d_out, int out_size, void* d_ws, size_t ws_size, hipStream_t stream) {
    if (n_in != 30 || out_size != T * D || ws_size < WS_END) { fprintf(stderr, "kernel_launch: unexpected shapes (n_in %d out %d ws %zu)\n", n_in, out_size, ws_size); return; }
    mk_setup(); if (g_grid < 0) return;
    Args base{};
    for (int i = 0; i < 30; ++i) base.in[i] = (const float*)d_in[i];
    base.out = (float*)d_out; base.ws = (unsigned char*)d_ws;
    (void)hipMemsetAsync((char*)d_ws + WS_CTL, 0, CTL_ZERO_BYTES, stream);
#if MK_MODE == 1
    mk_launch(base, 0, P_COUNT, 0, stream);
#else
    const float* x = (const float*)d_in[0]; const float* c = (const float*)d_in[1]; const float* w_ada = (const float*)d_in[2]; const float* b_ada = (const float*)d_in[3];
    const float* norm_mix = (const float*)d_in[4]; const float* w_in = (const float*)d_in[5]; const float* b_in = (const float*)d_in[6];
    const float* q_norm = (const float*)d_in[7]; const float* k_norm = (const float*)d_in[8]; const float* sinks = (const float*)d_in[9];
    const float* lam_re = (const float*)d_in[10]; const float* lam_im = (const float*)d_in[11]; const float* log_dt = (const float*)d_in[12];
    const float* b_re = (const float*)d_in[13]; const float* b_im = (const float*)d_in[14]; const float* c_re = (const float*)d_in[15]; const float* c_im = (const float*)d_in[16];
    const float* d_skip = (const float*)d_in[17]; const float* w_glu = (const float*)d_in[18]; const float* b_glu = (const float*)d_in[19];
    const float* attn_out_norm = (const float*)d_in[20]; const float* ssm_out_norm = (const float*)d_in[21]; const float* w_out = (const float*)d_in[22];
    const float* norm_ffn = (const float*)d_in[23]; const float* w_router = (const float*)d_in[24]; const float* b_router = (const float*)d_in[25];
    const float* w_gate_up = (const float*)d_in[26]; const float* b_gate_up = (const float*)d_in[27]; const float* w_down = (const float*)d_in[28]; const float* b_down = (const float*)d_in[29];
    unsigned char* ws = (unsigned char*)d_ws; float* out = (float*)d_out;
    float* MOD = (float*)(ws + WS_MOD); float* SSMT = (float*)(ws + WS_SSMT);
    bf16* WTIN = (bf16*)(ws + WS_WTIN); bf16* WTGLU = (bf16*)(ws + WS_WTGLU); bf16* WTOUT = (bf16*)(ws + WS_WTOUT); bf16* WTGU = (bf16*)(ws + WS_WTGU); bf16* WTDN = (bf16*)(ws + WS_WTDN);
    bf16* H = (bf16*)(ws + WS_H); bf16* PROJ = (bf16*)(ws + WS_PROJ); bf16* ATT = (bf16*)(ws + WS_ATT); bf16* Gb = (bf16*)(ws + WS_G); bf16* SSMG = (bf16*)(ws + WS_SSMG); bf16* MIXED = (bf16*)(ws + WS_MIXED);
    int* TOPE = (int*)(ws + WS_TOPE); float* TOPW = (float*)(ws + WS_TOPW); int* HIST = (int*)(ws + WS_HIST); int* TOKROW = (int*)(ws + WS_TOKROW); int* ROWPAIR = (int*)(ws + WS_ROWPAIR);
    float* WROW = (float*)(ws + WS_WROW); int* TILEE = (int*)(ws + WS_TILEE); bf16* ACT = (bf16*)(ws + WS_ACT); bf16* YS = (bf16*)(ws + WS_YS);
    float* XST = (float*)(ws + WS_XST); float* SC = (float*)(ws + WS_SC);
#ifndef REF_PRO
#define REF_PRO 1
#endif
#ifndef REF_NORM1
#define REF_NORM1 1
#endif
#ifndef REF_INPROJ
#define REF_INPROJ 1
#endif
#ifndef REF_MIX
#define REF_MIX 1
#endif
#ifndef REF_GLU
#define REF_GLU 1
#endif
#ifndef REF_MIXNORM
#define REF_MIXNORM 1
#endif
#ifndef REF_OUTPROJ
#define REF_OUTPROJ 1
#endif
#ifndef REF_ROUTER
#define REF_ROUTER 1
#endif
#ifndef REF_SORT
#define REF_SORT 1
#endif
#ifndef REF_GATEUP
#define REF_GATEUP 1
#endif
#ifndef REF_DOWN
#define REF_DOWN 1
#endif
#ifndef REF_COMBINE
#define REF_COMBINE 1
#endif
    int li = 0;
    if (REF_PRO) {
        hipLaunchKernelGGL(k_transpose_cvt, dim3(DIN / 32, D / 32, 1), dim3(32, 8), 0, stream, w_in, WTIN, D, DIN, 0);
        hipLaunchKernelGGL(k_transpose_cvt, dim3(DSSM / 32, DSSM / 32, 1), dim3(32, 8), 0, stream, w_glu, WTGLU, DSSM, DSSM, 0);
        hipLaunchKernelGGL(k_transpose_cvt, dim3(D / 32, D / 32, 1), dim3(32, 8), 0, stream, w_out, WTOUT, D, D, 0);
        hipLaunchKernelGGL(k_transpose_cvt, dim3(2 * DFF / 32, D / 32, NE), dim3(32, 8), 0, stream, w_gate_up, WTGU, D, 2 * DFF, 1);
        hipLaunchKernelGGL(k_transpose_cvt, dim3(D / 32, DFF / 32, NE), dim3(32, 8), 0, stream, w_down, WTDN, DFF, D, 0);
        hipLaunchKernelGGL(k_mod, dim3(6 * D / 256), dim3(256), 0, stream, c, w_ada, b_ada, MOD);
        hipLaunchKernelGGL(k_ssm_tables, dim3(NG * NST / 256), dim3(256), 0, stream, lam_re, lam_im, log_dt, b_re, b_im, SSMT);
    } else mk_launch(base, P_PRO, P_PRO + 1, li++, stream);
    if (REF_NORM1) hipLaunchKernelGGL(k_norm_mod, dim3(T / 4), dim3(256), 0, stream, x, norm_mix, (const float*)MOD, 0, D, H);
    else mk_launch(base, P_NORM1, P_NORM1 + 1, li++, stream);
    if (REF_INPROJ) { NEpiProj e{}; e.A = H; e.Bt = WTIN; e.bias = b_in; e.O = PROJ; hipLaunchKernelGGL(k_gemm_naive<NEpiProj>, dim3(T, DIN / 256), dim3(256), 0, stream, e, DIN, D); }
    else mk_launch(base, P_INPROJ, P_INPROJ + 1, li++, stream);
    if (REF_MIX) {
        hipLaunchKernelGGL(k_attn_scores, dim3(T * NH / 256), dim3(256), 0, stream, (const bf16*)PROJ, q_norm, k_norm, SC);
        hipLaunchKernelGGL(k_attn_out, dim3(T * NH * HD / 256), dim3(256), 0, stream, (const bf16*)PROJ, (const float*)SC, sinks, ATT);
        hipLaunchKernelGGL(k_ssm_scan, dim3(NB * NG * NST / 64), dim3(64), 0, stream, (const bf16*)PROJ, (const float*)SSMT, XST);
        hipLaunchKernelGGL(k_ssm_out, dim3(T * DSSM / 256), dim3(256), 0, stream, (const bf16*)PROJ, (const float*)XST, c_re, c_im, d_skip, Gb);
    } else { mk_launch(base, P_MIX_A, P_MIX_A + 1, li++, stream); mk_launch(base, P_MIX_B, P_MIX_B + 1, li++, stream); }
    if (REF_GLU) { NEpiGlu e{}; e.A = Gb; e.Bt = WTGLU; e.bias = b_glu; e.O = SSMG; hipLaunchKernelGGL(k_gemm_naive<NEpiGlu>, dim3(T, DSSM / 256), dim3(256), 0, stream, e, DSSM, DSSM); }
    else mk_launch(base, P_GLU, P_GLU + 1, li++, stream);
    if (REF_MIXNORM) hipLaunchKernelGGL(k_mixnorm, dim3(T / 4), dim3(256), 0, stream, (const bf16*)ATT, (const bf16*)SSMG, attn_out_norm, ssm_out_norm, MIXED);
    else mk_launch(base, P_MIXNORM, P_MIXNORM + 1, li++, stream);
    if (REF_OUTPROJ) { NEpiOut e{}; e.A = MIXED; e.Bt = WTOUT; e.x = x; e.mod = MOD; e.O = out; hipLaunchKernelGGL(k_gemm_naive<NEpiOut>, dim3(T, D / 256), dim3(256), 0, stream, e, D, D); }
    else mk_launch(base, P_OUTPROJ, P_OUTPROJ + 1, li++, stream);
    if (REF_ROUTER) hipLaunchKernelGGL(k_norm2_router, dim3(256), dim3(512), 32 * 1024 * 4 + 256 + 4096, stream, (const float*)out, norm_ffn, (const float*)MOD, w_router, b_router, H, TOPE, TOPW, HIST);
    else mk_launch(base, P_ROUTER, P_ROUTER + 1, li++, stream);
    if (REF_SORT) hipLaunchKernelGGL(k_sort, dim3(256), dim3(512), 0, stream, (const int*)HIST, (const int*)TOPE, (const float*)TOPW, TOKROW, ROWPAIR, WROW, TILEE);
    else mk_launch(base, P_SORT, P_SORT + 1, li++, stream);
    if (REF_GATEUP) { NEpiGU e{}; e.H = H; e.Wt = WTGU; e.bias = b_gate_up; e.tokrow = TOKROW; e.tilee = TILEE; e.ACT = ACT; hipLaunchKernelGGL(k_moe_gu_naive, dim3(MPAD, DFF / 256), dim3(256), 0, stream, e); }
    else mk_launch(base, P_GATEUP, P_GATEUP + 1, li++, stream);
    if (REF_DOWN) { NEpiDown e{}; e.ACT = ACT; e.Wt = WTDN; e.bias = b_down; e.wrow = WROW; e.tilee = TILEE; e.YS = YS; hipLaunchKernelGGL(k_gemm_naive<NEpiDown>, dim3(MPAD, D / 256), dim3(256), 0, stream, e, D, DFF); }
    else mk_launch(base, P_DOWN, P_DOWN + 1, li++, stream);
    if (REF_COMBINE) hipLaunchKernelGGL(k_combine, dim3(T / 4), dim3(256), 0, stream, out, (const float*)MOD, (const bf16*)YS, (const int*)ROWPAIR);
    else mk_launch(base, P_COMBINE, P_COMBINE + 1, li++, stream);
#endif
}
```

```cpp
#include <hip/hip_runtime.h>
#include <stdint.h>
#include <stdio.h>

#ifndef FAST_ATTN
#define FAST_ATTN 1
#endif
#ifndef FAST_SSM
#define FAST_SSM 1
#endif
#ifndef MOE_FP8_GU
#define MOE_FP8_GU 1
#endif
#ifndef MOE_FP8_DN
#define MOE_FP8_DN 1
#endif
#ifndef YS_FP8
#define YS_FP8 1
#endif
#ifndef P3_CONV
#define P3_CONV 0
#endif
#ifndef FUSE_MIXNORM
#define FUSE_MIXNORM 1
#endif
#ifndef X1_DELTA
#define X1_DELTA 1
#endif
#ifndef SSM_MFMA_CARRY
#define SSM_MFMA_CARRY 1
#endif
#ifndef X1_BF16
#define X1_BF16 1
#endif
#ifndef FAST_SORT
#define FAST_SORT 1
#endif
#ifndef FAST_ROUTER
#define FAST_ROUTER 1
#endif
#ifndef MK_MODE
#define MK_MODE 1
#endif

typedef unsigned short bf16;
typedef float f32x4 __attribute__((ext_vector_type(4)));
typedef float f32x2 __attribute__((ext_vector_type(2)));
typedef unsigned u32x4 __attribute__((ext_vector_type(4)));
typedef unsigned u32x2 __attribute__((ext_vector_type(2)));
typedef short bf16x8 __attribute__((ext_vector_type(8)));
typedef int i32x4 __attribute__((ext_vector_type(4)));
typedef int i32x8 __attribute__((ext_vector_type(8)));
constexpr float W8_SCALE = 32.0f, H8_SCALE = 4.0f, A8_SCALE = 4.0f, Y8_SCALE = 16.0f;
#define GAS __attribute__((address_space(1)))
#define LAS __attribute__((address_space(3)))

constexpr int D = 1024, NB = 8, S = 2048, T = NB * S;
constexpr int DATT = 512, HD = 64, NH = 8, NKV = 2, DKV = 128;
constexpr int DSSM = 512, SG = 16, NG = 32, NST = 64;
constexpr int DIN = 1280, NE = 32, TOPK = 4, DFF = 1024;
constexpr int QOFF = 0, KOFF = 512, VOFF = 640, UOFF = 768;
constexpr float EPS = 1e-6f;
constexpr int MAXTILES = 288, MPAD = MAXTILES * 256;

constexpr size_t MiB = 1u << 20;
constexpr size_t WS_CTL = 0, CTL_ZERO_BYTES = 256 * 1024;
constexpr size_t WS_MOD = 1 * MiB;
constexpr size_t WS_SSMT = 2 * MiB;
constexpr size_t WS_WTIN = 4 * MiB;
constexpr size_t WS_WTGLU = 7 * MiB;
constexpr size_t WS_WTOUT = 8 * MiB;
constexpr size_t WS_WTGU = 16 * MiB;
constexpr size_t WS_WTDN = 144 * MiB;
constexpr size_t WS_H = 208 * MiB;
constexpr size_t WS_PROJ = 240 * MiB;
constexpr size_t WS_ATT = 280 * MiB;
constexpr size_t WS_G = 296 * MiB;
constexpr size_t WS_SSMG = 312 * MiB;
constexpr size_t WS_MIXED = 328 * MiB;
constexpr size_t WS_TOPE = 360 * MiB;
constexpr size_t WS_TOPW = 361 * MiB;
constexpr size_t WS_HIST = 362 * MiB;
constexpr size_t WS_TOKROW = 363 * MiB;
constexpr size_t WS_ROWPAIR = 364 * MiB;
constexpr size_t WS_WROW = 365 * MiB;
constexpr size_t WS_TILEE = 366 * MiB;
constexpr size_t WS_CNT = 1024;
constexpr int CNT_STRIDE = 64;
constexpr size_t WS_TOKE = 332 * MiB;
constexpr size_t WS_WROWE = 336 * MiB;
constexpr size_t WS_APOW = 340 * MiB;
constexpr size_t WS_DELTA = 624 * MiB;
constexpr size_t WS_H8 = 660 * MiB;
constexpr size_t WS_WRI = 367 * MiB;
constexpr size_t WS_ACT = 368 * MiB;
constexpr size_t WS_YS = 512 * MiB;
constexpr size_t WS_XST = 368 * MiB;
constexpr size_t WS_SC = 624 * MiB;
constexpr size_t WS_X1B = 700 * MiB;
constexpr size_t WS_END = 740 * MiB;
constexpr int CW_BAR = 4096;

constexpr int ST_AR = 0, ST_AI = 64, ST_BR = 128, ST_BI = 128 + 1024, SSMT_STRIDE = 128 + 2048;

__host__ __device__ __forceinline__ int gu_row(int n) { const int j = n >> 1, half = n & 1; return (j >> 7) * 256 + half * 128 + (j & 127); }

__device__ __forceinline__ unsigned f2bf(float f) { unsigned u = __builtin_bit_cast(unsigned, f); return (u + 0x7fffu + ((u >> 16) & 1u)) >> 16; }
__device__ __forceinline__ float bf2f(unsigned b) { return __builtin_bit_cast(float, (b & 0xffffu) << 16); }
__device__ __forceinline__ unsigned pk2(float lo, float hi) { return f2bf(lo) | (f2bf(hi) << 16); }
__device__ __forceinline__ unsigned pk4_fp8(float a, float b, float c, float d) { unsigned w = 0u; w = __builtin_amdgcn_cvt_pk_fp8_f32(a, b, w, false); w = __builtin_amdgcn_cvt_pk_fp8_f32(c, d, w, true); return w; }
__device__ __forceinline__ float bflo(unsigned w) { return __builtin_bit_cast(float, w << 16); }
__device__ __forceinline__ float bfhi(unsigned w) { return __builtin_bit_cast(float, w & 0xffff0000u); }
__device__ __forceinline__ float wave_sum(float v) {
#pragma unroll
    for (int o = 1; o < 64; o <<= 1) v += __shfl_xor(v, o);
    return v;
}
__device__ __forceinline__ float sigmoidf_(float x) { return __builtin_amdgcn_rcpf(1.0f + __expf(-x)); }
__device__ __forceinline__ float gelu_tanh(float x) { const float u2 = 1.5957691216057308f * (x + 0.044715f * x * x * x); return x * sigmoidf_(u2); }
__device__ __forceinline__ float dot8(u32x4 a, u32x4 b, float acc) {
    acc = fmaf(bflo(a.x), bflo(b.x), acc); acc = fmaf(bfhi(a.x), bfhi(b.x), acc);
    acc = fmaf(bflo(a.y), bflo(b.y), acc); acc = fmaf(bfhi(a.y), bfhi(b.y), acc);
    acc = fmaf(bflo(a.z), bflo(b.z), acc); acc = fmaf(bfhi(a.z), bfhi(b.z), acc);
    acc = fmaf(bflo(a.w), bflo(b.w), acc); acc = fmaf(bfhi(a.w), bfhi(b.w), acc);
    return acc;
}

__device__ __forceinline__ void ssm_table_item(int i, const float* lam_re, const float* lam_im, const float* log_dt, const float* b_re, const float* b_im, float* tab) {
    const int g = i / NST, p = i % NST;
    const float lr = lam_re[i], li = lam_im[i], dt = expf(log_dt[g]);
    const float mag = expf(lr * dt), ang = li * dt;
    const float lbr = mag * cosf(ang), lbi = mag * sinf(ang);
    const float den = lr * lr + li * li;
    const float cr = ((lbr - 1.0f) * lr + lbi * li) / den, ci = (lbi * lr - (lbr - 1.0f) * li) / den;
    float* t = tab + (size_t)g * SSMT_STRIDE;
    t[ST_AR + p] = lbr; t[ST_AI + p] = lbi;
    for (int h = 0; h < SG; ++h) { const float br = b_re[(size_t)i * SG + h], bi = b_im[(size_t)i * SG + h];
        t[ST_BR + p * SG + h] = cr * br - ci * bi; t[ST_BI + p * SG + h] = cr * bi + ci * br; }
}
__device__ __forceinline__ void norm_mod_row(int row, int lane, const float* x, const float* gain, const float* mod, int sh_off, int sc_off, bf16* H) {
    const int b = row / S;
    const f32x4* xr = (const f32x4*)(x + (size_t)row * D) + lane;
    f32x4 v[4]; float s = 0.f;
#pragma unroll
    for (int j = 0; j < 4; ++j) { v[j] = xr[64 * j]; s += (v[j].x * v[j].x + v[j].y * v[j].y) + (v[j].z * v[j].z + v[j].w * v[j].w); }
    const float r = rsqrtf(wave_sum(s) * (1.0f / D) + EPS);
    u32x2* o = (u32x2*)(H + (size_t)row * D) + lane;
#pragma unroll
    for (int j = 0; j < 4; ++j) { const int c = 4 * lane + 256 * j;
        const f32x4 g = *(const f32x4*)(gain + c), sc = *(const f32x4*)(mod + b * 6 * D + sc_off + c), sh = *(const f32x4*)(mod + b * 6 * D + sh_off + c);
        f32x4 y; y.x = v[j].x * r * g.x * (1.f + sc.x) + sh.x; y.y = v[j].y * r * g.y * (1.f + sc.y) + sh.y; y.z = v[j].z * r * g.z * (1.f + sc.z) + sh.z; y.w = v[j].w * r * g.w * (1.f + sc.w) + sh.w;
        u32x2 w; w.x = pk2(y.x, y.y); w.y = pk2(y.z, y.w); o[64 * j] = w; }
}
__device__ __forceinline__ void mixnorm_row(int row, int lane, const bf16* ATT, const bf16* SSMG, const float* ga, const float* gs, bf16* MIXED) {
    const u32x4 a = *((const u32x4*)(ATT + (size_t)row * DATT) + lane), s = *((const u32x4*)(SSMG + (size_t)row * DSSM) + lane);
    const float av[8] = {bflo(a.x), bfhi(a.x), bflo(a.y), bfhi(a.y), bflo(a.z), bfhi(a.z), bflo(a.w), bfhi(a.w)};
    const float sv[8] = {bflo(s.x), bfhi(s.x), bflo(s.y), bfhi(s.y), bflo(s.z), bfhi(s.z), bflo(s.w), bfhi(s.w)};
    float qa = 0.f, qs = 0.f;
#pragma unroll
    for (int i = 0; i < 8; ++i) { qa += av[i] * av[i]; qs += sv[i] * sv[i]; }
    const float ra = rsqrtf(wave_sum(qa) * (1.0f / DATT) + EPS), rs = rsqrtf(wave_sum(qs) * (1.0f / DSSM) + EPS);
    const f32x4 ga0 = *(const f32x4*)(ga + 8 * lane), ga1 = *(const f32x4*)(ga + 8 * lane + 4), gs0 = *(const f32x4*)(gs + 8 * lane), gs1 = *(const f32x4*)(gs + 8 * lane + 4);
    u32x4 oa, os;
    oa.x = pk2(av[0] * ra * ga0.x, av[1] * ra * ga0.y); oa.y = pk2(av[2] * ra * ga0.z, av[3] * ra * ga0.w); oa.z = pk2(av[4] * ra * ga1.x, av[5] * ra * ga1.y); oa.w = pk2(av[6] * ra * ga1.z, av[7] * ra * ga1.w);
    os.x = pk2(sv[0] * rs * gs0.x, sv[1] * rs * gs0.y); os.y = pk2(sv[2] * rs * gs0.z, sv[3] * rs * gs0.w); os.z = pk2(sv[4] * rs * gs1.x, sv[5] * rs * gs1.y); os.w = pk2(sv[6] * rs * gs1.z, sv[7] * rs * gs1.w);
    *((u32x4*)(MIXED + (size_t)row * D) + lane) = oa; *((u32x4*)(MIXED + (size_t)row * D + DATT) + lane) = os;
}
__device__ __forceinline__ void combine_row(int row, int lane, float* out, const float* mod, const bf16* YS, const int* rowpair) {
    const int b = row / S; const int* rp = rowpair + (size_t)row * 4;
    const int r0 = rp[0], r1 = rp[1], r2 = rp[2], r3 = rp[3];
#pragma unroll
    for (int j = 0; j < 2; ++j) { const int c = 8 * lane + 512 * j;
        const u32x4 a = *(const u32x4*)(YS + (size_t)r0 * D + c), b2 = *(const u32x4*)(YS + (size_t)r1 * D + c), c2 = *(const u32x4*)(YS + (size_t)r2 * D + c), d2 = *(const u32x4*)(YS + (size_t)r3 * D + c);
        float y[8];
        y[0] = bflo(a.x) + bflo(b2.x) + bflo(c2.x) + bflo(d2.x); y[1] = bfhi(a.x) + bfhi(b2.x) + bfhi(c2.x) + bfhi(d2.x);
        y[2] = bflo(a.y) + bflo(b2.y) + bflo(c2.y) + bflo(d2.y); y[3] = bfhi(a.y) + bfhi(b2.y) + bfhi(c2.y) + bfhi(d2.y);
        y[4] = bflo(a.z) + bflo(b2.z) + bflo(c2.z) + bflo(d2.z); y[5] = bfhi(a.z) + bfhi(b2.z) + bfhi(c2.z) + bfhi(d2.z);
        y[6] = bflo(a.w) + bflo(b2.w) + bflo(c2.w) + bflo(d2.w); y[7] = bfhi(a.w) + bfhi(b2.w) + bfhi(c2.w) + bfhi(d2.w);
        float* op = out + (size_t)row * D + c; const float* g2 = mod + b * 6 * D + 5 * D + c;
        f32x4 o0 = *(f32x4*)op, o1 = *(f32x4*)(op + 4); const f32x4 g0 = *(const f32x4*)g2, g1 = *(const f32x4*)(g2 + 4);
        o0.x += g0.x * y[0]; o0.y += g0.y * y[1]; o0.z += g0.z * y[2]; o0.w += g0.w * y[3]; o1.x += g1.x * y[4]; o1.y += g1.y * y[5]; o1.z += g1.z * y[6]; o1.w += g1.w * y[7];
        *(f32x4*)op = o0; *(f32x4*)(op + 4) = o1; }
}
__device__ __forceinline__ void combine_row8(int row, int lane, float* out, const float* mod, const unsigned char* YS8, const int* rowpair) {
    const int b = row / S; const i32x4 rp = *(const i32x4*)(rowpair + (size_t)row * 4); const int c = 16 * lane;
    const u32x4 q0 = *(const u32x4*)(YS8 + (size_t)rp.x * D + c), q1 = *(const u32x4*)(YS8 + (size_t)rp.y * D + c), q2 = *(const u32x4*)(YS8 + (size_t)rp.z * D + c), q3 = *(const u32x4*)(YS8 + (size_t)rp.w * D + c);
    float* op = out + (size_t)row * D + c; const float* g2 = mod + b * 6 * D + 5 * D + c;
#pragma unroll
    for (int j = 0; j < 4; ++j) { const unsigned w0 = q0[j], w1 = q1[j], w2 = q2[j], w3 = q3[j];
        const f32x2 lo = __builtin_amdgcn_cvt_pk_f32_fp8(w0, false) + __builtin_amdgcn_cvt_pk_f32_fp8(w1, false) + __builtin_amdgcn_cvt_pk_f32_fp8(w2, false) + __builtin_amdgcn_cvt_pk_f32_fp8(w3, false);
        const f32x2 hi = __builtin_amdgcn_cvt_pk_f32_fp8(w0, true) + __builtin_amdgcn_cvt_pk_f32_fp8(w1, true) + __builtin_amdgcn_cvt_pk_f32_fp8(w2, true) + __builtin_amdgcn_cvt_pk_f32_fp8(w3, true);
        f32x4 o = *(f32x4*)(op + 4 * j); const f32x4 g = *(const f32x4*)(g2 + 4 * j);
        o.x += g.x * lo.x * (1.0f / Y8_SCALE); o.y += g.y * lo.y * (1.0f / Y8_SCALE); o.z += g.z * hi.x * (1.0f / Y8_SCALE); o.w += g.w * hi.y * (1.0f / Y8_SCALE);
        *(f32x4*)(op + 4 * j) = o; }
}
__device__ __forceinline__ void combine_rows8x2(int row, int lane, float* out, const float* mod, const unsigned char* YS8, const int* rowpair, const float* xin = nullptr, const bf16* delta = nullptr, const LAS int* cb = nullptr) {
    const int b = row / S, c = 16 * lane; i32x4 rp0 = *(const i32x4*)(rowpair + (size_t)row * 4), rp1 = *(const i32x4*)(rowpair + (size_t)row * 4 + 4);
    if (FAST_SORT && cb) {
#pragma unroll
        for (int k = 0; k < 4; ++k) { rp0[k] = (rp0[k] & 0xFFFFF) + cb[32 + (rp0[k] >> 20)]; rp1[k] = (rp1[k] & 0xFFFFF) + cb[32 + (rp1[k] >> 20)]; } }
    u32x4 q[2][4];
    q[0][0] = *(const u32x4*)(YS8 + (size_t)rp0.x * D + c); q[0][1] = *(const u32x4*)(YS8 + (size_t)rp0.y * D + c); q[0][2] = *(const u32x4*)(YS8 + (size_t)rp0.z * D + c); q[0][3] = *(const u32x4*)(YS8 + (size_t)rp0.w * D + c);
    q[1][0] = *(const u32x4*)(YS8 + (size_t)rp1.x * D + c); q[1][1] = *(const u32x4*)(YS8 + (size_t)rp1.y * D + c); q[1][2] = *(const u32x4*)(YS8 + (size_t)rp1.z * D + c); q[1][3] = *(const u32x4*)(YS8 + (size_t)rp1.w * D + c);
    const float* g2 = mod + b * 6 * D + 5 * D + c;
    f32x4 g[4], o[2][4];
#pragma unroll
    for (int j = 0; j < 4; ++j) { g[j] = *(const f32x4*)(g2 + 4 * j) * (1.0f / Y8_SCALE); const float* src = delta ? xin : out;
        if (src) { o[0][j] = *(const f32x4*)(src + (size_t)row * D + c + 4 * j); o[1][j] = *(const f32x4*)(src + (size_t)(row + 1) * D + c + 4 * j); } else { o[0][j] = (f32x4){0.f, 0.f, 0.f, 0.f}; o[1][j] = o[0][j]; } }
    if (delta) {
#pragma unroll
        for (int r = 0; r < 2; ++r) { const u32x4 d0 = *(const u32x4*)(delta + (size_t)(row + r) * D + c), d1 = *(const u32x4*)(delta + (size_t)(row + r) * D + c + 8);
            o[r][0] += (f32x4){bflo(d0.x), bfhi(d0.x), bflo(d0.y), bfhi(d0.y)}; o[r][1] += (f32x4){bflo(d0.z), bfhi(d0.z), bflo(d0.w), bfhi(d0.w)};
            o[r][2] += (f32x4){bflo(d1.x), bfhi(d1.x), bflo(d1.y), bfhi(d1.y)}; o[r][3] += (f32x4){bflo(d1.z), bfhi(d1.z), bflo(d1.w), bfhi(d1.w)}; } }
#pragma unroll
    for (int r = 0; r < 2; ++r)
#pragma unroll
        for (int j = 0; j < 4; ++j) { const unsigned w0 = q[r][0][j], w1 = q[r][1][j], w2 = q[r][2][j], w3 = q[r][3][j];
            const f32x2 lo = __builtin_amdgcn_cvt_pk_f32_fp8(w0, false) + __builtin_amdgcn_cvt_pk_f32_fp8(w1, false) + __builtin_amdgcn_cvt_pk_f32_fp8(w2, false) + __builtin_amdgcn_cvt_pk_f32_fp8(w3, false);
            const f32x2 hi = __builtin_amdgcn_cvt_pk_f32_fp8(w0, true) + __builtin_amdgcn_cvt_pk_f32_fp8(w1, true) + __builtin_amdgcn_cvt_pk_f32_fp8(w2, true) + __builtin_amdgcn_cvt_pk_f32_fp8(w3, true);
            f32x4 t = o[r][j]; t.x += g[j].x * lo.x; t.y += g[j].y * lo.y; t.z += g[j].z * hi.x; t.w += g[j].w * hi.y;
            *(f32x4*)(out + (size_t)(row + r) * D + c + 4 * j) = t; }
}
__device__ __forceinline__ void attn_scores_item(int idx, const bf16* PROJ, const float* qg, const float* kg, float* SC) {
    const int t = idx / NH, h = idx % NH, kvh = h / 4, b = t / S, tl = t % S;
    const bf16* q = PROJ + (size_t)t * DIN + QOFF + h * HD;
    float sq = 0.f;
    for (int d = 0; d < HD; ++d) { const float v = bf2f(q[d]); sq += v * v; }
    const float rq = rsqrtf(sq * (1.0f / HD) + EPS);
    for (int i = 0; i < 128; ++i) {
        const int sl = tl - 127 + i; float sc = -1e30f;
        if (sl >= 0) { const bf16* k = PROJ + (size_t)(b * S + sl) * DIN + KOFF + kvh * HD;
            float sk = 0.f, dt = 0.f;
            for (int d = 0; d < HD; ++d) { const float kv = bf2f(k[d]); sk += kv * kv; dt += bf2f(q[d]) * qg[d] * kv * kg[d]; }
            sc = dt * rq * rsqrtf(sk * (1.0f / HD) + EPS) * 0.125f; }
        SC[(size_t)idx * 128 + i] = sc; }
}
__device__ __forceinline__ void attn_out_item(int idx, const bf16* PROJ, const float* SC, const float* sinks, bf16* ATT) {
    const int d = idx % HD, th = idx / HD, h = th % NH, t = th / NH, kvh = h / 4, b = t / S, tl = t % S;
    const float* sc = SC + (size_t)th * 128; const float sink = sinks[h];
    float m = sink;
    for (int i = 0; i < 128; ++i) m = fmaxf(m, sc[i]);
    float den = __expf(sink - m), o = 0.f;
    for (int i = 0; i < 128; ++i) { const int sl = tl - 127 + i; if (sl < 0) continue;
        const float p = __expf(sc[i] - m); den += p; o += p * bf2f(PROJ[(size_t)(b * S + sl) * DIN + VOFF + kvh * HD + d]); }
    ATT[(size_t)t * DATT + h * HD + d] = (bf16)f2bf(o / den);
}
__device__ __forceinline__ void ssm_scan_item(int idx, const bf16* PROJ, const float* tab, float* XST) {
    const int p = idx % NST, g = (idx / NST) % NG, b = idx / (NST * NG);
    const float* tg = tab + (size_t)g * SSMT_STRIDE;
    const float ar = tg[ST_AR + p], ai = tg[ST_AI + p];
    float br[SG], bi[SG];
#pragma unroll
    for (int h = 0; h < SG; ++h) { br[h] = tg[ST_BR + p * SG + h]; bi[h] = tg[ST_BI + p * SG + h]; }
    float xr = 0.f, xi = 0.f;
    for (int t = 0; t < S; ++t) {
        const u32x4* up = (const u32x4*)(PROJ + (size_t)(b * S + t) * DIN + UOFF + g * SG);
        const u32x4 u0 = up[0], u1 = up[1];
        const float u[SG] = {bflo(u0.x), bfhi(u0.x), bflo(u0.y), bfhi(u0.y), bflo(u0.z), bfhi(u0.z), bflo(u0.w), bfhi(u0.w),
                             bflo(u1.x), bfhi(u1.x), bflo(u1.y), bfhi(u1.y), bflo(u1.z), bfhi(u1.z), bflo(u1.w), bfhi(u1.w)};
        float bur = 0.f, bui = 0.f;
#pragma unroll
        for (int h = 0; h < SG; ++h) { bur = fmaf(br[h], u[h], bur); bui = fmaf(bi[h], u[h], bui); }
        const float nr = ar * xr - ai * xi + bur, ni = ar * xi + ai * xr + bui; xr = nr; xi = ni;
        float* o = XST + (((size_t)(b * S + t) * NG + g) * NST + p) * 2; o[0] = xr; o[1] = xi;
    }
}
__device__ __forceinline__ void ssm_out_item(int idx, const bf16* PROJ, const float* XST, const float* c_re, const float* c_im, const float* d_skip, bf16* G) {
    const int ch = idx % DSSM, t = idx / DSSM, g = ch / SG, h = ch % SG;
    const float* x = XST + ((size_t)t * NG + g) * NST * 2; const float* cr = c_re + ((size_t)g * SG + h) * NST; const float* ci = c_im + ((size_t)g * SG + h) * NST;
    float y = 0.f;
    for (int p = 0; p < NST; ++p) y += cr[p] * x[2 * p] - ci[p] * x[2 * p + 1];
    y += d_skip[ch] * bf2f(PROJ[(size_t)t * DIN + UOFF + ch]);
    G[(size_t)t * DSSM + ch] = (bf16)f2bf(gelu_tanh(y));
}
__device__ __forceinline__ void norm2_router_rows(int blk, int wave, int lane, const float* x1, const float* gain, const float* mod, const float* b_router,
                                                  const LAS float* wr, LAS int* lh, LAS float* xs, bf16* H, int* tope, float* topw, unsigned char* H8 = nullptr) {
    const int b = (blk * 64) / S;
    f32x4 gm[4], sh[4];
#pragma unroll
    for (int j = 0; j < 4; ++j) { const int c = 4 * lane + 256 * j; const f32x4 g = *(const f32x4*)(gain + c), sc = *(const f32x4*)(mod + b * 6 * D + 4 * D + c);
        gm[j] = g * (1.0f + sc); sh[j] = *(const f32x4*)(mod + b * 6 * D + 3 * D + c); }
    const int my_e = lane >> 1; const float my_b = b_router[my_e];
    LAS float* lg = xs + wave * 128;
    LAS int* sel_e = (LAS int*)(xs + wave * 128 + 64);
    LAS float* sel_v = xs + wave * 128 + 72;
#pragma unroll 1
    for (int i = 0; i < 8; i += 2) {
        const int row0 = blk * 64 + wave * 8 + i;
        f32x4 v[2][4]; float ssq[2];
#pragma unroll
        for (int r = 0; r < 2; ++r) { const f32x4* xr = (const f32x4*)(x1 + (size_t)(row0 + r) * D) + lane; float s = 0.f;
#pragma unroll
            for (int j = 0; j < 4; ++j) { v[r][j] = xr[64 * j]; s += (v[r][j].x * v[r][j].x + v[r][j].y * v[r][j].y) + (v[r][j].z * v[r][j].z + v[r][j].w * v[r][j].w); }
            ssq[r] = s; }
#pragma unroll
        for (int o2 = 1; o2 < 64; o2 <<= 1) { ssq[0] += __shfl_xor(ssq[0], o2); asm volatile("" : "+v"(ssq[0])); ssq[1] += __shfl_xor(ssq[1], o2); asm volatile("" : "+v"(ssq[1])); }
#pragma unroll
        for (int r = 0; r < 2; ++r) { const float rs = rsqrtf(ssq[r] * (1.0f / D) + EPS); u32x2* o = (u32x2*)(H + (size_t)(row0 + r) * D) + lane;
#pragma unroll
            for (int j = 0; j < 4; ++j) { v[r][j] = v[r][j] * rs * gm[j] + sh[j]; if (H) { u32x2 w; w.x = pk2(v[r][j].x, v[r][j].y); w.y = pk2(v[r][j].z, v[r][j].w); o[64 * j] = w; }
                if (H8) *(unsigned*)(H8 + (size_t)(row0 + r) * D + 4 * lane + 256 * j) = pk4_fp8(v[r][j].x * H8_SCALE, v[r][j].y * H8_SCALE, v[r][j].z * H8_SCALE, v[r][j].w * H8_SCALE); } }
        float pe0[NE], pe1[NE];
#pragma unroll
        for (int e = 0; e < NE; ++e) { float a0 = 0.f, a1 = 0.f;
#pragma unroll
            for (int j = 0; j < 4; ++j) { const f32x4 w = *(const LAS f32x4*)(wr + e * D + 4 * lane + 256 * j);
                a0 += (v[0][j].x * w.x + v[0][j].y * w.y) + (v[0][j].z * w.z + v[0][j].w * w.w); asm volatile("" : "+v"(a0)); a1 += (v[1][j].x * w.x + v[1][j].y * w.y) + (v[1][j].z * w.z + v[1][j].w * w.w); asm volatile("" : "+v"(a1)); }
            pe0[e] = a0; pe1[e] = a1; }
#define BFLY(half, bit) { const bool up = (lane & (bit)) != 0; _Pragma("unroll") for (int k = 0; k < (half); ++k) { \
            const float k0 = up ? pe0[(half) + k] : pe0[k], s0 = up ? pe0[k] : pe0[(half) + k], k1 = up ? pe1[(half) + k] : pe1[k], s1 = up ? pe1[k] : pe1[(half) + k]; \
            pe0[k] = k0 + __shfl_xor(s0, (bit)); asm volatile("" : "+v"(pe0[k])); pe1[k] = k1 + __shfl_xor(s1, (bit)); asm volatile("" : "+v"(pe1[k])); } }
        BFLY(16, 32) BFLY(8, 16) BFLY(4, 8) BFLY(2, 4) BFLY(1, 2)
#undef BFLY
        const float l0 = pe0[0] + __shfl_xor(pe0[0], 1) + my_b, l1 = pe1[0] + __shfl_xor(pe1[0], 1) + my_b;
        if ((lane & 1) == 0) { lg[my_e] = l0; lg[32 + my_e] = l1; }
        asm volatile("s_waitcnt lgkmcnt(0)" ::: "memory");
        int rk0 = 0, rk1 = 0;
#pragma unroll
        for (int q = 0; q < 8; ++q) { const f32x4 a = *(const LAS f32x4*)(lg + 4 * q), c = *(const LAS f32x4*)(lg + 32 + 4 * q);
#pragma unroll
            for (int t = 0; t < 4; ++t) { const int e2 = 4 * q + t; rk0 += (a[t] > l0 || (a[t] == l0 && e2 < my_e)) ? 1 : 0; rk1 += (c[t] > l1 || (c[t] == l1 && e2 < my_e)) ? 1 : 0; } }
        if ((lane & 1) == 0) { if (rk0 < 4) { sel_e[rk0] = my_e; sel_v[rk0] = l0; } if (rk1 < 4) { sel_e[4 + rk1] = my_e; sel_v[4 + rk1] = l1; } }
        asm volatile("s_waitcnt lgkmcnt(0)" ::: "memory");
        if (lane < 2) { const i32x4 ee = *(const LAS i32x4*)(sel_e + 4 * lane); const f32x4 vv = *(const LAS f32x4*)(sel_v + 4 * lane);
            const int e0 = ee.x, e1 = ee.y, e2 = ee.z, e3 = ee.w;
            const float x1v = __expf(vv.y - vv.x), x2v = __expf(vv.z - vv.x), x3v = __expf(vv.w - vv.x), inv = 1.0f / (1.0f + x1v + x2v + x3v);
            int* te = tope + (size_t)(row0 + lane) * 4; float* tw = topw + (size_t)(row0 + lane) * 4;
            *(i32x4*)te = (i32x4){e0, e1, e2, e3}; *(f32x4*)tw = (f32x4){inv, x1v * inv, x2v * inv, x3v * inv};
            (void)__hip_atomic_fetch_add(&lh[e0], 1, __ATOMIC_RELAXED, __HIP_MEMORY_SCOPE_WORKGROUP); (void)__hip_atomic_fetch_add(&lh[e1], 1, __ATOMIC_RELAXED, __HIP_MEMORY_SCOPE_WORKGROUP);
            (void)__hip_atomic_fetch_add(&lh[e2], 1, __ATOMIC_RELAXED, __HIP_MEMORY_SCOPE_WORKGROUP); (void)__hip_atomic_fetch_add(&lh[e3], 1, __ATOMIC_RELAXED, __HIP_MEMORY_SCOPE_WORKGROUP); }
        asm volatile("s_waitcnt lgkmcnt(0)" ::: "memory");
    }
}
__device__ __forceinline__ void sort_block(int blk, int tid, LAS int* sm, const int* hist, const int* tope, const float* topw, int* tokrow, int* rowpair, float* wrow, int* tilee) {
    LAS int* tot = sm; LAS int* mine = sm + 32; LAS int* base = sm + 64; LAS int* es = sm + 128;
    { const int e = tid & 31, part = tid >> 5; int hv[16]; int a = 0, m = 0;
#pragma unroll
      for (int k = 0; k < 16; ++k) hv[k] = hist[(16 * part + k) * NE + e];
#pragma unroll
      for (int k = 0; k < 16; ++k) { a += hv[k]; if (16 * part + k < blk) m += hv[k]; }
      LAS int* pa = sm + 384; pa[part * 32 + e] = a; pa[512 + part * 32 + e] = m; }
    __syncthreads();
    if (tid < NE) { const LAS int* pa = sm + 384; int a = 0, m = 0;
#pragma unroll
        for (int p = 0; p < 16; ++p) { a += pa[p * 32 + tid]; m += pa[512 + p * 32 + tid]; } tot[tid] = a; mine[tid] = m; }
    __syncthreads();
    if (tid == 0) { int o = 0; for (int e = 0; e < NE; ++e) { base[e] = o; o += ((tot[e] + 255) >> 8) << 8; } base[NE] = o; }
    int my_e = 0, rank = 0;
    if (tid < 256) { my_e = tope[(size_t)(blk * 64) * 4 + tid]; const int lane = tid & 63, w = tid >> 6;
        const unsigned long long lt = (lane == 0) ? 0ull : (~0ull >> (64 - lane));
#pragma unroll 4
        for (int e = 0; e < NE; ++e) { const unsigned long long m = __ballot(my_e == e); if (my_e == e) rank = __popcll(m & lt); if (lane == 0) es[w * 32 + e] = __popcll(m); } }
    __syncthreads();
    if (tid < 256) { const int e = my_e, w = tid >> 6; for (int w2 = 0; w2 < w; ++w2) rank += es[w2 * 32 + e];
        const int pos = base[e] + mine[e] + rank, tok = blk * 64 + (tid >> 2);
        tokrow[pos] = tok; rowpair[(size_t)blk * 256 + tid] = pos; wrow[pos] = topw[(size_t)blk * 256 + tid]; }
    if (blk < NE) { const int e = blk; for (int r = base[e] + tot[e] + tid; r < base[e + 1]; r += 512) { tokrow[r] = 0; wrow[r] = 0.f; }
        for (int ti = (base[e] >> 8) + tid; ti < (base[e + 1] >> 8); ti += 512) tilee[64 + ti] = e; }
    if (blk == 0 && tid == 0) tilee[0] = base[NE] >> 8;
    __syncthreads();
}

__global__ void k_transpose_cvt(const float* __restrict__ W, bf16* __restrict__ WT, int K, int N, int perm_gu) {
    __shared__ float tile[32][33];
    const float* Wb = W + (size_t)blockIdx.z * K * N; bf16* WTb = WT + (size_t)blockIdx.z * K * N;
    const int n0 = blockIdx.x * 32, k0 = blockIdx.y * 32;
    for (int i = threadIdx.y; i < 32; i += 8) tile[i][threadIdx.x] = Wb[(size_t)(k0 + i) * N + n0 + threadIdx.x];
    __syncthreads();
    for (int i = threadIdx.y; i < 32; i += 8) { const int n = n0 + i, nr = perm_gu ? gu_row(n) : n; WTb[(size_t)nr * K + k0 + threadIdx.x] = (bf16)f2bf(tile[threadIdx.x][i]); }
}
__global__ void k_mod(const float* __restrict__ c, const float* __restrict__ w_ada, const float* __restrict__ b_ada, float* __restrict__ mod) {
    __shared__ float ca[NB][D];
    for (int i = threadIdx.x; i < NB * D; i += blockDim.x) { const float v = c[i]; ca[i / D][i % D] = v * sigmoidf_(v); }
    __syncthreads();
    const int j = blockIdx.x * blockDim.x + threadIdx.x;
    float acc[NB];
#pragma unroll
    for (int b = 0; b < NB; ++b) acc[b] = 0.f;
    for (int k = 0; k < D; ++k) { const float w = w_ada[(size_t)k * (6 * D) + j];
#pragma unroll
        for (int b = 0; b < NB; ++b) acc[b] = fmaf(ca[b][k], w, acc[b]); }
#pragma unroll
    for (int b = 0; b < NB; ++b) mod[b * 6 * D + j] = acc[b] + b_ada[j];
}
__global__ void k_ssm_tables(const float* lam_re, const float* lam_im, const float* log_dt, const float* b_re, const float* b_im, float* tab) {
    const int i = blockIdx.x * blockDim.x + threadIdx.x; if (i >= NG * NST) return;
    ssm_table_item(i, lam_re, lam_im, log_dt, b_re, b_im, tab);
}
__global__ void k_norm_mod(const float* x, const float* gain, const float* mod, int sh_off, int sc_off, bf16* H) {
    const int row = blockIdx.x * (blockDim.x / 64) + (threadIdx.x >> 6), lane = threadIdx.x & 63; if (row >= T) return;
    norm_mod_row(row, lane, x, gain, mod, sh_off, sc_off, H);
}
template <class Epi> __global__ void k_gemm_naive(Epi e, int N, int K) {
    const int n = blockIdx.y * blockDim.x + threadIdx.x, m = blockIdx.x; if (n >= N) return;
    if (!e.active(m)) return;
    const bf16* a = e.arow(m); const bf16* b = e.brow(m, n);
    float acc = 0.f;
    for (int k = 0; k < K; k += 8) acc = dot8(*(const u32x4*)(a + k), *(const u32x4*)(b + k), acc);
    e.store(m, n, acc);
}
struct NEpiProj { const bf16* A; const bf16* Bt; const float* bias; bf16* O;
    __device__ bool active(int) const { return true; }
    __device__ const bf16* arow(int m) const { return A + (size_t)m * D; }
    __device__ const bf16* brow(int, int n) const { return Bt + (size_t)n * D; }
    __device__ void store(int m, int n, float acc) const { O[(size_t)m * DIN + n] = (bf16)f2bf(acc + bias[n]); } };
struct NEpiGlu { const bf16* A; const bf16* Bt; const float* bias; bf16* O;
    __device__ bool active(int) const { return true; }
    __device__ const bf16* arow(int m) const { return A + (size_t)m * DSSM; }
    __device__ const bf16* brow(int, int n) const { return Bt + (size_t)n * DSSM; }
    __device__ void store(int m, int n, float acc) const { const float g = bf2f(A[(size_t)m * DSSM + n]); O[(size_t)m * DSSM + n] = (bf16)f2bf(g * sigmoidf_(acc + bias[n])); } };
struct NEpiOut { const bf16* A; const bf16* Bt; const float* x; const float* mod; float* O;
    __device__ bool active(int) const { return true; }
    __device__ const bf16* arow(int m) const { return A + (size_t)m * D; }
    __device__ const bf16* brow(int, int n) const { return Bt + (size_t)n * D; }
    __device__ void store(int m, int n, float acc) const { const int b = m / S; O[(size_t)m * D + n] = x[(size_t)m * D + n] + mod[b * 6 * D + 2 * D + n] * acc; } };
struct NEpiGU { const bf16* H; const bf16* Wt; const float* bias; const int* tokrow; const int* tilee; bf16* ACT; };
struct NEpiDown { const bf16* ACT; const bf16* Wt; const float* bias; const float* wrow; const int* tilee; bf16* YS;
    __device__ bool active(int m) const { return (m >> 8) < tilee[0]; }
    __device__ const bf16* arow(int m) const { return ACT + (size_t)m * DFF; }
    __device__ const bf16* brow(int m, int n) const { const int e = tilee[64 + (m >> 8)]; return Wt + ((size_t)e * D + n) * DFF; }
    __device__ void store(int m, int n, float acc) const { const int e = tilee[64 + (m >> 8)]; YS[(size_t)m * D + n] = (bf16)f2bf((acc + bias[e * D + n]) * wrow[m]); } };
__global__ void k_moe_gu_naive(NEpiGU e) {
    const int j = blockIdx.y * blockDim.x + threadIdx.x, m = blockIdx.x;
    if ((m >> 8) >= e.tilee[0]) return;
    const int ex = e.tilee[64 + (m >> 8)], t = e.tokrow[m];
    const bf16* a = e.H + (size_t)t * D; const bf16* b0 = e.Wt + ((size_t)ex * 2 * DFF + gu_row(2 * j)) * D; const bf16* b1 = e.Wt + ((size_t)ex * 2 * DFF + gu_row(2 * j + 1)) * D;
    float g = 0.f, u = 0.f;
    for (int k = 0; k < D; k += 8) { const u32x4 av = *(const u32x4*)(a + k); g = dot8(av, *(const u32x4*)(b0 + k), g); u = dot8(av, *(const u32x4*)(b1 + k), u); }
    g += e.bias[ex * 2 * DFF + 2 * j]; u += e.bias[ex * 2 * DFF + 2 * j + 1];
    g = fminf(g, 7.0f); u = fminf(fmaxf(u, -7.0f), 7.0f);
    e.ACT[(size_t)m * DFF + j] = (bf16)f2bf((u + 1.0f) * (g * sigmoidf_(1.702f * g)));
}
__global__ void k_attn_scores(const bf16* PROJ, const float* qg, const float* kg, float* SC) { const int idx = blockIdx.x * blockDim.x + threadIdx.x; if (idx < T * NH) attn_scores_item(idx, PROJ, qg, kg, SC); }
__global__ void k_attn_out(const bf16* PROJ, const float* SC, const float* sinks, bf16* ATT) { const int idx = blockIdx.x * blockDim.x + threadIdx.x; if (idx < T * NH * HD) attn_out_item(idx, PROJ, SC, sinks, ATT); }
__global__ void k_ssm_scan(const bf16* PROJ, const float* tab, float* XST) { const int idx = blockIdx.x * blockDim.x + threadIdx.x; if (idx < NB * NG * NST) ssm_scan_item(idx, PROJ, tab, XST); }
__global__ void k_ssm_out(const bf16* PROJ, const float* XST, const float* c_re, const float* c_im, const float* d_skip, bf16* G) { const int idx = blockIdx.x * blockDim.x + threadIdx.x; if (idx < T * DSSM) ssm_out_item(idx, PROJ, XST, c_re, c_im, d_skip, G); }
__global__ void k_mixnorm(const bf16* ATT, const bf16* SSMG, const float* ga, const float* gs, bf16* MIXED) {
    const int row = blockIdx.x * (blockDim.x / 64) + (threadIdx.x >> 6), lane = threadIdx.x & 63; if (row >= T) return;
    mixnorm_row(row, lane, ATT, SSMG, ga, gs, MIXED);
}
__global__ void __launch_bounds__(512) k_norm2_router(const float* x1, const float* gain, const float* mod, const float* w_router, const float* b_router, bf16* H, int* tope, float* topw, int* hist) {
    extern __shared__ __attribute__((aligned(16))) unsigned char smem[];
    LAS float* wr = (LAS float*)smem; LAS int* lh = (LAS int*)((LAS unsigned char*)smem + 32 * 1024 * 4);
    const int tid = threadIdx.x;
    for (int i = tid; i < D * NE; i += 512) { const int c = i / NE, e = i % NE; wr[e * D + c] = w_router[i]; }
    if (tid < NE) lh[tid] = 0;
    __syncthreads();
    norm2_router_rows(blockIdx.x, tid >> 6, tid & 63, x1, gain, mod, b_router, wr, lh, (LAS float*)((LAS unsigned char*)smem + 32 * 1024 * 4 + 256), H, tope, topw);
    __syncthreads();
    if (tid < NE) hist[blockIdx.x * NE + tid] = lh[tid];
}
__global__ void __launch_bounds__(512) k_sort(const int* hist, const int* tope, const float* topw, int* tokrow, int* rowpair, float* wrow, int* tilee) {
    __shared__ int sm[1408];
    sort_block(blockIdx.x, threadIdx.x, (LAS int*)sm, hist, tope, topw, tokrow, rowpair, wrow, tilee);
}
__global__ void k_combine(float* out, const float* mod, const bf16* YS, const int* rowpair) {
    const int row = blockIdx.x * (blockDim.x / 64) + (threadIdx.x >> 6), lane = threadIdx.x & 63; if (row >= T) return;
    combine_row(row, lane, out, mod, YS, rowpair);
}

namespace pg8 {
constexpr int BM = 256, BK = 64, HALF = 128, HTB = HALF * BK * 2  , STAGE_BYTES = 8 * HTB, NXCD = 8, WGM = 8;
__host__ __device__ __forceinline__ int lds_byte(int r, int c) { const int st = (r >> 4) * 2 + (c >> 5), rr = r & 15, cc = c & 31, ob = rr * 64 + cc * 2; return st * 1024 + (ob ^ (((ob >> 9) & 1) << 5)); }
__host__ __device__ __forceinline__ void stage_rc(int b, int& R, int& C) { const int st = b / 1024, sb = b % 1024, swz = sb ^ (((sb >> 9) & 1) << 5); R = (st >> 1) * 16 + swz / 64; C = (st & 1) * 32 + (swz % 64) / 2; }
__host__ __device__ __forceinline__ int perm32(int rho) { const int n = rho >> 4, i = rho & 15; return 8 * (i >> 2) + 4 * n + (i & 3); }
struct Unit { int pm, pn; };
__device__ __forceinline__ bool order_next(int nM, int nN, int G, int c, int i, Unit& u) {
    const int nwg = nM * nN; const long L = (long)i * G + c; if (L >= nwg) return false;
    int wgid = (int)L; { const int q = nwg / NXCD, r = nwg % NXCD, xcd = wgid % NXCD, off = wgid / NXCD; wgid = (xcd < r ? xcd * (q + 1) : r * (q + 1) + (xcd - r) * q) + off; }
    const int nig = WGM * nN, gid = wgid / nig, fm = gid * WGM, gsz = (nM - fm) < WGM ? (nM - fm) : WGM;
    u.pm = fm + ((wgid % nig) % gsz); u.pn = (wgid % nig) / gsz; return true;
}
struct DenseOrder {
    const char* A; const char* Bt; int nM, nN, G, c; size_t tstep;
    __device__ __forceinline__ bool next(int i, Unit& u) const { return order_next(nM, nN, G, c, i, u); }
    __device__ __forceinline__ const char* a_base(const Unit& u) const { return A + (size_t)u.pm * tstep; }
    __device__ __forceinline__ const char* b_base(const Unit& u) const { return Bt + (size_t)u.pn * tstep; }
    __device__ __forceinline__ int a_row(int) const { return 0; }
    __device__ __forceinline__ int ka(int K) const { return K; }
    __device__ __forceinline__ size_t a_koff(int t) const { return (size_t)t * (BK * 2); }
};
struct MixOrder {
    const char* A; const char* Bt; int nM, nN, G, c; size_t delta;
    __device__ __forceinline__ bool next(int i, Unit& u) const { return order_next(nM, nN, G, c, i, u); }
    __device__ __forceinline__ const char* a_base(const Unit& u) const { return A + (size_t)u.pm * (256 * 512 * 2); }
    __device__ __forceinline__ const char* b_base(const Unit& u) const { return Bt + (size_t)u.pn * (256 * 1024 * 2); }
    __device__ __forceinline__ int a_row(int) const { return 0; }
    __device__ __forceinline__ int ka(int) const { return 512; }
    __device__ __forceinline__ size_t a_koff(int t) const { return (size_t)(t & 7) * (BK * 2) + (size_t)(t >> 3) * delta; }
};
struct MoeOrder {
    const char* A; const char* Bt; const int* tokrow; const LAS int* te; int nM, nN, G, c; size_t tstep, estride; const LAS int* cb = nullptr;
    __device__ __forceinline__ bool next(int i, Unit& u) const { return order_next(nM, nN, G, c, i, u); }
    __device__ __forceinline__ const char* a_base(const Unit& u) const { return A + (size_t)u.pm * tstep; }
    __device__ __forceinline__ const char* b_base(const Unit& u) const { return Bt + (size_t)__builtin_amdgcn_readfirstlane(te[u.pm]) * estride + (size_t)u.pn * tstep; }
    __device__ __forceinline__ int a_row(int r) const { if (FAST_SORT && cb) { const int e = te[r >> 8], rin = r - cb[32 + e]; return rin < cb[e] ? tokrow[(size_t)e * T + rin] : 0; } return tokrow[r]; }
    __device__ __forceinline__ int ka(int K) const { return K; }
    __device__ __forceinline__ size_t a_koff(int t) const { return (size_t)t * (BK * 2); }
};
__device__ __forceinline__ unsigned cvt_pk_bf16(float lo, float hi) { unsigned r; asm volatile("v_cvt_pk_bf16_f32 %0, %1, %2" : "=v"(r) : "v"(lo), "v"(hi)); return r; }

__device__ __forceinline__ void dma_row256(const float* src, LAS float* dst) { if (threadIdx.x < 64) __builtin_amdgcn_global_load_lds((const unsigned*)(src + 4 * threadIdx.x), (LAS unsigned*)dst, 16, 0, 0); }
struct EpiProj {
    static constexpr bool PERM = true, MIDK = false, BEGIN = true;
    bf16* O; int ldc; const float* bias; LAS float* tb;
    __device__ __forceinline__ void begin(const Unit& u, int ui) const { dma_row256(bias + u.pn * BM, tb + (ui & 1) * 512); }
    __device__ __forceinline__ void operator()(const f32x4 (&acc)[2][2][4][2], const Unit& u, int wr, int wc, int fr, int fq, int ui) const {
        const int row0 = u.pm * BM + wr * 64 + fr, col0 = u.pn * BM + wc * 32 + 8 * fq;
        f32x4 bv[2][2];
#pragma unroll
        for (int bj = 0; bj < 2; ++bj)
#pragma unroll
            for (int n = 0; n < 2; ++n) bv[bj][n] = *(const LAS f32x4*)(tb + (ui & 1) * 512 + wc * 32 + 8 * fq + bj * HALF + 4 * n);
#pragma unroll
        for (int ai = 0; ai < 2; ++ai)
#pragma unroll
            for (int m = 0; m < 4; ++m) { bf16* rowp = O + (size_t)(row0 + ai * HALF + m * 16) * ldc + col0;
#pragma unroll
                for (int bj = 0; bj < 2; ++bj) { const f32x4 v0 = acc[ai][bj][m][0] + bv[bj][0], v1 = acc[ai][bj][m][1] + bv[bj][1];
                    u32x4 w; w.x = cvt_pk_bf16(v0[0], v0[1]); w.y = cvt_pk_bf16(v0[2], v0[3]); w.z = cvt_pk_bf16(v1[0], v1[1]); w.w = cvt_pk_bf16(v1[2], v1[3]);
                    *(u32x4*)(rowp + bj * HALF) = w; } }
    }
};
struct EpiGlu {
    static constexpr bool PERM = true, MIDK = false, BEGIN = true;
    const bf16* Gin; bf16* O; const float* bias; float* SQ; LAS float* tb;
    __device__ __forceinline__ void begin(const Unit& u, int ui) const { dma_row256(bias + u.pn * BM, tb + (ui & 1) * 512); }
    __device__ __forceinline__ void operator()(const f32x4 (&acc)[2][2][4][2], const Unit& u, int wr, int wc, int fr, int fq, int ui) const {
        const int row0 = u.pm * BM + wr * 64 + fr, col0 = u.pn * BM + wc * 32 + 8 * fq;
        f32x4 bv[2][2];
#pragma unroll
        for (int bj = 0; bj < 2; ++bj)
#pragma unroll
            for (int n = 0; n < 2; ++n) bv[bj][n] = *(const LAS f32x4*)(tb + (ui & 1) * 512 + wc * 32 + 8 * fq + bj * HALF + 4 * n);
#pragma unroll
        for (int ai = 0; ai < 2; ++ai) {
            u32x4 gin[4][2];
#pragma unroll
            for (int m = 0; m < 4; ++m)
#pragma unroll
                for (int bj = 0; bj < 2; ++bj) gin[m][bj] = *(const u32x4*)(Gin + (size_t)(row0 + ai * HALF + m * 16) * DSSM + col0 + bj * HALF);
#pragma unroll
            for (int m = 0; m < 4; ++m) { const int row = row0 + ai * HALF + m * 16; const size_t off = (size_t)row * DSSM + col0; float sq = 0.f;
#pragma unroll
                for (int bj = 0; bj < 2; ++bj) { const f32x4 z0 = acc[ai][bj][m][0] + bv[bj][0], z1 = acc[ai][bj][m][1] + bv[bj][1];
                    const u32x4 g = gin[m][bj];
                    const float p0 = bflo(g.x) * sigmoidf_(z0[0]), p1 = bfhi(g.x) * sigmoidf_(z0[1]), p2 = bflo(g.y) * sigmoidf_(z0[2]), p3 = bfhi(g.y) * sigmoidf_(z0[3]);
                    const float p4 = bflo(g.z) * sigmoidf_(z1[0]), p5 = bfhi(g.z) * sigmoidf_(z1[1]), p6 = bflo(g.w) * sigmoidf_(z1[2]), p7 = bfhi(g.w) * sigmoidf_(z1[3]);
                    sq += ((p0 * p0 + p1 * p1) + (p2 * p2 + p3 * p3)) + ((p4 * p4 + p5 * p5) + (p6 * p6 + p7 * p7));
                    u32x4 w; w.x = cvt_pk_bf16(p0, p1); w.y = cvt_pk_bf16(p2, p3); w.z = cvt_pk_bf16(p4, p5); w.w = cvt_pk_bf16(p6, p7);
                    *(u32x4*)(O + off + bj * HALF) = w; }
                if (SQ) { sq += __shfl_xor(sq, 16); sq += __shfl_xor(sq, 32); if (fq == 0) SQ[(size_t)row * 8 + u.pn * 4 + wc] = sq; } } }
    }
};
struct EpiOut {
    static constexpr bool PERM = X1_DELTA != 0, MIDK = FUSE_MIXNORM != 0, BEGIN = true;
    const float* x; const float* mod; float* O; const float* ASQ; const float* SSQ; LAS float* tbl; LAS float* tb;
    __device__ __forceinline__ float row_sum8(const float* p, int row) const { const f32x4 a = *(const f32x4*)(p + (size_t)row * 8), b = *(const f32x4*)(p + (size_t)row * 8 + 4); return ((a.x + a.y) + (a.z + a.w)) + ((b.x + b.y) + (b.z + b.w)); }
    __device__ __forceinline__ void begin(const Unit& u, int ui) const {
        if (X1_DELTA) { const int b = (u.pm * BM) / S; dma_row256(mod + b * 6 * D + 2 * D + u.pn * BM, tb + (ui & 1) * 512); }
        if constexpr (!MIDK) return;
        const int r = threadIdx.x; if (r < BM) { const int row = u.pm * BM + r;
            const float ra = rsqrtf(row_sum8(ASQ, row) * (1.0f / DATT) + EPS), rs = rsqrtf(row_sum8(SSQ, row) * (1.0f / DSSM) + EPS);
            *(LAS f32x2*)(tbl + (ui & 1) * 512 + 2 * r) = (f32x2){ra / rs, rs}; }
    }
    __device__ __forceinline__ void mid(f32x4 (&acc)[2][2][4][2], int ui, int wr, int fr) const {
#pragma unroll
        for (int ai = 0; ai < 2; ++ai)
#pragma unroll
            for (int m = 0; m < 4; ++m) { const float rho = tbl[(ui & 1) * 512 + 2 * (wr * 64 + fr + ai * HALF + m * 16)];
#pragma unroll
                for (int bj = 0; bj < 2; ++bj)
#pragma unroll
                    for (int n = 0; n < 2; ++n) acc[ai][bj][m][n] = acc[ai][bj][m][n] * rho; }
    }
    __device__ __forceinline__ void operator()(const f32x4 (&acc)[2][2][4][2], const Unit& u, int wr, int wc, int fr, int fq, int ui = 0) const {
        const int b = (u.pm * BM) / S;
        if constexpr (X1_DELTA) {
            const int col0 = u.pn * BM + wc * 32 + 8 * fq;
            f32x4 gv[2][2];
#pragma unroll
            for (int bj = 0; bj < 2; ++bj)
#pragma unroll
                for (int n = 0; n < 2; ++n) gv[bj][n] = *(const LAS f32x4*)(tb + (ui & 1) * 512 + wc * 32 + 8 * fq + bj * HALF + 4 * n);
#pragma unroll
            for (int ai = 0; ai < 2; ++ai)
#pragma unroll
                for (int m = 0; m < 4; ++m) { const int lr = wr * 64 + fr + ai * HALF + m * 16; bf16* rowp = (bf16*)O + (size_t)(u.pm * BM + lr) * D + col0;
                    const float rs = MIDK ? tbl[(ui & 1) * 512 + 2 * lr + 1] : 1.0f;
#pragma unroll
                    for (int bj = 0; bj < 2; ++bj) { const f32x4 v0 = gv[bj][0] * (acc[ai][bj][m][0] * rs), v1 = gv[bj][1] * (acc[ai][bj][m][1] * rs);
                        u32x4 w; w.x = cvt_pk_bf16(v0[0], v0[1]); w.y = cvt_pk_bf16(v0[2], v0[3]); w.z = cvt_pk_bf16(v1[0], v1[1]); w.w = cvt_pk_bf16(v1[2], v1[3]);
                        *(u32x4*)(rowp + bj * HALF) = w; } }
        } else {
        const int row0 = u.pm * BM + wr * 64 + fr, col0 = u.pn * BM + wc * 32 + 4 * fq;
        f32x4 gv[2][2];
#pragma unroll
        for (int bj = 0; bj < 2; ++bj)
#pragma unroll
            for (int n = 0; n < 2; ++n) gv[bj][n] = *(const f32x4*)(mod + b * 6 * D + 2 * D + col0 + bj * HALF + n * 16);
#pragma unroll
        for (int ai = 0; ai < 2; ++ai)
#pragma unroll
            for (int m = 0; m < 4; ++m) { const int lr = wr * 64 + fr + ai * HALF + m * 16; const size_t off = (size_t)(u.pm * BM + lr) * D + col0;
                const float rs = MIDK ? tbl[(ui & 1) * 512 + 2 * lr + 1] : 1.0f;
#pragma unroll
                for (int bj = 0; bj < 2; ++bj)
#pragma unroll
                    for (int n = 0; n < 2; ++n) { const f32x4 xv = __builtin_nontemporal_load((const f32x4*)(x + off + bj * HALF + n * 16)); *(f32x4*)(O + off + bj * HALF + n * 16) = xv + gv[bj][n] * (acc[ai][bj][m][n] * rs); } }
        }
    }
};
template <bool OUT8> struct EpiGateUp {
    static constexpr bool PERM = true, MIDK = false, BEGIN = true;
    void* ACTp; const float* bias; const LAS int* te; float ascale; LAS float* tb;
    __device__ __forceinline__ void begin(const Unit& u, int ui) const { const int e = __builtin_amdgcn_readfirstlane(te[u.pm]); dma_row256(bias + (size_t)e * 2 * DFF + 2 * (u.pn * HALF), tb + (ui & 1) * 512); }
    __device__ __forceinline__ void operator()(const f32x4 (&acc)[2][2][4][2], const Unit& u, int wr, int wc, int fr, int fq, int ui) const {
        const int row0 = u.pm * BM + wr * 64 + fr, ac0 = u.pn * HALF + wc * 32 + 8 * fq;
        const LAS float* bp = tb + (ui & 1) * 512 + 2 * (wc * 32 + 8 * fq);
        const f32x4 b0 = *(const LAS f32x4*)bp, b1 = *(const LAS f32x4*)(bp + 4), b2 = *(const LAS f32x4*)(bp + 8), b3 = *(const LAS f32x4*)(bp + 12);
        const float bg[8] = {b0[0], b0[2], b1[0], b1[2], b2[0], b2[2], b3[0], b3[2]}, bu[8] = {b0[1], b0[3], b1[1], b1[3], b2[1], b2[3], b3[1], b3[3]};
        const f32x2 asc2 = {ascale, ascale}, zc2 = {-1.702f * 1.4426950408889634f, -1.702f * 1.4426950408889634f}, one2 = {1.0f, 1.0f}, os2 = {OUT8 ? A8_SCALE : 1.0f, OUT8 ? A8_SCALE : 1.0f};
#pragma unroll
        for (int ai = 0; ai < 2; ++ai)
#pragma unroll
            for (int m = 0; m < 4; ++m) { float a[8];
#pragma unroll
                for (int k = 0; k < 8; k += 2) {
                    f32x2 g = (f32x2){acc[ai][0][m][k >> 2][k & 3], acc[ai][0][m][k >> 2][(k & 3) + 1]} * asc2 + (f32x2){bg[k], bg[k + 1]};
                    f32x2 up = (f32x2){acc[ai][1][m][k >> 2][k & 3], acc[ai][1][m][k >> 2][(k & 3) + 1]} * asc2 + (f32x2){bu[k], bu[k + 1]};
                    g.x = fminf(g.x, 7.0f); g.y = fminf(g.y, 7.0f); up.x = __builtin_amdgcn_fmed3f(up.x, -7.0f, 7.0f); up.y = __builtin_amdgcn_fmed3f(up.y, -7.0f, 7.0f);
                    const f32x2 z = g * zc2; f32x2 ex; ex.x = __builtin_amdgcn_exp2f(z.x); ex.y = __builtin_amdgcn_exp2f(z.y);
                    const f32x2 dn = ex + one2; f32x2 sg; sg.x = __builtin_amdgcn_rcpf(dn.x); sg.y = __builtin_amdgcn_rcpf(dn.y);
                    const f32x2 r2 = (up * os2 + os2) * (g * sg); a[k] = r2.x; a[k + 1] = r2.y; }
                const size_t off = (size_t)(row0 + ai * HALF + m * 16) * DFF + ac0;
                if constexpr (OUT8) { u32x2 w; w.x = pk4_fp8(a[0], a[1], a[2], a[3]); w.y = pk4_fp8(a[4], a[5], a[6], a[7]); *(u32x2*)((unsigned char*)ACTp + off) = w; }
                else { u32x4 w; w.x = cvt_pk_bf16(a[0], a[1]); w.y = cvt_pk_bf16(a[2], a[3]); w.z = cvt_pk_bf16(a[4], a[5]); w.w = cvt_pk_bf16(a[6], a[7]); *(u32x4*)((bf16*)ACTp + off) = w; } }
    }
};
template <bool OUT8> struct EpiDown {
    static constexpr bool PERM = true, MIDK = false, BEGIN = true;
    void* YSp; const float* bias; const float* wrow; const LAS int* te; float ascale; const LAS int* cb; LAS float* tb;
    const float* zero;
    __device__ __forceinline__ void begin(const Unit& u, int ui) const { const int t = threadIdx.x, e = __builtin_amdgcn_readfirstlane(te[u.pm]);
        dma_row256(bias + (size_t)e * D + u.pn * BM, tb + (ui & 1) * 512);
        if (t >= 64 && t < 320) { const int w4 = __builtin_amdgcn_readfirstlane((t >> 6) - 1), r = t - 64, row = u.pm * BM + r; const float* src;
            if (FAST_SORT && cb) { const int rin = row - cb[32 + e]; src = rin < cb[e] ? wrow + (size_t)e * T + rin : zero; } else src = wrow + row;
            __builtin_amdgcn_global_load_lds((const unsigned*)src, (LAS unsigned*)(tb + (ui & 1) * 512 + 256 + 64 * w4), 4, 0, 0); } }
    __device__ __forceinline__ void operator()(const f32x4 (&acc)[2][2][4][2], const Unit& u, int wr, int wc, int fr, int fq, int ui) const {
        const int row0 = u.pm * BM + wr * 64 + fr, col0 = u.pn * BM + wc * 32 + 8 * fq;
        f32x4 bv[2][2];
#pragma unroll
        for (int bj = 0; bj < 2; ++bj)
#pragma unroll
            for (int n = 0; n < 2; ++n) bv[bj][n] = *(const LAS f32x4*)(tb + (ui & 1) * 512 + wc * 32 + 8 * fq + bj * HALF + 4 * n);
        float wts[2][4];
#pragma unroll
        for (int ai = 0; ai < 2; ++ai)
#pragma unroll
            for (int m = 0; m < 4; ++m) wts[ai][m] = tb[(ui & 1) * 512 + 256 + wr * 64 + fr + ai * HALF + m * 16];
#pragma unroll
        for (int ai = 0; ai < 2; ++ai)
#pragma unroll
            for (int m = 0; m < 4; ++m) { const int row = row0 + ai * HALF + m * 16; const float wt = wts[ai][m] * (OUT8 ? Y8_SCALE : 1.0f); const size_t off = (size_t)row * D + col0;
#pragma unroll
                for (int bj = 0; bj < 2; ++bj) { const f32x4 v0 = (acc[ai][bj][m][0] * ascale + bv[bj][0]) * wt, v1 = (acc[ai][bj][m][1] * ascale + bv[bj][1]) * wt;
                    if constexpr (OUT8) { u32x2 w; w.x = pk4_fp8(v0[0], v0[1], v0[2], v0[3]); w.y = pk4_fp8(v1[0], v1[1], v1[2], v1[3]); *(u32x2*)((unsigned char*)YSp + off + bj * HALF) = w; }
                    else { u32x4 w; w.x = cvt_pk_bf16(v0[0], v0[1]); w.y = cvt_pk_bf16(v0[2], v0[3]); w.z = cvt_pk_bf16(v1[0], v1[1]); w.w = cvt_pk_bf16(v1[2], v1[3]); *(u32x4*)((bf16*)YSp + off + bj * HALF) = w; } } }
    }
};

template <class Epi, class Sched, bool ALIGN_EPI, bool GATHER, bool FP8 = false>
__device__ __forceinline__ void gemm_phase(LAS unsigned char* lds, const int K, const Sched& S, const Epi& E) {
    const int tid = threadIdx.x, wid = __builtin_amdgcn_readfirstlane(tid >> 6), lane = tid & 63, wr = wid >> 2, wc = wid & 3, fr = lane & 15, fq = lane >> 4;
    const int nt = K / BK;
    int Rr[2], Cc[2]; unsigned voffA[2], voffB[2];
#pragma unroll
    for (int i = 0; i < 2; ++i) { int R, C; stage_rc(tid * 16 + i * 8192, R, C); const int Rb = Epi::PERM ? ((R & ~31) + perm32(R & 31)) : R;
        Rr[i] = R; Cc[i] = C; voffA[i] = (unsigned)(R * S.ka(K) + C) * 2u; voffB[i] = (unsigned)(Rb * K + C) * 2u; }
    const size_t kstep = (size_t)(BK * 2);
    const size_t hstep = (size_t)HALF * K * 2;
    const size_t hstepA = (size_t)HALF * S.ka(K) * 2;
    const unsigned ldsw = (unsigned)wid * 1024u;
    const int aoff = lds_byte(wr * 64 + fr, fq * 8), boff = lds_byte(wc * 32 + fr, fq * 8);
#define PG8_SA(b, h) (((b) * 2 + (h)) * HTB)
#define PG8_SB(b, h) ((4 + (b) * 2 + (h)) * HTB)
#define PG8_STAGE(bufoff, gbase, voff) do { _Pragma("unroll") for (int _i = 0; _i < 2; ++_i) \
        __builtin_amdgcn_global_load_lds((const unsigned*)((const char*)(gbase) + (voff)[_i]), (LAS unsigned*)(lds + (bufoff) + ldsw + _i * 8192), 16, 0, 0); } while (0)
#define PG8_STAGE_A(bufoff, ab, koff, h, g0, g1) do { if constexpr (GATHER) { if ((h) == 0) PG8_STAGE(bufoff, (ab) + (koff), g0); else PG8_STAGE(bufoff, (ab) + (koff), g1); } \
        else { PG8_STAGE(bufoff, (ab) + (koff) + (h) * hstepA, voffA); } } while (0)
#define PG8_LDA(dst, b, h) do { if constexpr (FP8) { _Pragma("unroll") for (int m = 0; m < 4; ++m) dst##8[m] = __builtin_shufflevector(*(const LAS i32x4*)(lds + PG8_SA(b, h) + aoff + m * 2048), *(const LAS i32x4*)(lds + PG8_SA(b, h) + aoff + m * 2048 + 1024), 0, 1, 2, 3, 4, 5, 6, 7); } \
        else { _Pragma("unroll") for (int m = 0; m < 4; ++m) _Pragma("unroll") for (int k = 0; k < 2; ++k) dst[m][k] = *(const LAS bf16x8*)(lds + PG8_SA(b, h) + aoff + m * 2048 + k * 1024); } } while (0)
#define PG8_LDB(dst, b, h) do { if constexpr (FP8) { _Pragma("unroll") for (int n = 0; n < 2; ++n) dst##8[n] = __builtin_shufflevector(*(const LAS i32x4*)(lds + PG8_SB(b, h) + boff + n * 2048), *(const LAS i32x4*)(lds + PG8_SB(b, h) + boff + n * 2048 + 1024), 0, 1, 2, 3, 4, 5, 6, 7); } \
        else { _Pragma("unroll") for (int n = 0; n < 2; ++n) _Pragma("unroll") for (int k = 0; k < 2; ++k) dst[n][k] = *(const LAS bf16x8*)(lds + PG8_SB(b, h) + boff + n * 2048 + k * 1024); } } while (0)
#define PG8_CAT8(x) __builtin_shufflevector(__builtin_bit_cast(i32x4, (x)[0]), __builtin_bit_cast(i32x4, (x)[1]), 0, 1, 2, 3, 4, 5, 6, 7)
#define PG8_MMA(ai, bj, At, Bt) do { __builtin_amdgcn_s_setprio(1); if constexpr (FP8) { _Pragma("unroll") for (int m = 0; m < 4; ++m) _Pragma("unroll") for (int n = 0; n < 2; ++n) \
        asm volatile("v_mfma_scale_f32_16x16x128_f8f6f4 %0, %1, %2, %0, %3, %3 op_sel_hi:[0,0,0]" : "+v"(acc[ai][bj][m][n]) : "v"(Bt##8[n]), "v"(At##8[m]), "v"(one8)); } \
      else { _Pragma("unroll") for (int m = 0; m < 4; ++m) _Pragma("unroll") for (int n = 0; n < 2; ++n) _Pragma("unroll") for (int k = 0; k < 2; ++k) \
        acc[ai][bj][m][n] = __builtin_amdgcn_mfma_f32_16x16x32_bf16(Bt[n][k], At[m][k], acc[ai][bj][m][n], 0, 0, 0); } __builtin_amdgcn_s_setprio(0); } while (0)
#define PG8_WAIT_V(n) asm volatile("s_waitcnt vmcnt(" #n ")" ::: "memory")
#define PG8_WAIT_L(n) asm volatile("s_waitcnt lgkmcnt(" #n ")" ::: "memory")
#define PG8_BAR __builtin_amdgcn_s_barrier()
#define PG8_SCHED __builtin_amdgcn_sched_barrier(0)
#define PG8_GOFF(U, o0, o1) do { if constexpr (GATHER) { _Pragma("unroll") for (int _i = 0; _i < 2; ++_i) { \
        o0[_i] = (unsigned)(S.a_row((U).pm * BM + Rr[_i]) * K + Cc[_i]) * 2u; o1[_i] = (unsigned)(S.a_row((U).pm * BM + HALF + Rr[_i]) * K + Cc[_i]) * 2u; } } } while (0)
    Unit cur, nxt; int ui = 0;
    if (!S.next(0, cur)) return;
    f32x4 acc[2][2][4][2];
#pragma unroll
    for (int a = 0; a < 2; ++a)
#pragma unroll
        for (int b = 0; b < 2; ++b)
#pragma unroll
            for (int m = 0; m < 4; ++m)
#pragma unroll
                for (int n = 0; n < 2; ++n) acc[a][b][m][n] = (f32x4){0.f, 0.f, 0.f, 0.f};
    const int one8 = 0x7f7f7f7f;
    bf16x8 At[4][2], B0[2][2], B1[2][2]; i32x8 At8[4], B08[2], B18[2];
    unsigned cg0[2] = {0u, 0u}, cg1[2] = {0u, 0u}, ng0[2] = {0u, 0u}, ng1[2] = {0u, 0u};
    const char* cA = GATHER ? S.A : S.a_base(cur); const char* cB = S.b_base(cur);
    PG8_GOFF(cur, cg0, cg1);
    PG8_STAGE(PG8_SB(0, 0), cB, voffB); PG8_STAGE(PG8_SB(0, 1), cB + hstep, voffB); PG8_STAGE_A(PG8_SA(0, 0), cA, 0, 0, cg0, cg1); PG8_STAGE_A(PG8_SA(0, 1), cA, 0, 1, cg0, cg1);
    if constexpr (Epi::BEGIN) E.begin(cur, 0);
    if (wr == 1) PG8_BAR;
    PG8_WAIT_V(2); PG8_BAR;
    PG8_STAGE(PG8_SB(1, 0), cB + kstep, voffB); PG8_STAGE_A(PG8_SA(1, 0), cA, S.a_koff(1), 0, cg0, cg1); PG8_STAGE(PG8_SB(1, 1), cB + hstep + kstep, voffB);
    PG8_WAIT_V(6); PG8_BAR;
    for (;;) {
        const bool has_next = S.next(ui + 1, nxt);
        const char* nA = has_next ? (GATHER ? S.A : S.a_base(nxt)) : cA; const char* nB = has_next ? S.b_base(nxt) : cB;
        if constexpr (GATHER) { if (has_next) { PG8_GOFF(nxt, ng0, ng1); } else { ng0[0] = cg0[0]; ng0[1] = cg0[1]; ng1[0] = cg1[0]; ng1[1] = cg1[1]; } }
#pragma unroll 1
        for (int t = 0; t < nt; t += 2) {
            const bool last = (t == nt - 2);
            if constexpr (Epi::MIDK) { if (t == nt / 2) E.mid(acc, ui, wr, fr); }
            const size_t k1 = S.a_koff(t + 1);
            const char* a2 = last ? nA : cA; const char* b2 = last ? nB : cB + (size_t)(t + 2) * kstep;
            const size_t k2 = last ? S.a_koff(0) : S.a_koff(t + 2), k3 = last ? S.a_koff(1) : S.a_koff(t + 3);
            const char* b3 = b2 + kstep;
            unsigned s0[2], s1[2];
            if constexpr (GATHER) { s0[0] = last ? ng0[0] : cg0[0]; s0[1] = last ? ng0[1] : cg0[1]; s1[0] = last ? ng1[0] : cg1[0]; s1[1] = last ? ng1[1] : cg1[1]; } else { s0[0] = s0[1] = s1[0] = s1[1] = 0u; }
            PG8_LDB(B0, 0, 0); PG8_LDB(B1, 0, 1); PG8_SCHED; PG8_LDA(At, 0, 0); PG8_STAGE_A(PG8_SA(1, 1), cA, k1, 1, cg0, cg1);
            PG8_WAIT_V(8); PG8_WAIT_L(0); PG8_BAR; PG8_MMA(0, 0, At, B0); PG8_MMA(0, 1, At, B1); PG8_BAR; PG8_SCHED;
            PG8_LDA(At, 0, 1); PG8_STAGE(PG8_SB(0, 0), b2, voffB); PG8_STAGE(PG8_SB(0, 1), b2 + hstep, voffB); PG8_STAGE_A(PG8_SA(0, 0), a2, k2, 0, s0, s1);
            PG8_WAIT_V(8); PG8_WAIT_L(0); PG8_BAR; PG8_MMA(1, 0, At, B0); PG8_MMA(1, 1, At, B1); PG8_BAR; PG8_SCHED;
            PG8_LDB(B0, 1, 0); PG8_LDB(B1, 1, 1); PG8_SCHED; PG8_LDA(At, 1, 0); PG8_STAGE_A(PG8_SA(0, 1), a2, k2, 1, s0, s1);
            PG8_WAIT_V(8); PG8_WAIT_L(0); PG8_BAR; PG8_MMA(0, 0, At, B0); PG8_MMA(0, 1, At, B1); PG8_BAR; PG8_SCHED;
            PG8_LDA(At, 1, 1); PG8_STAGE(PG8_SB(1, 0), b3, voffB); PG8_STAGE(PG8_SB(1, 1), b3 + hstep, voffB); PG8_STAGE_A(PG8_SA(1, 0), a2, k3, 0, s0, s1);
            PG8_WAIT_V(8); PG8_WAIT_L(0); PG8_BAR; PG8_MMA(1, 0, At, B0); PG8_MMA(1, 1, At, B1); PG8_BAR; PG8_SCHED;
        }
        if constexpr (ALIGN_EPI) { if (wr == 0) PG8_BAR; }
        if constexpr (FP8) asm volatile("s_nop 15\n\ts_nop 15" ::: "memory");
        E(acc, cur, wr, wc, fr, fq, ui);
        if (!has_next) break;
#pragma unroll
        for (int a = 0; a < 2; ++a)
#pragma unroll
            for (int b = 0; b < 2; ++b)
#pragma unroll
                for (int m = 0; m < 4; ++m)
#pragma unroll
                    for (int n = 0; n < 2; ++n) acc[a][b][m][n] = (f32x4){0.f, 0.f, 0.f, 0.f};
        cur = nxt; cA = nA; cB = nB; ++ui;
        if constexpr (Epi::BEGIN) E.begin(cur, ui);
        if constexpr (GATHER) { cg0[0] = ng0[0]; cg0[1] = ng0[1]; cg1[0] = ng1[0]; cg1[1] = ng1[1]; }
        if constexpr (ALIGN_EPI) { if (wr == 1) PG8_BAR; }
    }
    PG8_WAIT_V(0);
    if constexpr (!ALIGN_EPI) { if (wr == 0) PG8_BAR; }
    PG8_BAR;
#undef PG8_SA
#undef PG8_SB
#undef PG8_STAGE
#undef PG8_STAGE_A
#undef PG8_LDA
#undef PG8_LDB
#undef PG8_MMA
#undef PG8_CAT8
#undef PG8_WAIT_V
#undef PG8_WAIT_L
#undef PG8_BAR
#undef PG8_SCHED
#undef PG8_GOFF
}
}

#ifndef BAR_ACQUIRE
#define BAR_ACQUIRE 0
#endif
#define XB_TMO      128
#define XB_XCNT(j)  (256  + 64 * (j))
#define XB_XSUB(j)  (1280 + 64 * (j))
#define XB_XGEN(j)  (2304 + 64 * (j))
#define XB_TOP      3328
#define XB_TOPGEN   3392
#define XCD_BAR_WORDS 3456
#define XB_SPIN_CAP (1u << 18)

__device__ __forceinline__ unsigned xb_ld(unsigned* p)              { return __hip_atomic_load(p, __ATOMIC_RELAXED, __HIP_MEMORY_SCOPE_AGENT); }
__device__ __forceinline__ unsigned xb_add(unsigned* p, unsigned v) { return __hip_atomic_fetch_add(p, v, __ATOMIC_RELAXED, __HIP_MEMORY_SCOPE_AGENT); }
__device__ __forceinline__ unsigned xb_xcc_id() { return (unsigned)__builtin_amdgcn_s_getreg((3 << 11) | 20) & 0xFu; }
#define XB_SPIN(cond, bar) do { unsigned _sp = 0; while (cond) { __builtin_amdgcn_s_sleep(1); \
    if ((++_sp & 255u) == 0u) { if (xb_ld(&(bar)[XB_TMO])) break; if (_sp > XB_SPIN_CAP) { atomicAdd(&(bar)[XB_TMO], 1u); break; } } } } while (0)

struct XcdBarrier {
    unsigned* bar; unsigned x;
    volatile LAS unsigned* st;
};
__device__ __forceinline__ XcdBarrier xcd_barrier_post(unsigned* bar, volatile LAS unsigned* st) {
    XcdBarrier b; b.bar = bar; b.x = xb_xcc_id(); b.st = st;
    if (threadIdx.x == 0) (void)xb_add(&bar[XB_XCNT(b.x)], 1u);
    return b;
}
__device__ __forceinline__ void xcd_barrier_complete(unsigned* bar, unsigned x, unsigned& nloc, unsigned& nx) {
    const unsigned G = gridDim.x * gridDim.y * gridDim.z;
    unsigned sum, cnt, mine, sp = 0u;
    for (;;) {
        sum = 0u; cnt = 0u; mine = 0u;
#pragma unroll
        for (unsigned j = 0; j < 16; ++j) { const unsigned c = xb_ld(&bar[XB_XCNT(j)]); sum += c; cnt += (c > 0u) ? 1u : 0u; mine = (j == x) ? c : mine; }
        if (sum == G) break;
        __builtin_amdgcn_s_sleep(1);
        if ((++sp & 255u) == 0u) { if (xb_ld(&bar[XB_TMO])) break; if (sp > XB_SPIN_CAP) { atomicAdd(&bar[XB_TMO], 1u); break; } }
    }
    nloc = mine > 0u ? mine : 1u; nx = cnt > 0u ? cnt : 1u;
}
__device__ __forceinline__ void xcd_barrier(const XcdBarrier& b) {
    asm volatile("s_waitcnt vmcnt(0)" ::: "memory");
    __syncthreads();
    if (threadIdx.x == 0) {
        unsigned* bar = b.bar;
        __builtin_amdgcn_s_waitcnt(0);
        unsigned nloc = b.st[0], nx = b.st[1];
        if (nloc == 0u) { xcd_barrier_complete(bar, b.x, nloc, nx); b.st[0] = nloc; b.st[1] = nx; }
        const unsigned old = xb_add(&bar[XB_XSUB(b.x)], 1u);
        const unsigned gen = old / nloc;
        if (old + 1u == (gen + 1u) * nloc) {
            __builtin_amdgcn_fence(__ATOMIC_RELEASE, "agent");
            asm volatile("s_waitcnt vmcnt(0)" ::: "memory");
            (void)xb_add(&bar[XB_TOP], 1u);
        }
        XB_SPIN(xb_ld(&bar[XB_TOP]) < (gen + 1u) * nx, bar);
        if (BAR_ACQUIRE) __builtin_amdgcn_fence(__ATOMIC_ACQUIRE, "agent");
        asm volatile("s_waitcnt vmcnt(0)" ::: "memory");
    }
    __syncthreads();
}


__device__ __forceinline__ bf16x8 as_bf16x8(u32x4 v) { return __builtin_bit_cast(bf16x8, v); }
typedef __bf16 bf16x2_t __attribute__((ext_vector_type(2)));
__device__ __forceinline__ unsigned cvtpk(float lo, float hi) { const f32x2 v = {lo, hi}; const bf16x2_t b = __builtin_convertvector(v, bf16x2_t); return __builtin_bit_cast(unsigned, b); }
#define LDS_FENCE() asm volatile("s_waitcnt lgkmcnt(0)" ::: "memory")
__device__ __forceinline__ float fma_s(float a, float b, float c) { float r; asm("v_fma_f32 %0, %1, %2, %3" : "=v"(r) : "v"(a), "v"(b), "v"(c)); return r; }

constexpr int KN_PITCH = 144, VT_PITCH = 528;
constexpr int ATT_KN_OFF = 0, ATT_VT_OFF = 256 * KN_PITCH, ATT_LDS_BYTES = ATT_VT_OFF + 64 * VT_PITCH;
__device__ __forceinline__ void attn_unit(LAS unsigned char* lds, int unit, int tid, const bf16* PROJ, const float* qg, const float* kg, const float* sinks, bf16* ATT, float* ATTSQ = nullptr) {
    const int lane = tid & 63, wave = __builtin_amdgcn_readfirstlane(tid >> 6), l15 = lane & 15, q4 = lane >> 4;
    const int kvh = unit & 1, n = (unit >> 1) & 15, b = unit >> 5;
    const int tok0 = b * S + n * 128;
    {
        const int c = tid & 7; const f32x4 g0 = *(const f32x4*)(kg + 8 * c), g1 = *(const f32x4*)(kg + 8 * c + 4);
        const int vkey = tid & 255; const bool vvalid = (n > 0) || (vkey >= 128);
        u32x4 kraw[4], vraw[4];
#pragma unroll
        for (int j = 0; j < 4; ++j) { const int key = (tid >> 3) + 64 * j; const bool valid = (n > 0) || (key >= 128);
            kraw[j] = (u32x4){0u, 0u, 0u, 0u}; if (valid) kraw[j] = *(const u32x4*)(PROJ + (size_t)(tok0 - 128 + key) * DIN + KOFF + kvh * HD + 8 * c);
            vraw[j] = (u32x4){0u, 0u, 0u, 0u}; if (vvalid) vraw[j] = *(const u32x4*)(PROJ + (size_t)(tok0 - 128 + vkey) * DIN + VOFF + kvh * HD + 8 * ((tid >> 8) + 2 * j)); }
#pragma unroll
        for (int j = 0; j < 4; ++j) { const int key = (tid >> 3) + 64 * j; const u32x4 raw = kraw[j];
            const float f[8] = {bflo(raw.x), bfhi(raw.x), bflo(raw.y), bfhi(raw.y), bflo(raw.z), bfhi(raw.z), bflo(raw.w), bfhi(raw.w)};
            float ss = 0.f;
#pragma unroll
            for (int i = 0; i < 8; ++i) ss += f[i] * f[i];
            ss += __shfl_xor(ss, 1); ss += __shfl_xor(ss, 2); ss += __shfl_xor(ss, 4);
            const float r = rsqrtf(ss * (1.0f / HD) + EPS);
            u32x4 w; w.x = cvtpk(f[0] * r * g0.x, f[1] * r * g0.y); w.y = cvtpk(f[2] * r * g0.z, f[3] * r * g0.w); w.z = cvtpk(f[4] * r * g1.x, f[5] * r * g1.y); w.w = cvtpk(f[6] * r * g1.z, f[7] * r * g1.w);
            *(LAS u32x4*)(lds + ATT_KN_OFF + key * KN_PITCH + c * 16) = w; }
#pragma unroll
        for (int j = 0; j < 4; ++j) { const int cc = (tid >> 8) + 2 * j; const u32x4 raw = vraw[j];
            LAS unsigned short* vt = (LAS unsigned short*)(lds + ATT_VT_OFF + (8 * cc) * VT_PITCH + vkey * 2);
            vt[0 * (VT_PITCH / 2)] = (unsigned short)(raw.x & 0xffffu); vt[1 * (VT_PITCH / 2)] = (unsigned short)(raw.x >> 16);
            vt[2 * (VT_PITCH / 2)] = (unsigned short)(raw.y & 0xffffu); vt[3 * (VT_PITCH / 2)] = (unsigned short)(raw.y >> 16);
            vt[4 * (VT_PITCH / 2)] = (unsigned short)(raw.z & 0xffffu); vt[5 * (VT_PITCH / 2)] = (unsigned short)(raw.z >> 16);
            vt[6 * (VT_PITCH / 2)] = (unsigned short)(raw.w & 0xffffu); vt[7 * (VT_PITCH / 2)] = (unsigned short)(raw.w >> 16); }
    }
    __syncthreads();
    const int g = wave >> 1, h = kvh * 4 + g, qi0 = 64 * (wave & 1);
    const float sink = sinks[h];
    const f32x4 gq00 = *(const f32x4*)(qg + 8 * q4), gq01 = *(const f32x4*)(qg + 8 * q4 + 4), gq10 = *(const f32x4*)(qg + 32 + 8 * q4), gq11 = *(const f32x4*)(qg + 32 + 8 * q4 + 4);
    u32x4 qn0, qn1;
    { const size_t tq0 = (size_t)(tok0 + qi0 + l15); qn0 = *(const u32x4*)(PROJ + tq0 * DIN + QOFF + h * HD + 8 * q4); qn1 = *(const u32x4*)(PROJ + tq0 * DIN + QOFF + h * HD + 32 + 8 * q4); }
#pragma unroll 1
    for (int qt = 0; qt < 4; ++qt) {
        const int q0 = qi0 + 16 * qt, qi = q0 + l15; const size_t tq = (size_t)(tok0 + qi);
        const u32x4 r0 = qn0, r1 = qn1;
        { const size_t tqn = (size_t)(tok0 + qi0 + 16 * ((qt + 1) & 3) + l15); qn0 = *(const u32x4*)(PROJ + tqn * DIN + QOFF + h * HD + 8 * q4); qn1 = *(const u32x4*)(PROJ + tqn * DIN + QOFF + h * HD + 32 + 8 * q4); }
        const float f0[8] = {bflo(r0.x), bfhi(r0.x), bflo(r0.y), bfhi(r0.y), bflo(r0.z), bfhi(r0.z), bflo(r0.w), bfhi(r0.w)};
        const float f1[8] = {bflo(r1.x), bfhi(r1.x), bflo(r1.y), bfhi(r1.y), bflo(r1.z), bfhi(r1.z), bflo(r1.w), bfhi(r1.w)};
        float ss = 0.f;
#pragma unroll
        for (int i = 0; i < 8; ++i) ss += f0[i] * f0[i] + f1[i] * f1[i];
        ss += __shfl_xor(ss, 16); ss += __shfl_xor(ss, 32);
        const float rq = rsqrtf(ss * (1.0f / HD) + EPS) * 0.125f;
        u32x4 w0, w1;
        w0.x = cvtpk(f0[0] * rq * gq00.x, f0[1] * rq * gq00.y); w0.y = cvtpk(f0[2] * rq * gq00.z, f0[3] * rq * gq00.w); w0.z = cvtpk(f0[4] * rq * gq01.x, f0[5] * rq * gq01.y); w0.w = cvtpk(f0[6] * rq * gq01.z, f0[7] * rq * gq01.w);
        w1.x = cvtpk(f1[0] * rq * gq10.x, f1[1] * rq * gq10.y); w1.y = cvtpk(f1[2] * rq * gq10.z, f1[3] * rq * gq10.w); w1.z = cvtpk(f1[4] * rq * gq11.x, f1[5] * rq * gq11.y); w1.w = cvtpk(f1[6] * rq * gq11.z, f1[7] * rq * gq11.w);
        const bf16x8 bq0 = as_bf16x8(w0), bq1 = as_bf16x8(w1);
        const int kt0 = ((q0 >> 4) >> 1) * 2;
        f32x4 s[10];
#pragma unroll
        for (int i = 0; i < 10; ++i) { const LAS unsigned char* kp = lds + ATT_KN_OFF + (16 * (kt0 + i) + l15) * KN_PITCH + 16 * q4;
            const bf16x8 a0 = *(const LAS bf16x8*)kp, a1 = *(const LAS bf16x8*)(kp + 64);
            f32x4 z = (f32x4){0.f, 0.f, 0.f, 0.f};
            z = __builtin_amdgcn_mfma_f32_16x16x32_bf16(a0, bq0, z, 0, 0, 0); s[i] = __builtin_amdgcn_mfma_f32_16x16x32_bf16(a1, bq1, z, 0, 0, 0); }
        float m = sink;
#pragma unroll
        for (int i = 0; i < 10; ++i)
#pragma unroll
            for (int r = 0; r < 4; ++r) { const int kj = 16 * (kt0 + i) + 4 * q4 + r; const bool valid = (kj < 128) ? ((kj > qi) && (n > 0)) : ((kj - 128) <= qi);
                const float v = valid ? s[i][r] : -1e30f; s[i][r] = v; m = fmaxf(m, v); }
        m = fmaxf(m, __shfl_xor(m, 16)); m = fmaxf(m, __shfl_xor(m, 32));
        float den = 0.f;
#pragma unroll
        for (int i = 0; i < 10; ++i)
#pragma unroll
            for (int r = 0; r < 4; ++r) { const float p = __expf(s[i][r] - m); s[i][r] = p; den += p; }
        den += __shfl_xor(den, 16); den += __shfl_xor(den, 32); den += __expf(sink - m);
        f32x4 o[4];
#pragma unroll
        for (int dt = 0; dt < 4; ++dt) o[dt] = (f32x4){0.f, 0.f, 0.f, 0.f};
#pragma unroll
        for (int ks = 0; ks < 5; ++ks) { u32x4 pw; pw.x = cvtpk(s[2 * ks][0], s[2 * ks][1]); pw.y = cvtpk(s[2 * ks][2], s[2 * ks][3]); pw.z = cvtpk(s[2 * ks + 1][0], s[2 * ks + 1][1]); pw.w = cvtpk(s[2 * ks + 1][2], s[2 * ks + 1][3]);
            const bf16x8 bp = as_bf16x8(pw); const int keyb = 16 * kt0 + 32 * ks + 4 * q4;
#pragma unroll
            for (int dt = 0; dt < 4; ++dt) { const LAS unsigned char* vp = lds + ATT_VT_OFF + (16 * dt + l15) * VT_PITCH + keyb * 2;
                const u32x2 lo = *(const LAS u32x2*)vp, hi = *(const LAS u32x2*)(vp + 32);
                u32x4 av; av.x = lo.x; av.y = lo.y; av.z = hi.x; av.w = hi.y;
                o[dt] = __builtin_amdgcn_mfma_f32_16x16x32_bf16(as_bf16x8(av), bp, o[dt], 0, 0, 0); } }
        const float inv = 1.0f / den; float osq = 0.f;
#pragma unroll
        for (int dt = 0; dt < 4; ++dt) { const float o0 = o[dt][0] * inv, o1 = o[dt][1] * inv, o2 = o[dt][2] * inv, o3 = o[dt][3] * inv; osq += (o0 * o0 + o1 * o1) + (o2 * o2 + o3 * o3);
            u32x2 w; w.x = cvtpk(o0, o1); w.y = cvtpk(o2, o3);
            *(u32x2*)(ATT + tq * DATT + h * HD + 16 * dt + 4 * q4) = w; }
        if (ATTSQ) { osq += __shfl_xor(osq, 16); osq += __shfl_xor(osq, 32); if (q4 == 0) ATTSQ[tq * NH + h] = osq; }
    }
    __syncthreads();
}


__device__ __forceinline__ void ssm_apow_item(int i, const float* lam_re, const float* lam_im, const float* log_dt, unsigned char* APOW) {
    const int lane = i & 63, f = (i >> 6) & 63, g = i >> 12, ks = f & 7, rt = f >> 3, st = rt >> 1, c = rt & 1, fr = lane & 15, fq = lane >> 4, p = 16 * st + fr;
    const float dt = expf(log_dt[g]), lrd = lam_re[g * NST + p] * dt, lid = lam_im[g * NST + p] * dt;
    float v[8];
#pragma unroll
    for (int j = 0; j < 8; ++j) { const int t = 32 * ks + 16 * (j >> 2) + 4 * fq + (j & 3); const float k = (float)(255 - t), m = __expf(lrd * k), a = __builtin_amdgcn_fractf(lid * 0.15915494309189535f * k);
        v[j] = m * (c ? __builtin_amdgcn_sinf(a) : __builtin_amdgcn_cosf(a)); }
    u32x4 w; w.x = cvtpk(v[0], v[1]); w.y = cvtpk(v[2], v[3]); w.z = cvtpk(v[4], v[5]); w.w = cvtpk(v[6], v[7]);
    *(u32x4*)(APOW + (size_t)i * 16) = w;
}
struct Tr8 { const float* src; unsigned char* dst; int N, K, n0, k0, isgu, pad; };
__device__ __forceinline__ void tr8_setup(Tr8& t, const float* W, int K, int N, unsigned char* WT, int item, int lane, int isgu) {
    const int nblk = N / 32, kb = item / nblk, nb = item % nblk, q = lane & 7, o = lane >> 3;
    t.k0 = 128 * kb + 16 * o; t.n0 = 32 * nb + 4 * q; t.N = N; t.K = K; t.isgu = isgu; t.src = W + (size_t)t.k0 * N + t.n0; t.dst = WT; t.pad = 0;
}
__device__ __forceinline__ void tr8_load(const Tr8& t, f32x4 (&v)[16]) {
#pragma unroll
    for (int j = 0; j < 16; ++j) v[j] = __builtin_nontemporal_load((const f32x4*)(t.src + (size_t)j * t.N));
}
__device__ __forceinline__ void tr8_store(const Tr8& t, const f32x4 (&v)[16]) {
#pragma unroll
    for (int i = 0; i < 4; ++i) { const int nr = t.isgu ? gu_row(t.n0 + i) : (t.n0 + i);
        u32x4 a; a.x = pk4_fp8(v[0][i] * W8_SCALE, v[1][i] * W8_SCALE, v[2][i] * W8_SCALE, v[3][i] * W8_SCALE); a.y = pk4_fp8(v[4][i] * W8_SCALE, v[5][i] * W8_SCALE, v[6][i] * W8_SCALE, v[7][i] * W8_SCALE);
        a.z = pk4_fp8(v[8][i] * W8_SCALE, v[9][i] * W8_SCALE, v[10][i] * W8_SCALE, v[11][i] * W8_SCALE); a.w = pk4_fp8(v[12][i] * W8_SCALE, v[13][i] * W8_SCALE, v[14][i] * W8_SCALE, v[15][i] * W8_SCALE);
        __builtin_nontemporal_store(a, (u32x4*)(t.dst + (size_t)nr * t.K + t.k0)); }
}
struct ConvStream { const float* w_gu; const float* w_dn; unsigned char* wt_gu; unsigned char* wt_dn; int gu_first, n_gu, n_dn, stride; };

constexpr int SSM_BU_PITCH = 132, SSM_BU_BYTES = 16 * SSM_BU_PITCH * 4, SSM_X_PITCH = 272, SSM_WAVE_BYTES = SSM_BU_BYTES + 16 * SSM_X_PITCH, SSM_XEND_OFF = 8 * SSM_WAVE_BYTES, SSM_LDS_BYTES = SSM_XEND_OFF + 8 * 64 * 8;
__device__ __forceinline__ void ssm_unit(LAS unsigned char* lds, int unit, int tid, const bf16* PROJ, const float* tab, const float* c_re, const float* c_im, const float* d_skip, bf16* Gout, const bool has_cs, const ConvStream cs, const unsigned char* APOW = nullptr) {
    const int lane = tid & 63, wave = __builtin_amdgcn_readfirstlane(tid >> 6), l15 = lane & 15, q4 = lane >> 4;
    const int g = unit & 31, b = unit >> 5;
    if constexpr (SSM_MFMA_CARRY && !P3_CONV) {
        const unsigned char* gsrc = APOW + (size_t)g * 65536 + (size_t)wave * 8192 + lane * 16;
#pragma unroll
        for (int c4 = 0; c4 < 2; ++c4) { const unsigned* gp = (const unsigned*)(gsrc + c4 * 4096); LAS unsigned* lp = (LAS unsigned*)(lds + wave * 8192 + c4 * 4096);
            __builtin_amdgcn_global_load_lds(gp, lp, 16, 0, 0); __builtin_amdgcn_global_load_lds(gp, lp, 16, 1024, 0); __builtin_amdgcn_global_load_lds(gp, lp, 16, 2048, 0); __builtin_amdgcn_global_load_lds(gp, lp, 16, 3072, 0); } }
    Tr8 ct; ct.src = nullptr; ct.dst = nullptr; ct.N = ct.K = ct.n0 = ct.k0 = ct.isgu = ct.pad = 0; f32x4 cv[16]; bool cpend = false; int cq = unit * 8 + wave;
#pragma unroll
    for (int j = 0; j < 16; ++j) cv[j] = (f32x4){0.f, 0.f, 0.f, 0.f};
#define SSM_CONV_STEP() do { if (has_cs) { if (cpend) tr8_store(ct, cv); \
        constexpr int IGU = (D / 128) * (2 * DFF / 32), IDN = (DFF / 128) * (D / 32); cpend = cq < cs.n_gu + cs.n_dn; \
        { const bool isgu = cq < cs.n_gu || !cpend; const int r = !cpend ? 0 : (isgu ? cs.gu_first + cq : cq - cs.n_gu), e = r / (isgu ? IGU : IDN), it = r % (isgu ? IGU : IDN); \
          if (isgu) tr8_setup(ct, cs.w_gu + (size_t)e * D * 2 * DFF, D, 2 * DFF, cs.wt_gu + (size_t)e * 2 * DFF * D, it, lane, 1); \
          else tr8_setup(ct, cs.w_dn + (size_t)e * DFF * D, DFF, D, cs.wt_dn + (size_t)e * D * DFF, it, lane, 0); } \
        tr8_load(ct, cv); cq += cs.stride; } } while (0)
    const float* tg = tab + (size_t)g * SSMT_STRIDE;
    const float ar = tg[ST_AR + lane], ai = tg[ST_AI + lane], nai = -ai;
    bf16x8 bb[8];
#define SSM_SETUP_BB() do { _Pragma("unroll") for (int nt = 0; nt < 8; ++nt) { u32x4 w = (u32x4){0u, 0u, 0u, 0u}; \
        if (q4 < 2) { const int p = 8 * nt + (l15 >> 1); const float* src = tg + ((l15 & 1) ? ST_BI : ST_BR) + p * SG + 8 * q4; const f32x4 v0 = *(const f32x4*)src, v1 = *(const f32x4*)(src + 4); \
            w.x = cvtpk(v0.x, v0.y); w.y = cvtpk(v0.z, v0.w); w.z = cvtpk(v1.x, v1.y); w.w = cvtpk(v1.z, v1.w); } \
        bb[nt] = as_bf16x8(w); } } while (0)
    if constexpr (!(SSM_MFMA_CARRY && !P3_CONV)) SSM_SETUP_BB();
    bf16x8 cm[4];
#pragma unroll
    for (int ks = 0; ks < 4; ++ks) { const int pb = 16 * ks + 4 * q4; const f32x4 cr = *(const f32x4*)(c_re + ((size_t)g * SG + l15) * NST + pb), ci = *(const f32x4*)(c_im + ((size_t)g * SG + l15) * NST + pb);
        u32x4 w; w.x = cvtpk(cr.x, -ci.x); w.y = cvtpk(cr.y, -ci.y); w.z = cvtpk(cr.z, -ci.z); w.w = cvtpk(cr.w, -ci.w); cm[ks] = as_bf16x8(w); }
    LAS float* BU = (LAS float*)(lds + wave * SSM_WAVE_BYTES); LAS unsigned char* XT = lds + wave * SSM_WAVE_BYTES + SSM_BU_BYTES;
    LAS f32x2* xend = (LAS f32x2*)(lds + SSM_XEND_OFF);
    const bf16* ubase = PROJ + (size_t)(b * S) * DIN + UOFF + g * SG;
    const int tseg = 256 * wave;
    float xr = 0.f, xi = 0.f;
#define SSM_LOAD_U(dst, t0) do { dst = (u32x4){0u, 0u, 0u, 0u}; if (q4 < 2) dst = *(const u32x4*)(ubase + (size_t)((t0) + l15) * DIN + 8 * q4); } while (0)
#define SSM_BU_TILE(araw) do { const bf16x8 afr = as_bf16x8(araw); \
        _Pragma("unroll") for (int nt = 0; nt < 8; ++nt) { const f32x4 d = __builtin_amdgcn_mfma_f32_16x16x32_bf16(afr, bb[nt], (f32x4){0.f, 0.f, 0.f, 0.f}, 0, 0, 0); \
            _Pragma("unroll") for (int r = 0; r < 4; ++r) BU[(4 * q4 + r) * SSM_BU_PITCH + 16 * nt + l15] = d[r]; } LDS_FENCE(); } while (0)
    u32x4 ucur, unext, unn; SSM_LOAD_U(ucur, tseg); SSM_LOAD_U(unext, tseg + 16);
    if constexpr (SSM_MFMA_CARRY && !P3_CONV) {
        u32x4 idw = (u32x4){0u, 0u, 0u, 0u};
        { const int m = l15 - 8 * q4; const unsigned one = (m & 1) ? 0x3F800000u : 0x00003F80u;
          if (q4 < 2 && m >= 0 && m < 8) { idw.x = (m >> 1) == 0 ? one : 0u; idw.y = (m >> 1) == 1 ? one : 0u; idw.z = (m >> 1) == 2 ? one : 0u; idw.w = (m >> 1) == 3 ? one : 0u; } }
        const bf16x8 ident = as_bf16x8(idw);
        f32x4 V[8]; u32x4 na, nb;
#pragma unroll
        for (int rt = 0; rt < 8; ++rt) V[rt] = (f32x4){0.f, 0.f, 0.f, 0.f};
        asm volatile("s_waitcnt vmcnt(0)" ::: "memory");
        __syncthreads();
#pragma unroll 2
        for (int ks = 0; ks < 8; ++ks) {
            SSM_LOAD_U(na, tseg + 16 * ((2 * ks + 2) & 15)); SSM_LOAD_U(nb, tseg + 16 * ((2 * ks + 3) & 15));
            u32x4 afc[8];
#pragma unroll
            for (int rt = 0; rt < 8; ++rt) afc[rt] = *(const LAS u32x4*)(lds + (rt * 8 + ks) * 1024 + lane * 16);
            const f32x4 d0 = __builtin_amdgcn_mfma_f32_16x16x32_bf16(as_bf16x8(ucur), ident, (f32x4){0.f, 0.f, 0.f, 0.f}, 0, 0, 0), d1 = __builtin_amdgcn_mfma_f32_16x16x32_bf16(as_bf16x8(unext), ident, (f32x4){0.f, 0.f, 0.f, 0.f}, 0, 0, 0);
            u32x4 utw; utw.x = cvtpk(d0[0], d0[1]); utw.y = cvtpk(d0[2], d0[3]); utw.z = cvtpk(d1[0], d1[1]); utw.w = cvtpk(d1[2], d1[3]);
            const bf16x8 ut = as_bf16x8(utw);
#pragma unroll
            for (int rt = 0; rt < 8; ++rt) V[rt] = __builtin_amdgcn_mfma_f32_16x16x32_bf16(as_bf16x8(afc[rt]), ut, V[rt], 0, 0, 0);
            ucur = na; unext = nb; }
        __syncthreads();
        float bre[4][4], bim[4][4];
#pragma unroll
        for (int st = 0; st < 4; ++st)
#pragma unroll
            for (int i = 0; i < 4; ++i) { const int p = 16 * st + 4 * q4 + i; bre[st][i] = bf2f(f2bf(tg[ST_BR + p * SG + l15])); bim[st][i] = bf2f(f2bf(tg[ST_BI + p * SG + l15])); }
        LAS f32x2* PP = (LAS f32x2*)(lds + wave * SSM_WAVE_BYTES);
#pragma unroll
        for (int st = 0; st < 4; ++st)
#pragma unroll
            for (int i = 0; i < 4; ++i) { const float vr = V[2 * st][i], vi = V[2 * st + 1][i], br = bre[st][i], bi = bim[st][i];
                PP[(16 * st + 4 * q4 + i) * 18 + l15] = (f32x2){br * vr - bi * vi, br * vi + bi * vr}; }
        LDS_FENCE();
        { float sr = 0.f, si = 0.f;
#pragma unroll
          for (int q = 0; q < 8; ++q) { const f32x4 v = *(const LAS f32x4*)(PP + lane * 18 + 2 * q); sr += v.x + v.z; si += v.y + v.w; }
          xr = sr; xi = si; }
        LDS_FENCE();
    } else {
#pragma unroll 1
    for (int tile4 = 0; tile4 < 16; tile4 += 4) {
#pragma unroll
      for (int ti = 0; ti < 4; ++ti) { const int tile = tile4 + ti; SSM_LOAD_U(unn, tseg + 16 * ((tile + 2) & 15)); if (ti == 0) SSM_CONV_STEP(); SSM_BU_TILE(ucur); ucur = unext; unext = unn;
#pragma unroll
        for (int tt = 0; tt < 16; ++tt) { const f32x2 bu = *(const LAS f32x2*)(BU + tt * SSM_BU_PITCH + 2 * lane); const float nr = fma_s(ar, xr, fma_s(nai, xi, bu.x)), ni = fma_s(ar, xi, fma_s(ai, xr, bu.y)); xr = nr; xi = ni; }
        LDS_FENCE(); } }
    }
    xend[wave * 64 + lane] = (f32x2){xr, xi};
    __syncthreads();
    { float pr = ar, pi = ai;
#pragma unroll
      for (int i = 0; i < 8; ++i) { const float nr = pr * pr - pi * pi, ni = 2.0f * pr * pi; pr = nr; pi = ni; }
      xr = 0.f; xi = 0.f;
      for (int w2 = 0; w2 < wave; ++w2) { const f32x2 e = xend[w2 * 64 + lane]; const float npi = -pi; const float nr = fma_s(pr, xr, fma_s(npi, xi, e.x)), ni = fma_s(pr, xi, fma_s(pi, xr, e.y)); xr = nr; xi = ni; } }
    const f32x4 dsk = *(const f32x4*)(d_skip + g * SG + 4 * q4);
    if constexpr (SSM_MFMA_CARRY && !P3_CONV) SSM_SETUP_BB();
    u32x2 uucur = *(const u32x2*)(ubase + (size_t)(tseg + l15) * DIN + 4 * q4), uunext = *(const u32x2*)(ubase + (size_t)(tseg + 16 + l15) * DIN + 4 * q4), uunn;
#pragma unroll 1
    for (int tile4 = 0; tile4 < 16; tile4 += 4) {
#pragma unroll
      for (int ti = 0; ti < 4; ++ti) { const int tile = tile4 + ti; const int t0 = tseg + 16 * tile; SSM_LOAD_U(unn, tseg + 16 * ((tile + 2) & 15)); uunn = *(const u32x2*)(ubase + (size_t)(tseg + 16 * ((tile + 2) & 15) + l15) * DIN + 4 * q4); if (ti == 0) SSM_CONV_STEP(); SSM_BU_TILE(ucur); ucur = unext; unext = unn;
        f32x2 buv[16];
#pragma unroll
        for (int tt = 0; tt < 16; ++tt) buv[tt] = *(const LAS f32x2*)(BU + tt * SSM_BU_PITCH + 2 * lane);
#pragma unroll
        for (int tt = 0; tt < 16; ++tt) { const f32x2 bu = buv[tt]; const float nr = fma_s(ar, xr, fma_s(nai, xi, bu.x)), ni = fma_s(ar, xi, fma_s(ai, xr, bu.y)); xr = nr; xi = ni;
            *(LAS unsigned*)(XT + tt * SSM_X_PITCH + 4 * lane) = cvtpk(xr, xi); }
        LDS_FENCE();
        f32x4 y = (f32x4){0.f, 0.f, 0.f, 0.f};
#pragma unroll
        for (int ks = 0; ks < 4; ++ks) { const bf16x8 bx = *(const LAS bf16x8*)(XT + l15 * SSM_X_PITCH + (32 * ks + 8 * q4) * 2); y = __builtin_amdgcn_mfma_f32_16x16x32_bf16(cm[ks], bx, y, 0, 0, 0); }
        const size_t t = (size_t)(t0 + l15); const u32x2 uu = uucur; uucur = uunext; uunext = uunn;
        const float y0 = gelu_tanh(y[0] + dsk.x * bflo(uu.x)), y1 = gelu_tanh(y[1] + dsk.y * bfhi(uu.x)), y2 = gelu_tanh(y[2] + dsk.z * bflo(uu.y)), y3 = gelu_tanh(y[3] + dsk.w * bfhi(uu.y));
        u32x2 w; w.x = cvtpk(y0, y1); w.y = cvtpk(y2, y3);
        *(u32x2*)(Gout + ((size_t)(b * S) + t) * DSSM + g * SG + 4 * q4) = w;
        LDS_FENCE(); } }
#undef SSM_BU_TILE
#undef SSM_SETUP_BB
#undef SSM_LOAD_U
#undef SSM_CONV_STEP
    if (has_cs && cpend) tr8_store(ct, cv);
    __syncthreads();
}

constexpr int NWAVES = 8;
constexpr int RING_OFF = 0, RING_BYTES = 131072;
constexpr int LDSCTL_OFF = RING_BYTES;
constexpr int MISC_OFF = LDSCTL_OFF + 320;
constexpr int LH_OFF = LDSCTL_OFF + 512;
constexpr int SORT_OFF = RING_OFF;
constexpr int RSCR_OFF = LDSCTL_OFF + 8192;
constexpr int TE_OFF = LDSCTL_OFF + 4096;
constexpr int LDS_BYTES = 147456;
#define LDS_WAIT() asm volatile("s_waitcnt lgkmcnt(0)" ::: "memory")
#ifndef DEFER_P4_N
#define DEFER_P4_N 4
#endif
#ifndef DEFER_P2_N
#define DEFER_P2_N 5
#endif
#ifndef DN_DEFER_P9_N
#define DN_DEFER_P9_N 3072
#endif
constexpr int DN_DEFER_P9 = (MOE_FP8_GU && MOE_FP8_DN) ? DN_DEFER_P9_N : 0;
constexpr int DEFER_P2_PER_WAVE = MOE_FP8_GU ? DEFER_P2_N : 0, DEFER_P4_PER_WAVE = MOE_FP8_GU ? DEFER_P4_N : 0;
#ifndef P2_RESHAPE
#define P2_RESHAPE 1
#endif
#ifndef P2_CONV_N
#define P2_CONV_N 10
#endif
constexpr int P2_GEMM_WGS = 160;
constexpr int GU_DEFER_P2 = (P2_RESHAPE && MOE_FP8_GU) ? (256 - P2_GEMM_WGS) * 8 * P2_CONV_N : 192 * 8 * DEFER_P2_PER_WAVE, GU_DEFER_P4 = 128 * 8 * DEFER_P4_PER_WAVE, GU_DEFER = GU_DEFER_P2 + GU_DEFER_P4;
enum Phase { P_PRO = 0, P_NORM1, P_INPROJ, P_MIX_A, P_MIX_B, P_GLU, P_MIXNORM, P_OUTPROJ, P_ROUTER, P_SORT, P_GATEUP, P_DOWN, P_COMBINE, P_COUNT };

__device__ __forceinline__ void router_image_item(int i, const float* w_router, unsigned char* WRI) {
    const int lane = i & 63, rest = i >> 6, hl = rest & 1, nt = (rest >> 1) & 1, ks = (rest >> 2) & 3, w = rest >> 4, fr = lane & 15, fq = lane >> 4;
    const float* src = w_router + (size_t)(128 * w + 32 * ks + 8 * fq) * NE + 16 * nt + fr;
    float v[8];
#pragma unroll
    for (int j = 0; j < 8; ++j) v[j] = src[j * NE];
    u32x4 p;
#pragma unroll
    for (int j = 0; j < 4; ++j) { float a = v[2 * j], b = v[2 * j + 1]; unsigned hi = cvtpk(a, b); if (hl) { a -= bflo(hi); b -= bfhi(hi); hi = cvtpk(a, b); } p[j] = hi; }
    *(u32x4*)(WRI + (size_t)i * 16) = p;
}
__device__ __forceinline__ void router_block_mfma(LAS unsigned char* lds, int blk, int tid, int wave, int lane, const float* x1, const float* gain, const float* mod, const float* b_router,
                                                  const unsigned char* WRI, LAS int* lh, unsigned char* H8, int* tope, float* topw, const bf16* delta = nullptr, int* cnt = nullptr, int* toke = nullptr, float* wrowe = nullptr, int* paire = nullptr, bf16* x1b = nullptr) {
    asm volatile("" : "+v"(lane), "+v"(tid));
    const int b = (blk * 64) / S, fr = lane & 15, fq = lane >> 4;
    LAS unsigned char* Wl = lds + RING_OFF + wave * 16384;
    LAS float* gsh = (LAS float*)(lds + RSCR_OFF);
    LAS float* ssqx = (LAS float*)(lds + TE_OFF);
    LAS int* sel_e = (LAS int*)(lds + TE_OFF + 2048);
    LAS float* sel_v = (LAS float*)(lds + TE_OFF + 3072);
    LAS float* lg = (LAS float*)(lds + RING_OFF + 8192);
    { const unsigned char* gsrc = WRI + (size_t)wave * 16384 + lane * 16;
#pragma unroll
      for (int c4 = 0; c4 < 4; ++c4) { const unsigned* gp = (const unsigned*)(gsrc + c4 * 4096); LAS unsigned* lp = (LAS unsigned*)(Wl + c4 * 4096);
          __builtin_amdgcn_global_load_lds(gp, lp, 16, 0, 0); __builtin_amdgcn_global_load_lds(gp, lp, 16, 1024, 0); __builtin_amdgcn_global_load_lds(gp, lp, 16, 2048, 0); __builtin_amdgcn_global_load_lds(gp, lp, 16, 3072, 0); } }
    f32x4 xv[4][4][2];
    const float* xb = x1 + (size_t)(blk * 64 + fr) * D + 128 * wave + 8 * fq;
#pragma unroll
    for (int m = 0; m < 4; ++m)
#pragma unroll
        for (int ks = 0; ks < 4; ++ks) { xv[m][ks][0] = *(const f32x4*)(xb + (size_t)(16 * m) * D + 32 * ks); xv[m][ks][1] = *(const f32x4*)(xb + (size_t)(16 * m) * D + 32 * ks + 4); }
    if (delta) {
        const bf16* db = delta + (size_t)(blk * 64 + fr) * D + 128 * wave + 8 * fq; u32x4 dv[4][4];
#pragma unroll
        for (int m = 0; m < 4; ++m)
#pragma unroll
            for (int ks = 0; ks < 4; ++ks) dv[m][ks] = *(const u32x4*)(db + (size_t)(16 * m) * D + 32 * ks);
#pragma unroll
        for (int m = 0; m < 4; ++m)
#pragma unroll
            for (int ks = 0; ks < 4; ++ks) { const u32x4 d = dv[m][ks];
                xv[m][ks][0] += (f32x4){bflo(d.x), bfhi(d.x), bflo(d.y), bfhi(d.y)}; xv[m][ks][1] += (f32x4){bflo(d.z), bfhi(d.z), bflo(d.w), bfhi(d.w)}; } }
    if (x1b) { bf16* xo = x1b + (size_t)(blk * 64 + fr) * D + 128 * wave + 8 * fq;
#pragma unroll
        for (int m = 0; m < 4; ++m)
#pragma unroll
            for (int ks = 0; ks < 4; ++ks) { const f32x4 a = xv[m][ks][0], c2 = xv[m][ks][1]; u32x4 w; w.x = cvtpk(a.x, a.y); w.y = cvtpk(a.z, a.w); w.z = cvtpk(c2.x, c2.y); w.w = cvtpk(c2.z, c2.w);
                *(u32x4*)(xo + (size_t)(16 * m) * D + 32 * ks) = w; } }
    if (lane < 32) { const int c = 128 * wave + 4 * lane; const f32x4 g = *(const f32x4*)(gain + c), sc = *(const f32x4*)(mod + b * 6 * D + 4 * D + c);
        *(LAS f32x4*)(gsh + c) = g * (1.0f + sc); *(LAS f32x4*)(gsh + 1024 + c) = *(const f32x4*)(mod + b * 6 * D + 3 * D + c); }
    float ss[4];
#pragma unroll
    for (int m = 0; m < 4; ++m) { float a = 0.f;
#pragma unroll
        for (int ks = 0; ks < 4; ++ks)
#pragma unroll
            for (int h = 0; h < 2; ++h) { const f32x4 v = xv[m][ks][h]; a += (v.x * v.x + v.y * v.y) + (v.z * v.z + v.w * v.w); }
        a += __shfl_xor(a, 16); a += __shfl_xor(a, 32); ss[m] = a; }
    if (fq == 0) {
#pragma unroll
        for (int m = 0; m < 4; ++m) ssqx[(16 * m + fr) * 8 + wave] = ss[m]; }
    asm volatile("s_waitcnt vmcnt(0)" ::: "memory");
    __syncthreads();
    float r[4];
#pragma unroll
    for (int m = 0; m < 4; ++m) { const f32x4 a = *(const LAS f32x4*)(ssqx + (16 * m + fr) * 8), c = *(const LAS f32x4*)(ssqx + (16 * m + fr) * 8 + 4);
        r[m] = rsqrtf((((a.x + a.y) + (a.z + a.w)) + ((c.x + c.y) + (c.z + c.w))) * (1.0f / D) + EPS); }
    f32x4 acc[4][2];
#pragma unroll
    for (int m = 0; m < 4; ++m)
#pragma unroll
        for (int nt = 0; nt < 2; ++nt) acc[m][nt] = (f32x4){0.f, 0.f, 0.f, 0.f};
#pragma unroll
    for (int ks = 0; ks < 4; ++ks) { const int kk = 128 * wave + 32 * ks + 8 * fq;
        const f32x4 g0 = *(const LAS f32x4*)(gsh + kk), g1 = *(const LAS f32x4*)(gsh + kk + 4), s0 = *(const LAS f32x4*)(gsh + 1024 + kk), s1 = *(const LAS f32x4*)(gsh + 1024 + kk + 4);
        bf16x8 Wh[2], Wo[2];
#pragma unroll
        for (int nt = 0; nt < 2; ++nt) { Wh[nt] = *(const LAS bf16x8*)(Wl + ((ks * 2 + nt) * 2 + 0) * 1024 + lane * 16); Wo[nt] = *(const LAS bf16x8*)(Wl + ((ks * 2 + nt) * 2 + 1) * 1024 + lane * 16); }
#pragma unroll
        for (int m = 0; m < 4; ++m) { const f32x4 h0 = xv[m][ks][0] * r[m] * g0 + s0, h1 = xv[m][ks][1] * r[m] * g1 + s1;
            u32x2 w8; w8.x = pk4_fp8(h0.x * H8_SCALE, h0.y * H8_SCALE, h0.z * H8_SCALE, h0.w * H8_SCALE); w8.y = pk4_fp8(h1.x * H8_SCALE, h1.y * H8_SCALE, h1.z * H8_SCALE, h1.w * H8_SCALE);
            *(u32x2*)(H8 + (size_t)(blk * 64 + 16 * m + fr) * D + kk) = w8;
            u32x4 hi, lo;
            hi.x = cvtpk(h0.x, h0.y); hi.y = cvtpk(h0.z, h0.w); hi.z = cvtpk(h1.x, h1.y); hi.w = cvtpk(h1.z, h1.w);
            lo.x = cvtpk(h0.x - bflo(hi.x), h0.y - bfhi(hi.x)); lo.y = cvtpk(h0.z - bflo(hi.y), h0.w - bfhi(hi.y)); lo.z = cvtpk(h1.x - bflo(hi.z), h1.y - bfhi(hi.z)); lo.w = cvtpk(h1.z - bflo(hi.w), h1.w - bfhi(hi.w));
            const bf16x8 Xh = __builtin_bit_cast(bf16x8, hi), Xl = __builtin_bit_cast(bf16x8, lo);
#pragma unroll
            for (int nt = 0; nt < 2; ++nt) { acc[m][nt] = __builtin_amdgcn_mfma_f32_16x16x32_bf16(Wo[nt], Xh, acc[m][nt], 0, 0, 0); acc[m][nt] = __builtin_amdgcn_mfma_f32_16x16x32_bf16(Wh[nt], Xl, acc[m][nt], 0, 0, 0);
                acc[m][nt] = __builtin_amdgcn_mfma_f32_16x16x32_bf16(Wh[nt], Xh, acc[m][nt], 0, 0, 0); } } }
    { LAS float* part = (LAS float*)Wl;
#pragma unroll
      for (int m = 0; m < 4; ++m)
#pragma unroll
          for (int nt = 0; nt < 2; ++nt) *(LAS f32x4*)(part + (16 * m + fr) * 32 + 16 * nt + 4 * fq) = acc[m][nt]; }
    __syncthreads();
    { const int row = tid >> 3, eg = tid & 7; f32x4 sum = *(const f32x4*)(b_router + 4 * eg);
#pragma unroll
      for (int w2 = 0; w2 < 8; ++w2) sum += *(const LAS f32x4*)(lds + RING_OFF + w2 * 16384 + (row * 32 + 4 * eg) * 4);
      *(LAS f32x4*)(lg + row * 32 + 4 * eg) = sum; }
    __syncthreads();
    { const int row = 8 * wave + (lane >> 3), eg = lane & 7; const LAS float* lgr = lg + row * 32;
      const f32x4 mine = *(const LAS f32x4*)(lgr + 4 * eg); const int e0m = 4 * eg;
      int rk0 = 0, rk1 = 0, rk2 = 0, rk3 = 0;
#pragma unroll
      for (int q = 0; q < 8; ++q) { const f32x4 a = *(const LAS f32x4*)(lgr + 4 * q);
#pragma unroll
          for (int t = 0; t < 4; ++t) { const int e2 = 4 * q + t; const float av = a[t];
              rk0 += (av > mine.x || (av == mine.x && e2 < e0m + 0)) ? 1 : 0; rk1 += (av > mine.y || (av == mine.y && e2 < e0m + 1)) ? 1 : 0;
              rk2 += (av > mine.z || (av == mine.z && e2 < e0m + 2)) ? 1 : 0; rk3 += (av > mine.w || (av == mine.w && e2 < e0m + 3)) ? 1 : 0; } }
      if (rk0 < 4) { sel_e[row * 4 + rk0] = e0m + 0; sel_v[row * 4 + rk0] = mine.x; }
      if (rk1 < 4) { sel_e[row * 4 + rk1] = e0m + 1; sel_v[row * 4 + rk1] = mine.y; }
      if (rk2 < 4) { sel_e[row * 4 + rk2] = e0m + 2; sel_v[row * 4 + rk2] = mine.z; }
      if (rk3 < 4) { sel_e[row * 4 + rk3] = e0m + 3; sel_v[row * 4 + rk3] = mine.w; }
      asm volatile("s_waitcnt lgkmcnt(0)" ::: "memory");
      if (eg == 0) { const i32x4 ee = *(const LAS i32x4*)(sel_e + row * 4); const f32x4 vv = *(const LAS f32x4*)(sel_v + row * 4);
          const float x1v = __expf(vv.y - vv.x), x2v = __expf(vv.z - vv.x), x3v = __expf(vv.w - vv.x), inv = 1.0f / (1.0f + x1v + x2v + x3v);
          const size_t g = (size_t)(blk * 64 + row) * 4;
          if (cnt) *(LAS f32x4*)(sel_v + row * 4) = (f32x4){inv, x1v * inv, x2v * inv, x3v * inv};
          else { *(i32x4*)(tope + g) = ee; *(f32x4*)(topw + g) = (f32x4){inv, x1v * inv, x2v * inv, x3v * inv}; }
          (void)__hip_atomic_fetch_add(&lh[ee.x], 1, __ATOMIC_RELAXED, __HIP_MEMORY_SCOPE_WORKGROUP); (void)__hip_atomic_fetch_add(&lh[ee.y], 1, __ATOMIC_RELAXED, __HIP_MEMORY_SCOPE_WORKGROUP);
          (void)__hip_atomic_fetch_add(&lh[ee.z], 1, __ATOMIC_RELAXED, __HIP_MEMORY_SCOPE_WORKGROUP); (void)__hip_atomic_fetch_add(&lh[ee.w], 1, __ATOMIC_RELAXED, __HIP_MEMORY_SCOPE_WORKGROUP); }
      asm volatile("s_waitcnt lgkmcnt(0)" ::: "memory"); }
    if (cnt) {
        LAS int* offs = (LAS int*)ssqx; LAS int* es = (LAS int*)ssqx + 32;
        __syncthreads();
        if (tid < NE) { offs[tid] = __hip_atomic_fetch_add(cnt + tid * CNT_STRIDE, lh[tid], __ATOMIC_RELAXED, __HIP_MEMORY_SCOPE_AGENT); lh[tid] = 0; }
        int my_e = 0, rank = 0;
        if (tid < 256) { my_e = sel_e[tid]; const unsigned long long lt = (lane == 0) ? 0ull : (~0ull >> (64 - lane));
#pragma unroll 4
            for (int e = 0; e < NE; ++e) { const unsigned long long mk = __ballot(my_e == e); if (my_e == e) rank = __popcll(mk & lt); if (lane == 0) es[wave * 32 + e] = __popcll(mk); } }
        __syncthreads();
        if (tid < 256) { for (int w2 = 0; w2 < wave; ++w2) rank += es[w2 * 32 + my_e];
            const int slot = offs[my_e] + rank;
            toke[(size_t)my_e * T + slot] = blk * 64 + (tid >> 2); wrowe[(size_t)my_e * T + slot] = sel_v[tid]; paire[(size_t)blk * 256 + tid] = slot | (my_e << 20); }
    }
}

struct Args { const float* in[30]; float* out; unsigned char* ws; int ph_lo, ph_hi, li, pad; };

template <bool GU> __device__ __forceinline__ void p0_transpose_item(const float* W, int K, int N, bf16* WT, int item, int lane, const float* kscale = nullptr) {
    const int nblk = N / 64, kb = item / nblk, nb = item % nblk, q = lane & 15, o = lane >> 4, k0 = 64 * kb + 16 * o, n0 = 64 * nb + 4 * q;
    const float* src = W + (size_t)k0 * N + n0;
    f32x4 v[16];
#pragma unroll
    for (int j = 0; j < 16; ++j) v[j] = *(const f32x4*)(src + (size_t)j * N);
    if (kscale) {
#pragma unroll
        for (int j = 0; j < 16; ++j) v[j] = v[j] * kscale[k0 + j]; }
#pragma unroll
    for (int i = 0; i < 4; ++i) { const int nr = GU ? gu_row(n0 + i) : (n0 + i);
        u32x4 a, b;
        a.x = cvtpk(v[0][i], v[1][i]); a.y = cvtpk(v[2][i], v[3][i]); a.z = cvtpk(v[4][i], v[5][i]); a.w = cvtpk(v[6][i], v[7][i]);
        b.x = cvtpk(v[8][i], v[9][i]); b.y = cvtpk(v[10][i], v[11][i]); b.z = cvtpk(v[12][i], v[13][i]); b.w = cvtpk(v[14][i], v[15][i]);
        u32x4* dst = (u32x4*)(WT + (size_t)nr * K + k0); dst[0] = a; dst[1] = b; }
}

template <bool GU> __device__ __forceinline__ void p0_transpose_item_fp8(const float* W, int K, int N, unsigned char* WT, int item, int lane) {
    const int nblk = N / 32, kb = item / nblk, nb = item % nblk, q = lane & 7, o = lane >> 3, k0 = 128 * kb + 16 * o, n0 = 32 * nb + 4 * q;
    const float* src = W + (size_t)k0 * N + n0;
    f32x4 v[16];
#pragma unroll
    for (int j = 0; j < 16; ++j) v[j] = __builtin_nontemporal_load((const f32x4*)(src + (size_t)j * N)) * W8_SCALE;
#pragma unroll
    for (int i = 0; i < 4; ++i) { const int nr = GU ? gu_row(n0 + i) : (n0 + i);
        u32x4 a; a.x = pk4_fp8(v[0][i], v[1][i], v[2][i], v[3][i]); a.y = pk4_fp8(v[4][i], v[5][i], v[6][i], v[7][i]); a.z = pk4_fp8(v[8][i], v[9][i], v[10][i], v[11][i]); a.w = pk4_fp8(v[12][i], v[13][i], v[14][i], v[15][i]);
        __builtin_nontemporal_store(a, (u32x4*)(WT + (size_t)nr * K + k0)); }
}

__global__ void __launch_bounds__(NWAVES * 64, 2) mk_fwd(Args args) {
    extern __shared__ __attribute__((aligned(16))) unsigned char lds_raw[];
    LAS unsigned char* lds = (LAS unsigned char*)lds_raw;
    const int tid = threadIdx.x, lane = tid & 63, wave = __builtin_amdgcn_readfirstlane(tid >> 6);
    const int G = gridDim.x, bx = blockIdx.x, vcu = (G % 8 == 0) ? (bx % 8) * (G / 8) + bx / 8 : bx;
    const int gw = vcu * NWAVES + wave, NGW = G * NWAVES;
    unsigned char* ws = args.ws;
    const float* x = args.in[0]; const float* c_in = args.in[1]; const float* w_ada = args.in[2]; const float* b_ada = args.in[3];
    const float* norm_mix = args.in[4]; const float* w_in = args.in[5]; const float* b_in = args.in[6];
    const float* q_norm = args.in[7]; const float* k_norm = args.in[8]; const float* sinks = args.in[9];
    const float* lam_re = args.in[10]; const float* lam_im = args.in[11]; const float* log_dt = args.in[12];
    const float* b_re = args.in[13]; const float* b_im = args.in[14]; const float* c_re = args.in[15]; const float* c_im = args.in[16];
    const float* d_skip = args.in[17]; const float* w_glu = args.in[18]; const float* b_glu = args.in[19];
    const float* attn_out_norm = args.in[20]; const float* ssm_out_norm = args.in[21]; const float* w_out = args.in[22];
    const float* norm_ffn = args.in[23]; const float* w_router = args.in[24]; const float* b_router = args.in[25];
    const float* w_gate_up = args.in[26]; const float* b_gate_up = args.in[27]; const float* w_down = args.in[28]; const float* b_down = args.in[29];
    float* out = args.out;
    float* MOD = (float*)(ws + WS_MOD); float* SSMT = (float*)(ws + WS_SSMT);
    bf16* WTIN = (bf16*)(ws + WS_WTIN); bf16* WTGLU = (bf16*)(ws + WS_WTGLU); bf16* WTOUT = (bf16*)(ws + WS_WTOUT); bf16* WTGU = (bf16*)(ws + WS_WTGU); bf16* WTDN = (bf16*)(ws + WS_WTDN);
    bf16* H = (bf16*)(ws + WS_H); bf16* PROJ = (bf16*)(ws + WS_PROJ); bf16* ATT = (bf16*)(ws + WS_ATT); bf16* Gb = (bf16*)(ws + WS_G); bf16* SSMG = (bf16*)(ws + WS_SSMG); bf16* MIXED = (bf16*)(ws + WS_MIXED);
    int* TOPE = (int*)(ws + WS_TOPE); float* TOPW = (float*)(ws + WS_TOPW); int* HIST = (int*)(ws + WS_HIST); int* TOKROW = (int*)(ws + WS_TOKROW); int* ROWPAIR = (int*)(ws + WS_ROWPAIR);
    float* WROW = (float*)(ws + WS_WROW); int* TILEE = (int*)(ws + WS_TILEE); bf16* ACT = (bf16*)(ws + WS_ACT); bf16* YS = (bf16*)(ws + WS_YS);
    float* XST = (float*)(ws + WS_XST); float* SC = (float*)(ws + WS_SC);

    for (int u = tid; u < (LDS_BYTES - LDSCTL_OFF) / 4; u += NWAVES * 64) ((LAS unsigned*)(lds + LDSCTL_OFF))[u] = 0u;
    __syncthreads();
    volatile LAS unsigned* MISC = (volatile LAS unsigned*)(lds + MISC_OFF);
    XcdBarrier bar = xcd_barrier_post((unsigned*)(ws + WS_CTL) + CW_BAR + args.li * XCD_BAR_WORDS, MISC + 8);
    const int lo = args.ph_lo, hi = args.ph_hi;
#define IN(k) (lo <= (k) && (k) < hi)
#define SEAM(k) do { if (IN(k) && IN((k) + 1)) xcd_barrier(bar); } while (0)

    if (IN(P_PRO)) {
        if (vcu < 96) {
            LAS float* ca = (LAS float*)(lds + RING_OFF);
            LAS float* red = (LAS float*)(lds + RING_OFF + 32768);
            for (int k = tid; k < D; k += 512) { float cv8[NB];
#pragma unroll
                for (int b = 0; b < NB; ++b) { const float v = c_in[b * D + k]; cv8[b] = v * sigmoidf_(v); }
                *(LAS f32x4*)(ca + k * 8) = (f32x4){cv8[0], cv8[1], cv8[2], cv8[3]}; *(LAS f32x4*)(ca + k * 8 + 4) = (f32x4){cv8[4], cv8[5], cv8[6], cv8[7]}; }
            __syncthreads();
            float acc[NB];
#pragma unroll
            for (int b = 0; b < NB; ++b) acc[b] = 0.f;
            const float* wp = w_ada + (size_t)(128 * wave) * (6 * D) + 64 * vcu + lane;
#pragma unroll 1
            for (int k0 = 0; k0 < 128; k0 += 64) {
                float wv[64];
#pragma unroll
                for (int j = 0; j < 64; ++j) wv[j] = __builtin_nontemporal_load(wp + (size_t)(k0 + j) * (6 * D));
#pragma unroll
                for (int j = 0; j < 64; ++j) { const float w = wv[j]; const f32x4 c0 = *(const LAS f32x4*)(ca + (128 * wave + k0 + j) * 8), c1 = *(const LAS f32x4*)(ca + (128 * wave + k0 + j) * 8 + 4);
                    acc[0] = fmaf(c0.x, w, acc[0]); acc[1] = fmaf(c0.y, w, acc[1]); acc[2] = fmaf(c0.z, w, acc[2]); acc[3] = fmaf(c0.w, w, acc[3]);
                    acc[4] = fmaf(c1.x, w, acc[4]); acc[5] = fmaf(c1.y, w, acc[5]); acc[6] = fmaf(c1.z, w, acc[6]); acc[7] = fmaf(c1.w, w, acc[7]); } }
#pragma unroll
            for (int b = 0; b < NB; ++b) red[(wave * 8 + b) * 64 + lane] = acc[b];
            __syncthreads();
            { float s = b_ada[64 * vcu + lane];
#pragma unroll
              for (int w2 = 0; w2 < 8; ++w2) s += red[(w2 * 8 + wave) * 64 + lane];
              MOD[wave * 6 * D + 64 * vcu + lane] = s; }
            __syncthreads();
        } else if (vcu < 100) { const int i = (vcu - 96) * 512 + tid; ssm_table_item(i, lam_re, lam_im, log_dt, b_re, b_im, SSMT); }
        else if (FAST_ROUTER && MOE_FP8_GU && vcu < 116) router_image_item((vcu - 100) * 512 + tid, w_router, ws + WS_WRI);
        if constexpr (SSM_MFMA_CARRY && !P3_CONV) for (int i = vcu * 512 + tid; i < NG * 64 * 64; i += G * 512) ssm_apow_item(i, lam_re, lam_im, log_dt, ws + WS_APOW);
        constexpr int I_IN = (D / 64) * (DIN / 64), I_GLU = (DSSM / 64) * (DSSM / 64), I_OUT = (D / 64) * (D / 64), I_GU = MOE_FP8_GU ? (D / 128) * (2 * DFF / 32) : (D / 64) * (2 * DFF / 64), I_DN = MOE_FP8_DN ? (DFF / 128) * (D / 32) : (DFF / 64) * (D / 64);
        constexpr int NITEMS = I_IN + I_GLU + I_OUT + NE * I_GU + NE * I_DN;
        const int gu_defer = (G == 256) ? GU_DEFER : 0;
        const int nitems_p0 = (G == 256 && P3_CONV) ? (I_IN + I_GLU + I_OUT) : (NITEMS - gu_defer - (G == 256 ? DN_DEFER_P9 : 0));
        for (int it0 = gw; it0 < nitems_p0; it0 += NGW) {
            int r = (it0 < I_IN + I_GLU + I_OUT) ? it0 : it0 + gu_defer;
            if (r < I_IN) { p0_transpose_item<false>(w_in, D, DIN, WTIN, r, lane); continue; } r -= I_IN;
            if (r < I_GLU) { p0_transpose_item<false>(w_glu, DSSM, DSSM, WTGLU, r, lane); continue; } r -= I_GLU;
            if (r < I_OUT) { const int kb = r / (D / 64);
                p0_transpose_item<false>(w_out, D, D, WTOUT, r, lane, FUSE_MIXNORM ? (kb < 8 ? attn_out_norm : ssm_out_norm - DATT) : nullptr); continue; } r -= I_OUT;
            if (r < NE * I_GU) { const int e = r / I_GU;
                if constexpr (MOE_FP8_GU) p0_transpose_item_fp8<true>(w_gate_up + (size_t)e * D * 2 * DFF, D, 2 * DFF, (unsigned char*)WTGU + (size_t)e * 2 * DFF * D, r % I_GU, lane);
                else p0_transpose_item<true>(w_gate_up + (size_t)e * D * 2 * DFF, D, 2 * DFF, WTGU + (size_t)e * 2 * DFF * D, r % I_GU, lane);
                continue; } r -= NE * I_GU;
            { const int e = r / I_DN;
              if constexpr (MOE_FP8_DN) p0_transpose_item_fp8<false>(w_down + (size_t)e * DFF * D, DFF, D, (unsigned char*)WTDN + (size_t)e * D * DFF, r % I_DN, lane);
              else p0_transpose_item<false>(w_down + (size_t)e * DFF * D, DFF, D, WTDN + (size_t)e * D * DFF, r % I_DN, lane); }
        }
    }
    SEAM(P_PRO);
    if (IN(P_NORM1)) {
        for (int m0 = 8 * gw; m0 < T; m0 += 8 * NGW) { const int b = m0 / S; f32x4 gm[4], shv[4];
#pragma unroll
            for (int j = 0; j < 4; ++j) { const int c = 4 * lane + 256 * j; gm[j] = *(const f32x4*)(norm_mix + c) * (1.0f + *(const f32x4*)(MOD + b * 6 * D + D + c)); shv[j] = *(const f32x4*)(MOD + b * 6 * D + c); }
#pragma unroll 2
            for (int i = 0; i < 8; ++i) { const int m = m0 + i; const f32x4* xr = (const f32x4*)(x + (size_t)m * D) + lane; f32x4 v[4]; float ss = 0.f;
#pragma unroll
                for (int j = 0; j < 4; ++j) { v[j] = xr[64 * j]; ss += (v[j].x * v[j].x + v[j].y * v[j].y) + (v[j].z * v[j].z + v[j].w * v[j].w); }
                const float r = rsqrtf(wave_sum(ss) * (1.0f / D) + EPS); u32x2* o = (u32x2*)(H + (size_t)m * D) + lane;
#pragma unroll
                for (int j = 0; j < 4; ++j) { const f32x4 y = v[j] * r * gm[j] + shv[j]; u32x2 w; w.x = cvtpk(y.x, y.y); w.y = cvtpk(y.z, y.w); o[64 * j] = w; } } }
    }
    SEAM(P_NORM1);
    if (IN(P_INPROJ)) {
        constexpr int I_GU8 = (D / 128) * (2 * DFF / 32);
        const bool reshape = P2_RESHAPE && GU_DEFER_P2 > 0 && G == 256;
        const int Gg = reshape ? P2_GEMM_WGS : G;
        if (bx < Gg) {
            pg8::DenseOrder So{(const char*)H, (const char*)WTIN, T / 256, DIN / 256, Gg, bx, (size_t)256 * D * 2};
            pg8::EpiProj E{PROJ, DIN, b_in, (LAS float*)(lds + RSCR_OFF + 4096)};
            pg8::gemm_phase<pg8::EpiProj, pg8::DenseOrder, true, false>(lds + RING_OFF, D, So, E);
            if constexpr (GU_DEFER_P2 > 0 && !P2_RESHAPE) { if (G == 256 && bx >= 64) {
                for (int k = 0; k < DEFER_P2_PER_WAVE; ++k) { const int r = ((bx - 64) * 8 + wave) * DEFER_P2_PER_WAVE + k, e = r / I_GU8;
                    p0_transpose_item_fp8<true>(w_gate_up + (size_t)e * D * 2 * DFF, D, 2 * DFF, (unsigned char*)WTGU + (size_t)e * 2 * DFF * D, r % I_GU8, lane); } } }
        } else {
            const int nconv = (G - Gg) * 8;
            for (int r = (bx - Gg) * 8 + wave; r < GU_DEFER_P2; r += nconv) { const int e = r / I_GU8;
                p0_transpose_item_fp8<true>(w_gate_up + (size_t)e * D * 2 * DFF, D, 2 * DFF, (unsigned char*)WTGU + (size_t)e * 2 * DFF * D, r % I_GU8, lane); }
        }
    }
    SEAM(P_INPROJ);
    if (IN(P_MIX_A)) {
#if FAST_ATTN
        for (int u = vcu; u < NB * 16 * NKV; u += G) attn_unit(lds + RING_OFF, u, tid, PROJ, q_norm, k_norm, sinks, ATT, FUSE_MIXNORM ? (float*)(ws + WS_MIXED) : nullptr);
#else
        for (int idx = bx * 512 + tid; idx < T * NH; idx += G * 512) attn_scores_item(idx, PROJ, q_norm, k_norm, SC);
#endif
#if FAST_SSM
        { constexpr int IGU = (D / 128) * (2 * DFF / 32), IDN = (DFF / 128) * (D / 32);
          const ConvStream cstr{w_gate_up, w_down, (unsigned char*)WTGU, (unsigned char*)WTDN, GU_DEFER, NE * IGU - GU_DEFER, NE * IDN - DN_DEFER_P9, 2048};
          const bool use_cs = (G == 256) && P3_CONV;
          for (int u = vcu; u < NB * NG; u += G) ssm_unit(lds + RING_OFF, u, tid, PROJ, SSMT, c_re, c_im, d_skip, Gb, use_cs, cstr, ws + WS_APOW); }
#else
        if (wave == 0) for (int idx = bx * 64 + lane; idx < NB * NG * NST; idx += G * 64) ssm_scan_item(idx, PROJ, SSMT, XST);
#endif
    }
    SEAM(P_MIX_A);
    if (IN(P_MIX_B)) {
#if !FAST_ATTN
        for (int idx = bx * 512 + tid; idx < T * NH * HD; idx += G * 512) attn_out_item(idx, PROJ, SC, sinks, ATT);
#endif
#if !FAST_SSM
        for (int idx = bx * 512 + tid; idx < T * DSSM; idx += G * 512) ssm_out_item(idx, PROJ, XST, c_re, c_im, d_skip, Gb);
#endif
    }
#if !(FAST_ATTN && FAST_SSM)
    SEAM(P_MIX_B);
#endif
    if (IN(P_GLU)) {
        pg8::DenseOrder So{(const char*)Gb, (const char*)WTGLU, T / 256, DSSM / 256, G, bx, (size_t)256 * DSSM * 2};
        pg8::EpiGlu E{Gb, SSMG, b_glu, FUSE_MIXNORM ? (float*)(ws + WS_MIXED + MiB) : nullptr, (LAS float*)(lds + RSCR_OFF + 4096)};
        pg8::gemm_phase<pg8::EpiGlu, pg8::DenseOrder, true, false>(lds + RING_OFF, DSSM, So, E);
        if constexpr (GU_DEFER_P4 > 0) { if (G == 256 && bx >= 128) {
            constexpr int I_GU8 = (D / 128) * (2 * DFF / 32);
            for (int k = 0; k < DEFER_P4_PER_WAVE; ++k) { const int r = GU_DEFER_P2 + ((bx - 128) * 8 + wave) * DEFER_P4_PER_WAVE + k, e = r / I_GU8;
                p0_transpose_item_fp8<true>(w_gate_up + (size_t)e * D * 2 * DFF, D, 2 * DFF, (unsigned char*)WTGU + (size_t)e * 2 * DFF * D, r % I_GU8, lane); } } }
    }
    SEAM(P_GLU);
    if (IN(P_MIXNORM) && !FUSE_MIXNORM) {
        const f32x4 ga0 = *(const f32x4*)(attn_out_norm + 8 * lane), ga1 = *(const f32x4*)(attn_out_norm + 8 * lane + 4), gs0 = *(const f32x4*)(ssm_out_norm + 8 * lane), gs1 = *(const f32x4*)(ssm_out_norm + 8 * lane + 4);
        for (int m0 = 2 * gw; m0 < T; m0 += 2 * NGW) {
            u32x4 a[2], q[2];
#pragma unroll
            for (int r = 0; r < 2; ++r) { a[r] = *((const u32x4*)(ATT + (size_t)(m0 + r) * DATT) + lane); q[r] = *((const u32x4*)(SSMG + (size_t)(m0 + r) * DSSM) + lane); }
#pragma unroll
            for (int r = 0; r < 2; ++r) {
                const float av[8] = {bflo(a[r].x), bfhi(a[r].x), bflo(a[r].y), bfhi(a[r].y), bflo(a[r].z), bfhi(a[r].z), bflo(a[r].w), bfhi(a[r].w)};
                const float sv[8] = {bflo(q[r].x), bfhi(q[r].x), bflo(q[r].y), bfhi(q[r].y), bflo(q[r].z), bfhi(q[r].z), bflo(q[r].w), bfhi(q[r].w)};
                float qa = 0.f, qs = 0.f;
#pragma unroll
                for (int i = 0; i < 8; ++i) { qa += av[i] * av[i]; qs += sv[i] * sv[i]; }
                const float ra = rsqrtf(wave_sum(qa) * (1.0f / DATT) + EPS), rs = rsqrtf(wave_sum(qs) * (1.0f / DSSM) + EPS);
                u32x4 oa, os;
                oa.x = pk2(av[0] * ra * ga0.x, av[1] * ra * ga0.y); oa.y = pk2(av[2] * ra * ga0.z, av[3] * ra * ga0.w); oa.z = pk2(av[4] * ra * ga1.x, av[5] * ra * ga1.y); oa.w = pk2(av[6] * ra * ga1.z, av[7] * ra * ga1.w);
                os.x = pk2(sv[0] * rs * gs0.x, sv[1] * rs * gs0.y); os.y = pk2(sv[2] * rs * gs0.z, sv[3] * rs * gs0.w); os.z = pk2(sv[4] * rs * gs1.x, sv[5] * rs * gs1.y); os.w = pk2(sv[6] * rs * gs1.z, sv[7] * rs * gs1.w);
                *((u32x4*)(MIXED + (size_t)(m0 + r) * D) + lane) = oa; *((u32x4*)(MIXED + (size_t)(m0 + r) * D + DATT) + lane) = os; } }
    }
    if (!FUSE_MIXNORM) SEAM(P_MIXNORM);
    if (IN(P_OUTPROJ)) {
        if constexpr (FUSE_MIXNORM) {
            pg8::MixOrder So{(const char*)ATT, (const char*)WTOUT, T / 256, D / 256, G, bx, (size_t)(WS_SSMG - WS_ATT)};
            pg8::EpiOut E{x, MOD, X1_DELTA ? (float*)(ws + WS_DELTA) : out, (const float*)(ws + WS_MIXED), (const float*)(ws + WS_MIXED + MiB), (LAS float*)(lds + RSCR_OFF), (LAS float*)(lds + RSCR_OFF + 4096)};
            pg8::gemm_phase<pg8::EpiOut, pg8::MixOrder, false, false>(lds + RING_OFF, D, So, E);
        } else {
            pg8::DenseOrder So{(const char*)MIXED, (const char*)WTOUT, T / 256, D / 256, G, bx, (size_t)256 * D * 2};
            pg8::EpiOut E{x, MOD, X1_DELTA ? (float*)(ws + WS_DELTA) : out, nullptr, nullptr, (LAS float*)(lds + RSCR_OFF), (LAS float*)(lds + RSCR_OFF + 4096)};
            pg8::gemm_phase<pg8::EpiOut, pg8::DenseOrder, false, false>(lds + RING_OFF, D, So, E);
        }
    }
    SEAM(P_OUTPROJ);
    if (IN(P_ROUTER)) {
        LAS float* wr = (LAS float*)(lds + RING_OFF); LAS int* lh = (LAS int*)(lds + LH_OFF);
        constexpr bool FR = FAST_ROUTER && MOE_FP8_GU, FS = FR && FAST_SORT && MOE_FP8_DN && YS_FP8;
        if constexpr (!FR) for (int c = tid; c < D; c += 512) {
            f32x4 wv[8];
#pragma unroll
            for (int k = 0; k < 8; ++k) wv[k] = *(const f32x4*)(w_router + (size_t)c * NE + 4 * k);
#pragma unroll
            for (int k = 0; k < 8; ++k) { wr[(4 * k + 0) * D + c] = wv[k].x; wr[(4 * k + 1) * D + c] = wv[k].y; wr[(4 * k + 2) * D + c] = wv[k].z; wr[(4 * k + 3) * D + c] = wv[k].w; } }
        if (tid < NE) lh[tid] = 0;
        __syncthreads();
        for (int vb = vcu; vb < 256; vb += G) {
            if constexpr (FR) router_block_mfma(lds, vb, tid, wave, lane, X1_DELTA ? x : out, norm_ffn, MOD, b_router, ws + WS_WRI, lh, ws + WS_H8, TOPE, TOPW, X1_DELTA ? (const bf16*)(ws + WS_DELTA) : nullptr, FS ? (int*)(ws + WS_CNT) : nullptr, (int*)(ws + WS_TOKE), (float*)(ws + WS_WROWE), ROWPAIR, (X1_DELTA && X1_BF16) ? (bf16*)(ws + WS_X1B) : nullptr);
            else norm2_router_rows(vb, wave, lane, out, norm_ffn, MOD, b_router, wr, lh, (LAS float*)(lds + RSCR_OFF), MOE_FP8_GU ? (bf16*)nullptr : H, TOPE, TOPW, MOE_FP8_GU ? (unsigned char*)PROJ : nullptr);
            __syncthreads();
            if (!FS && tid < NE) { HIST[vb * NE + tid] = lh[tid]; lh[tid] = 0; }
            __syncthreads();
        }
    }
    SEAM(P_ROUTER);
    constexpr bool FSK = FAST_ROUTER && MOE_FP8_GU && FAST_SORT && MOE_FP8_DN && YS_FP8;
    if (IN(P_SORT) && !FSK) for (int vb = bx; vb < 256; vb += G) sort_block(vb, tid, (LAS int*)(lds + SORT_OFF), HIST, TOPE, TOPW, TOKROW, ROWPAIR, WROW, TILEE);
    if (!FSK) SEAM(P_SORT);
    LAS int* cbt = (LAS int*)(lds + TE_OFF + 2048);
    if (IN(P_GATEUP) || IN(P_DOWN) || (FSK && IN(P_COMBINE))) {
        LAS int* te = (LAS int*)(lds + TE_OFF);
        if constexpr (FSK) {
            if (wave == 0) { const int cv = (lane < NE) ? ((const int*)(ws + WS_CNT))[lane * CNT_STRIDE] : 0; int inc = ((cv + 255) >> 8) << 8;
#pragma unroll
                for (int o = 1; o < 32; o <<= 1) { const int t = __shfl_up(inc, o); if (lane >= o) inc += t; }
                if (lane < NE) { cbt[lane] = cv; cbt[33 + lane] = inc; } if (lane == 0) cbt[32] = 0; }
            __syncthreads();
            if (tid < NE) for (int ti = cbt[32 + tid] >> 8; ti < (cbt[33 + tid] >> 8); ++ti) te[ti] = tid;
        } else for (int i = tid; i < MAXTILES; i += 512) te[i] = TILEE[64 + i];
        __syncthreads();
    }
    if (IN(P_GATEUP)) {
        const LAS int* te = (const LAS int*)(lds + TE_OFF); const int ntiles = __builtin_amdgcn_readfirstlane(FSK ? (cbt[64] >> 8) : TILEE[0]);
        if constexpr (MOE_FP8_GU) {
            pg8::MoeOrder So{(const char*)(ws + WS_H8), (const char*)WTGU, FSK ? (const int*)(ws + WS_TOKE) : TOKROW, te, ntiles, 2 * DFF / 256, G, bx, (size_t)256 * D, (size_t)2 * DFF * D, FSK ? cbt : nullptr};
            pg8::EpiGateUp<MOE_FP8_DN != 0> E{(void*)ACT, b_gate_up, te, 1.0f / (W8_SCALE * H8_SCALE), (LAS float*)(lds + RSCR_OFF + 4096)};
            pg8::gemm_phase<pg8::EpiGateUp<MOE_FP8_DN != 0>, pg8::MoeOrder, true, true, true>(lds + RING_OFF, D / 2, So, E);
            if constexpr (DN_DEFER_P9 > 0) { if (G == 256) {
                constexpr int IDN8 = (DFF / 128) * (D / 32);
                const int rem = (ntiles * (2 * DFF / 256)) % G; const bool all = (rem == 0) || (G - rem < 64);
                const int n_idle = all ? G : G - rem, j = all ? bx : bx - rem;
                if (j >= 0) for (int r = NE * IDN8 - DN_DEFER_P9 + j * 8 + wave; r < NE * IDN8; r += n_idle * 8) { const int e = r / IDN8;
                    p0_transpose_item_fp8<false>(w_down + (size_t)e * DFF * D, DFF, D, (unsigned char*)WTDN + (size_t)e * D * DFF, r % IDN8, lane); } } }
        } else {
            pg8::MoeOrder So{(const char*)H, (const char*)WTGU, TOKROW, te, ntiles, 2 * DFF / 256, G, bx, (size_t)256 * D * 2, (size_t)2 * DFF * D * 2};
            pg8::EpiGateUp<MOE_FP8_DN != 0> E{(void*)ACT, b_gate_up, te, 1.0f, (LAS float*)(lds + RSCR_OFF + 4096)};
            pg8::gemm_phase<pg8::EpiGateUp<MOE_FP8_DN != 0>, pg8::MoeOrder, true, true, false>(lds + RING_OFF, D, So, E);
        }
    }
    SEAM(P_GATEUP);
    if (IN(P_DOWN)) {
        const LAS int* te = (const LAS int*)(lds + TE_OFF); const int ntiles = __builtin_amdgcn_readfirstlane(FSK ? (cbt[64] >> 8) : TILEE[0]);
        if constexpr (MOE_FP8_DN) {
            pg8::MoeOrder So{(const char*)ACT, (const char*)WTDN, TOKROW, te, ntiles, D / 256, G, bx, (size_t)256 * DFF, (size_t)D * DFF};
            pg8::EpiDown<YS_FP8 != 0> E{(void*)YS, b_down, FSK ? (const float*)(ws + WS_WROWE) : WROW, te, 1.0f / (W8_SCALE * A8_SCALE), FSK ? cbt : nullptr, (LAS float*)(lds + RSCR_OFF + 4096), (const float*)(ws + WS_CTL)};
            pg8::gemm_phase<pg8::EpiDown<YS_FP8 != 0>, pg8::MoeOrder, true, false, true>(lds + RING_OFF, DFF / 2, So, E);
        } else {
            pg8::MoeOrder So{(const char*)ACT, (const char*)WTDN, TOKROW, te, ntiles, D / 256, G, bx, (size_t)256 * DFF * 2, (size_t)D * DFF * 2};
            pg8::EpiDown<YS_FP8 != 0> E{(void*)YS, b_down, WROW, te, 1.0f, nullptr, (LAS float*)(lds + RSCR_OFF + 4096), (const float*)(ws + WS_CTL)};
            pg8::gemm_phase<pg8::EpiDown<YS_FP8 != 0>, pg8::MoeOrder, true, false, false>(lds + RING_OFF, DFF, So, E);
        }
    }
    SEAM(P_DOWN);
    if (IN(P_COMBINE)) { if constexpr (YS_FP8) { for (int m = 2 * gw; m < T; m += 2 * NGW) combine_rows8x2(m, lane, out, MOD, (const unsigned char*)YS, ROWPAIR, (X1_DELTA && !X1_BF16) ? x : nullptr, X1_DELTA ? (const bf16*)(ws + (X1_BF16 ? WS_X1B : WS_DELTA)) : nullptr, FSK ? cbt : nullptr); } else { for (int m = gw; m < T; m += NGW) combine_row(m, lane, out, MOD, YS, ROWPAIR); } }
#undef IN
#undef SEAM
}

static int g_grid = 0;
static void mk_setup() {
    if (g_grid != 0) return;
    int dev = 0, cus = 0, per_cu = 0;
    if (hipGetDevice(&dev) != hipSuccess || hipDeviceGetAttribute(&cus, hipDeviceAttributeMultiprocessorCount, dev) != hipSuccess) { fprintf(stderr, "kernel_launch: device query failed\n"); g_grid = -1; return; }
    if (hipFuncSetAttribute((const void*)mk_fwd, hipFuncAttributeMaxDynamicSharedMemorySize, LDS_BYTES) != hipSuccess) { fprintf(stderr, "kernel_launch: hipFuncSetAttribute failed\n"); g_grid = -1; return; }
    if (hipOccupancyMaxActiveBlocksPerMultiprocessor(&per_cu, (const void*)mk_fwd, NWAVES * 64, LDS_BYTES) != hipSuccess || per_cu < 1) { fprintf(stderr, "kernel_launch: occupancy query says %d workgroups per CU\n", per_cu); (void)hipGetLastError(); g_grid = -1; return; }
    g_grid = cus;
    (void)hipFuncSetAttribute((const void*)k_norm2_router, hipFuncAttributeMaxDynamicSharedMemorySize, 32 * 1024 * 4 + 256 + 4096);
}
static void mk_launch(const Args& base, int lo, int hi, int li, hipStream_t stream) {
    Args a = base; a.ph_lo = lo; a.ph_hi = hi; a.li = li; a.pad = 0;
    hipLaunchKernelGGL(mk_fwd, dim3(g_grid), dim3(NWAVES * 64), LDS_BYTES, stream, a);
}

extern "C" void kernel_launch(void* const* d_in, const int* in_sizes, int n_in, void* d_out, int out_size, void* d_ws, size_t ws_size, hipStream_t stream) {
    if (n_in != 30 || out_size != T * D || ws_size < WS_END) { fprintf(stderr, "kernel_launch: unexpected shapes (n_in %d out %d ws %zu)\n", n_in, out_size, ws_size); return; }
    mk_setup(); if (g_grid < 0) return;
    Args base{};
    for (int i = 0; i < 30; ++i) base.in[i] = (const float*)d_in[i];
    base.out = (float*)d_out; base.ws = (unsigned char*)d_ws;
    (void)hipMemsetAsync((char*)d_ws + WS_CTL, 0, CTL_ZERO_BYTES, stream);
#if MK_MODE == 1
    mk_launch(base, 0, P_COUNT, 0, stream);
#else
    const float* x = (const float*)d_in[0]; const float* c = (const float*)d_in[1]; const float* w_ada = (const float*)d_in[2]; const float* b_ada = (const float*)d_in[3];
    const float* norm_mix = (const float*)d_in[4]; const float* w_in = (const float*)d_in[5]; const float* b_in = (const float*)d_in[6];
    const float* q_norm = (const float*)d_in[7]; const float* k_norm = (const float*)d_in[8]; const float* sinks = (const float*)d_in[9];
    const float* lam_re = (const float*)d_in[10]; const float* lam_im = (const float*)d_in[11]; const float* log_dt = (const float*)d_in[12];
    const float* b_re = (const float*)d_in[13]; const float* b_im = (const float*)d_in[14]; const float* c_re = (const float*)d_in[15]; const float* c_im = (const float*)d_in[16];
    const float* d_skip = (const float*)d_in[17]; const float* w_glu = (const float*)d_in[18]; const float* b_glu = (const float*)d_in[19];
    const float* attn_out_norm = (const float*)d_in[20]; const float* ssm_out_norm = (const float*)d_in[21]; const float* w_out = (const float*)d_in[22];
    const float* norm_ffn = (const float*)d_in[23]; const float* w_router = (const float*)d_in[24]; const float* b_router = (const float*)d_in[25];
    const float* w_gate_up = (const float*)d_in[26]; const float* b_gate_up = (const float*)d_in[27]; const float* w_down = (const float*)d_in[28]; const float* b_down = (const float*)d_in[29];
    unsigned char* ws = (unsigned char*)d_ws; float* out = (float*)d_out;
    float* MOD = (float*)(ws + WS_MOD); float* SSMT = (float*)(ws + WS_SSMT);
    bf16* WTIN = (bf16*)(ws + WS_WTIN); bf16* WTGLU = (bf16*)(ws + WS_WTGLU); bf16* WTOUT = (bf16*)(ws + WS_WTOUT); bf16* WTGU = (bf16*)(ws + WS_WTGU); bf16* WTDN = (bf16*)(ws + WS_WTDN);
    bf16* H = (bf16*)(ws + WS_H); bf16* PROJ = (bf16*)(ws + WS_PROJ); bf16* ATT = (bf16*)(ws + WS_ATT); bf16* Gb = (bf16*)(ws + WS_G); bf16* SSMG = (bf16*)(ws + WS_SSMG); bf16* MIXED = (bf16*)(ws + WS_MIXED);
    int* TOPE = (int*)(ws + WS_TOPE); float* TOPW = (float*)(ws + WS_TOPW); int* HIST = (int*)(ws + WS_HIST); int* TOKROW = (int*)(ws + WS_TOKROW); int* ROWPAIR = (int*)(ws + WS_ROWPAIR);
    float* WROW = (float*)(ws + WS_WROW); int* TILEE = (int*)(ws + WS_TILEE); bf16* ACT = (bf16*)(ws + WS_ACT); bf16* YS = (bf16*)(ws + WS_YS);
    float* XST = (float*)(ws + WS_XST); float* SC = (float*)(ws + WS_SC);
#ifndef REF_PRO
#define REF_PRO 1
#endif
#ifndef REF_NORM1
#define REF_NORM1 1
#endif
#ifndef REF_INPROJ
#define REF_INPROJ 1
#endif
#ifndef REF_MIX
#define REF_MIX 1
#endif
#ifndef REF_GLU
#define REF_GLU 1
#endif
#ifndef REF_MIXNORM
#define REF_MIXNORM 1
#endif
#ifndef REF_OUTPROJ
#define REF_OUTPROJ 1
#endif
#ifndef REF_ROUTER
#define REF_ROUTER 1
#endif
#ifndef REF_SORT
#define REF_SORT 1
#endif
#ifndef REF_GATEUP
#define REF_GATEUP 1
#endif
#ifndef REF_DOWN
#define REF_DOWN 1
#endif
#ifndef REF_COMBINE
#define REF_COMBINE 1
#endif
    int li = 0;
    if (REF_PRO) {
        hipLaunchKernelGGL(k_transpose_cvt, dim3(DIN / 32, D / 32, 1), dim3(32, 8), 0, stream, w_in, WTIN, D, DIN, 0);
        hipLaunchKernelGGL(k_transpose_cvt, dim3(DSSM / 32, DSSM / 32, 1), dim3(32, 8), 0, stream, w_glu, WTGLU, DSSM, DSSM, 0);
        hipLaunchKernelGGL(k_transpose_cvt, dim3(D / 32, D / 32, 1), dim3(32, 8), 0, stream, w_out, WTOUT, D, D, 0);
        hipLaunchKernelGGL(k_transpose_cvt, dim3(2 * DFF / 32, D / 32, NE), dim3(32, 8), 0, stream, w_gate_up, WTGU, D, 2 * DFF, 1);
        hipLaunchKernelGGL(k_transpose_cvt, dim3(D / 32, DFF / 32, NE), dim3(32, 8), 0, stream, w_down, WTDN, DFF, D, 0);
        hipLaunchKernelGGL(k_mod, dim3(6 * D / 256), dim3(256), 0, stream, c, w_ada, b_ada, MOD);
        hipLaunchKernelGGL(k_ssm_tables, dim3(NG * NST / 256), dim3(256), 0, stream, lam_re, lam_im, log_dt, b_re, b_im, SSMT);
    } else mk_launch(base, P_PRO, P_PRO + 1, li++, stream);
    if (REF_NORM1) hipLaunchKernelGGL(k_norm_mod, dim3(T / 4), dim3(256), 0, stream, x, norm_mix, (const float*)MOD, 0, D, H);
    else mk_launch(base, P_NORM1, P_NORM1 + 1, li++, stream);
    if (REF_INPROJ) { NEpiProj e{}; e.A = H; e.Bt = WTIN; e.bias = b_in; e.O = PROJ; hipLaunchKernelGGL(k_gemm_naive<NEpiProj>, dim3(T, DIN / 256), dim3(256), 0, stream, e, DIN, D); }
    else mk_launch(base, P_INPROJ, P_INPROJ + 1, li++, stream);
    if (REF_MIX) {
        hipLaunchKernelGGL(k_attn_scores, dim3(T * NH / 256), dim3(256), 0, stream, (const bf16*)PROJ, q_norm, k_norm, SC);
        hipLaunchKernelGGL(k_attn_out, dim3(T * NH * HD / 256), dim3(256), 0, stream, (const bf16*)PROJ, (const float*)SC, sinks, ATT);
        hipLaunchKernelGGL(k_ssm_scan, dim3(NB * NG * NST / 64), dim3(64), 0, stream, (const bf16*)PROJ, (const float*)SSMT, XST);
        hipLaunchKernelGGL(k_ssm_out, dim3(T * DSSM / 256), dim3(256), 0, stream, (const bf16*)PROJ, (const float*)XST, c_re, c_im, d_skip, Gb);
    } else { mk_launch(base, P_MIX_A, P_MIX_A + 1, li++, stream); mk_launch(base, P_MIX_B, P_MIX_B + 1, li++, stream); }
    if (REF_GLU) { NEpiGlu e{}; e.A = Gb; e.Bt = WTGLU; e.bias = b_glu; e.O = SSMG; hipLaunchKernelGGL(k_gemm_naive<NEpiGlu>, dim3(T, DSSM / 256), dim3(256), 0, stream, e, DSSM, DSSM); }
    else mk_launch(base, P_GLU, P_GLU + 1, li++, stream);
    if (REF_MIXNORM) hipLaunchKernelGGL(k_mixnorm, dim3(T / 4), dim3(256), 0, stream, (const bf16*)ATT, (const bf16*)SSMG, attn_out_norm, ssm_out_norm, MIXED);
    else mk_launch(base, P_MIXNORM, P_MIXNORM + 1, li++, stream);
    if (REF_OUTPROJ) { NEpiOut e{}; e.A = MIXED; e.Bt = WTOUT; e.x = x; e.mod = MOD; e.O = out; hipLaunchKernelGGL(k_gemm_naive<NEpiOut>, dim3(T, D / 256), dim3(256), 0, stream, e, D, D); }
    else mk_launch(base, P_OUTPROJ, P_OUTPROJ + 1, li++, stream);
    if (REF_ROUTER) hipLaunchKernelGGL(k_norm2_router, dim3(256), dim3(512), 32 * 1024 * 4 + 256 + 4096, stream, (const float*)out, norm_ffn, (const float*)MOD, w_router, b_router, H, TOPE, TOPW, HIST);
    else mk_launch(base, P_ROUTER, P_ROUTER + 1, li++, stream);
    if (REF_SORT) hipLaunchKernelGGL(k_sort, dim3(256), dim3(512), 0, stream, (const int*)HIST, (const int*)TOPE, (const float*)TOPW, TOKROW, ROWPAIR, WROW, TILEE);
    else mk_launch(base, P_SORT, P_SORT + 1, li++, stream);
    if (REF_GATEUP) { NEpiGU e{}; e.H = H; e.Wt = WTGU; e.bias = b_gate_up; e.tokrow = TOKROW; e.tilee = TILEE; e.ACT = ACT; hipLaunchKernelGGL(k_moe_gu_naive, dim3(MPAD, DFF / 256), dim3(256), 0, stream, e); }
    else mk_launch(base, P_GATEUP, P_GATEUP + 1, li++, stream);
    if (REF_DOWN) { NEpiDown e{}; e.ACT = ACT; e.Wt = WTDN; e.bias = b_down; e.wrow = WROW; e.tilee = TILEE; e.YS = YS; hipLaunchKernelGGL(k_gemm_naive<NEpiDown>, dim3(MPAD, D / 256), dim3(256), 0, stream, e, D, DFF); }
    else mk_launch(base, P_DOWN, P_DOWN + 1, li++, stream);
    if (REF_COMBINE) hipLaunchKernelGGL(k_combine, dim3(T / 4), dim3(256), 0, stream, out, (const float*)MOD, (const bf16*)YS, (const int*)ROWPAIR);
    else mk_launch(base, P_COMBINE, P_COMBINE + 1, li++, stream);
#endif
}
```

```cpp
#include <hip/hip_runtime.h>
#include <stdint.h>
#include <stdio.h>

#ifndef FAST_ATTN
#define FAST_ATTN 1
#endif
#ifndef FAST_SSM
#define FAST_SSM 1
#endif
#ifndef MOE_FP8_GU
#define MOE_FP8_GU 1
#endif
#ifndef MOE_FP8_DN
#define MOE_FP8_DN 1
#endif
#ifndef YS_FP8
#define YS_FP8 1
#endif
#ifndef P3_CONV
#define P3_CONV 0
#endif
#ifndef FUSE_MIXNORM
#define FUSE_MIXNORM 1
#endif
#ifndef X1_DELTA
#define X1_DELTA 1
#endif
#ifndef SSM_MFMA_CARRY
#define SSM_MFMA_CARRY 1
#endif
#ifndef X1_BF16
#define X1_BF16 1
#endif
#ifndef FAST_SORT
#define FAST_SORT 1
#endif
#ifndef FAST_ROUTER
#define FAST_ROUTER 1
#endif
#ifndef MK_MODE
#define MK_MODE 1
#endif

typedef unsigned short bf16;
typedef float f32x4 __attribute__((ext_vector_type(4)));
typedef float f32x2 __attribute__((ext_vector_type(2)));
typedef unsigned u32x4 __attribute__((ext_vector_type(4)));
typedef unsigned u32x2 __attribute__((ext_vector_type(2)));
typedef short bf16x8 __attribute__((ext_vector_type(8)));
typedef int i32x4 __attribute__((ext_vector_type(4)));
typedef int i32x8 __attribute__((ext_vector_type(8)));
constexpr float W8_SCALE = 32.0f, H8_SCALE = 4.0f, A8_SCALE = 4.0f, Y8_SCALE = 16.0f;
#define GAS __attribute__((address_space(1)))
#define LAS __attribute__((address_space(3)))

constexpr int D = 1024, NB = 8, S = 2048, T = NB * S;
constexpr int DATT = 512, HD = 64, NH = 8, NKV = 2, DKV = 128;
constexpr int DSSM = 512, SG = 16, NG = 32, NST = 64;
constexpr int DIN = 1280, NE = 32, TOPK = 4, DFF = 1024;
constexpr int QOFF = 0, KOFF = 512, VOFF = 640, UOFF = 768;
constexpr float EPS = 1e-6f;
constexpr int MAXTILES = 288, MPAD = MAXTILES * 256;

constexpr size_t MiB = 1u << 20;
constexpr size_t WS_CTL = 0, CTL_ZERO_BYTES = 256 * 1024;
constexpr size_t WS_MOD = 1 * MiB;
constexpr size_t WS_SSMT = 2 * MiB;
constexpr size_t WS_WTIN = 4 * MiB;
constexpr size_t WS_WTGLU = 7 * MiB;
constexpr size_t WS_WTOUT = 8 * MiB;
constexpr size_t WS_WTGU = 16 * MiB;
constexpr size_t WS_WTDN = 144 * MiB;
constexpr size_t WS_H = 208 * MiB;
constexpr size_t WS_PROJ = 240 * MiB;
constexpr size_t WS_ATT = 280 * MiB;
constexpr size_t WS_G = 296 * MiB;
constexpr size_t WS_SSMG = 312 * MiB;
constexpr size_t WS_MIXED = 328 * MiB;
constexpr size_t WS_TOPE = 360 * MiB;
constexpr size_t WS_TOPW = 361 * MiB;
constexpr size_t WS_HIST = 362 * MiB;
constexpr size_t WS_TOKROW = 363 * MiB;
constexpr size_t WS_ROWPAIR = 364 * MiB;
constexpr size_t WS_WROW = 365 * MiB;
constexpr size_t WS_TILEE = 366 * MiB;
constexpr size_t WS_CNT = 1024;
constexpr int CNT_STRIDE = 64;
constexpr size_t WS_TOKE = 332 * MiB;
constexpr size_t WS_WROWE = 336 * MiB;
constexpr size_t WS_APOW = 340 * MiB;
constexpr size_t WS_DELTA = 624 * MiB;
constexpr size_t WS_H8 = 660 * MiB;
constexpr size_t WS_WRI = 367 * MiB;
constexpr size_t WS_ACT = 368 * MiB;
constexpr size_t WS_YS = 512 * MiB;
constexpr size_t WS_XST = 368 * MiB;
constexpr size_t WS_SC = 624 * MiB;
constexpr size_t WS_X1B = 700 * MiB;
constexpr size_t WS_END = 740 * MiB;
constexpr int CW_BAR = 4096;

constexpr int ST_AR = 0, ST_AI = 64, ST_BR = 128, ST_BI = 128 + 1024, SSMT_STRIDE = 128 + 2048;

__host__ __device__ __forceinline__ int gu_row(int n) { const int j = n >> 1, half = n & 1; return (j >> 7) * 256 + half * 128 + (j & 127); }

__device__ __forceinline__ unsigned f2bf(float f) { unsigned u = __builtin_bit_cast(unsigned, f); return (u + 0x7fffu + ((u >> 16) & 1u)) >> 16; }
__device__ __forceinline__ float bf2f(unsigned b) { return __builtin_bit_cast(float, (b & 0xffffu) << 16); }
__device__ __forceinline__ unsigned pk2(float lo, float hi) { return f2bf(lo) | (f2bf(hi) << 16); }
__device__ __forceinline__ unsigned pk4_fp8(float a, float b, float c, float d) { unsigned w = 0u; w = __builtin_amdgcn_cvt_pk_fp8_f32(a, b, w, false); w = __builtin_amdgcn_cvt_pk_fp8_f32(c, d, w, true); return w; }
__device__ __forceinline__ float bflo(unsigned w) { return __builtin_bit_cast(float, w << 16); }
__device__ __forceinline__ float bfhi(unsigned w) { return __builtin_bit_cast(float, w & 0xffff0000u); }
__device__ __forceinline__ float wave_sum(float v) {
#pragma unroll
    for (int o = 1; o < 64; o <<= 1) v += __shfl_xor(v, o);
    return v;
}
__device__ __forceinline__ float sigmoidf_(float x) { return __builtin_amdgcn_rcpf(1.0f + __expf(-x)); }
__device__ __forceinline__ float gelu_tanh(float x) { const float u2 = 1.5957691216057308f * (x + 0.044715f * x * x * x); return x * sigmoidf_(u2); }
__device__ __forceinline__ float dot8(u32x4 a, u32x4 b, float acc) {
    acc = fmaf(bflo(a.x), bflo(b.x), acc); acc = fmaf(bfhi(a.x), bfhi(b.x), acc);
    acc = fmaf(bflo(a.y), bflo(b.y), acc); acc = fmaf(bfhi(a.y), bfhi(b.y), acc);
    acc = fmaf(bflo(a.z), bflo(b.z), acc); acc = fmaf(bfhi(a.z), bfhi(b.z), acc);
    acc = fmaf(bflo(a.w), bflo(b.w), acc); acc = fmaf(bfhi(a.w), bfhi(b.w), acc);
    return acc;
}

__device__ __forceinline__ void ssm_table_item(int i, const float* lam_re, const float* lam_im, const float* log_dt, const float* b_re, const float* b_im, float* tab) {
    const int g = i / NST, p = i % NST;
    const float lr = lam_re[i], li = lam_im[i], dt = expf(log_dt[g]);
    const float mag = expf(lr * dt), ang = li * dt;
    const float lbr = mag * cosf(ang), lbi = mag * sinf(ang);
    const float den = lr * lr + li * li;
    const float cr = ((lbr - 1.0f) * lr + lbi * li) / den, ci = (lbi * lr - (lbr - 1.0f) * li) / den;
    float* t = tab + (size_t)g * SSMT_STRIDE;
    t[ST_AR + p] = lbr; t[ST_AI + p] = lbi;
    for (int h = 0; h < SG; ++h) { const float br = b_re[(size_t)i * SG + h], bi = b_im[(size_t)i * SG + h];
        t[ST_BR + p * SG + h] = cr * br - ci * bi; t[ST_BI + p * SG + h] = cr * bi + ci * br; }
}
__device__ __forceinline__ void norm_mod_row(int row, int lane, const float* x, const float* gain, const float* mod, int sh_off, int sc_off, bf16* H) {
    const int b = row / S;
    const f32x4* xr = (const f32x4*)(x + (size_t)row * D) + lane;
    f32x4 v[4]; float s = 0.f;
#pragma unroll
    for (int j = 0; j < 4; ++j) { v[j] = xr[64 * j]; s += (v[j].x * v[j].x + v[j].y * v[j].y) + (v[j].z * v[j].z + v[j].w * v[j].w); }
    const float r = rsqrtf(wave_sum(s) * (1.0f / D) + EPS);
    u32x2* o = (u32x2*)(H + (size_t)row * D) + lane;
#pragma unroll
    for (int j = 0; j < 4; ++j) { const int c = 4 * lane + 256 * j;
        const f32x4 g = *(const f32x4*)(gain + c), sc = *(const f32x4*)(mod + b * 6 * D + sc_off + c), sh = *(const f32x4*)(mod + b * 6 * D + sh_off + c);
        f32x4 y; y.x = v[j].x * r * g.x * (1.f + sc.x) + sh.x; y.y = v[j].y * r * g.y * (1.f + sc.y) + sh.y; y.z = v[j].z * r * g.z * (1.f + sc.z) + sh.z; y.w = v[j].w * r * g.w * (1.f + sc.w) + sh.w;
        u32x2 w; w.x = pk2(y.x, y.y); w.y = pk2(y.z, y.w); o[64 * j] = w; }
}
__device__ __forceinline__ void mixnorm_row(int row, int lane, const bf16* ATT, const bf16* SSMG, const float* ga, const float* gs, bf16* MIXED) {
    const u32x4 a = *((const u32x4*)(ATT + (size_t)row * DATT) + lane), s = *((const u32x4*)(SSMG + (size_t)row * DSSM) + lane);
    const float av[8] = {bflo(a.x), bfhi(a.x), bflo(a.y), bfhi(a.y), bflo(a.z), bfhi(a.z), bflo(a.w), bfhi(a.w)};
    const float sv[8] = {bflo(s.x), bfhi(s.x), bflo(s.y), bfhi(s.y), bflo(s.z), bfhi(s.z), bflo(s.w), bfhi(s.w)};
    float qa = 0.f, qs = 0.f;
#pragma unroll
    for (int i = 0; i < 8; ++i) { qa += av[i] * av[i]; qs += sv[i] * sv[i]; }
    const float ra = rsqrtf(wave_sum(qa) * (1.0f / DATT) + EPS), rs = rsqrtf(wave_sum(qs) * (1.0f / DSSM) + EPS);
    const f32x4 ga0 = *(const f32x4*)(ga + 8 * lane), ga1 = *(const f32x4*)(ga + 8 * lane + 4), gs0 = *(const f32x4*)(gs + 8 * lane), gs1 = *(const f32x4*)(gs + 8 * lane + 4);
    u32x4 oa, os;
    oa.x = pk2(av[0] * ra * ga0.x, av[1] * ra * ga0.y); oa.y = pk2(av[2] * ra * ga0.z, av[3] * ra * ga0.w); oa.z = pk2(av[4] * ra * ga1.x, av[5] * ra * ga1.y); oa.w = pk2(av[6] * ra * ga1.z, av[7] * ra * ga1.w);
    os.x = pk2(sv[0] * rs * gs0.x, sv[1] * rs * gs0.y); os.y = pk2(sv[2] * rs * gs0.z, sv[3] * rs * gs0.w); os.z = pk2(sv[4] * rs * gs1.x, sv[5] * rs * gs1.y); os.w = pk2(sv[6] * rs * gs1.z, sv[7] * rs * gs1.w);
    *((u32x4*)(MIXED + (size_t)row * D) + lane) = oa; *((u32x4*)(MIXED + (size_t)row * D + DATT) + lane) = os;
}
__device__ __forceinline__ void combine_row(int row, int lane, float* out, const float* mod, const bf16* YS, const int* rowpair) {
    const int b = row / S; const int* rp = rowpair + (size_t)row * 4;
    const int r0 = rp[0], r1 = rp[1], r2 = rp[2], r3 = rp[3];
#pragma unroll
    for (int j = 0; j < 2; ++j) { const int c = 8 * lane + 512 * j;
        const u32x4 a = *(const u32x4*)(YS + (size_t)r0 * D + c), b2 = *(const u32x4*)(YS + (size_t)r1 * D + c), c2 = *(const u32x4*)(YS + (size_t)r2 * D + c), d2 = *(const u32x4*)(YS + (size_t)r3 * D + c);
        float y[8];
        y[0] = bflo(a.x) + bflo(b2.x) + bflo(c2.x) + bflo(d2.x); y[1] = bfhi(a.x) + bfhi(b2.x) + bfhi(c2.x) + bfhi(d2.x);
        y[2] = bflo(a.y) + bflo(b2.y) + bflo(c2.y) + bflo(d2.y); y[3] = bfhi(a.y) + bfhi(b2.y) + bfhi(c2.y) + bfhi(d2.y);
        y[4] = bflo(a.z) + bflo(b2.z) + bflo(c2.z) + bflo(d2.z); y[5] = bfhi(a.z) + bfhi(b2.z) + bfhi(c2.z) + bfhi(d2.z);
        y[6] = bflo(a.w) + bflo(b2.w) + bflo(c2.w) + bflo(d2.w); y[7] = bfhi(a.w) + bfhi(b2.w) + bfhi(c2.w) + bfhi(d2.w);
        float* op = out + (size_t)row * D + c; const float* g2 = mod + b * 6 * D + 5 * D + c;
        f32x4 o0 = *(f32x4*)op, o1 = *(f32x4*)(op + 4); const f32x4 g0 = *(const f32x4*)g2, g1 = *(const f32x4*)(g2 + 4);
        o0.x += g0.x * y[0]; o0.y += g0.y * y[1]; o0.z += g0.z * y[2]; o0.w += g0.w * y[3]; o1.x += g1.x * y[4]; o1.y += g1.y * y[5]; o1.z += g1.z * y[6]; o1.w += g1.w * y[7];
        *(f32x4*)op = o0; *(f32x4*)(op + 4) = o1; }
}
__device__ __forceinline__ void combine_row8(int row, int lane, float* out, const float* mod, const unsigned char* YS8, const int* rowpair) {
    const int b = row / S; const i32x4 rp = *(const i32x4*)(rowpair + (size_t)row * 4); const int c = 16 * lane;
    const u32x4 q0 = *(const u32x4*)(YS8 + (size_t)rp.x * D + c), q1 = *(const u32x4*)(YS8 + (size_t)rp.y * D + c), q2 = *(const u32x4*)(YS8 + (size_t)rp.z * D + c), q3 = *(const u32x4*)(YS8 + (size_t)rp.w * D + c);
    float* op = out + (size_t)row * D + c; const float* g2 = mod + b * 6 * D + 5 * D + c;
#pragma unroll
    for (int j = 0; j < 4; ++j) { const unsigned w0 = q0[j], w1 = q1[j], w2 = q2[j], w3 = q3[j];
        const f32x2 lo = __builtin_amdgcn_cvt_pk_f32_fp8(w0, false) + __builtin_amdgcn_cvt_pk_f32_fp8(w1, false) + __builtin_amdgcn_cvt_pk_f32_fp8(w2, false) + __builtin_amdgcn_cvt_pk_f32_fp8(w3, false);
        const f32x2 hi = __builtin_amdgcn_cvt_pk_f32_fp8(w0, true) + __builtin_amdgcn_cvt_pk_f32_fp8(w1, true) + __builtin_amdgcn_cvt_pk_f32_fp8(w2, true) + __builtin_amdgcn_cvt_pk_f32_fp8(w3, true);
        f32x4 o = *(f32x4*)(op + 4 * j); const f32x4 g = *(const f32x4*)(g2 + 4 * j);
        o.x += g.x * lo.x * (1.0f / Y8_SCALE); o.y += g.y * lo.y * (1.0f / Y8_SCALE); o.z += g.z * hi.x * (1.0f / Y8_SCALE); o.w += g.w * hi.y * (1.0f / Y8_SCALE);
        *(f32x4*)(op + 4 * j) = o; }
}
__device__ __forceinline__ void combine_rows8x2(int row, int lane, float* out, const float* mod, const unsigned char* YS8, const int* rowpair, const float* xin = nullptr, const bf16* delta = nullptr, const LAS int* cb = nullptr) {
    const int b = row / S, c = 16 * lane; i32x4 rp0 = *(const i32x4*)(rowpair + (size_t)row * 4), rp1 = *(const i32x4*)(rowpair + (size_t)row * 4 + 4);
    if (FAST_SORT && cb) {
#pragma unroll
        for (int k = 0; k < 4; ++k) { rp0[k] = (rp0[k] & 0xFFFFF) + cb[32 + (rp0[k] >> 20)]; rp1[k] = (rp1[k] & 0xFFFFF) + cb[32 + (rp1[k] >> 20)]; } }
    u32x4 q[2][4];
    q[0][0] = *(const u32x4*)(YS8 + (size_t)rp0.x * D + c); q[0][1] = *(const u32x4*)(YS8 + (size_t)rp0.y * D + c); q[0][2] = *(const u32x4*)(YS8 + (size_t)rp0.z * D + c); q[0][3] = *(const u32x4*)(YS8 + (size_t)rp0.w * D + c);
    q[1][0] = *(const u32x4*)(YS8 + (size_t)rp1.x * D + c); q[1][1] = *(const u32x4*)(YS8 + (size_t)rp1.y * D + c); q[1][2] = *(const u32x4*)(YS8 + (size_t)rp1.z * D + c); q[1][3] = *(const u32x4*)(YS8 + (size_t)rp1.w * D + c);
    const float* g2 = mod + b * 6 * D + 5 * D + c;
    f32x4 g[4], o[2][4];
#pragma unroll
    for (int j = 0; j < 4; ++j) { g[j] = *(const f32x4*)(g2 + 4 * j) * (1.0f / Y8_SCALE); const float* src = delta ? xin : out;
        if (src) { o[0][j] = *(const f32x4*)(src + (size_t)row * D + c + 4 * j); o[1][j] = *(const f32x4*)(src + (size_t)(row + 1) * D + c + 4 * j); } else { o[0][j] = (f32x4){0.f, 0.f, 0.f, 0.f}; o[1][j] = o[0][j]; } }
    if (delta) {
#pragma unroll
        for (int r = 0; r < 2; ++r) { const u32x4 d0 = *(const u32x4*)(delta + (size_t)(row + r) * D + c), d1 = *(const u32x4*)(delta + (size_t)(row + r) * D + c + 8);
            o[r][0] += (f32x4){bflo(d0.x), bfhi(d0.x), bflo(d0.y), bfhi(d0.y)}; o[r][1] += (f32x4){bflo(d0.z), bfhi(d0.z), bflo(d0.w), bfhi(d0.w)};
            o[r][2] += (f32x4){bflo(d1.x), bfhi(d1.x), bflo(d1.y), bfhi(d1.y)}; o[r][3] += (f32x4){bflo(d1.z), bfhi(d1.z), bflo(d1.w), bfhi(d1.w)}; } }
#pragma unroll
    for (int r = 0; r < 2; ++r)
#pragma unroll
        for (int j = 0; j < 4; ++j) { const unsigned w0 = q[r][0][j], w1 = q[r][1][j], w2 = q[r][2][j], w3 = q[r][3][j];
            const f32x2 lo = __builtin_amdgcn_cvt_pk_f32_fp8(w0, false) + __builtin_amdgcn_cvt_pk_f32_fp8(w1, false) + __builtin_amdgcn_cvt_pk_f32_fp8(w2, false) + __builtin_amdgcn_cvt_pk_f32_fp8(w3, false);
            const f32x2 hi = __builtin_amdgcn_cvt_pk_f32_fp8(w0, true) + __builtin_amdgcn_cvt_pk_f32_fp8(w1, true) + __builtin_amdgcn_cvt_pk_f32_fp8(w2, true) + __builtin_amdgcn_cvt_pk_f32_fp8(w3, true);
            f32x4 t = o[r][j]; t.x += g[j].x * lo.x; t.y += g[j].y * lo.y; t.z += g[j].z * hi.x; t.w += g[j].w * hi.y;
            *(f32x4*)(out + (size_t)(row + r) * D + c + 4 * j) = t; }
}
__device__ __forceinline__ void attn_scores_item(int idx, const bf16* PROJ, const float* qg, const float* kg, float* SC) {
    const int t = idx / NH, h = idx % NH, kvh = h / 4, b = t / S, tl = t % S;
    const bf16* q = PROJ + (size_t)t * DIN + QOFF + h * HD;
    float sq = 0.f;
    for (int d = 0; d < HD; ++d) { const float v = bf2f(q[d]); sq += v * v; }
    const float rq = rsqrtf(sq * (1.0f / HD) + EPS);
    for (int i = 0; i < 128; ++i) {
        const int sl = tl - 127 + i; float sc = -1e30f;
        if (sl >= 0) { const bf16* k = PROJ + (size_t)(b * S + sl) * DIN + KOFF + kvh * HD;
            float sk = 0.f, dt = 0.f;
            for (int d = 0; d < HD; ++d) { const float kv = bf2f(k[d]); sk += kv * kv; dt += bf2f(q[d]) * qg[d] * kv * kg[d]; }
            sc = dt * rq * rsqrtf(sk * (1.0f / HD) + EPS) * 0.125f; }
        SC[(size_t)idx * 128 + i] = sc; }
}
__device__ __forceinline__ void attn_out_item(int idx, const bf16* PROJ, const float* SC, const float* sinks, bf16* ATT) {
    const int d = idx % HD, th = idx / HD, h = th % NH, t = th / NH, kvh = h / 4, b = t / S, tl = t % S;
    const float* sc = SC + (size_t)th * 128; const float sink = sinks[h];
    float m = sink;
    for (int i = 0; i < 128; ++i) m = fmaxf(m, sc[i]);
    float den = __expf(sink - m), o = 0.f;
    for (int i = 0; i < 128; ++i) { const int sl = tl - 127 + i; if (sl < 0) continue;
        const float p = __expf(sc[i] - m); den += p; o += p * bf2f(PROJ[(size_t)(b * S + sl) * DIN + VOFF + kvh * HD + d]); }
    ATT[(size_t)t * DATT + h * HD + d] = (bf16)f2bf(o / den);
}
__device__ __forceinline__ void ssm_scan_item(int idx, const bf16* PROJ, const float* tab, float* XST) {
    const int p = idx % NST, g = (idx / NST) % NG, b = idx / (NST * NG);
    const float* tg = tab + (size_t)g * SSMT_STRIDE;
    const float ar = tg[ST_AR + p], ai = tg[ST_AI + p];
    float br[SG], bi[SG];
#pragma unroll
    for (int h = 0; h < SG; ++h) { br[h] = tg[ST_BR + p * SG + h]; bi[h] = tg[ST_BI + p * SG + h]; }
    float xr = 0.f, xi = 0.f;
    for (int t = 0; t < S; ++t) {
        const u32x4* up = (const u32x4*)(PROJ + (size_t)(b * S + t) * DIN + UOFF + g * SG);
        const u32x4 u0 = up[0], u1 = up[1];
        const float u[SG] = {bflo(u0.x), bfhi(u0.x), bflo(u0.y), bfhi(u0.y), bflo(u0.z), bfhi(u0.z), bflo(u0.w), bfhi(u0.w),
                             bflo(u1.x), bfhi(u1.x), bflo(u1.y), bfhi(u1.y), bflo(u1.z), bfhi(u1.z), bflo(u1.w), bfhi(u1.w)};
        float bur = 0.f, bui = 0.f;
#pragma unroll
        for (int h = 0; h < SG; ++h) { bur = fmaf(br[h], u[h], bur); bui = fmaf(bi[h], u[h], bui); }
        const float nr = ar * xr - ai * xi + bur, ni = ar * xi + ai * xr + bui; xr = nr; xi = ni;
        float* o = XST + (((size_t)(b * S + t) * NG + g) * NST + p) * 2; o[0] = xr; o[1] = xi;
    }
}
__device__ __forceinline__ void ssm_out_item(int idx, const bf16* PROJ, const float* XST, const float* c_re, const float* c_im, const float* d_skip, bf16* G) {
    const int ch = idx % DSSM, t = idx / DSSM, g = ch / SG, h = ch % SG;
    const float* x = XST + ((size_t)t * NG + g) * NST * 2; const float* cr = c_re + ((size_t)g * SG + h) * NST; const float* ci = c_im + ((size_t)g * SG + h) * NST;
    float y = 0.f;
    for (int p = 0; p < NST; ++p) y += cr[p] * x[2 * p] - ci[p] * x[2 * p + 1];
    y += d_skip[ch] * bf2f(PROJ[(size_t)t * DIN + UOFF + ch]);
    G[(size_t)t * DSSM + ch] = (bf16)f2bf(gelu_tanh(y));
}
__device__ __forceinline__ void norm2_router_rows(int blk, int wave, int lane, const float* x1, const float* gain, const float* mod, const float* b_router,
                                                  const LAS float* wr, LAS int* lh, LAS float* xs, bf16* H, int* tope, float* topw, unsigned char* H8 = nullptr) {
    const int b = (blk * 64) / S;
    f32x4 gm[4], sh[4];
#pragma unroll
    for (int j = 0; j < 4; ++j) { const int c = 4 * lane + 256 * j; const f32x4 g = *(const f32x4*)(gain + c), sc = *(const f32x4*)(mod + b * 6 * D + 4 * D + c);
        gm[j] = g * (1.0f + sc); sh[j] = *(const f32x4*)(mod + b * 6 * D + 3 * D + c); }
    const int my_e = lane >> 1; const float my_b = b_router[my_e];
    LAS float* lg = xs + wave * 128;
    LAS int* sel_e = (LAS int*)(xs + wave * 128 + 64);
    LAS float* sel_v = xs + wave * 128 + 72;
#pragma unroll 1
    for (int i = 0; i < 8; i += 2) {
        const int row0 = blk * 64 + wave * 8 + i;
        f32x4 v[2][4]; float ssq[2];
#pragma unroll
        for (int r = 0; r < 2; ++r) { const f32x4* xr = (const f32x4*)(x1 + (size_t)(row0 + r) * D) + lane; float s = 0.f;
#pragma unroll
            for (int j = 0; j < 4; ++j) { v[r][j] = xr[64 * j]; s += (v[r][j].x * v[r][j].x + v[r][j].y * v[r][j].y) + (v[r][j].z * v[r][j].z + v[r][j].w * v[r][j].w); }
            ssq[r] = s; }
#pragma unroll
        for (int o2 = 1; o2 < 64; o2 <<= 1) { ssq[0] += __shfl_xor(ssq[0], o2); asm volatile("" : "+v"(ssq[0])); ssq[1] += __shfl_xor(ssq[1], o2); asm volatile("" : "+v"(ssq[1])); }
#pragma unroll
        for (int r = 0; r < 2; ++r) { const float rs = rsqrtf(ssq[r] * (1.0f / D) + EPS); u32x2* o = (u32x2*)(H + (size_t)(row0 + r) * D) + lane;
#pragma unroll
            for (int j = 0; j < 4; ++j) { v[r][j] = v[r][j] * rs * gm[j] + sh[j]; if (H) { u32x2 w; w.x = pk2(v[r][j].x, v[r][j].y); w.y = pk2(v[r][j].z, v[r][j].w); o[64 * j] = w; }
                if (H8) *(unsigned*)(H8 + (size_t)(row0 + r) * D + 4 * lane + 256 * j) = pk4_fp8(v[r][j].x * H8_SCALE, v[r][j].y * H8_SCALE, v[r][j].z * H8_SCALE, v[r][j].w * H8_SCALE); } }
        float pe0[NE], pe1[NE];
#pragma unroll
        for (int e = 0; e < NE; ++e) { float a0 = 0.f, a1 = 0.f;
#pragma unroll
            for (int j = 0; j < 4; ++j) { const f32x4 w = *(const LAS f32x4*)(wr + e * D + 4 * lane + 256 * j);
                a0 += (v[0][j].x * w.x + v[0][j].y * w.y) + (v[0][j].z * w.z + v[0][j].w * w.w); asm volatile("" : "+v"(a0)); a1 += (v[1][j].x * w.x + v[1][j].y * w.y) + (v[1][j].z * w.z + v[1][j].w * w.w); asm volatile("" : "+v"(a1)); }
            pe0[e] = a0; pe1[e] = a1; }
#define BFLY(half, bit) { const bool up = (lane & (bit)) != 0; _Pragma("unroll") for (int k = 0; k < (half); ++k) { \
            const float k0 = up ? pe0[(half) + k] : pe0[k], s0 = up ? pe0[k] : pe0[(half) + k], k1 = up ? pe1[(half) + k] : pe1[k], s1 = up ? pe1[k] : pe1[(half) + k]; \
            pe0[k] = k0 + __shfl_xor(s0, (bit)); asm volatile("" : "+v"(pe0[k])); pe1[k] = k1 + __shfl_xor(s1, (bit)); asm volatile("" : "+v"(pe1[k])); } }
        BFLY(16, 32) BFLY(8, 16) BFLY(4, 8) BFLY(2, 4) BFLY(1, 2)
#undef BFLY
        const float l0 = pe0[0] + __shfl_xor(pe0[0], 1) + my_b, l1 = pe1[0] + __shfl_xor(pe1[0], 1) + my_b;
        if ((lane & 1) == 0) { lg[my_e] = l0; lg[32 + my_e] = l1; }
        asm volatile("s_waitcnt lgkmcnt(0)" ::: "memory");
        int rk0 = 0, rk1 = 0;
#pragma unroll
        for (int q = 0; q < 8; ++q) { const f32x4 a = *(const LAS f32x4*)(lg + 4 * q), c = *(const LAS f32x4*)(lg + 32 + 4 * q);
#pragma unroll
            for (int t = 0; t < 4; ++t) { const int e2 = 4 * q + t; rk0 += (a[t] > l0 || (a[t] == l0 && e2 < my_e)) ? 1 : 0; rk1 += (c[t] > l1 || (c[t] == l1 && e2 < my_e)) ? 1 : 0; } }
        if ((lane & 1) == 0) { if (rk0 < 4) { sel_e[rk0] = my_e; sel_v[rk0] = l0; } if (rk1 < 4) { sel_e[4 + rk1] = my_e; sel_v[4 + rk1] = l1; } }
        asm volatile("s_waitcnt lgkmcnt(0)" ::: "memory");
        if (lane < 2) { const i32x4 ee = *(const LAS i32x4*)(sel_e + 4 * lane); const f32x4 vv = *(const LAS f32x4*)(sel_v + 4 * lane);
            const int e0 = ee.x, e1 = ee.y, e2 = ee.z, e3 = ee.w;
            const float x1v = __expf(vv.y - vv.x), x2v = __expf(vv.z - vv.x), x3v = __expf(vv.w - vv.x), inv = 1.0f / (1.0f + x1v + x2v + x3v);
            int* te = tope + (size_t)(row0 + lane) * 4; float* tw = topw + (size_t)(row0 + lane) * 4;
            *(i32x4*)te = (i32x4){e0, e1, e2, e3}; *(f32x4*)tw = (f32x4){inv, x1v * inv, x2v * inv, x3v * inv};
            (void)__hip_atomic_fetch_add(&lh[e0], 1, __ATOMIC_RELAXED, __HIP_MEMORY_SCOPE_WORKGROUP); (void)__hip_atomic_fetch_add(&lh[e1], 1, __ATOMIC_RELAXED, __HIP_MEMORY_SCOPE_WORKGROUP);
            (void)__hip_atomic_fetch_add(&lh[e2], 1, __ATOMIC_RELAXED, __HIP_MEMORY_SCOPE_WORKGROUP); (void)__hip_atomic_fetch_add(&lh[e3], 1, __ATOMIC_RELAXED, __HIP_MEMORY_SCOPE_WORKGROUP); }
        asm volatile("s_waitcnt lgkmcnt(0)" ::: "memory");
    }
}
__device__ __forceinline__ void sort_block(int blk, int tid, LAS int* sm, const int* hist, const int* tope, const float* topw, int* tokrow, int* rowpair, float* wrow, int* tilee) {
    LAS int* tot = sm; LAS int* mine = sm + 32; LAS int* base = sm + 64; LAS int* es = sm + 128;
    { const int e = tid & 31, part = tid >> 5; int hv[16]; int a = 0, m = 0;
#pragma unroll
      for (int k = 0; k < 16; ++k) hv[k] = hist[(16 * part + k) * NE + e];
#pragma unroll
      for (int k = 0; k < 16; ++k) { a += hv[k]; if (16 * part + k < blk) m += hv[k]; }
      LAS int* pa = sm + 384; pa[part * 32 + e] = a; pa[512 + part * 32 + e] = m; }
    __syncthreads();
    if (tid < NE) { const LAS int* pa = sm + 384; int a = 0, m = 0;
#pragma unroll
        for (int p = 0; p < 16; ++p) { a += pa[p * 32 + tid]; m += pa[512 + p * 32 + tid]; } tot[tid] = a; mine[tid] = m; }
    __syncthreads();
    if (tid == 0) { int o = 0; for (int e = 0; e < NE; ++e) { base[e] = o; o += ((tot[e] + 255) >> 8) << 8; } base[NE] = o; }
    int my_e = 0, rank = 0;
    if (tid < 256) { my_e = tope[(size_t)(blk * 64) * 4 + tid]; const int lane = tid & 63, w = tid >> 6;
        const unsigned long long lt = (lane == 0) ? 0ull : (~0ull >> (64 - lane));
#pragma unroll 4
        for (int e = 0; e < NE; ++e) { const unsigned long long m = __ballot(my_e == e); if (my_e == e) rank = __popcll(m & lt); if (lane == 0) es[w * 32 + e] = __popcll(m); } }
    __syncthreads();
    if (tid < 256) { const int e = my_e, w = tid >> 6; for (int w2 = 0; w2 < w; ++w2) rank += es[w2 * 32 + e];
        const int pos = base[e] + mine[e] + rank, tok = blk * 64 + (tid >> 2);
        tokrow[pos] = tok; rowpair[(size_t)blk * 256 + tid] = pos; wrow[pos] = topw[(size_t)blk * 256 + tid]; }
    if (blk < NE) { const int e = blk; for (int r = base[e] + tot[e] + tid; r < base[e + 1]; r += 512) { tokrow[r] = 0; wrow[r] = 0.f; }
        for (int ti = (base[e] >> 8) + tid; ti < (base[e + 1] >> 8); ti += 512) tilee[64 + ti] = e; }
    if (blk == 0 && tid == 0) tilee[0] = base[NE] >> 8;
    __syncthreads();
}

__global__ void k_transpose_cvt(const float* __restrict__ W, bf16* __restrict__ WT, int K, int N, int perm_gu) {
    __shared__ float tile[32][33];
    const float* Wb = W + (size_t)blockIdx.z * K * N; bf16* WTb = WT + (size_t)blockIdx.z * K * N;
    const int n0 = blockIdx.x * 32, k0 = blockIdx.y * 32;
    for (int i = threadIdx.y; i < 32; i += 8) tile[i][threadIdx.x] = Wb[(size_t)(k0 + i) * N + n0 + threadIdx.x];
    __syncthreads();
    for (int i = threadIdx.y; i < 32; i += 8) { const int n = n0 + i, nr = perm_gu ? gu_row(n) : n; WTb[(size_t)nr * K + k0 + threadIdx.x] = (bf16)f2bf(tile[threadIdx.x][i]); }
}
__global__ void k_mod(const float* __restrict__ c, const float* __restrict__ w_ada, const float* __restrict__ b_ada, float* __restrict__ mod) {
    __shared__ float ca[NB][D];
    for (int i = threadIdx.x; i < NB * D; i += blockDim.x) { const float v = c[i]; ca[i / D][i % D] = v * sigmoidf_(v); }
    __syncthreads();
    const int j = blockIdx.x * blockDim.x + threadIdx.x;
    float acc[NB];
#pragma unroll
    for (int b = 0; b < NB; ++b) acc[b] = 0.f;
    for (int k = 0; k < D; ++k) { const float w = w_ada[(size_t)k * (6 * D) + j];
#pragma unroll
        for (int b = 0; b < NB; ++b) acc[b] = fmaf(ca[b][k], w, acc[b]); }
#pragma unroll
    for (int b = 0; b < NB; ++b) mod[b * 6 * D + j] = acc[b] + b_ada[j];
}
__global__ void k_ssm_tables(const float* lam_re, const float* lam_im, const float* log_dt, const float* b_re, const float* b_im, float* tab) {
    const int i = blockIdx.x * blockDim.x + threadIdx.x; if (i >= NG * NST) return;
    ssm_table_item(i, lam_re, lam_im, log_dt, b_re, b_im, tab);
}
__global__ void k_norm_mod(const float* x, const float* gain, const float* mod, int sh_off, int sc_off, bf16* H) {
    const int row = blockIdx.x * (blockDim.x / 64) + (threadIdx.x >> 6), lane = threadIdx.x & 63; if (row >= T) return;
    norm_mod_row(row, lane, x, gain, mod, sh_off, sc_off, H);
}
template <class Epi> __global__ void k_gemm_naive(Epi e, int N, int K) {
    const int n = blockIdx.y * blockDim.x + threadIdx.x, m = blockIdx.x; if (n >= N) return;
    if (!e.active(m)) return;
    const bf16* a = e.arow(m); const bf16* b = e.brow(m, n);
    float acc = 0.f;
    for (int k = 0; k < K; k += 8) acc = dot8(*(const u32x4*)(a + k), *(const u32x4*)(b + k), acc);
    e.store(m, n, acc);
}
struct NEpiProj { const bf16* A; const bf16* Bt; const float* bias; bf16* O;
    __device__ bool active(int) const { return true; }
    __device__ const bf16* arow(int m) const { return A + (size_t)m * D; }
    __device__ const bf16* brow(int, int n) const { return Bt + (size_t)n * D; }
    __device__ void store(int m, int n, float acc) const { O[(size_t)m * DIN + n] = (bf16)f2bf(acc + bias[n]); } };
struct NEpiGlu { const bf16* A; const bf16* Bt; const float* bias; bf16* O;
    __device__ bool active(int) const { return true; }
    __device__ const bf16* arow(int m) const { return A + (size_t)m * DSSM; }
    __device__ const bf16* brow(int, int n) const { return Bt + (size_t)n * DSSM; }
    __device__ void store(int m, int n, float acc) const { const float g = bf2f(A[(size_t)m * DSSM + n]); O[(size_t)m * DSSM + n] = (bf16)f2bf(g * sigmoidf_(acc + bias[n])); } };
struct NEpiOut { const bf16* A; const bf16* Bt; const float* x; const float* mod; float* O;
    __device__ bool active(int) const { return true; }
    __device__ const bf16* arow(int m) const { return A + (size_t)m * D; }
    __device__ const bf16* brow(int, int n) const { return Bt + (size_t)n * D; }
    __device__ void store(int m, int n, float acc) const { const int b = m / S; O[(size_t)m * D + n] = x[(size_t)m * D + n] + mod[b * 6 * D + 2 * D + n] * acc; } };
struct NEpiGU { const bf16* H; const bf16* Wt; const float* bias; const int* tokrow; const int* tilee; bf16* ACT; };
struct NEpiDown { const bf16* ACT; const bf16* Wt; const float* bias; const float* wrow; const int* tilee; bf16* YS;
    __device__ bool active(int m) const { return (m >> 8) < tilee[0]; }
    __device__ const bf16* arow(int m) const { return ACT + (size_t)m * DFF; }
    __device__ const bf16* brow(int m, int n) const { const int e = tilee[64 + (m >> 8)]; return Wt + ((size_t)e * D + n) * DFF; }
    __device__ void store(int m, int n, float acc) const { const int e = tilee[64 + (m >> 8)]; YS[(size_t)m * D + n] = (bf16)f2bf((acc + bias[e * D + n]) * wrow[m]); } };
__global__ void k_moe_gu_naive(NEpiGU e) {
    const int j = blockIdx.y * blockDim.x + threadIdx.x, m = blockIdx.x;
    if ((m >> 8) >= e.tilee[0]) return;
    const int ex = e.tilee[64 + (m >> 8)], t = e.tokrow[m];
    const bf16* a = e.H + (size_t)t * D; const bf16* b0 = e.Wt + ((size_t)ex * 2 * DFF + gu_row(2 * j)) * D; const bf16* b1 = e.Wt + ((size_t)ex * 2 * DFF + gu_row(2 * j + 1)) * D;
    float g = 0.f, u = 0.f;
    for (int k = 0; k < D; k += 8) { const u32x4 av = *(const u32x4*)(a + k); g = dot8(av, *(const u32x4*)(b0 + k), g); u = dot8(av, *(const u32x4*)(b1 + k), u); }
    g += e.bias[ex * 2 * DFF + 2 * j]; u += e.bias[ex * 2 * DFF + 2 * j + 1];
    g = fminf(g, 7.0f); u = fminf(fmaxf(u, -7.0f), 7.0f);
    e.ACT[(size_t)m * DFF + j] = (bf16)f2bf((u + 1.0f) * (g * sigmoidf_(1.702f * g)));
}
__global__ void k_attn_scores(const bf16* PROJ, const float* qg, const float* kg, float* SC) { const int idx = blockIdx.x * blockDim.x + threadIdx.x; if (idx < T * NH) attn_scores_item(idx, PROJ, qg, kg, SC); }
__global__ void k_attn_out(const bf16* PROJ, const float* SC, const float* sinks, bf16* ATT) { const int idx = blockIdx.x * blockDim.x + threadIdx.x; if (idx < T * NH * HD) attn_out_item(idx, PROJ, SC, sinks, ATT); }
__global__ void k_ssm_scan(const bf16* PROJ, const float* tab, float* XST) { const int idx = blockIdx.x * blockDim.x + threadIdx.x; if (idx < NB * NG * NST) ssm_scan_item(idx, PROJ, tab, XST); }
__global__ void k_ssm_out(const bf16* PROJ, const float* XST, const float* c_re, const float* c_im, const float* d_skip, bf16* G) { const int idx = blockIdx.x * blockDim.x + threadIdx.x; if (idx < T * DSSM) ssm_out_item(idx, PROJ, XST, c_re, c_im, d_skip, G); }
__global__ void k_mixnorm(const bf16* ATT, const bf16* SSMG, const float* ga, const float* gs, bf16* MIXED) {
    const int row = blockIdx.x * (blockDim.x / 64) + (threadIdx.x >> 6), lane = threadIdx.x & 63; if (row >= T) return;
    mixnorm_row(row, lane, ATT, SSMG, ga, gs, MIXED);
}
__global__ void __launch_bounds__(512) k_norm2_router(const float* x1, const float* gain, const float* mod, const float* w_router, const float* b_router, bf16* H, int* tope, float* topw, int* hist) {
    extern __shared__ __attribute__((aligned(16))) unsigned char smem[];
    LAS float* wr = (LAS float*)smem; LAS int* lh = (LAS int*)((LAS unsigned char*)smem + 32 * 1024 * 4);
    const int tid = threadIdx.x;
    for (int i = tid; i < D * NE; i += 512) { const int c = i / NE, e = i % NE; wr[e * D + c] = w_router[i]; }
    if (tid < NE) lh[tid] = 0;
    __syncthreads();
    norm2_router_rows(blockIdx.x, tid >> 6, tid & 63, x1, gain, mod, b_router, wr, lh, (LAS float*)((LAS unsigned char*)smem + 32 * 1024 * 4 + 256), H, tope, topw);
    __syncthreads();
    if (tid < NE) hist[blockIdx.x * NE + tid] = lh[tid];
}
__global__ void __launch_bounds__(512) k_sort(const int* hist, const int* tope, const float* topw, int* tokrow, int* rowpair, float* wrow, int* tilee) {
    __shared__ int sm[1408];
    sort_block(blockIdx.x, threadIdx.x, (LAS int*)sm, hist, tope, topw, tokrow, rowpair, wrow, tilee);
}
__global__ void k_combine(float* out, const float* mod, const bf16* YS, const int* rowpair) {
    const int row = blockIdx.x * (blockDim.x / 64) + (threadIdx.x >> 6), lane = threadIdx.x & 63; if (row >= T) return;
    combine_row(row, lane, out, mod, YS, rowpair);
}

namespace pg8 {
constexpr int BM = 256, BK = 64, HALF = 128, HTB = HALF * BK * 2  , STAGE_BYTES = 8 * HTB, NXCD = 8, WGM = 4;
__host__ __device__ __forceinline__ int lds_byte(int r, int c) { const int st = (r >> 4) * 2 + (c >> 5), rr = r & 15, cc = c & 31, ob = rr * 64 + cc * 2; return st * 1024 + (ob ^ (((ob >> 9) & 1) << 5)); }
__host__ __device__ __forceinline__ void stage_rc(int b, int& R, int& C) { const int st = b / 1024, sb = b % 1024, swz = sb ^ (((sb >> 9) & 1) << 5); R = (st >> 1) * 16 + swz / 64; C = (st & 1) * 32 + (swz % 64) / 2; }
__host__ __device__ __forceinline__ int perm32(int rho) { const int n = rho >> 4, i = rho & 15; return 8 * (i >> 2) + 4 * n + (i & 3); }
struct Unit { int pm, pn; };
__device__ __forceinline__ bool order_next(int nM, int nN, int G, int c, int i, Unit& u, bool rev = false) {
    const int nwg = nM * nN; const long L = (long)i * G + c; if (L >= nwg) return false;
    int wgid = (int)L; { const int q = nwg / NXCD, r = nwg % NXCD, xcd = wgid % NXCD, len = xcd < r ? q + 1 : q; int off = wgid / NXCD; if (rev) off = len - 1 - off; wgid = (xcd < r ? xcd * (q + 1) : r * (q + 1) + (xcd - r) * q) + off; }
    const int nig = WGM * nN, gid = wgid / nig, fm = gid * WGM, gsz = (nM - fm) < WGM ? (nM - fm) : WGM;
    u.pm = fm + ((wgid % nig) % gsz); u.pn = (wgid % nig) / gsz; return true;
}
struct DenseOrder {
    const char* A; const char* Bt; int nM, nN, G, c; size_t tstep;
    __device__ __forceinline__ bool next(int i, Unit& u) const { return order_next(nM, nN, G, c, i, u); }
    __device__ __forceinline__ const char* a_base(const Unit& u) const { return A + (size_t)u.pm * tstep; }
    __device__ __forceinline__ const char* b_base(const Unit& u) const { return Bt + (size_t)u.pn * tstep; }
    __device__ __forceinline__ int a_row(int) const { return 0; }
    __device__ __forceinline__ int ka(int K) const { return K; }
    __device__ __forceinline__ size_t a_koff(int t) const { return (size_t)t * (BK * 2); }
};
struct MixOrder {
    const char* A; const char* Bt; int nM, nN, G, c; size_t delta;
    __device__ __forceinline__ bool next(int i, Unit& u) const { return order_next(nM, nN, G, c, i, u); }
    __device__ __forceinline__ const char* a_base(const Unit& u) const { return A + (size_t)u.pm * (256 * 512 * 2); }
    __device__ __forceinline__ const char* b_base(const Unit& u) const { return Bt + (size_t)u.pn * (256 * 1024 * 2); }
    __device__ __forceinline__ int a_row(int) const { return 0; }
    __device__ __forceinline__ int ka(int) const { return 512; }
    __device__ __forceinline__ size_t a_koff(int t) const { return (size_t)(t & 7) * (BK * 2) + (size_t)(t >> 3) * delta; }
};
struct MoeOrder {
    const char* A; const char* Bt; const int* tokrow; const LAS int* te; int nM, nN, G, c; size_t tstep, estride; const LAS int* cb = nullptr; bool rev = false;
    __device__ __forceinline__ bool next(int i, Unit& u) const { return order_next(nM, nN, G, c, i, u, rev); }
    __device__ __forceinline__ const char* a_base(const Unit& u) const { return A + (size_t)u.pm * tstep; }
    __device__ __forceinline__ const char* b_base(const Unit& u) const { return Bt + (size_t)__builtin_amdgcn_readfirstlane(te[u.pm]) * estride + (size_t)u.pn * tstep; }
    __device__ __forceinline__ int a_row(int r) const { if (FAST_SORT && cb) { const int e = te[r >> 8], rin = r - cb[32 + e], last = cb[e] - 1; return tokrow[(size_t)e * T + (rin < last ? rin : last)]; } return tokrow[r]; }
    __device__ __forceinline__ int ka(int K) const { return K; }
    __device__ __forceinline__ size_t a_koff(int t) const { return (size_t)t * (BK * 2); }
};
__device__ __forceinline__ unsigned cvt_pk_bf16(float lo, float hi) { unsigned r; asm volatile("v_cvt_pk_bf16_f32 %0, %1, %2" : "=v"(r) : "v"(lo), "v"(hi)); return r; }

__device__ __forceinline__ void dma_row256(const float* src, LAS float* dst) { if (threadIdx.x < 64) __builtin_amdgcn_global_load_lds((const unsigned*)(src + 4 * threadIdx.x), (LAS unsigned*)dst, 16, 0, 0); }
struct EpiProj {
    static constexpr bool PERM = true, MIDK = false, BEGIN = true;
    bf16* O; int ldc; const float* bias; LAS float* tb;
    __device__ __forceinline__ void begin(const Unit& u, int ui) const { dma_row256(bias + u.pn * BM, tb + (ui & 1) * 512); }
    __device__ __forceinline__ void operator()(const f32x4 (&acc)[2][2][4][2], const Unit& u, int wr, int wc, int fr, int fq, int ui) const {
        const int row0 = u.pm * BM + wr * 64 + fr, col0 = u.pn * BM + wc * 32 + 8 * fq;
        f32x4 bv[2][2];
#pragma unroll
        for (int bj = 0; bj < 2; ++bj)
#pragma unroll
            for (int n = 0; n < 2; ++n) bv[bj][n] = *(const LAS f32x4*)(tb + (ui & 1) * 512 + wc * 32 + 8 * fq + bj * HALF + 4 * n);
#pragma unroll
        for (int ai = 0; ai < 2; ++ai)
#pragma unroll
            for (int m = 0; m < 4; ++m) { bf16* rowp = O + (size_t)(row0 + ai * HALF + m * 16) * ldc + col0;
#pragma unroll
                for (int bj = 0; bj < 2; ++bj) { const f32x4 v0 = acc[ai][bj][m][0] + bv[bj][0], v1 = acc[ai][bj][m][1] + bv[bj][1];
                    u32x4 w; w.x = cvt_pk_bf16(v0[0], v0[1]); w.y = cvt_pk_bf16(v0[2], v0[3]); w.z = cvt_pk_bf16(v1[0], v1[1]); w.w = cvt_pk_bf16(v1[2], v1[3]);
                    *(u32x4*)(rowp + bj * HALF) = w; } }
    }
};
struct EpiGlu {
    static constexpr bool PERM = true, MIDK = false, BEGIN = true;
    const bf16* Gin; bf16* O; const float* bias; float* SQ; LAS float* tb;
    __device__ __forceinline__ void begin(const Unit& u, int ui) const { dma_row256(bias + u.pn * BM, tb + (ui & 1) * 512); }
    __device__ __forceinline__ void operator()(const f32x4 (&acc)[2][2][4][2], const Unit& u, int wr, int wc, int fr, int fq, int ui) const {
        const int row0 = u.pm * BM + wr * 64 + fr, col0 = u.pn * BM + wc * 32 + 8 * fq;
        f32x4 bv[2][2];
#pragma unroll
        for (int bj = 0; bj < 2; ++bj)
#pragma unroll
            for (int n = 0; n < 2; ++n) bv[bj][n] = *(const LAS f32x4*)(tb + (ui & 1) * 512 + wc * 32 + 8 * fq + bj * HALF + 4 * n);
#pragma unroll
        for (int ai = 0; ai < 2; ++ai) {
            u32x4 gin[4][2];
#pragma unroll
            for (int m = 0; m < 4; ++m)
#pragma unroll
                for (int bj = 0; bj < 2; ++bj) gin[m][bj] = *(const u32x4*)(Gin + (size_t)(row0 + ai * HALF + m * 16) * DSSM + col0 + bj * HALF);
#pragma unroll
            for (int m = 0; m < 4; ++m) { const int row = row0 + ai * HALF + m * 16; const size_t off = (size_t)row * DSSM + col0; float sq = 0.f;
#pragma unroll
                for (int bj = 0; bj < 2; ++bj) { const f32x4 z0 = acc[ai][bj][m][0] + bv[bj][0], z1 = acc[ai][bj][m][1] + bv[bj][1];
                    const u32x4 g = gin[m][bj];
                    const float p0 = bflo(g.x) * sigmoidf_(z0[0]), p1 = bfhi(g.x) * sigmoidf_(z0[1]), p2 = bflo(g.y) * sigmoidf_(z0[2]), p3 = bfhi(g.y) * sigmoidf_(z0[3]);
                    const float p4 = bflo(g.z) * sigmoidf_(z1[0]), p5 = bfhi(g.z) * sigmoidf_(z1[1]), p6 = bflo(g.w) * sigmoidf_(z1[2]), p7 = bfhi(g.w) * sigmoidf_(z1[3]);
                    sq += ((p0 * p0 + p1 * p1) + (p2 * p2 + p3 * p3)) + ((p4 * p4 + p5 * p5) + (p6 * p6 + p7 * p7));
                    u32x4 w; w.x = cvt_pk_bf16(p0, p1); w.y = cvt_pk_bf16(p2, p3); w.z = cvt_pk_bf16(p4, p5); w.w = cvt_pk_bf16(p6, p7);
                    *(u32x4*)(O + off + bj * HALF) = w; }
                if (SQ) { sq += __shfl_xor(sq, 16); sq += __shfl_xor(sq, 32); if (fq == 0) SQ[(size_t)row * 8 + u.pn * 4 + wc] = sq; } } }
    }
};
struct EpiOut {
    static constexpr bool PERM = X1_DELTA != 0, MIDK = FUSE_MIXNORM != 0, BEGIN = true;
    const float* x; const float* mod; float* O; const float* ASQ; const float* SSQ; LAS float* tbl; LAS float* tb;
    __device__ __forceinline__ float row_sum8(const float* p, int row) const { const f32x4 a = *(const f32x4*)(p + (size_t)row * 8), b = *(const f32x4*)(p + (size_t)row * 8 + 4); return ((a.x + a.y) + (a.z + a.w)) + ((b.x + b.y) + (b.z + b.w)); }
    __device__ __forceinline__ void begin(const Unit& u, int ui) const {
        if (X1_DELTA) { const int b = (u.pm * BM) / S; dma_row256(mod + b * 6 * D + 2 * D + u.pn * BM, tb + (ui & 1) * 512); }
        if constexpr (!MIDK) return;
        const int r = threadIdx.x; if (r < BM) { const int row = u.pm * BM + r;
            const float ra = rsqrtf(row_sum8(ASQ, row) * (1.0f / DATT) + EPS), rs = rsqrtf(row_sum8(SSQ, row) * (1.0f / DSSM) + EPS);
            *(LAS f32x2*)(tbl + (ui & 1) * 512 + 2 * r) = (f32x2){ra / rs, rs}; }
    }
    __device__ __forceinline__ void mid(f32x4 (&acc)[2][2][4][2], int ui, int wr, int fr) const {
#pragma unroll
        for (int ai = 0; ai < 2; ++ai)
#pragma unroll
            for (int m = 0; m < 4; ++m) { const float rho = tbl[(ui & 1) * 512 + 2 * (wr * 64 + fr + ai * HALF + m * 16)];
#pragma unroll
                for (int bj = 0; bj < 2; ++bj)
#pragma unroll
                    for (int n = 0; n < 2; ++n) acc[ai][bj][m][n] = acc[ai][bj][m][n] * rho; }
    }
    __device__ __forceinline__ void operator()(const f32x4 (&acc)[2][2][4][2], const Unit& u, int wr, int wc, int fr, int fq, int ui = 0) const {
        const int b = (u.pm * BM) / S;
        if constexpr (X1_DELTA) {
            const int col0 = u.pn * BM + wc * 32 + 8 * fq;
            f32x4 gv[2][2];
#pragma unroll
            for (int bj = 0; bj < 2; ++bj)
#pragma unroll
                for (int n = 0; n < 2; ++n) gv[bj][n] = *(const LAS f32x4*)(tb + (ui & 1) * 512 + wc * 32 + 8 * fq + bj * HALF + 4 * n);
#pragma unroll
            for (int ai = 0; ai < 2; ++ai)
#pragma unroll
                for (int m = 0; m < 4; ++m) { const int lr = wr * 64 + fr + ai * HALF + m * 16; bf16* rowp = (bf16*)O + (size_t)(u.pm * BM + lr) * D + col0;
                    const float rs = MIDK ? tbl[(ui & 1) * 512 + 2 * lr + 1] : 1.0f;
#pragma unroll
                    for (int bj = 0; bj < 2; ++bj) { const f32x4 v0 = gv[bj][0] * (acc[ai][bj][m][0] * rs), v1 = gv[bj][1] * (acc[ai][bj][m][1] * rs);
                        u32x4 w; w.x = cvt_pk_bf16(v0[0], v0[1]); w.y = cvt_pk_bf16(v0[2], v0[3]); w.z = cvt_pk_bf16(v1[0], v1[1]); w.w = cvt_pk_bf16(v1[2], v1[3]);
                        *(u32x4*)(rowp + bj * HALF) = w; } }
        } else {
        const int row0 = u.pm * BM + wr * 64 + fr, col0 = u.pn * BM + wc * 32 + 4 * fq;
        f32x4 gv[2][2];
#pragma unroll
        for (int bj = 0; bj < 2; ++bj)
#pragma unroll
            for (int n = 0; n < 2; ++n) gv[bj][n] = *(const f32x4*)(mod + b * 6 * D + 2 * D + col0 + bj * HALF + n * 16);
#pragma unroll
        for (int ai = 0; ai < 2; ++ai)
#pragma unroll
            for (int m = 0; m < 4; ++m) { const int lr = wr * 64 + fr + ai * HALF + m * 16; const size_t off = (size_t)(u.pm * BM + lr) * D + col0;
                const float rs = MIDK ? tbl[(ui & 1) * 512 + 2 * lr + 1] : 1.0f;
#pragma unroll
                for (int bj = 0; bj < 2; ++bj)
#pragma unroll
                    for (int n = 0; n < 2; ++n) { const f32x4 xv = __builtin_nontemporal_load((const f32x4*)(x + off + bj * HALF + n * 16)); *(f32x4*)(O + off + bj * HALF + n * 16) = xv + gv[bj][n] * (acc[ai][bj][m][n] * rs); } }
        }
    }
};
template <bool OUT8> struct EpiGateUp {
    static constexpr bool PERM = true, MIDK = false, BEGIN = true;
    void* ACTp; const float* bias; const LAS int* te; float ascale; LAS float* tb;
    __device__ __forceinline__ void begin(const Unit& u, int ui) const { const int e = __builtin_amdgcn_readfirstlane(te[u.pm]); dma_row256(bias + (size_t)e * 2 * DFF + 2 * (u.pn * HALF), tb + (ui & 1) * 512); }
    __device__ __forceinline__ void operator()(const f32x4 (&acc)[2][2][4][2], const Unit& u, int wr, int wc, int fr, int fq, int ui) const {
        const int row0 = u.pm * BM + wr * 64 + fr, ac0 = u.pn * HALF + wc * 32 + 8 * fq;
        const LAS float* bp = tb + (ui & 1) * 512 + 2 * (wc * 32 + 8 * fq);
        const f32x4 b0 = *(const LAS f32x4*)bp, b1 = *(const LAS f32x4*)(bp + 4), b2 = *(const LAS f32x4*)(bp + 8), b3 = *(const LAS f32x4*)(bp + 12);
        const float bg[8] = {b0[0], b0[2], b1[0], b1[2], b2[0], b2[2], b3[0], b3[2]}, bu[8] = {b0[1], b0[3], b1[1], b1[3], b2[1], b2[3], b3[1], b3[3]};
        const f32x2 asc2 = {ascale, ascale}, zc2 = {-1.702f * 1.4426950408889634f, -1.702f * 1.4426950408889634f}, one2 = {1.0f, 1.0f}, os2 = {OUT8 ? A8_SCALE : 1.0f, OUT8 ? A8_SCALE : 1.0f};
#pragma unroll
        for (int ai = 0; ai < 2; ++ai)
#pragma unroll
            for (int m = 0; m < 4; ++m) { float a[8];
#pragma unroll
                for (int k = 0; k < 8; k += 2) {
                    f32x2 g = (f32x2){acc[ai][0][m][k >> 2][k & 3], acc[ai][0][m][k >> 2][(k & 3) + 1]} * asc2 + (f32x2){bg[k], bg[k + 1]};
                    f32x2 up = (f32x2){acc[ai][1][m][k >> 2][k & 3], acc[ai][1][m][k >> 2][(k & 3) + 1]} * asc2 + (f32x2){bu[k], bu[k + 1]};
                    g.x = fminf(g.x, 7.0f); g.y = fminf(g.y, 7.0f); up.x = __builtin_amdgcn_fmed3f(up.x, -7.0f, 7.0f); up.y = __builtin_amdgcn_fmed3f(up.y, -7.0f, 7.0f);
                    const f32x2 z = g * zc2; f32x2 ex; ex.x = __builtin_amdgcn_exp2f(z.x); ex.y = __builtin_amdgcn_exp2f(z.y);
                    const f32x2 dn = ex + one2; f32x2 sg; sg.x = __builtin_amdgcn_rcpf(dn.x); sg.y = __builtin_amdgcn_rcpf(dn.y);
                    const f32x2 r2 = (up * os2 + os2) * (g * sg); a[k] = r2.x; a[k + 1] = r2.y; }
                const size_t off = (size_t)(row0 + ai * HALF + m * 16) * DFF + ac0;
                if constexpr (OUT8) { u32x2 w; w.x = pk4_fp8(a[0], a[1], a[2], a[3]); w.y = pk4_fp8(a[4], a[5], a[6], a[7]); *(u32x2*)((unsigned char*)ACTp + off) = w; }
                else { u32x4 w; w.x = cvt_pk_bf16(a[0], a[1]); w.y = cvt_pk_bf16(a[2], a[3]); w.z = cvt_pk_bf16(a[4], a[5]); w.w = cvt_pk_bf16(a[6], a[7]); *(u32x4*)((bf16*)ACTp + off) = w; } }
    }
};
template <bool OUT8> struct EpiDown {
    static constexpr bool PERM = true, MIDK = false, BEGIN = true;
    void* YSp; const float* bias; const float* wrow; const LAS int* te; float ascale; const LAS int* cb; LAS float* tb;
    const float* zero;
    __device__ __forceinline__ void begin(const Unit& u, int ui) const { const int t = threadIdx.x, e = __builtin_amdgcn_readfirstlane(te[u.pm]);
        dma_row256(bias + (size_t)e * D + u.pn * BM, tb + (ui & 1) * 512);
        if (t >= 64 && t < 320) { const int w4 = __builtin_amdgcn_readfirstlane((t >> 6) - 1), r = t - 64, row = u.pm * BM + r; const float* src;
            if (FAST_SORT && cb) { const int rin = row - cb[32 + e]; src = rin < cb[e] ? wrow + (size_t)e * T + rin : zero; } else src = wrow + row;
            __builtin_amdgcn_global_load_lds((const unsigned*)src, (LAS unsigned*)(tb + (ui & 1) * 512 + 256 + 64 * w4), 4, 0, 0); } }
    __device__ __forceinline__ void operator()(const f32x4 (&acc)[2][2][4][2], const Unit& u, int wr, int wc, int fr, int fq, int ui) const {
        const int row0 = u.pm * BM + wr * 64 + fr, col0 = u.pn * BM + wc * 32 + 8 * fq;
        f32x4 bv[2][2];
#pragma unroll
        for (int bj = 0; bj < 2; ++bj)
#pragma unroll
            for (int n = 0; n < 2; ++n) bv[bj][n] = *(const LAS f32x4*)(tb + (ui & 1) * 512 + wc * 32 + 8 * fq + bj * HALF + 4 * n);
        float wts[2][4];
#pragma unroll
        for (int ai = 0; ai < 2; ++ai)
#pragma unroll
            for (int m = 0; m < 4; ++m) wts[ai][m] = tb[(ui & 1) * 512 + 256 + wr * 64 + fr + ai * HALF + m * 16];
#pragma unroll
        for (int ai = 0; ai < 2; ++ai)
#pragma unroll
            for (int m = 0; m < 4; ++m) { const int row = row0 + ai * HALF + m * 16; const float wt = wts[ai][m] * (OUT8 ? Y8_SCALE : 1.0f); const size_t off = (size_t)row * D + col0;
#pragma unroll
                for (int bj = 0; bj < 2; ++bj) { const f32x4 v0 = (acc[ai][bj][m][0] * ascale + bv[bj][0]) * wt, v1 = (acc[ai][bj][m][1] * ascale + bv[bj][1]) * wt;
                    if constexpr (OUT8) { u32x2 w; w.x = pk4_fp8(v0[0], v0[1], v0[2], v0[3]); w.y = pk4_fp8(v1[0], v1[1], v1[2], v1[3]); *(u32x2*)((unsigned char*)YSp + off + bj * HALF) = w; }
                    else { u32x4 w; w.x = cvt_pk_bf16(v0[0], v0[1]); w.y = cvt_pk_bf16(v0[2], v0[3]); w.z = cvt_pk_bf16(v1[0], v1[1]); w.w = cvt_pk_bf16(v1[2], v1[3]); *(u32x4*)((bf16*)YSp + off + bj * HALF) = w; } } }
    }
};

template <class Epi, class Sched, bool ALIGN_EPI, bool GATHER, bool FP8 = false>
__device__ __forceinline__ void gemm_phase(LAS unsigned char* lds, const int K, const Sched& S, const Epi& E) {
    const int tid = threadIdx.x, wid = __builtin_amdgcn_readfirstlane(tid >> 6), lane = tid & 63, wr = wid >> 2, wc = wid & 3, fr = lane & 15, fq = lane >> 4;
    const int nt = K / BK;
    int Rr[2], Cc[2]; unsigned voffA[2], voffB[2];
#pragma unroll
    for (int i = 0; i < 2; ++i) { int R, C; stage_rc(tid * 16 + i * 8192, R, C); const int Rb = Epi::PERM ? ((R & ~31) + perm32(R & 31)) : R;
        Rr[i] = R; Cc[i] = C; voffA[i] = (unsigned)(R * S.ka(K) + C) * 2u; voffB[i] = (unsigned)(Rb * K + C) * 2u; }
    const size_t kstep = (size_t)(BK * 2);
    const size_t hstep = (size_t)HALF * K * 2;
    const size_t hstepA = (size_t)HALF * S.ka(K) * 2;
    const unsigned ldsw = (unsigned)wid * 1024u;
    const int aoff = lds_byte(wr * 64 + fr, fq * 8), boff = lds_byte(wc * 32 + fr, fq * 8);
#define PG8_SA(b, h) (((b) * 2 + (h)) * HTB)
#define PG8_SB(b, h) ((4 + (b) * 2 + (h)) * HTB)
#define PG8_STAGE(bufoff, gbase, voff) do { _Pragma("unroll") for (int _i = 0; _i < 2; ++_i) \
        __builtin_amdgcn_global_load_lds((const unsigned*)((const char*)(gbase) + (voff)[_i]), (LAS unsigned*)(lds + (bufoff) + ldsw + _i * 8192), 16, 0, 0); } while (0)
#define PG8_STAGE_A(bufoff, ab, koff, h, g0, g1) do { if constexpr (GATHER) { if ((h) == 0) PG8_STAGE(bufoff, (ab) + (koff), g0); else PG8_STAGE(bufoff, (ab) + (koff), g1); } \
        else { PG8_STAGE(bufoff, (ab) + (koff) + (h) * hstepA, voffA); } } while (0)
#define PG8_LDA(dst, b, h) do { if constexpr (FP8) { _Pragma("unroll") for (int m = 0; m < 4; ++m) dst##8[m] = __builtin_shufflevector(*(const LAS i32x4*)(lds + PG8_SA(b, h) + aoff + m * 2048), *(const LAS i32x4*)(lds + PG8_SA(b, h) + aoff + m * 2048 + 1024), 0, 1, 2, 3, 4, 5, 6, 7); } \
        else { _Pragma("unroll") for (int m = 0; m < 4; ++m) _Pragma("unroll") for (int k = 0; k < 2; ++k) dst[m][k] = *(const LAS bf16x8*)(lds + PG8_SA(b, h) + aoff + m * 2048 + k * 1024); } } while (0)
#define PG8_LDB(dst, b, h) do { if constexpr (FP8) { _Pragma("unroll") for (int n = 0; n < 2; ++n) dst##8[n] = __builtin_shufflevector(*(const LAS i32x4*)(lds + PG8_SB(b, h) + boff + n * 2048), *(const LAS i32x4*)(lds + PG8_SB(b, h) + boff + n * 2048 + 1024), 0, 1, 2, 3, 4, 5, 6, 7); } \
        else { _Pragma("unroll") for (int n = 0; n < 2; ++n) _Pragma("unroll") for (int k = 0; k < 2; ++k) dst[n][k] = *(const LAS bf16x8*)(lds + PG8_SB(b, h) + boff + n * 2048 + k * 1024); } } while (0)
#define PG8_CAT8(x) __builtin_shufflevector(__builtin_bit_cast(i32x4, (x)[0]), __builtin_bit_cast(i32x4, (x)[1]), 0, 1, 2, 3, 4, 5, 6, 7)
#define PG8_MMA(ai, bj, At, Bt) do { __builtin_amdgcn_s_setprio(1); if constexpr (FP8) { _Pragma("unroll") for (int m = 0; m < 4; ++m) _Pragma("unroll") for (int n = 0; n < 2; ++n) \
        asm volatile("v_mfma_scale_f32_16x16x128_f8f6f4 %0, %1, %2, %0, %3, %3 op_sel_hi:[0,0,0]" : "+v"(acc[ai][bj][m][n]) : "v"(Bt##8[n]), "v"(At##8[m]), "v"(one8)); } \
      else { _Pragma("unroll") for (int m = 0; m < 4; ++m) _Pragma("unroll") for (int n = 0; n < 2; ++n) _Pragma("unroll") for (int k = 0; k < 2; ++k) \
        acc[ai][bj][m][n] = __builtin_amdgcn_mfma_f32_16x16x32_bf16(Bt[n][k], At[m][k], acc[ai][bj][m][n], 0, 0, 0); } __builtin_amdgcn_s_setprio(0); } while (0)
#define PG8_WAIT_V(n) asm volatile("s_waitcnt vmcnt(" #n ")" ::: "memory")
#define PG8_WAIT_L(n) asm volatile("s_waitcnt lgkmcnt(" #n ")" ::: "memory")
#define PG8_BAR __builtin_amdgcn_s_barrier()
#define PG8_SCHED __builtin_amdgcn_sched_barrier(0)
#define PG8_GOFF(U, o0, o1) do { if constexpr (GATHER) { _Pragma("unroll") for (int _i = 0; _i < 2; ++_i) { \
        o0[_i] = (unsigned)(S.a_row((U).pm * BM + Rr[_i]) * K + Cc[_i]) * 2u; o1[_i] = (unsigned)(S.a_row((U).pm * BM + HALF + Rr[_i]) * K + Cc[_i]) * 2u; } } } while (0)
    Unit cur, nxt; int ui = 0;
    if (!S.next(0, cur)) return;
    f32x4 acc[2][2][4][2];
#pragma unroll
    for (int a = 0; a < 2; ++a)
#pragma unroll
        for (int b = 0; b < 2; ++b)
#pragma unroll
            for (int m = 0; m < 4; ++m)
#pragma unroll
                for (int n = 0; n < 2; ++n) acc[a][b][m][n] = (f32x4){0.f, 0.f, 0.f, 0.f};
    const int one8 = 0x7f7f7f7f;
    bf16x8 At[4][2], B0[2][2], B1[2][2]; i32x8 At8[4], B08[2], B18[2];
    unsigned cg0[2] = {0u, 0u}, cg1[2] = {0u, 0u}, ng0[2] = {0u, 0u}, ng1[2] = {0u, 0u};
    const char* cA = GATHER ? S.A : S.a_base(cur); const char* cB = S.b_base(cur);
    PG8_GOFF(cur, cg0, cg1);
    PG8_STAGE(PG8_SB(0, 0), cB, voffB); PG8_STAGE(PG8_SB(0, 1), cB + hstep, voffB); PG8_STAGE_A(PG8_SA(0, 0), cA, 0, 0, cg0, cg1); PG8_STAGE_A(PG8_SA(0, 1), cA, 0, 1, cg0, cg1);
    if constexpr (Epi::BEGIN) E.begin(cur, 0);
    if (wr == 1) PG8_BAR;
    PG8_WAIT_V(2); PG8_BAR;
    PG8_STAGE(PG8_SB(1, 0), cB + kstep, voffB); PG8_STAGE_A(PG8_SA(1, 0), cA, S.a_koff(1), 0, cg0, cg1); PG8_STAGE(PG8_SB(1, 1), cB + hstep + kstep, voffB);
    PG8_WAIT_V(6); PG8_BAR;
    for (;;) {
        const bool has_next = S.next(ui + 1, nxt);
        const char* nA = has_next ? (GATHER ? S.A : S.a_base(nxt)) : cA; const char* nB = has_next ? S.b_base(nxt) : cB;
        if constexpr (GATHER) { if (has_next) { PG8_GOFF(nxt, ng0, ng1); } else { ng0[0] = cg0[0]; ng0[1] = cg0[1]; ng1[0] = cg1[0]; ng1[1] = cg1[1]; } }
#pragma unroll 1
        for (int t = 0; t < nt; t += 2) {
            const bool last = (t == nt - 2);
            if constexpr (Epi::MIDK) { if (t == nt / 2) E.mid(acc, ui, wr, fr); }
            const size_t k1 = S.a_koff(t + 1);
            const char* a2 = last ? nA : cA; const char* b2 = last ? nB : cB + (size_t)(t + 2) * kstep;
            const size_t k2 = last ? S.a_koff(0) : S.a_koff(t + 2), k3 = last ? S.a_koff(1) : S.a_koff(t + 3);
            const char* b3 = b2 + kstep;
            unsigned s0[2], s1[2];
            if constexpr (GATHER) { s0[0] = last ? ng0[0] : cg0[0]; s0[1] = last ? ng0[1] : cg0[1]; s1[0] = last ? ng1[0] : cg1[0]; s1[1] = last ? ng1[1] : cg1[1]; } else { s0[0] = s0[1] = s1[0] = s1[1] = 0u; }
            PG8_LDB(B0, 0, 0); PG8_LDB(B1, 0, 1); PG8_SCHED; PG8_LDA(At, 0, 0); PG8_STAGE_A(PG8_SA(1, 1), cA, k1, 1, cg0, cg1);
            PG8_WAIT_V(8); PG8_WAIT_L(0); PG8_BAR; PG8_MMA(0, 0, At, B0); PG8_MMA(0, 1, At, B1); PG8_BAR; PG8_SCHED;
            PG8_LDA(At, 0, 1); PG8_STAGE(PG8_SB(0, 0), b2, voffB); PG8_STAGE(PG8_SB(0, 1), b2 + hstep, voffB); PG8_STAGE_A(PG8_SA(0, 0), a2, k2, 0, s0, s1);
            PG8_WAIT_V(8); PG8_WAIT_L(0); PG8_BAR; PG8_MMA(1, 0, At, B0); PG8_MMA(1, 1, At, B1); PG8_BAR; PG8_SCHED;
            PG8_LDB(B0, 1, 0); PG8_LDB(B1, 1, 1); PG8_SCHED; PG8_LDA(At, 1, 0); PG8_STAGE_A(PG8_SA(0, 1), a2, k2, 1, s0, s1);
            PG8_WAIT_V(8); PG8_WAIT_L(0); PG8_BAR; PG8_MMA(0, 0, At, B0); PG8_MMA(0, 1, At, B1); PG8_BAR; PG8_SCHED;
            PG8_LDA(At, 1, 1); PG8_STAGE(PG8_SB(1, 0), b3, voffB); PG8_STAGE(PG8_SB(1, 1), b3 + hstep, voffB); PG8_STAGE_A(PG8_SA(1, 0), a2, k3, 0, s0, s1);
            PG8_WAIT_V(8); PG8_WAIT_L(0); PG8_BAR; PG8_MMA(1, 0, At, B0); PG8_MMA(1, 1, At, B1); PG8_BAR; PG8_SCHED;
        }
        if constexpr (ALIGN_EPI) { if (wr == 0) PG8_BAR; }
        if constexpr (FP8) asm volatile("s_nop 15\n\ts_nop 15" ::: "memory");
        E(acc, cur, wr, wc, fr, fq, ui);
        if (!has_next) break;
#pragma unroll
        for (int a = 0; a < 2; ++a)
#pragma unroll
            for (int b = 0; b < 2; ++b)
#pragma unroll
                for (int m = 0; m < 4; ++m)
#pragma unroll
                    for (int n = 0; n < 2; ++n) acc[a][b][m][n] = (f32x4){0.f, 0.f, 0.f, 0.f};
        cur = nxt; cA = nA; cB = nB; ++ui;
        if constexpr (Epi::BEGIN) E.begin(cur, ui);
        if constexpr (GATHER) { cg0[0] = ng0[0]; cg0[1] = ng0[1]; cg1[0] = ng1[0]; cg1[1] = ng1[1]; }
        if constexpr (ALIGN_EPI) { if (wr == 1) PG8_BAR; }
    }
    PG8_WAIT_V(0);
    if constexpr (!ALIGN_EPI) { if (wr == 0) PG8_BAR; }
    PG8_BAR;
#undef PG8_SA
#undef PG8_SB
#undef PG8_STAGE
#undef PG8_STAGE_A
#undef PG8_LDA
#undef PG8_LDB
#undef PG8_MMA
#undef PG8_CAT8
#undef PG8_WAIT_V
#undef PG8_WAIT_L
#undef PG8_BAR
#undef PG8_SCHED
#undef PG8_GOFF
}
}

#ifndef EARLY_BAR
#define EARLY_BAR 1
#endif
#ifndef LOCAL_BAR
#define LOCAL_BAR 1
#endif
#ifndef BAR_ACQUIRE
#define BAR_ACQUIRE 0
#endif
#define XB_TMO      128
#define XB_XCNT(j)  (256  + 64 * (j))
#define XB_XSUB(j)  (1280 + 64 * (j))
#define XB_XGEN(j)  (2304 + 64 * (j))
#define XB_TOP      3328
#define XB_TOPGEN   3392
#define XCD_BAR_WORDS 3456
#define XB_SPIN_CAP (1u << 18)

__device__ __forceinline__ unsigned xb_ld(unsigned* p)              { return __hip_atomic_load(p, __ATOMIC_RELAXED, __HIP_MEMORY_SCOPE_AGENT); }
__device__ __forceinline__ unsigned xb_add(unsigned* p, unsigned v) { return __hip_atomic_fetch_add(p, v, __ATOMIC_RELAXED, __HIP_MEMORY_SCOPE_AGENT); }
__device__ __forceinline__ unsigned xb_xcc_id() { return (unsigned)__builtin_amdgcn_s_getreg((3 << 11) | 20) & 0xFu; }
#define XB_SPIN(cond, bar) do { unsigned _sp = 0; while (cond) { __builtin_amdgcn_s_sleep(1); \
    if ((++_sp & 255u) == 0u) { if (xb_ld(&(bar)[XB_TMO])) break; if (_sp > XB_SPIN_CAP) { atomicAdd(&(bar)[XB_TMO], 1u); break; } } } } while (0)

struct XcdBarrier {
    unsigned* bar; unsigned x;
    volatile LAS unsigned* st;
};
__device__ __forceinline__ XcdBarrier xcd_barrier_post(unsigned* bar, volatile LAS unsigned* st) {
    XcdBarrier b; b.bar = bar; b.x = xb_xcc_id(); b.st = st;
    if (threadIdx.x == 0) (void)xb_add(&bar[XB_XCNT(b.x)], 1u);
    return b;
}
__device__ __forceinline__ void xcd_barrier_complete(unsigned* bar, unsigned x, unsigned& nloc, unsigned& nx) {
    const unsigned G = gridDim.x * gridDim.y * gridDim.z;
    unsigned sum, cnt, mine, sp = 0u;
    for (;;) {
        sum = 0u; cnt = 0u; mine = 0u;
#pragma unroll
        for (unsigned j = 0; j < 16; ++j) { const unsigned c = xb_ld(&bar[XB_XCNT(j)]); sum += c; cnt += (c > 0u) ? 1u : 0u; mine = (j == x) ? c : mine; }
        if (sum == G) break;
        __builtin_amdgcn_s_sleep(1);
        if ((++sp & 255u) == 0u) { if (xb_ld(&bar[XB_TMO])) break; if (sp > XB_SPIN_CAP) { atomicAdd(&bar[XB_TMO], 1u); break; } }
    }
    nloc = mine > 0u ? mine : 1u; nx = cnt > 0u ? cnt : 1u;
}
__device__ __forceinline__ void xcd_barrier(const XcdBarrier& b) {
    asm volatile("s_waitcnt vmcnt(0)" ::: "memory");
    __syncthreads();
    if (threadIdx.x == 0) {
        unsigned* bar = b.bar;
        __builtin_amdgcn_s_waitcnt(0);
        unsigned nloc = b.st[0], nx = b.st[1];
        if (nloc == 0u) { xcd_barrier_complete(bar, b.x, nloc, nx); b.st[0] = nloc; b.st[1] = nx; }
        const unsigned old = xb_add(&bar[XB_XSUB(b.x)], 1u);
        const unsigned gen = old / nloc;
        if (old + 1u == (gen + 1u) * nloc) {
            __builtin_amdgcn_fence(__ATOMIC_RELEASE, "agent");
            asm volatile("s_waitcnt vmcnt(0)" ::: "memory");
            (void)xb_add(&bar[XB_TOP], 1u);
        }
        XB_SPIN(xb_ld(&bar[XB_TOP]) < (gen + 1u) * nx, bar);
        if (BAR_ACQUIRE) __builtin_amdgcn_fence(__ATOMIC_ACQUIRE, "agent");
        asm volatile("s_waitcnt vmcnt(0)" ::: "memory");
    }
    __syncthreads();
}

__device__ __forceinline__ void xcd_barrier_arrive(const XcdBarrier& b) {
    asm volatile("s_waitcnt vmcnt(0)" ::: "memory");
    __syncthreads();
    if (threadIdx.x == 0) {
        unsigned* bar = b.bar;
        __builtin_amdgcn_s_waitcnt(0);
        unsigned nloc = b.st[0], nx = b.st[1];
        if (nloc == 0u) { xcd_barrier_complete(bar, b.x, nloc, nx); b.st[0] = nloc; b.st[1] = nx; }
        const unsigned old = xb_add(&bar[XB_XSUB(b.x)], 1u);
        const unsigned gen = old / nloc;
        if (old + 1u == (gen + 1u) * nloc) {
            __builtin_amdgcn_fence(__ATOMIC_RELEASE, "agent");
            asm volatile("s_waitcnt vmcnt(0)" ::: "memory");
            (void)xb_add(&bar[XB_TOP], 1u);
        }
        b.st[2] = (gen + 1u) * nx;
    }
}
__device__ __forceinline__ void xcd_barrier_wait(const XcdBarrier& b) {
    if (threadIdx.x == 0) {
        unsigned* bar = b.bar; const unsigned tgt = b.st[2];
        XB_SPIN(xb_ld(&bar[XB_TOP]) < tgt, bar);
        if (BAR_ACQUIRE) __builtin_amdgcn_fence(__ATOMIC_ACQUIRE, "agent");
        asm volatile("s_waitcnt vmcnt(0)" ::: "memory");
    }
    __syncthreads();
}

#define XL_MAP(j)  (60000 + 64 * (j))
#define XL_CNT(j)  (61000 + 64 * (j))
__device__ __forceinline__ void xcd_local_barrier(unsigned* ctl, unsigned x) {
    asm volatile("s_waitcnt vmcnt(0)" ::: "memory");
    __syncthreads();
    if (threadIdx.x == 0) {
        __builtin_amdgcn_s_waitcnt(0);
        unsigned* w = ctl + XL_CNT(x);
        const unsigned old = xb_add(w, 1u), tgt = (old / 32u + 1u) * 32u;
        XB_SPIN(xb_ld(w) < tgt, ctl + CW_BAR);
        asm volatile("s_waitcnt vmcnt(0)" ::: "memory");
    }
    __syncthreads();
}

__device__ __forceinline__ bf16x8 as_bf16x8(u32x4 v) { return __builtin_bit_cast(bf16x8, v); }
typedef __bf16 bf16x2_t __attribute__((ext_vector_type(2)));
__device__ __forceinline__ unsigned cvtpk(float lo, float hi) { const f32x2 v = {lo, hi}; const bf16x2_t b = __builtin_convertvector(v, bf16x2_t); return __builtin_bit_cast(unsigned, b); }
#define LDS_FENCE() asm volatile("s_waitcnt lgkmcnt(0)" ::: "memory")
__device__ __forceinline__ float fma_s(float a, float b, float c) { float r; asm("v_fma_f32 %0, %1, %2, %3" : "=v"(r) : "v"(a), "v"(b), "v"(c)); return r; }

constexpr int KN_PITCH = 144, VT_PITCH = 528;
constexpr int ATT_KN_OFF = 0, ATT_VT_OFF = 256 * KN_PITCH, ATT_LDS_BYTES = ATT_VT_OFF + 64 * VT_PITCH;
__device__ __forceinline__ void attn_unit(LAS unsigned char* lds, int unit, int tid, const bf16* PROJ, const float* qg, const float* kg, const float* sinks, bf16* ATT, float* ATTSQ = nullptr) {
    const int lane = tid & 63, wave = __builtin_amdgcn_readfirstlane(tid >> 6), l15 = lane & 15, q4 = lane >> 4;
    const int kvh = unit & 1, n = (unit >> 1) & 15, b = unit >> 5;
    const int tok0 = b * S + n * 128;
    {
        const int c = tid & 7; const f32x4 g0 = *(const f32x4*)(kg + 8 * c), g1 = *(const f32x4*)(kg + 8 * c + 4);
        const int vkey = tid & 255; const bool vvalid = (n > 0) || (vkey >= 128);
        u32x4 kraw[4], vraw[4];
#pragma unroll
        for (int j = 0; j < 4; ++j) { const int key = (tid >> 3) + 64 * j; const bool valid = (n > 0) || (key >= 128);
            kraw[j] = (u32x4){0u, 0u, 0u, 0u}; if (valid) kraw[j] = *(const u32x4*)(PROJ + (size_t)(tok0 - 128 + key) * DIN + KOFF + kvh * HD + 8 * c);
            vraw[j] = (u32x4){0u, 0u, 0u, 0u}; if (vvalid) vraw[j] = *(const u32x4*)(PROJ + (size_t)(tok0 - 128 + vkey) * DIN + VOFF + kvh * HD + 8 * ((tid >> 8) + 2 * j)); }
#pragma unroll
        for (int j = 0; j < 4; ++j) { const int key = (tid >> 3) + 64 * j; const u32x4 raw = kraw[j];
            const float f[8] = {bflo(raw.x), bfhi(raw.x), bflo(raw.y), bfhi(raw.y), bflo(raw.z), bfhi(raw.z), bflo(raw.w), bfhi(raw.w)};
            float ss = 0.f;
#pragma unroll
            for (int i = 0; i < 8; ++i) ss += f[i] * f[i];
            ss += __shfl_xor(ss, 1); ss += __shfl_xor(ss, 2); ss += __shfl_xor(ss, 4);
            const float r = rsqrtf(ss * (1.0f / HD) + EPS);
            u32x4 w; w.x = cvtpk(f[0] * r * g0.x, f[1] * r * g0.y); w.y = cvtpk(f[2] * r * g0.z, f[3] * r * g0.w); w.z = cvtpk(f[4] * r * g1.x, f[5] * r * g1.y); w.w = cvtpk(f[6] * r * g1.z, f[7] * r * g1.w);
            *(LAS u32x4*)(lds + ATT_KN_OFF + key * KN_PITCH + c * 16) = w; }
#pragma unroll
        for (int j = 0; j < 4; ++j) { const int cc = (tid >> 8) + 2 * j; const u32x4 raw = vraw[j];
            LAS unsigned short* vt = (LAS unsigned short*)(lds + ATT_VT_OFF + (8 * cc) * VT_PITCH + vkey * 2);
            vt[0 * (VT_PITCH / 2)] = (unsigned short)(raw.x & 0xffffu); vt[1 * (VT_PITCH / 2)] = (unsigned short)(raw.x >> 16);
            vt[2 * (VT_PITCH / 2)] = (unsigned short)(raw.y & 0xffffu); vt[3 * (VT_PITCH / 2)] = (unsigned short)(raw.y >> 16);
            vt[4 * (VT_PITCH / 2)] = (unsigned short)(raw.z & 0xffffu); vt[5 * (VT_PITCH / 2)] = (unsigned short)(raw.z >> 16);
            vt[6 * (VT_PITCH / 2)] = (unsigned short)(raw.w & 0xffffu); vt[7 * (VT_PITCH / 2)] = (unsigned short)(raw.w >> 16); }
    }
    __syncthreads();
    const int g = wave >> 1, h = kvh * 4 + g, qi0 = 64 * (wave & 1);
    const float sink = sinks[h];
    const f32x4 gq00 = *(const f32x4*)(qg + 8 * q4), gq01 = *(const f32x4*)(qg + 8 * q4 + 4), gq10 = *(const f32x4*)(qg + 32 + 8 * q4), gq11 = *(const f32x4*)(qg + 32 + 8 * q4 + 4);
    u32x4 qn0, qn1;
    { const size_t tq0 = (size_t)(tok0 + qi0 + l15); qn0 = *(const u32x4*)(PROJ + tq0 * DIN + QOFF + h * HD + 8 * q4); qn1 = *(const u32x4*)(PROJ + tq0 * DIN + QOFF + h * HD + 32 + 8 * q4); }
#pragma unroll 1
    for (int qt = 0; qt < 4; ++qt) {
        const int q0 = qi0 + 16 * qt, qi = q0 + l15; const size_t tq = (size_t)(tok0 + qi);
        const u32x4 r0 = qn0, r1 = qn1;
        { const size_t tqn = (size_t)(tok0 + qi0 + 16 * ((qt + 1) & 3) + l15); qn0 = *(const u32x4*)(PROJ + tqn * DIN + QOFF + h * HD + 8 * q4); qn1 = *(const u32x4*)(PROJ + tqn * DIN + QOFF + h * HD + 32 + 8 * q4); }
        const float f0[8] = {bflo(r0.x), bfhi(r0.x), bflo(r0.y), bfhi(r0.y), bflo(r0.z), bfhi(r0.z), bflo(r0.w), bfhi(r0.w)};
        const float f1[8] = {bflo(r1.x), bfhi(r1.x), bflo(r1.y), bfhi(r1.y), bflo(r1.z), bfhi(r1.z), bflo(r1.w), bfhi(r1.w)};
        float ss = 0.f;
#pragma unroll
        for (int i = 0; i < 8; ++i) ss += f0[i] * f0[i] + f1[i] * f1[i];
        ss += __shfl_xor(ss, 16); ss += __shfl_xor(ss, 32);
        const float rq = rsqrtf(ss * (1.0f / HD) + EPS) * 0.125f;
        u32x4 w0, w1;
        w0.x = cvtpk(f0[0] * rq * gq00.x, f0[1] * rq * gq00.y); w0.y = cvtpk(f0[2] * rq * gq00.z, f0[3] * rq * gq00.w); w0.z = cvtpk(f0[4] * rq * gq01.x, f0[5] * rq * gq01.y); w0.w = cvtpk(f0[6] * rq * gq01.z, f0[7] * rq * gq01.w);
        w1.x = cvtpk(f1[0] * rq * gq10.x, f1[1] * rq * gq10.y); w1.y = cvtpk(f1[2] * rq * gq10.z, f1[3] * rq * gq10.w); w1.z = cvtpk(f1[4] * rq * gq11.x, f1[5] * rq * gq11.y); w1.w = cvtpk(f1[6] * rq * gq11.z, f1[7] * rq * gq11.w);
        const bf16x8 bq0 = as_bf16x8(w0), bq1 = as_bf16x8(w1);
        const int kt0 = ((q0 >> 4) >> 1) * 2;
        f32x4 s[10];
#pragma unroll
        for (int i = 0; i < 10; ++i) { const LAS unsigned char* kp = lds + ATT_KN_OFF + (16 * (kt0 + i) + l15) * KN_PITCH + 16 * q4;
            const bf16x8 a0 = *(const LAS bf16x8*)kp, a1 = *(const LAS bf16x8*)(kp + 64);
            f32x4 z = (f32x4){0.f, 0.f, 0.f, 0.f};
            z = __builtin_amdgcn_mfma_f32_16x16x32_bf16(a0, bq0, z, 0, 0, 0); s[i] = __builtin_amdgcn_mfma_f32_16x16x32_bf16(a1, bq1, z, 0, 0, 0); }
        float m = sink;
#pragma unroll
        for (int i = 0; i < 10; ++i)
#pragma unroll
            for (int r = 0; r < 4; ++r) { const int kj = 16 * (kt0 + i) + 4 * q4 + r; const bool valid = (kj < 128) ? ((kj > qi) && (n > 0)) : ((kj - 128) <= qi);
                const float v = valid ? s[i][r] : -1e30f; s[i][r] = v; m = fmaxf(m, v); }
        m = fmaxf(m, __shfl_xor(m, 16)); m = fmaxf(m, __shfl_xor(m, 32));
        float den = 0.f;
#pragma unroll
        for (int i = 0; i < 10; ++i)
#pragma unroll
            for (int r = 0; r < 4; ++r) { const float p = __expf(s[i][r] - m); s[i][r] = p; den += p; }
        den += __shfl_xor(den, 16); den += __shfl_xor(den, 32); den += __expf(sink - m);
        f32x4 o[4];
#pragma unroll
        for (int dt = 0; dt < 4; ++dt) o[dt] = (f32x4){0.f, 0.f, 0.f, 0.f};
#pragma unroll
        for (int ks = 0; ks < 5; ++ks) { u32x4 pw; pw.x = cvtpk(s[2 * ks][0], s[2 * ks][1]); pw.y = cvtpk(s[2 * ks][2], s[2 * ks][3]); pw.z = cvtpk(s[2 * ks + 1][0], s[2 * ks + 1][1]); pw.w = cvtpk(s[2 * ks + 1][2], s[2 * ks + 1][3]);
            const bf16x8 bp = as_bf16x8(pw); const int keyb = 16 * kt0 + 32 * ks + 4 * q4;
#pragma unroll
            for (int dt = 0; dt < 4; ++dt) { const LAS unsigned char* vp = lds + ATT_VT_OFF + (16 * dt + l15) * VT_PITCH + keyb * 2;
                const u32x2 lo = *(const LAS u32x2*)vp, hi = *(const LAS u32x2*)(vp + 32);
                u32x4 av; av.x = lo.x; av.y = lo.y; av.z = hi.x; av.w = hi.y;
                o[dt] = __builtin_amdgcn_mfma_f32_16x16x32_bf16(as_bf16x8(av), bp, o[dt], 0, 0, 0); } }
        const float inv = 1.0f / den; float osq = 0.f;
#pragma unroll
        for (int dt = 0; dt < 4; ++dt) { const float o0 = o[dt][0] * inv, o1 = o[dt][1] * inv, o2 = o[dt][2] * inv, o3 = o[dt][3] * inv; osq += (o0 * o0 + o1 * o1) + (o2 * o2 + o3 * o3);
            u32x2 w; w.x = cvtpk(o0, o1); w.y = cvtpk(o2, o3);
            *(u32x2*)(ATT + tq * DATT + h * HD + 16 * dt + 4 * q4) = w; }
        if (ATTSQ) { osq += __shfl_xor(osq, 16); osq += __shfl_xor(osq, 32); if (q4 == 0) ATTSQ[tq * NH + h] = osq; }
    }
    __syncthreads();
}


__device__ __forceinline__ void ssm_apow_item(int i, const float* lam_re, const float* lam_im, const float* log_dt, unsigned char* APOW) {
    const int lane = i & 63, f = (i >> 6) & 63, g = i >> 12, ks = f & 7, rt = f >> 3, st = rt >> 1, c = rt & 1, fr = lane & 15, fq = lane >> 4, p = 16 * st + fr;
    const float dt = expf(log_dt[g]), lrd = lam_re[g * NST + p] * dt, lid = lam_im[g * NST + p] * dt;
    float v[8];
#pragma unroll
    for (int j = 0; j < 8; ++j) { const int t = 32 * ks + 16 * (j >> 2) + 4 * fq + (j & 3); const float k = (float)(255 - t), m = __expf(lrd * k), a = __builtin_amdgcn_fractf(lid * 0.15915494309189535f * k);
        v[j] = m * (c ? __builtin_amdgcn_sinf(a) : __builtin_amdgcn_cosf(a)); }
    u32x4 w; w.x = cvtpk(v[0], v[1]); w.y = cvtpk(v[2], v[3]); w.z = cvtpk(v[4], v[5]); w.w = cvtpk(v[6], v[7]);
    *(u32x4*)(APOW + (size_t)i * 16) = w;
}
struct Tr8 { const float* src; unsigned char* dst; int N, K, n0, k0, isgu, pad; };
__device__ __forceinline__ void tr8_setup(Tr8& t, const float* W, int K, int N, unsigned char* WT, int item, int lane, int isgu) {
    const int nblk = N / 32, kb = item / nblk, nb = item % nblk, q = lane & 7, o = lane >> 3;
    t.k0 = 128 * kb + 16 * o; t.n0 = 32 * nb + 4 * q; t.N = N; t.K = K; t.isgu = isgu; t.src = W + (size_t)t.k0 * N + t.n0; t.dst = WT; t.pad = 0;
}
__device__ __forceinline__ void tr8_load(const Tr8& t, f32x4 (&v)[16]) {
#pragma unroll
    for (int j = 0; j < 16; ++j) v[j] = __builtin_nontemporal_load((const f32x4*)(t.src + (size_t)j * t.N));
}
__device__ __forceinline__ void tr8_store(const Tr8& t, const f32x4 (&v)[16]) {
#pragma unroll
    for (int i = 0; i < 4; ++i) { const int nr = t.isgu ? gu_row(t.n0 + i) : (t.n0 + i);
        u32x4 a; a.x = pk4_fp8(v[0][i] * W8_SCALE, v[1][i] * W8_SCALE, v[2][i] * W8_SCALE, v[3][i] * W8_SCALE); a.y = pk4_fp8(v[4][i] * W8_SCALE, v[5][i] * W8_SCALE, v[6][i] * W8_SCALE, v[7][i] * W8_SCALE);
        a.z = pk4_fp8(v[8][i] * W8_SCALE, v[9][i] * W8_SCALE, v[10][i] * W8_SCALE, v[11][i] * W8_SCALE); a.w = pk4_fp8(v[12][i] * W8_SCALE, v[13][i] * W8_SCALE, v[14][i] * W8_SCALE, v[15][i] * W8_SCALE);
        __builtin_nontemporal_store(a, (u32x4*)(t.dst + (size_t)nr * t.K + t.k0)); }
}
struct ConvStream { const float* w_gu; const float* w_dn; unsigned char* wt_gu; unsigned char* wt_dn; int gu_first, n_gu, n_dn, stride; };

constexpr int SSM_BU_PITCH = 132, SSM_BU_BYTES = 16 * SSM_BU_PITCH * 4, SSM_X_PITCH = 272, SSM_WAVE_BYTES = SSM_BU_BYTES + 16 * SSM_X_PITCH, SSM_XEND_OFF = 8 * SSM_WAVE_BYTES, SSM_LDS_BYTES = SSM_XEND_OFF + 8 * 64 * 8;
__device__ __forceinline__ void ssm_unit(LAS unsigned char* lds, int unit, int tid, const bf16* PROJ, const float* tab, const float* c_re, const float* c_im, const float* d_skip, bf16* Gout, const bool has_cs, const ConvStream cs, const unsigned char* APOW = nullptr) {
    const int lane = tid & 63, wave = __builtin_amdgcn_readfirstlane(tid >> 6), l15 = lane & 15, q4 = lane >> 4;
    const int g = unit & 31, b = unit >> 5;
    if constexpr (SSM_MFMA_CARRY && !P3_CONV) {
        const unsigned char* gsrc = APOW + (size_t)g * 65536 + (size_t)wave * 8192 + lane * 16;
#pragma unroll
        for (int c4 = 0; c4 < 2; ++c4) { const unsigned* gp = (const unsigned*)(gsrc + c4 * 4096); LAS unsigned* lp = (LAS unsigned*)(lds + wave * 8192 + c4 * 4096);
            __builtin_amdgcn_global_load_lds(gp, lp, 16, 0, 0); __builtin_amdgcn_global_load_lds(gp, lp, 16, 1024, 0); __builtin_amdgcn_global_load_lds(gp, lp, 16, 2048, 0); __builtin_amdgcn_global_load_lds(gp, lp, 16, 3072, 0); } }
    Tr8 ct; ct.src = nullptr; ct.dst = nullptr; ct.N = ct.K = ct.n0 = ct.k0 = ct.isgu = ct.pad = 0; f32x4 cv[16]; bool cpend = false; int cq = unit * 8 + wave;
#pragma unroll
    for (int j = 0; j < 16; ++j) cv[j] = (f32x4){0.f, 0.f, 0.f, 0.f};
#define SSM_CONV_STEP() do { if (has_cs) { if (cpend) tr8_store(ct, cv); \
        constexpr int IGU = (D / 128) * (2 * DFF / 32), IDN = (DFF / 128) * (D / 32); cpend = cq < cs.n_gu + cs.n_dn; \
        { const bool isgu = cq < cs.n_gu || !cpend; const int r = !cpend ? 0 : (isgu ? cs.gu_first + cq : cq - cs.n_gu), e = r / (isgu ? IGU : IDN), it = r % (isgu ? IGU : IDN); \
          if (isgu) tr8_setup(ct, cs.w_gu + (size_t)e * D * 2 * DFF, D, 2 * DFF, cs.wt_gu + (size_t)e * 2 * DFF * D, it, lane, 1); \
          else tr8_setup(ct, cs.w_dn + (size_t)e * DFF * D, DFF, D, cs.wt_dn + (size_t)e * D * DFF, it, lane, 0); } \
        tr8_load(ct, cv); cq += cs.stride; } } while (0)
    const float* tg = tab + (size_t)g * SSMT_STRIDE;
    const float ar = tg[ST_AR + lane], ai = tg[ST_AI + lane], nai = -ai;
    bf16x8 bb[8];
#define SSM_SETUP_BB() do { _Pragma("unroll") for (int nt = 0; nt < 8; ++nt) { u32x4 w = (u32x4){0u, 0u, 0u, 0u}; \
        if (q4 < 2) { const int p = 8 * nt + (l15 >> 1); const float* src = tg + ((l15 & 1) ? ST_BI : ST_BR) + p * SG + 8 * q4; const f32x4 v0 = *(const f32x4*)src, v1 = *(const f32x4*)(src + 4); \
            w.x = cvtpk(v0.x, v0.y); w.y = cvtpk(v0.z, v0.w); w.z = cvtpk(v1.x, v1.y); w.w = cvtpk(v1.z, v1.w); } \
        bb[nt] = as_bf16x8(w); } } while (0)
    if constexpr (!(SSM_MFMA_CARRY && !P3_CONV)) SSM_SETUP_BB();
    bf16x8 cm[4];
#pragma unroll
    for (int ks = 0; ks < 4; ++ks) { const int pb = 16 * ks + 4 * q4; const f32x4 cr = *(const f32x4*)(c_re + ((size_t)g * SG + l15) * NST + pb), ci = *(const f32x4*)(c_im + ((size_t)g * SG + l15) * NST + pb);
        u32x4 w; w.x = cvtpk(cr.x, -ci.x); w.y = cvtpk(cr.y, -ci.y); w.z = cvtpk(cr.z, -ci.z); w.w = cvtpk(cr.w, -ci.w); cm[ks] = as_bf16x8(w); }
    LAS float* BU = (LAS float*)(lds + wave * SSM_WAVE_BYTES); LAS unsigned char* XT = lds + wave * SSM_WAVE_BYTES + SSM_BU_BYTES;
    LAS f32x2* xend = (LAS f32x2*)(lds + SSM_XEND_OFF);
    const bf16* ubase = PROJ + (size_t)(b * S) * DIN + UOFF + g * SG;
    const int tseg = 256 * wave;
    float xr = 0.f, xi = 0.f;
#define SSM_LOAD_U(dst, t0) do { dst = (u32x4){0u, 0u, 0u, 0u}; if (q4 < 2) dst = *(const u32x4*)(ubase + (size_t)((t0) + l15) * DIN + 8 * q4); } while (0)
#define SSM_BU_TILE(araw) do { const bf16x8 afr = as_bf16x8(araw); \
        _Pragma("unroll") for (int nt = 0; nt < 8; ++nt) { const f32x4 d = __builtin_amdgcn_mfma_f32_16x16x32_bf16(afr, bb[nt], (f32x4){0.f, 0.f, 0.f, 0.f}, 0, 0, 0); \
            _Pragma("unroll") for (int r = 0; r < 4; ++r) BU[(4 * q4 + r) * SSM_BU_PITCH + 16 * nt + l15] = d[r]; } LDS_FENCE(); } while (0)
    u32x4 ucur, unext, unn; SSM_LOAD_U(ucur, tseg); SSM_LOAD_U(unext, tseg + 16);
    if constexpr (SSM_MFMA_CARRY && !P3_CONV) {
        u32x4 idw = (u32x4){0u, 0u, 0u, 0u};
        { const int m = l15 - 8 * q4; const unsigned one = (m & 1) ? 0x3F800000u : 0x00003F80u;
          if (q4 < 2 && m >= 0 && m < 8) { idw.x = (m >> 1) == 0 ? one : 0u; idw.y = (m >> 1) == 1 ? one : 0u; idw.z = (m >> 1) == 2 ? one : 0u; idw.w = (m >> 1) == 3 ? one : 0u; } }
        const bf16x8 ident = as_bf16x8(idw);
        f32x4 V[8]; u32x4 na, nb;
#pragma unroll
        for (int rt = 0; rt < 8; ++rt) V[rt] = (f32x4){0.f, 0.f, 0.f, 0.f};
        asm volatile("s_waitcnt vmcnt(0)" ::: "memory");
        __syncthreads();
#pragma unroll 2
        for (int ks = 0; ks < 8; ++ks) {
            SSM_LOAD_U(na, tseg + 16 * ((2 * ks + 2) & 15)); SSM_LOAD_U(nb, tseg + 16 * ((2 * ks + 3) & 15));
            u32x4 afc[8];
#pragma unroll
            for (int rt = 0; rt < 8; ++rt) afc[rt] = *(const LAS u32x4*)(lds + (rt * 8 + ks) * 1024 + lane * 16);
            const f32x4 d0 = __builtin_amdgcn_mfma_f32_16x16x32_bf16(as_bf16x8(ucur), ident, (f32x4){0.f, 0.f, 0.f, 0.f}, 0, 0, 0), d1 = __builtin_amdgcn_mfma_f32_16x16x32_bf16(as_bf16x8(unext), ident, (f32x4){0.f, 0.f, 0.f, 0.f}, 0, 0, 0);
            u32x4 utw; utw.x = cvtpk(d0[0], d0[1]); utw.y = cvtpk(d0[2], d0[3]); utw.z = cvtpk(d1[0], d1[1]); utw.w = cvtpk(d1[2], d1[3]);
            const bf16x8 ut = as_bf16x8(utw);
#pragma unroll
            for (int rt = 0; rt < 8; ++rt) V[rt] = __builtin_amdgcn_mfma_f32_16x16x32_bf16(as_bf16x8(afc[rt]), ut, V[rt], 0, 0, 0);
            ucur = na; unext = nb; }
        __syncthreads();
        float bre[4][4], bim[4][4];
#pragma unroll
        for (int st = 0; st < 4; ++st)
#pragma unroll
            for (int i = 0; i < 4; ++i) { const int p = 16 * st + 4 * q4 + i; bre[st][i] = bf2f(f2bf(tg[ST_BR + p * SG + l15])); bim[st][i] = bf2f(f2bf(tg[ST_BI + p * SG + l15])); }
        LAS f32x2* PP = (LAS f32x2*)(lds + wave * SSM_WAVE_BYTES);
#pragma unroll
        for (int st = 0; st < 4; ++st)
#pragma unroll
            for (int i = 0; i < 4; ++i) { const float vr = V[2 * st][i], vi = V[2 * st + 1][i], br = bre[st][i], bi = bim[st][i];
                PP[(16 * st + 4 * q4 + i) * 18 + l15] = (f32x2){br * vr - bi * vi, br * vi + bi * vr}; }
        LDS_FENCE();
        { float sr = 0.f, si = 0.f;
#pragma unroll
          for (int q = 0; q < 8; ++q) { const f32x4 v = *(const LAS f32x4*)(PP + lane * 18 + 2 * q); sr += v.x + v.z; si += v.y + v.w; }
          xr = sr; xi = si; }
        LDS_FENCE();
    } else {
#pragma unroll 1
    for (int tile4 = 0; tile4 < 16; tile4 += 4) {
#pragma unroll
      for (int ti = 0; ti < 4; ++ti) { const int tile = tile4 + ti; SSM_LOAD_U(unn, tseg + 16 * ((tile + 2) & 15)); if (ti == 0) SSM_CONV_STEP(); SSM_BU_TILE(ucur); ucur = unext; unext = unn;
#pragma unroll
        for (int tt = 0; tt < 16; ++tt) { const f32x2 bu = *(const LAS f32x2*)(BU + tt * SSM_BU_PITCH + 2 * lane); const float nr = fma_s(ar, xr, fma_s(nai, xi, bu.x)), ni = fma_s(ar, xi, fma_s(ai, xr, bu.y)); xr = nr; xi = ni; }
        LDS_FENCE(); } }
    }
    xend[wave * 64 + lane] = (f32x2){xr, xi};
    __syncthreads();
    { float pr = ar, pi = ai;
#pragma unroll
      for (int i = 0; i < 8; ++i) { const float nr = pr * pr - pi * pi, ni = 2.0f * pr * pi; pr = nr; pi = ni; }
      xr = 0.f; xi = 0.f;
      for (int w2 = 0; w2 < wave; ++w2) { const f32x2 e = xend[w2 * 64 + lane]; const float npi = -pi; const float nr = fma_s(pr, xr, fma_s(npi, xi, e.x)), ni = fma_s(pr, xi, fma_s(pi, xr, e.y)); xr = nr; xi = ni; } }
    const f32x4 dsk = *(const f32x4*)(d_skip + g * SG + 4 * q4);
    if constexpr (SSM_MFMA_CARRY && !P3_CONV) SSM_SETUP_BB();
    u32x2 uucur = *(const u32x2*)(ubase + (size_t)(tseg + l15) * DIN + 4 * q4), uunext = *(const u32x2*)(ubase + (size_t)(tseg + 16 + l15) * DIN + 4 * q4), uunn;
#pragma unroll 1
    for (int tile4 = 0; tile4 < 16; tile4 += 4) {
#pragma unroll
      for (int ti = 0; ti < 4; ++ti) { const int tile = tile4 + ti; const int t0 = tseg + 16 * tile; SSM_LOAD_U(unn, tseg + 16 * ((tile + 2) & 15)); uunn = *(const u32x2*)(ubase + (size_t)(tseg + 16 * ((tile + 2) & 15) + l15) * DIN + 4 * q4); if (ti == 0) SSM_CONV_STEP(); SSM_BU_TILE(ucur); ucur = unext; unext = unn;
        f32x2 buv[16];
#pragma unroll
        for (int tt = 0; tt < 16; ++tt) buv[tt] = *(const LAS f32x2*)(BU + tt * SSM_BU_PITCH + 2 * lane);
#pragma unroll
        for (int tt = 0; tt < 16; ++tt) { const f32x2 bu = buv[tt]; const float nr = fma_s(ar, xr, fma_s(nai, xi, bu.x)), ni = fma_s(ar, xi, fma_s(ai, xr, bu.y)); xr = nr; xi = ni;
            *(LAS unsigned*)(XT + tt * SSM_X_PITCH + 4 * lane) = cvtpk(xr, xi); }
        LDS_FENCE();
        f32x4 y = (f32x4){0.f, 0.f, 0.f, 0.f};
#pragma unroll
        for (int ks = 0; ks < 4; ++ks) { const bf16x8 bx = *(const LAS bf16x8*)(XT + l15 * SSM_X_PITCH + (32 * ks + 8 * q4) * 2); y = __builtin_amdgcn_mfma_f32_16x16x32_bf16(cm[ks], bx, y, 0, 0, 0); }
        const size_t t = (size_t)(t0 + l15); const u32x2 uu = uucur; uucur = uunext; uunext = uunn;
        const float y0 = gelu_tanh(y[0] + dsk.x * bflo(uu.x)), y1 = gelu_tanh(y[1] + dsk.y * bfhi(uu.x)), y2 = gelu_tanh(y[2] + dsk.z * bflo(uu.y)), y3 = gelu_tanh(y[3] + dsk.w * bfhi(uu.y));
        u32x2 w; w.x = cvtpk(y0, y1); w.y = cvtpk(y2, y3);
        *(u32x2*)(Gout + ((size_t)(b * S) + t) * DSSM + g * SG + 4 * q4) = w;
        LDS_FENCE(); } }
#undef SSM_BU_TILE
#undef SSM_SETUP_BB
#undef SSM_LOAD_U
#undef SSM_CONV_STEP
    if (has_cs && cpend) tr8_store(ct, cv);
    __syncthreads();
}

constexpr int NWAVES = 8;
constexpr int RING_OFF = 0, RING_BYTES = 131072;
constexpr int LDSCTL_OFF = RING_BYTES;
constexpr int MISC_OFF = LDSCTL_OFF + 320;
constexpr int LH_OFF = LDSCTL_OFF + 512;
constexpr int SORT_OFF = RING_OFF;
constexpr int RSCR_OFF = LDSCTL_OFF + 8192;
constexpr int TE_OFF = LDSCTL_OFF + 4096;
constexpr int LDS_BYTES = 147456;
#define LDS_WAIT() asm volatile("s_waitcnt lgkmcnt(0)" ::: "memory")
#ifndef DEFER_P4_N
#define DEFER_P4_N 4
#endif
#ifndef DEFER_P2_N
#define DEFER_P2_N 5
#endif
#ifndef DN_DEFER_P9_N
#define DN_DEFER_P9_N 3072
#endif
constexpr int DN_DEFER_P9 = (MOE_FP8_GU && MOE_FP8_DN) ? DN_DEFER_P9_N : 0;
constexpr int DEFER_P2_PER_WAVE = MOE_FP8_GU ? DEFER_P2_N : 0, DEFER_P4_PER_WAVE = MOE_FP8_GU ? DEFER_P4_N : 0;
#ifndef P2_RESHAPE
#define P2_RESHAPE 1
#endif
#ifndef P2_CONV_N
#define P2_CONV_N 10
#endif
constexpr int P2_GEMM_WGS = 160;
constexpr int GU_DEFER_P2 = (P2_RESHAPE && MOE_FP8_GU) ? (256 - P2_GEMM_WGS) * 8 * P2_CONV_N : 192 * 8 * DEFER_P2_PER_WAVE, GU_DEFER_P4 = 128 * 8 * DEFER_P4_PER_WAVE, GU_DEFER = GU_DEFER_P2 + GU_DEFER_P4;
enum Phase { P_PRO = 0, P_NORM1, P_INPROJ, P_MIX_A, P_MIX_B, P_GLU, P_MIXNORM, P_OUTPROJ, P_ROUTER, P_SORT, P_GATEUP, P_DOWN, P_COMBINE, P_COUNT };

__device__ __forceinline__ void router_image_item(int i, const float* w_router, unsigned char* WRI) {
    const int lane = i & 63, rest = i >> 6, hl = rest & 1, nt = (rest >> 1) & 1, ks = (rest >> 2) & 3, w = rest >> 4, fr = lane & 15, fq = lane >> 4;
    const float* src = w_router + (size_t)(128 * w + 32 * ks + 8 * fq) * NE + 16 * nt + fr;
    float v[8];
#pragma unroll
    for (int j = 0; j < 8; ++j) v[j] = src[j * NE];
    u32x4 p;
#pragma unroll
    for (int j = 0; j < 4; ++j) { float a = v[2 * j], b = v[2 * j + 1]; unsigned hi = cvtpk(a, b); if (hl) { a -= bflo(hi); b -= bfhi(hi); hi = cvtpk(a, b); } p[j] = hi; }
    *(u32x4*)(WRI + (size_t)i * 16) = p;
}
__device__ __forceinline__ void router_block_mfma(LAS unsigned char* lds, int blk, int tid, int wave, int lane, const float* x1, const float* gain, const float* mod, const float* b_router,
                                                  const unsigned char* WRI, LAS int* lh, unsigned char* H8, int* tope, float* topw, const bf16* delta = nullptr, int* cnt = nullptr, int* toke = nullptr, float* wrowe = nullptr, int* paire = nullptr, bf16* x1b = nullptr) {
    asm volatile("" : "+v"(lane), "+v"(tid));
    const int b = (blk * 64) / S, fr = lane & 15, fq = lane >> 4;
    LAS unsigned char* Wl = lds + RING_OFF + wave * 16384;
    LAS float* gsh = (LAS float*)(lds + RSCR_OFF);
    LAS float* ssqx = (LAS float*)(lds + TE_OFF);
    LAS int* sel_e = (LAS int*)(lds + TE_OFF + 2048);
    LAS float* sel_v = (LAS float*)(lds + TE_OFF + 3072);
    LAS float* lg = (LAS float*)(lds + RING_OFF + 8192);
    { const unsigned char* gsrc = WRI + (size_t)wave * 16384 + lane * 16;
#pragma unroll
      for (int c4 = 0; c4 < 4; ++c4) { const unsigned* gp = (const unsigned*)(gsrc + c4 * 4096); LAS unsigned* lp = (LAS unsigned*)(Wl + c4 * 4096);
          __builtin_amdgcn_global_load_lds(gp, lp, 16, 0, 0); __builtin_amdgcn_global_load_lds(gp, lp, 16, 1024, 0); __builtin_amdgcn_global_load_lds(gp, lp, 16, 2048, 0); __builtin_amdgcn_global_load_lds(gp, lp, 16, 3072, 0); } }
    f32x4 xv[4][4][2];
    const float* xb = x1 + (size_t)(blk * 64 + fr) * D + 128 * wave + 8 * fq;
#pragma unroll
    for (int m = 0; m < 4; ++m)
#pragma unroll
        for (int ks = 0; ks < 4; ++ks) { xv[m][ks][0] = *(const f32x4*)(xb + (size_t)(16 * m) * D + 32 * ks); xv[m][ks][1] = *(const f32x4*)(xb + (size_t)(16 * m) * D + 32 * ks + 4); }
    if (delta) {
        const bf16* db = delta + (size_t)(blk * 64 + fr) * D + 128 * wave + 8 * fq; u32x4 dv[4][4];
#pragma unroll
        for (int m = 0; m < 4; ++m)
#pragma unroll
            for (int ks = 0; ks < 4; ++ks) dv[m][ks] = *(const u32x4*)(db + (size_t)(16 * m) * D + 32 * ks);
#pragma unroll
        for (int m = 0; m < 4; ++m)
#pragma unroll
            for (int ks = 0; ks < 4; ++ks) { const u32x4 d = dv[m][ks];
                xv[m][ks][0] += (f32x4){bflo(d.x), bfhi(d.x), bflo(d.y), bfhi(d.y)}; xv[m][ks][1] += (f32x4){bflo(d.z), bfhi(d.z), bflo(d.w), bfhi(d.w)}; } }
    if (x1b) { bf16* xo = x1b + (size_t)(blk * 64 + fr) * D + 128 * wave + 8 * fq;
#pragma unroll
        for (int m = 0; m < 4; ++m)
#pragma unroll
            for (int ks = 0; ks < 4; ++ks) { const f32x4 a = xv[m][ks][0], c2 = xv[m][ks][1]; u32x4 w; w.x = cvtpk(a.x, a.y); w.y = cvtpk(a.z, a.w); w.z = cvtpk(c2.x, c2.y); w.w = cvtpk(c2.z, c2.w);
                *(u32x4*)(xo + (size_t)(16 * m) * D + 32 * ks) = w; } }
    if (lane < 32) { const int c = 128 * wave + 4 * lane; const f32x4 g = *(const f32x4*)(gain + c), sc = *(const f32x4*)(mod + b * 6 * D + 4 * D + c);
        *(LAS f32x4*)(gsh + c) = g * (1.0f + sc); *(LAS f32x4*)(gsh + 1024 + c) = *(const f32x4*)(mod + b * 6 * D + 3 * D + c); }
    float ss[4];
#pragma unroll
    for (int m = 0; m < 4; ++m) { float a = 0.f;
#pragma unroll
        for (int ks = 0; ks < 4; ++ks)
#pragma unroll
            for (int h = 0; h < 2; ++h) { const f32x4 v = xv[m][ks][h]; a += (v.x * v.x + v.y * v.y) + (v.z * v.z + v.w * v.w); }
        a += __shfl_xor(a, 16); a += __shfl_xor(a, 32); ss[m] = a; }
    if (fq == 0) {
#pragma unroll
        for (int m = 0; m < 4; ++m) ssqx[(16 * m + fr) * 8 + wave] = ss[m]; }
    asm volatile("s_waitcnt vmcnt(0)" ::: "memory");
    __syncthreads();
    float r[4];
#pragma unroll
    for (int m = 0; m < 4; ++m) { const f32x4 a = *(const LAS f32x4*)(ssqx + (16 * m + fr) * 8), c = *(const LAS f32x4*)(ssqx + (16 * m + fr) * 8 + 4);
        r[m] = rsqrtf((((a.x + a.y) + (a.z + a.w)) + ((c.x + c.y) + (c.z + c.w))) * (1.0f / D) + EPS); }
    f32x4 acc[4][2];
#pragma unroll
    for (int m = 0; m < 4; ++m)
#pragma unroll
        for (int nt = 0; nt < 2; ++nt) acc[m][nt] = (f32x4){0.f, 0.f, 0.f, 0.f};
#pragma unroll
    for (int ks = 0; ks < 4; ++ks) { const int kk = 128 * wave + 32 * ks + 8 * fq;
        const f32x4 g0 = *(const LAS f32x4*)(gsh + kk), g1 = *(const LAS f32x4*)(gsh + kk + 4), s0 = *(const LAS f32x4*)(gsh + 1024 + kk), s1 = *(const LAS f32x4*)(gsh + 1024 + kk + 4);
        bf16x8 Wh[2], Wo[2];
#pragma unroll
        for (int nt = 0; nt < 2; ++nt) { Wh[nt] = *(const LAS bf16x8*)(Wl + ((ks * 2 + nt) * 2 + 0) * 1024 + lane * 16); Wo[nt] = *(const LAS bf16x8*)(Wl + ((ks * 2 + nt) * 2 + 1) * 1024 + lane * 16); }
#pragma unroll
        for (int m = 0; m < 4; ++m) { const f32x4 h0 = xv[m][ks][0] * r[m] * g0 + s0, h1 = xv[m][ks][1] * r[m] * g1 + s1;
            u32x2 w8; w8.x = pk4_fp8(h0.x * H8_SCALE, h0.y * H8_SCALE, h0.z * H8_SCALE, h0.w * H8_SCALE); w8.y = pk4_fp8(h1.x * H8_SCALE, h1.y * H8_SCALE, h1.z * H8_SCALE, h1.w * H8_SCALE);
            *(u32x2*)(H8 + (size_t)(blk * 64 + 16 * m + fr) * D + kk) = w8;
            u32x4 hi, lo;
            hi.x = cvtpk(h0.x, h0.y); hi.y = cvtpk(h0.z, h0.w); hi.z = cvtpk(h1.x, h1.y); hi.w = cvtpk(h1.z, h1.w);
            lo.x = cvtpk(h0.x - bflo(hi.x), h0.y - bfhi(hi.x)); lo.y = cvtpk(h0.z - bflo(hi.y), h0.w - bfhi(hi.y)); lo.z = cvtpk(h1.x - bflo(hi.z), h1.y - bfhi(hi.z)); lo.w = cvtpk(h1.z - bflo(hi.w), h1.w - bfhi(hi.w));
            const bf16x8 Xh = __builtin_bit_cast(bf16x8, hi), Xl = __builtin_bit_cast(bf16x8, lo);
#pragma unroll
            for (int nt = 0; nt < 2; ++nt) { acc[m][nt] = __builtin_amdgcn_mfma_f32_16x16x32_bf16(Wo[nt], Xh, acc[m][nt], 0, 0, 0); acc[m][nt] = __builtin_amdgcn_mfma_f32_16x16x32_bf16(Wh[nt], Xl, acc[m][nt], 0, 0, 0);
                acc[m][nt] = __builtin_amdgcn_mfma_f32_16x16x32_bf16(Wh[nt], Xh, acc[m][nt], 0, 0, 0); } } }
    { LAS float* part = (LAS float*)Wl;
#pragma unroll
      for (int m = 0; m < 4; ++m)
#pragma unroll
          for (int nt = 0; nt < 2; ++nt) *(LAS f32x4*)(part + (16 * m + fr) * 32 + 16 * nt + 4 * fq) = acc[m][nt]; }
    __syncthreads();
    { const int row = tid >> 3, eg = tid & 7; f32x4 sum = *(const f32x4*)(b_router + 4 * eg);
#pragma unroll
      for (int w2 = 0; w2 < 8; ++w2) sum += *(const LAS f32x4*)(lds + RING_OFF + w2 * 16384 + (row * 32 + 4 * eg) * 4);
      *(LAS f32x4*)(lg + row * 32 + 4 * eg) = sum; }
    __syncthreads();
    { const int row = 8 * wave + (lane >> 3), eg = lane & 7; const LAS float* lgr = lg + row * 32;
      const f32x4 mine = *(const LAS f32x4*)(lgr + 4 * eg); const int e0m = 4 * eg;
      int rk0 = 0, rk1 = 0, rk2 = 0, rk3 = 0;
#pragma unroll
      for (int q = 0; q < 8; ++q) { const f32x4 a = *(const LAS f32x4*)(lgr + 4 * q);
#pragma unroll
          for (int t = 0; t < 4; ++t) { const int e2 = 4 * q + t; const float av = a[t];
              rk0 += (av > mine.x || (av == mine.x && e2 < e0m + 0)) ? 1 : 0; rk1 += (av > mine.y || (av == mine.y && e2 < e0m + 1)) ? 1 : 0;
              rk2 += (av > mine.z || (av == mine.z && e2 < e0m + 2)) ? 1 : 0; rk3 += (av > mine.w || (av == mine.w && e2 < e0m + 3)) ? 1 : 0; } }
      if (rk0 < 4) { sel_e[row * 4 + rk0] = e0m + 0; sel_v[row * 4 + rk0] = mine.x; }
      if (rk1 < 4) { sel_e[row * 4 + rk1] = e0m + 1; sel_v[row * 4 + rk1] = mine.y; }
      if (rk2 < 4) { sel_e[row * 4 + rk2] = e0m + 2; sel_v[row * 4 + rk2] = mine.z; }
      if (rk3 < 4) { sel_e[row * 4 + rk3] = e0m + 3; sel_v[row * 4 + rk3] = mine.w; }
      asm volatile("s_waitcnt lgkmcnt(0)" ::: "memory");
      if (eg == 0) { const i32x4 ee = *(const LAS i32x4*)(sel_e + row * 4); const f32x4 vv = *(const LAS f32x4*)(sel_v + row * 4);
          const float x1v = __expf(vv.y - vv.x), x2v = __expf(vv.z - vv.x), x3v = __expf(vv.w - vv.x), inv = 1.0f / (1.0f + x1v + x2v + x3v);
          const size_t g = (size_t)(blk * 64 + row) * 4;
          if (cnt) *(LAS f32x4*)(sel_v + row * 4) = (f32x4){inv, x1v * inv, x2v * inv, x3v * inv};
          else { *(i32x4*)(tope + g) = ee; *(f32x4*)(topw + g) = (f32x4){inv, x1v * inv, x2v * inv, x3v * inv}; }
          (void)__hip_atomic_fetch_add(&lh[ee.x], 1, __ATOMIC_RELAXED, __HIP_MEMORY_SCOPE_WORKGROUP); (void)__hip_atomic_fetch_add(&lh[ee.y], 1, __ATOMIC_RELAXED, __HIP_MEMORY_SCOPE_WORKGROUP);
          (void)__hip_atomic_fetch_add(&lh[ee.z], 1, __ATOMIC_RELAXED, __HIP_MEMORY_SCOPE_WORKGROUP); (void)__hip_atomic_fetch_add(&lh[ee.w], 1, __ATOMIC_RELAXED, __HIP_MEMORY_SCOPE_WORKGROUP); }
      asm volatile("s_waitcnt lgkmcnt(0)" ::: "memory"); }
    if (cnt) {
        LAS int* offs = (LAS int*)ssqx; LAS int* es = (LAS int*)ssqx + 32;
        __syncthreads();
        if (tid < NE) { offs[tid] = __hip_atomic_fetch_add(cnt + tid * CNT_STRIDE, lh[tid], __ATOMIC_RELAXED, __HIP_MEMORY_SCOPE_AGENT); lh[tid] = 0; }
        int my_e = 0, rank = 0;
        if (tid < 256) { my_e = sel_e[tid]; const unsigned long long lt = (lane == 0) ? 0ull : (~0ull >> (64 - lane));
#pragma unroll 4
            for (int e = 0; e < NE; ++e) { const unsigned long long mk = __ballot(my_e == e); if (my_e == e) rank = __popcll(mk & lt); if (lane == 0) es[wave * 32 + e] = __popcll(mk); } }
        __syncthreads();
        if (tid < 256) { for (int w2 = 0; w2 < wave; ++w2) rank += es[w2 * 32 + my_e];
            const int slot = offs[my_e] + rank;
            toke[(size_t)my_e * T + slot] = blk * 64 + (tid >> 2); wrowe[(size_t)my_e * T + slot] = sel_v[tid]; paire[(size_t)blk * 256 + tid] = slot | (my_e << 20); }
    }
}

struct Args { const float* in[30]; float* out; unsigned char* ws; int ph_lo, ph_hi, li, pad; };

template <bool GU> __device__ __forceinline__ void p0_transpose_item(const float* W, int K, int N, bf16* WT, int item, int lane, const float* kscale = nullptr) {
    const int nblk = N / 64, kb = item / nblk, nb = item % nblk, q = lane & 15, o = lane >> 4, k0 = 64 * kb + 16 * o, n0 = 64 * nb + 4 * q;
    const float* src = W + (size_t)k0 * N + n0;
    f32x4 v[16];
#pragma unroll
    for (int j = 0; j < 16; ++j) v[j] = *(const f32x4*)(src + (size_t)j * N);
    if (kscale) {
#pragma unroll
        for (int j = 0; j < 16; ++j) v[j] = v[j] * kscale[k0 + j]; }
#pragma unroll
    for (int i = 0; i < 4; ++i) { const int nr = GU ? gu_row(n0 + i) : (n0 + i);
        u32x4 a, b;
        a.x = cvtpk(v[0][i], v[1][i]); a.y = cvtpk(v[2][i], v[3][i]); a.z = cvtpk(v[4][i], v[5][i]); a.w = cvtpk(v[6][i], v[7][i]);
        b.x = cvtpk(v[8][i], v[9][i]); b.y = cvtpk(v[10][i], v[11][i]); b.z = cvtpk(v[12][i], v[13][i]); b.w = cvtpk(v[14][i], v[15][i]);
        u32x4* dst = (u32x4*)(WT + (size_t)nr * K + k0); dst[0] = a; dst[1] = b; }
}

template <bool GU> __device__ __forceinline__ void p0_transpose_item_fp8(const float* W, int K, int N, unsigned char* WT, int item, int lane) {
    const int nblk = N / 32, kb = item / nblk, nb = item % nblk, q = lane & 7, o = lane >> 3, k0 = 128 * kb + 16 * o, n0 = 32 * nb + 4 * q;
    const float* src = W + (size_t)k0 * N + n0;
    f32x4 v[16];
#pragma unroll
    for (int j = 0; j < 16; ++j) v[j] = __builtin_nontemporal_load((const f32x4*)(src + (size_t)j * N)) * W8_SCALE;
#pragma unroll
    for (int i = 0; i < 4; ++i) { const int nr = GU ? gu_row(n0 + i) : (n0 + i);
        u32x4 a; a.x = pk4_fp8(v[0][i], v[1][i], v[2][i], v[3][i]); a.y = pk4_fp8(v[4][i], v[5][i], v[6][i], v[7][i]); a.z = pk4_fp8(v[8][i], v[9][i], v[10][i], v[11][i]); a.w = pk4_fp8(v[12][i], v[13][i], v[14][i], v[15][i]);
        __builtin_nontemporal_store(a, (u32x4*)(WT + (size_t)nr * K + k0)); }
}

__global__ void __launch_bounds__(NWAVES * 64, 2) mk_fwd(Args args) {
    extern __shared__ __attribute__((aligned(16))) unsigned char lds_raw[];
    LAS unsigned char* lds = (LAS unsigned char*)lds_raw;
    const int tid = threadIdx.x, lane = tid & 63, wave = __builtin_amdgcn_readfirstlane(tid >> 6);
    const int G = gridDim.x, bx = blockIdx.x, vcu = (G % 8 == 0) ? (bx % 8) * (G / 8) + bx / 8 : bx;
    const int gw = vcu * NWAVES + wave, NGW = G * NWAVES;
    unsigned char* ws = args.ws;
    const float* x = args.in[0]; const float* c_in = args.in[1]; const float* w_ada = args.in[2]; const float* b_ada = args.in[3];
    const float* norm_mix = args.in[4]; const float* w_in = args.in[5]; const float* b_in = args.in[6];
    const float* q_norm = args.in[7]; const float* k_norm = args.in[8]; const float* sinks = args.in[9];
    const float* lam_re = args.in[10]; const float* lam_im = args.in[11]; const float* log_dt = args.in[12];
    const float* b_re = args.in[13]; const float* b_im = args.in[14]; const float* c_re = args.in[15]; const float* c_im = args.in[16];
    const float* d_skip = args.in[17]; const float* w_glu = args.in[18]; const float* b_glu = args.in[19];
    const float* attn_out_norm = args.in[20]; const float* ssm_out_norm = args.in[21]; const float* w_out = args.in[22];
    const float* norm_ffn = args.in[23]; const float* w_router = args.in[24]; const float* b_router = args.in[25];
    const float* w_gate_up = args.in[26]; const float* b_gate_up = args.in[27]; const float* w_down = args.in[28]; const float* b_down = args.in[29];
    float* out = args.out;
    float* MOD = (float*)(ws + WS_MOD); float* SSMT = (float*)(ws + WS_SSMT);
    bf16* WTIN = (bf16*)(ws + WS_WTIN); bf16* WTGLU = (bf16*)(ws + WS_WTGLU); bf16* WTOUT = (bf16*)(ws + WS_WTOUT); bf16* WTGU = (bf16*)(ws + WS_WTGU); bf16* WTDN = (bf16*)(ws + WS_WTDN);
    bf16* H = (bf16*)(ws + WS_H); bf16* PROJ = (bf16*)(ws + WS_PROJ); bf16* ATT = (bf16*)(ws + WS_ATT); bf16* Gb = (bf16*)(ws + WS_G); bf16* SSMG = (bf16*)(ws + WS_SSMG); bf16* MIXED = (bf16*)(ws + WS_MIXED);
    int* TOPE = (int*)(ws + WS_TOPE); float* TOPW = (float*)(ws + WS_TOPW); int* HIST = (int*)(ws + WS_HIST); int* TOKROW = (int*)(ws + WS_TOKROW); int* ROWPAIR = (int*)(ws + WS_ROWPAIR);
    float* WROW = (float*)(ws + WS_WROW); int* TILEE = (int*)(ws + WS_TILEE); bf16* ACT = (bf16*)(ws + WS_ACT); bf16* YS = (bf16*)(ws + WS_YS);
    float* XST = (float*)(ws + WS_XST); float* SC = (float*)(ws + WS_SC);

    for (int u = tid; u < (LDS_BYTES - LDSCTL_OFF) / 4; u += NWAVES * 64) ((LAS unsigned*)(lds + LDSCTL_OFF))[u] = 0u;
    __syncthreads();
    volatile LAS unsigned* MISC = (volatile LAS unsigned*)(lds + MISC_OFF);
    XcdBarrier bar = xcd_barrier_post((unsigned*)(ws + WS_CTL) + CW_BAR + args.li * XCD_BAR_WORDS, MISC + 8);
    const int lo = args.ph_lo, hi = args.ph_hi;
    unsigned* const ctlw = (unsigned*)(ws + WS_CTL);
    if (LOCAL_BAR && tid == 0 && G == 256) (void)__hip_atomic_fetch_or(&ctlw[XL_MAP(bx & 7)], 1u << bar.x, __ATOMIC_RELAXED, __HIP_MEMORY_SCOPE_AGENT);
    bool lok = false;
#define IN(k) (lo <= (k) && (k) < hi)
#define SEAM(k) do { if (IN(k) && IN((k) + 1)) xcd_barrier(bar); } while (0)
#define LSEAM(k) do { if (IN(k) && IN((k) + 1)) { if (lok) xcd_local_barrier(ctlw, bar.x); else xcd_barrier(bar); } } while (0)

    if (IN(P_PRO)) {
        if (vcu < 96) {
            LAS float* ca = (LAS float*)(lds + RING_OFF);
            LAS float* red = (LAS float*)(lds + RING_OFF + 32768);
            for (int k = tid; k < D; k += 512) { float cv8[NB];
#pragma unroll
                for (int b = 0; b < NB; ++b) { const float v = c_in[b * D + k]; cv8[b] = v * sigmoidf_(v); }
                *(LAS f32x4*)(ca + k * 8) = (f32x4){cv8[0], cv8[1], cv8[2], cv8[3]}; *(LAS f32x4*)(ca + k * 8 + 4) = (f32x4){cv8[4], cv8[5], cv8[6], cv8[7]}; }
            __syncthreads();
            float acc[NB];
#pragma unroll
            for (int b = 0; b < NB; ++b) acc[b] = 0.f;
            const float* wp = w_ada + (size_t)(128 * wave) * (6 * D) + 64 * vcu + lane;
#pragma unroll 1
            for (int k0 = 0; k0 < 128; k0 += 64) {
                float wv[64];
#pragma unroll
                for (int j = 0; j < 64; ++j) wv[j] = __builtin_nontemporal_load(wp + (size_t)(k0 + j) * (6 * D));
#pragma unroll
                for (int j = 0; j < 64; ++j) { const float w = wv[j]; const f32x4 c0 = *(const LAS f32x4*)(ca + (128 * wave + k0 + j) * 8), c1 = *(const LAS f32x4*)(ca + (128 * wave + k0 + j) * 8 + 4);
                    acc[0] = fmaf(c0.x, w, acc[0]); acc[1] = fmaf(c0.y, w, acc[1]); acc[2] = fmaf(c0.z, w, acc[2]); acc[3] = fmaf(c0.w, w, acc[3]);
                    acc[4] = fmaf(c1.x, w, acc[4]); acc[5] = fmaf(c1.y, w, acc[5]); acc[6] = fmaf(c1.z, w, acc[6]); acc[7] = fmaf(c1.w, w, acc[7]); } }
#pragma unroll
            for (int b = 0; b < NB; ++b) red[(wave * 8 + b) * 64 + lane] = acc[b];
            __syncthreads();
            { float s = b_ada[64 * vcu + lane];
#pragma unroll
              for (int w2 = 0; w2 < 8; ++w2) s += red[(w2 * 8 + wave) * 64 + lane];
              MOD[wave * 6 * D + 64 * vcu + lane] = s; }
            __syncthreads();
        } else if (vcu < 100) { const int i = (vcu - 96) * 512 + tid; ssm_table_item(i, lam_re, lam_im, log_dt, b_re, b_im, SSMT); }
        else if (FAST_ROUTER && MOE_FP8_GU && vcu < 116) router_image_item((vcu - 100) * 512 + tid, w_router, ws + WS_WRI);
        constexpr int I_IN = (D / 64) * (DIN / 64), I_GLU = (DSSM / 64) * (DSSM / 64), I_OUT = (D / 64) * (D / 64), I_GU = MOE_FP8_GU ? (D / 128) * (2 * DFF / 32) : (D / 64) * (2 * DFF / 64), I_DN = MOE_FP8_DN ? (DFF / 128) * (D / 32) : (DFF / 64) * (D / 64);
        constexpr int NITEMS = I_IN + I_GLU + I_OUT + NE * I_GU + NE * I_DN, NSMALL = I_IN + I_GLU + I_OUT;
        const bool early = EARLY_BAR && G == 256 && IN(P_PRO + 1);
        if (early) {
            if constexpr (SSM_MFMA_CARRY && !P3_CONV) { if (vcu >= 96) for (int i = (vcu - 96) * 512 + tid; i < NG * 64 * 64; i += 160 * 512) ssm_apow_item(i, lam_re, lam_im, log_dt, ws + WS_APOW); }
            if (vcu >= 116) for (int r = (vcu - 116) * 8 + wave; r < NSMALL; r += 140 * 8) {
                if (r < I_IN) p0_transpose_item<false>(w_in, D, DIN, WTIN, r, lane);
                else if (r < I_IN + I_GLU) p0_transpose_item<false>(w_glu, DSSM, DSSM, WTGLU, r - I_IN, lane);
                else { const int r2 = r - I_IN - I_GLU, kb = r2 / (D / 64); p0_transpose_item<false>(w_out, D, D, WTOUT, r2, lane, FUSE_MIXNORM ? (kb < 8 ? attn_out_norm : ssm_out_norm - DATT) : nullptr); } }
            xcd_barrier_arrive(bar);
        } else { if constexpr (SSM_MFMA_CARRY && !P3_CONV) for (int i = vcu * 512 + tid; i < NG * 64 * 64; i += G * 512) ssm_apow_item(i, lam_re, lam_im, log_dt, ws + WS_APOW); }
        const int gu_defer = (G == 256) ? GU_DEFER : 0;
        const int nitems_p0 = (G == 256 && P3_CONV) ? (I_IN + I_GLU + I_OUT) : (NITEMS - gu_defer - (G == 256 ? DN_DEFER_P9 : 0));
        const int gwb = early ? ((vcu >= 96 ? vcu - 96 : vcu + 160) * NWAVES + wave) : gw;
        for (int it0 = gwb + (early ? NSMALL : 0); it0 < nitems_p0; it0 += NGW) {
            int r = (it0 < I_IN + I_GLU + I_OUT) ? it0 : it0 + gu_defer;
            if (r < I_IN) { p0_transpose_item<false>(w_in, D, DIN, WTIN, r, lane); continue; } r -= I_IN;
            if (r < I_GLU) { p0_transpose_item<false>(w_glu, DSSM, DSSM, WTGLU, r, lane); continue; } r -= I_GLU;
            if (r < I_OUT) { const int kb = r / (D / 64);
                p0_transpose_item<false>(w_out, D, D, WTOUT, r, lane, FUSE_MIXNORM ? (kb < 8 ? attn_out_norm : ssm_out_norm - DATT) : nullptr); continue; } r -= I_OUT;
            if (r < NE * I_GU) { const int e = r / I_GU;
                if constexpr (MOE_FP8_GU) p0_transpose_item_fp8<true>(w_gate_up + (size_t)e * D * 2 * DFF, D, 2 * DFF, (unsigned char*)WTGU + (size_t)e * 2 * DFF * D, r % I_GU, lane);
                else p0_transpose_item<true>(w_gate_up + (size_t)e * D * 2 * DFF, D, 2 * DFF, WTGU + (size_t)e * 2 * DFF * D, r % I_GU, lane);
                continue; } r -= NE * I_GU;
            { const int e = r / I_DN;
              if constexpr (MOE_FP8_DN) p0_transpose_item_fp8<false>(w_down + (size_t)e * DFF * D, DFF, D, (unsigned char*)WTDN + (size_t)e * D * DFF, r % I_DN, lane);
              else p0_transpose_item<false>(w_down + (size_t)e * DFF * D, DFF, D, WTDN + (size_t)e * D * DFF, r % I_DN, lane); }
        }
    }
    if (EARLY_BAR && G == 256) { if (IN(P_PRO) && IN(P_PRO + 1)) xcd_barrier_wait(bar); } else SEAM(P_PRO);
    if (LOCAL_BAR && G == 256 && IN(P_PRO) && IN(P_NORM1)) {
        if (tid == 0) { unsigned all = 0u, ok = 1u;
#pragma unroll
            for (int j = 0; j < 8; ++j) { const unsigned m = xb_ld(&ctlw[XL_MAP(j)]); ok &= (__builtin_popcount(m) == 1) ? 1u : 0u; all |= m; }
            ok &= (__builtin_popcount(all) == 8) ? 1u : 0u;
            MISC[11] = ok; }
        __syncthreads();
        lok = __builtin_amdgcn_readfirstlane(MISC[11]) != 0u;
    }
    if (IN(P_NORM1)) {
        for (int m0 = 8 * (vcu * 8 + wave); m0 < T; m0 += 8 * NGW) { const int b = m0 / S; f32x4 gm[4], shv[4];
#pragma unroll
            for (int j = 0; j < 4; ++j) { const int c = 4 * lane + 256 * j; gm[j] = *(const f32x4*)(norm_mix + c) * (1.0f + *(const f32x4*)(MOD + b * 6 * D + D + c)); shv[j] = *(const f32x4*)(MOD + b * 6 * D + c); }
#pragma unroll 2
            for (int i = 0; i < 8; ++i) { const int m = m0 + i; const f32x4* xr = (const f32x4*)(x + (size_t)m * D) + lane; f32x4 v[4]; float ss = 0.f;
#pragma unroll
                for (int j = 0; j < 4; ++j) { v[j] = xr[64 * j]; ss += (v[j].x * v[j].x + v[j].y * v[j].y) + (v[j].z * v[j].z + v[j].w * v[j].w); }
                const float r = rsqrtf(wave_sum(ss) * (1.0f / D) + EPS); u32x2* o = (u32x2*)(H + (size_t)m * D) + lane;
#pragma unroll
                for (int j = 0; j < 4; ++j) { const f32x4 y = v[j] * r * gm[j] + shv[j]; u32x2 w; w.x = cvtpk(y.x, y.y); w.y = cvtpk(y.z, y.w); o[64 * j] = w; } } }
    }
    LSEAM(P_NORM1);
    if (IN(P_INPROJ)) {
        constexpr int I_GU8 = (D / 128) * (2 * DFF / 32);
        const bool reshape = P2_RESHAPE && GU_DEFER_P2 > 0 && G == 256;
        const int Gg = reshape ? P2_GEMM_WGS : G;
        if (bx < Gg) {
            pg8::DenseOrder So{(const char*)H, (const char*)WTIN, T / 256, DIN / 256, Gg, bx, (size_t)256 * D * 2};
            pg8::EpiProj E{PROJ, DIN, b_in, (LAS float*)(lds + RSCR_OFF + 4096)};
            pg8::gemm_phase<pg8::EpiProj, pg8::DenseOrder, true, false>(lds + RING_OFF, D, So, E);
            if constexpr (GU_DEFER_P2 > 0 && !P2_RESHAPE) { if (G == 256 && bx >= 64) {
                for (int k = 0; k < DEFER_P2_PER_WAVE; ++k) { const int r = ((bx - 64) * 8 + wave) * DEFER_P2_PER_WAVE + k, e = r / I_GU8;
                    p0_transpose_item_fp8<true>(w_gate_up + (size_t)e * D * 2 * DFF, D, 2 * DFF, (unsigned char*)WTGU + (size_t)e * 2 * DFF * D, r % I_GU8, lane); } } }
        } else {
            const int nconv = (G - Gg) * 8;
            for (int r = (bx - Gg) * 8 + wave; r < GU_DEFER_P2; r += nconv) { const int e = r / I_GU8;
                p0_transpose_item_fp8<true>(w_gate_up + (size_t)e * D * 2 * DFF, D, 2 * DFF, (unsigned char*)WTGU + (size_t)e * 2 * DFF * D, r % I_GU8, lane); }
        }
    }
    LSEAM(P_INPROJ);
    if (IN(P_MIX_A)) {
#if FAST_ATTN
        for (int u = vcu; u < NB * 16 * NKV; u += G) attn_unit(lds + RING_OFF, u, tid, PROJ, q_norm, k_norm, sinks, ATT, FUSE_MIXNORM ? (float*)(ws + WS_MIXED) : nullptr);
#else
        for (int idx = bx * 512 + tid; idx < T * NH; idx += G * 512) attn_scores_item(idx, PROJ, q_norm, k_norm, SC);
#endif
#if FAST_SSM
        { constexpr int IGU = (D / 128) * (2 * DFF / 32), IDN = (DFF / 128) * (D / 32);
          const ConvStream cstr{w_gate_up, w_down, (unsigned char*)WTGU, (unsigned char*)WTDN, GU_DEFER, NE * IGU - GU_DEFER, NE * IDN - DN_DEFER_P9, 2048};
          const bool use_cs = (G == 256) && P3_CONV;
          for (int u = vcu; u < NB * NG; u += G) ssm_unit(lds + RING_OFF, u, tid, PROJ, SSMT, c_re, c_im, d_skip, Gb, use_cs, cstr, ws + WS_APOW); }
#else
        if (wave == 0) for (int idx = bx * 64 + lane; idx < NB * NG * NST; idx += G * 64) ssm_scan_item(idx, PROJ, SSMT, XST);
#endif
    }
    LSEAM(P_MIX_A);
    if (IN(P_MIX_B)) {
#if !FAST_ATTN
        for (int idx = bx * 512 + tid; idx < T * NH * HD; idx += G * 512) attn_out_item(idx, PROJ, SC, sinks, ATT);
#endif
#if !FAST_SSM
        for (int idx = bx * 512 + tid; idx < T * DSSM; idx += G * 512) ssm_out_item(idx, PROJ, XST, c_re, c_im, d_skip, Gb);
#endif
    }
#if !(FAST_ATTN && FAST_SSM)
    SEAM(P_MIX_B);
#endif
    if (IN(P_GLU)) {
        pg8::DenseOrder So{(const char*)Gb, (const char*)WTGLU, T / 256, DSSM / 256, G, bx, (size_t)256 * DSSM * 2};
        pg8::EpiGlu E{Gb, SSMG, b_glu, FUSE_MIXNORM ? (float*)(ws + WS_MIXED + MiB) : nullptr, (LAS float*)(lds + RSCR_OFF + 4096)};
        pg8::gemm_phase<pg8::EpiGlu, pg8::DenseOrder, true, false>(lds + RING_OFF, DSSM, So, E);
        if constexpr (GU_DEFER_P4 > 0) { if (G == 256 && bx >= 128) {
            constexpr int I_GU8 = (D / 128) * (2 * DFF / 32);
            for (int k = 0; k < DEFER_P4_PER_WAVE; ++k) { const int r = GU_DEFER_P2 + ((bx - 128) * 8 + wave) * DEFER_P4_PER_WAVE + k, e = r / I_GU8;
                p0_transpose_item_fp8<true>(w_gate_up + (size_t)e * D * 2 * DFF, D, 2 * DFF, (unsigned char*)WTGU + (size_t)e * 2 * DFF * D, r % I_GU8, lane); } } }
    }
    LSEAM(P_GLU);
    if (IN(P_MIXNORM) && !FUSE_MIXNORM) {
        const f32x4 ga0 = *(const f32x4*)(attn_out_norm + 8 * lane), ga1 = *(const f32x4*)(attn_out_norm + 8 * lane + 4), gs0 = *(const f32x4*)(ssm_out_norm + 8 * lane), gs1 = *(const f32x4*)(ssm_out_norm + 8 * lane + 4);
        for (int m0 = 2 * gw; m0 < T; m0 += 2 * NGW) {
            u32x4 a[2], q[2];
#pragma unroll
            for (int r = 0; r < 2; ++r) { a[r] = *((const u32x4*)(ATT + (size_t)(m0 + r) * DATT) + lane); q[r] = *((const u32x4*)(SSMG + (size_t)(m0 + r) * DSSM) + lane); }
#pragma unroll
            for (int r = 0; r < 2; ++r) {
                const float av[8] = {bflo(a[r].x), bfhi(a[r].x), bflo(a[r].y), bfhi(a[r].y), bflo(a[r].z), bfhi(a[r].z), bflo(a[r].w), bfhi(a[r].w)};
                const float sv[8] = {bflo(q[r].x), bfhi(q[r].x), bflo(q[r].y), bfhi(q[r].y), bflo(q[r].z), bfhi(q[r].z), bflo(q[r].w), bfhi(q[r].w)};
                float qa = 0.f, qs = 0.f;
#pragma unroll
                for (int i = 0; i < 8; ++i) { qa += av[i] * av[i]; qs += sv[i] * sv[i]; }
                const float ra = rsqrtf(wave_sum(qa) * (1.0f / DATT) + EPS), rs = rsqrtf(wave_sum(qs) * (1.0f / DSSM) + EPS);
                u32x4 oa, os;
                oa.x = pk2(av[0] * ra * ga0.x, av[1] * ra * ga0.y); oa.y = pk2(av[2] * ra * ga0.z, av[3] * ra * ga0.w); oa.z = pk2(av[4] * ra * ga1.x, av[5] * ra * ga1.y); oa.w = pk2(av[6] * ra * ga1.z, av[7] * ra * ga1.w);
                os.x = pk2(sv[0] * rs * gs0.x, sv[1] * rs * gs0.y); os.y = pk2(sv[2] * rs * gs0.z, sv[3] * rs * gs0.w); os.z = pk2(sv[4] * rs * gs1.x, sv[5] * rs * gs1.y); os.w = pk2(sv[6] * rs * gs1.z, sv[7] * rs * gs1.w);
                *((u32x4*)(MIXED + (size_t)(m0 + r) * D) + lane) = oa; *((u32x4*)(MIXED + (size_t)(m0 + r) * D + DATT) + lane) = os; } }
    }
    if (!FUSE_MIXNORM) SEAM(P_MIXNORM);
    if (IN(P_OUTPROJ)) {
        if constexpr (FUSE_MIXNORM) {
            pg8::MixOrder So{(const char*)ATT, (const char*)WTOUT, T / 256, D / 256, G, bx, (size_t)(WS_SSMG - WS_ATT)};
            pg8::EpiOut E{x, MOD, X1_DELTA ? (float*)(ws + WS_DELTA) : out, (const float*)(ws + WS_MIXED), (const float*)(ws + WS_MIXED + MiB), (LAS float*)(lds + RSCR_OFF), (LAS float*)(lds + RSCR_OFF + 4096)};
            pg8::gemm_phase<pg8::EpiOut, pg8::MixOrder, false, false>(lds + RING_OFF, D, So, E);
        } else {
            pg8::DenseOrder So{(const char*)MIXED, (const char*)WTOUT, T / 256, D / 256, G, bx, (size_t)256 * D * 2};
            pg8::EpiOut E{x, MOD, X1_DELTA ? (float*)(ws + WS_DELTA) : out, nullptr, nullptr, (LAS float*)(lds + RSCR_OFF), (LAS float*)(lds + RSCR_OFF + 4096)};
            pg8::gemm_phase<pg8::EpiOut, pg8::DenseOrder, false, false>(lds + RING_OFF, D, So, E);
        }
    }
    LSEAM(P_OUTPROJ);
    if (IN(P_ROUTER)) {
        LAS float* wr = (LAS float*)(lds + RING_OFF); LAS int* lh = (LAS int*)(lds + LH_OFF);
        constexpr bool FR = FAST_ROUTER && MOE_FP8_GU, FS = FR && FAST_SORT && MOE_FP8_DN && YS_FP8;
        if constexpr (!FR) for (int c = tid; c < D; c += 512) {
            f32x4 wv[8];
#pragma unroll
            for (int k = 0; k < 8; ++k) wv[k] = *(const f32x4*)(w_router + (size_t)c * NE + 4 * k);
#pragma unroll
            for (int k = 0; k < 8; ++k) { wr[(4 * k + 0) * D + c] = wv[k].x; wr[(4 * k + 1) * D + c] = wv[k].y; wr[(4 * k + 2) * D + c] = wv[k].z; wr[(4 * k + 3) * D + c] = wv[k].w; } }
        if (tid < NE) lh[tid] = 0;
        __syncthreads();
        for (int vb = vcu; vb < 256; vb += G) {
            if constexpr (FR) router_block_mfma(lds, vb, tid, wave, lane, X1_DELTA ? x : out, norm_ffn, MOD, b_router, ws + WS_WRI, lh, ws + WS_H8, TOPE, TOPW, X1_DELTA ? (const bf16*)(ws + WS_DELTA) : nullptr, FS ? (int*)(ws + WS_CNT) : nullptr, (int*)(ws + WS_TOKE), (float*)(ws + WS_WROWE), ROWPAIR, (X1_DELTA && X1_BF16) ? (bf16*)(ws + WS_X1B) : nullptr);
            else norm2_router_rows(vb, wave, lane, out, norm_ffn, MOD, b_router, wr, lh, (LAS float*)(lds + RSCR_OFF), MOE_FP8_GU ? (bf16*)nullptr : H, TOPE, TOPW, MOE_FP8_GU ? (unsigned char*)PROJ : nullptr);
            __syncthreads();
            if (!FS && tid < NE) { HIST[vb * NE + tid] = lh[tid]; lh[tid] = 0; }
            __syncthreads();
        }
    }
    SEAM(P_ROUTER);
    constexpr bool FSK = FAST_ROUTER && MOE_FP8_GU && FAST_SORT && MOE_FP8_DN && YS_FP8;
    if (IN(P_SORT) && !FSK) for (int vb = bx; vb < 256; vb += G) sort_block(vb, tid, (LAS int*)(lds + SORT_OFF), HIST, TOPE, TOPW, TOKROW, ROWPAIR, WROW, TILEE);
    if (!FSK) SEAM(P_SORT);
    LAS int* cbt = (LAS int*)(lds + TE_OFF + 2048);
    if (IN(P_GATEUP) || IN(P_DOWN) || (FSK && IN(P_COMBINE))) {
        LAS int* te = (LAS int*)(lds + TE_OFF);
        if constexpr (FSK) {
            if (wave == 0) { const int cv = (lane < NE) ? ((const int*)(ws + WS_CNT))[lane * CNT_STRIDE] : 0; int inc = ((cv + 255) >> 8) << 8;
#pragma unroll
                for (int o = 1; o < 32; o <<= 1) { const int t = __shfl_up(inc, o); if (lane >= o) inc += t; }
                if (lane < NE) { cbt[lane] = cv; cbt[33 + lane] = inc; } if (lane == 0) cbt[32] = 0; }
            __syncthreads();
            if (tid < NE) for (int ti = cbt[32 + tid] >> 8; ti < (cbt[33 + tid] >> 8); ++ti) te[ti] = tid;
        } else for (int i = tid; i < MAXTILES; i += 512) te[i] = TILEE[64 + i];
        __syncthreads();
    }
    if (IN(P_GATEUP)) {
        const LAS int* te = (const LAS int*)(lds + TE_OFF); const int ntiles = __builtin_amdgcn_readfirstlane(FSK ? (cbt[64] >> 8) : TILEE[0]);
        if constexpr (MOE_FP8_GU) {
            pg8::MoeOrder So{(const char*)(ws + WS_H8), (const char*)WTGU, FSK ? (const int*)(ws + WS_TOKE) : TOKROW, te, ntiles, 2 * DFF / 256, G, bx, (size_t)256 * D, (size_t)2 * DFF * D, FSK ? cbt : nullptr};
            pg8::EpiGateUp<MOE_FP8_DN != 0> E{(void*)ACT, b_gate_up, te, 1.0f / (W8_SCALE * H8_SCALE), (LAS float*)(lds + RSCR_OFF + 4096)};
            pg8::gemm_phase<pg8::EpiGateUp<MOE_FP8_DN != 0>, pg8::MoeOrder, true, true, true>(lds + RING_OFF, D / 2, So, E);
            if constexpr (DN_DEFER_P9 > 0) { if (G == 256) {
                constexpr int IDN8 = (DFF / 128) * (D / 32);
                const int rem = (ntiles * (2 * DFF / 256)) % G; const bool all = (rem == 0) || (G - rem < 64);
                const int n_idle = all ? G : G - rem, j = all ? bx : bx - rem;
                if (j >= 0) for (int r = NE * IDN8 - DN_DEFER_P9 + j * 8 + wave; r < NE * IDN8; r += n_idle * 8) { const int e = r / IDN8;
                    p0_transpose_item_fp8<false>(w_down + (size_t)e * DFF * D, DFF, D, (unsigned char*)WTDN + (size_t)e * D * DFF, r % IDN8, lane); } } }
        } else {
            pg8::MoeOrder So{(const char*)H, (const char*)WTGU, TOKROW, te, ntiles, 2 * DFF / 256, G, bx, (size_t)256 * D * 2, (size_t)2 * DFF * D * 2};
            pg8::EpiGateUp<MOE_FP8_DN != 0> E{(void*)ACT, b_gate_up, te, 1.0f, (LAS float*)(lds + RSCR_OFF + 4096)};
            pg8::gemm_phase<pg8::EpiGateUp<MOE_FP8_DN != 0>, pg8::MoeOrder, true, true, false>(lds + RING_OFF, D, So, E);
        }
    }
    SEAM(P_GATEUP);
    if (IN(P_DOWN)) {
        const LAS int* te = (const LAS int*)(lds + TE_OFF); const int ntiles = __builtin_amdgcn_readfirstlane(FSK ? (cbt[64] >> 8) : TILEE[0]);
        if constexpr (MOE_FP8_DN) {
            pg8::MoeOrder So{(const char*)ACT, (const char*)WTDN, TOKROW, te, ntiles, D / 256, G, bx, (size_t)256 * DFF, (size_t)D * DFF, nullptr, true};
            pg8::EpiDown<YS_FP8 != 0> E{(void*)YS, b_down, FSK ? (const float*)(ws + WS_WROWE) : WROW, te, 1.0f / (W8_SCALE * A8_SCALE), FSK ? cbt : nullptr, (LAS float*)(lds + RSCR_OFF + 4096), (const float*)(ws + WS_CTL)};
            pg8::gemm_phase<pg8::EpiDown<YS_FP8 != 0>, pg8::MoeOrder, true, false, true>(lds + RING_OFF, DFF / 2, So, E);
        } else {
            pg8::MoeOrder So{(const char*)ACT, (const char*)WTDN, TOKROW, te, ntiles, D / 256, G, bx, (size_t)256 * DFF * 2, (size_t)D * DFF * 2};
            pg8::EpiDown<YS_FP8 != 0> E{(void*)YS, b_down, WROW, te, 1.0f, nullptr, (LAS float*)(lds + RSCR_OFF + 4096), (const float*)(ws + WS_CTL)};
            pg8::gemm_phase<pg8::EpiDown<YS_FP8 != 0>, pg8::MoeOrder, true, false, false>(lds + RING_OFF, DFF, So, E);
        }
    }
    SEAM(P_DOWN);
    if (IN(P_COMBINE)) { if constexpr (YS_FP8) { for (int m = 2 * gw; m < T; m += 2 * NGW) combine_rows8x2(m, lane, out, MOD, (const unsigned char*)YS, ROWPAIR, (X1_DELTA && !X1_BF16) ? x : nullptr, X1_DELTA ? (const bf16*)(ws + (X1_BF16 ? WS_X1B : WS_DELTA)) : nullptr, FSK ? cbt : nullptr); } else { for (int m = gw; m < T; m += NGW) combine_row(m, lane, out, MOD, YS, ROWPAIR); } }
#undef IN
#undef SEAM
#undef LSEAM
}

static int g_grid = 0;
static void mk_setup() {
    if (g_grid != 0) return;
    int dev = 0, cus = 0, per_cu = 0;
    if (hipGetDevice(&dev) != hipSuccess || hipDeviceGetAttribute(&cus, hipDeviceAttributeMultiprocessorCount, dev) != hipSuccess) { fprintf(stderr, "kernel_launch: device query failed\n"); g_grid = -1; return; }
    if (hipFuncSetAttribute((const void*)mk_fwd, hipFuncAttributeMaxDynamicSharedMemorySize, LDS_BYTES) != hipSuccess) { fprintf(stderr, "kernel_launch: hipFuncSetAttribute failed\n"); g_grid = -1; return; }
    if (hipOccupancyMaxActiveBlocksPerMultiprocessor(&per_cu, (const void*)mk_fwd, NWAVES * 64, LDS_BYTES) != hipSuccess || per_cu < 1) { fprintf(stderr, "kernel_launch: occupancy query says %d workgroups per CU\n", per_cu); (void)hipGetLastError(); g_grid = -1; return; }
    g_grid = cus;
    (void)hipFuncSetAttribute((const void*)k_norm2_router, hipFuncAttributeMaxDynamicSharedMemorySize, 32 * 1024 * 4 + 256 + 4096);
}
static void mk_launch(const Args& base, int lo, int hi, int li, hipStream_t stream) {
    Args a = base; a.ph_lo = lo; a.ph_hi = hi; a.li = li; a.pad = 0;
    hipLaunchKernelGGL(mk_fwd, dim3(g_grid), dim3(NWAVES * 64), LDS_BYTES, stream, a);
}

extern "C" void kernel_launch(void* const* d_in, const int* in_sizes, int n_in, void* d_out, int out_size, void* d_ws, size_t ws_size, hipStream_t stream) {
    if (n_in != 30 || out_size != T * D || ws_size < WS_END) { fprintf(stderr, "kernel_launch: unexpected shapes (n_in %d out %d ws %zu)\n", n_in, out_size, ws_size); return; }
    mk_setup(); if (g_grid < 0) return;
    Args base{};
    for (int i = 0; i < 30; ++i) base.in[i] = (const float*)d_in[i];
    base.out = (float*)d_out; base.ws = (unsigned char*)d_ws;
    (void)hipMemsetAsync((char*)d_ws + WS_CTL, 0, CTL_ZERO_BYTES, stream);
#if MK_MODE == 1
    mk_launch(base, 0, P_COUNT, 0, stream);
#else
    const float* x = (const float*)d_in[0]; const float* c = (const float*)d_in[1]; const float* w_ada = (const float*)d_in[2]; const float* b_ada = (const float*)d_in[3];
    const float* norm_mix = (const float*)d_in[4]; const float* w_in = (const float*)d_in[5]; const float* b_in = (const float*)d_in[6];
    const float* q_norm = (const float*)d_in[7]; const float* k_norm = (const float*)d_in[8]; const float* sinks = (const float*)d_in[9];
    const float* lam_re = (const float*)d_in[10]; const float* lam_im = (const float*)d_in[11]; const float* log_dt = (const float*)d_in[12];
    const float* b_re = (const float*)d_in[13]; const float* b_im = (const float*)d_in[14]; const float* c_re = (const float*)d_in[15]; const float* c_im = (const float*)d_in[16];
    const float* d_skip = (const float*)d_in[17]; const float* w_glu = (const float*)d_in[18]; const float* b_glu = (const float*)d_in[19];
    const float* attn_out_norm = (const float*)d_in[20]; const float* ssm_out_norm = (const float*)d_in[21]; const float* w_out = (const float*)d_in[22];
    const float* norm_ffn = (const float*)d_in[23]; const float* w_router = (const float*)d_in[24]; const float* b_router = (const float*)d_in[25];
    const float* w_gate_up = (const float*)d_in[26]; const float* b_gate_up = (const float*)d_in[27]; const float* w_down = (const float*)d_in[28]; const float* b_down = (const float*)d_in[29];
    unsigned char* ws = (unsigned char*)d_ws; float* out = (float*)d_out;
    float* MOD = (float*)(ws + WS_MOD); float* SSMT = (float*)(ws + WS_SSMT);
    bf16* WTIN = (bf16*)(ws + WS_WTIN); bf16* WTGLU = (bf16*)(ws + WS_WTGLU); bf16* WTOUT = (bf16*)(ws + WS_WTOUT); bf16* WTGU = (bf16*)(ws + WS_WTGU); bf16* WTDN = (bf16*)(ws + WS_WTDN);
    bf16* H = (bf16*)(ws + WS_H); bf16* PROJ = (bf16*)(ws + WS_PROJ); bf16* ATT = (bf16*)(ws + WS_ATT); bf16* Gb = (bf16*)(ws + WS_G); bf16* SSMG = (bf16*)(ws + WS_SSMG); bf16* MIXED = (bf16*)(ws + WS_MIXED);
    int* TOPE = (int*)(ws + WS_TOPE); float* TOPW = (float*)(ws + WS_TOPW); int* HIST = (int*)(ws + WS_HIST); int* TOKROW = (int*)(ws + WS_TOKROW); int* ROWPAIR = (int*)(ws + WS_ROWPAIR);
    float* WROW = (float*)(ws + WS_WROW); int* TILEE = (int*)(ws + WS_TILEE); bf16* ACT = (bf16*)(ws + WS_ACT); bf16* YS = (bf16*)(ws + WS_YS);
    float* XST = (float*)(ws + WS_XST); float* SC = (float*)(ws + WS_SC);
#ifndef REF_PRO
#define REF_PRO 1
#endif
#ifndef REF_NORM1
#define REF_NORM1 1
#endif
#ifndef REF_INPROJ
#define REF_INPROJ 1
#endif
#ifndef REF_MIX
#define REF_MIX 1
#endif
#ifndef REF_GLU
#define REF_GLU 1
#endif
#ifndef REF_MIXNORM
#define REF_MIXNORM 1
#endif
#ifndef REF_OUTPROJ
#define REF_OUTPROJ 1
#endif
#ifndef REF_ROUTER
#define REF_ROUTER 1
#endif
#ifndef REF_SORT
#define REF_SORT 1
#endif
#ifndef REF_GATEUP
#define REF_GATEUP 1
#endif
#ifndef REF_DOWN
#define REF_DOWN 1
#endif
#ifndef REF_COMBINE
#define REF_COMBINE 1
#endif
    int li = 0;
    if (REF_PRO) {
        hipLaunchKernelGGL(k_transpose_cvt, dim3(DIN / 32, D / 32, 1), dim3(32, 8), 0, stream, w_in, WTIN, D, DIN, 0);
        hipLaunchKernelGGL(k_transpose_cvt, dim3(DSSM / 32, DSSM / 32, 1), dim3(32, 8), 0, stream, w_glu, WTGLU, DSSM, DSSM, 0);
        hipLaunchKernelGGL(k_transpose_cvt, dim3(D / 32, D / 32, 1), dim3(32, 8), 0, stream, w_out, WTOUT, D, D, 0);
        hipLaunchKernelGGL(k_transpose_cvt, dim3(2 * DFF / 32, D / 32, NE), dim3(32, 8), 0, stream, w_gate_up, WTGU, D, 2 * DFF, 1);
        hipLaunchKernelGGL(k_transpose_cvt, dim3(D / 32, DFF / 32, NE), dim3(32, 8), 0, stream, w_down, WTDN, DFF, D, 0);
        hipLaunchKernelGGL(k_mod, dim3(6 * D / 256), dim3(256), 0, stream, c, w_ada, b_ada, MOD);
        hipLaunchKernelGGL(k_ssm_tables, dim3(NG * NST / 256), dim3(256), 0, stream, lam_re, lam_im, log_dt, b_re, b_im, SSMT);
    } else mk_launch(base, P_PRO, P_PRO + 1, li++, stream);
    if (REF_NORM1) hipLaunchKernelGGL(k_norm_mod, dim3(T / 4), dim3(256), 0, stream, x, norm_mix, (const float*)MOD, 0, D, H);
    else mk_launch(base, P_NORM1, P_NORM1 + 1, li++, stream);
    if (REF_INPROJ) { NEpiProj e{}; e.A = H; e.Bt = WTIN; e.bias = b_in; e.O = PROJ; hipLaunchKernelGGL(k_gemm_naive<NEpiProj>, dim3(T, DIN / 256), dim3(256), 0, stream, e, DIN, D); }
    else mk_launch(base, P_INPROJ, P_INPROJ + 1, li++, stream);
    if (REF_MIX) {
        hipLaunchKernelGGL(k_attn_scores, dim3(T * NH / 256), dim3(256), 0, stream, (const bf16*)PROJ, q_norm, k_norm, SC);
        hipLaunchKernelGGL(k_attn_out, dim3(T * NH * HD / 256), dim3(256), 0, stream, (const bf16*)PROJ, (const float*)SC, sinks, ATT);
        hipLaunchKernelGGL(k_ssm_scan, dim3(NB * NG * NST / 64), dim3(64), 0, stream, (const bf16*)PROJ, (const float*)SSMT, XST);
        hipLaunchKernelGGL(k_ssm_out, dim3(T * DSSM / 256), dim3(256), 0, stream, (const bf16*)PROJ, (const float*)XST, c_re, c_im, d_skip, Gb);
    } else { mk_launch(base, P_MIX_A, P_MIX_A + 1, li++, stream); mk_launch(base, P_MIX_B, P_MIX_B + 1, li++, stream); }
    if (REF_GLU) { NEpiGlu e{}; e.A = Gb; e.Bt = WTGLU; e.bias = b_glu; e.O = SSMG; hipLaunchKernelGGL(k_gemm_naive<NEpiGlu>, dim3(T, DSSM / 256), dim3(256), 0, stream, e, DSSM, DSSM); }
    else mk_launch(base, P_GLU, P_GLU + 1, li++, stream);
    if (REF_MIXNORM) hipLaunchKernelGGL(k_mixnorm, dim3(T / 4), dim3(256), 0, stream, (const bf16*)ATT, (const bf16*)SSMG, attn_out_norm, ssm_out_norm, MIXED);
    else mk_launch(base, P_MIXNORM, P_MIXNORM + 1, li++, stream);
    if (REF_OUTPROJ) { NEpiOut e{}; e.A = MIXED; e.Bt = WTOUT; e.x = x; e.mod = MOD; e.O = out; hipLaunchKernelGGL(k_gemm_naive<NEpiOut>, dim3(T, D / 256), dim3(256), 0, stream, e, D, D); }
    else mk_launch(base, P_OUTPROJ, P_OUTPROJ + 1, li++, stream);
    if (REF_ROUTER) hipLaunchKernelGGL(k_norm2_router, dim3(256), dim3(512), 32 * 1024 * 4 + 256 + 4096, stream, (const float*)out, norm_ffn, (const float*)MOD, w_router, b_router, H, TOPE, TOPW, HIST);
    else mk_launch(base, P_ROUTER, P_ROUTER + 1, li++, stream);
    if (REF_SORT) hipLaunchKernelGGL(k_sort, dim3(256), dim3(512), 0, stream, (const int*)HIST, (const int*)TOPE, (const float*)TOPW, TOKROW, ROWPAIR, WROW, TILEE);
    else mk_launch(base, P_SORT, P_SORT + 1, li++, stream);
    if (REF_GATEUP) { NEpiGU e{}; e.H = H; e.Wt = WTGU; e.bias = b_gate_up; e.tokrow = TOKROW; e.tilee = TILEE; e.ACT = ACT; hipLaunchKernelGGL(k_moe_gu_naive, dim3(MPAD, DFF / 256), dim3(256), 0, stream, e); }
    else mk_launch(base, P_GATEUP, P_GATEUP + 1, li++, stream);
    if (REF_DOWN) { NEpiDown e{}; e.ACT = ACT; e.Wt = WTDN; e.bias = b_down; e.wrow = WROW; e.tilee = TILEE; e.YS = YS; hipLaunchKernelGGL(k_gemm_naive<NEpiDown>, dim3(MPAD, D / 256), dim3(256), 0, stream, e, D, DFF); }
    else mk_launch(base, P_DOWN, P_DOWN + 1, li++, stream);
    if (REF_COMBINE) hipLaunchKernelGGL(k_combine, dim3(T / 4), dim3(256), 0, stream, out, (const float*)MOD, (const bf16*)YS, (const int*)ROWPAIR);
    else mk_launch(base, P_COMBINE, P_COMBINE + 1, li++, stream);
#endif
}
```
